# Optimizing an MI355X kernel written in HIP

```python
import math
import jax, jax.numpy as jnp
from jax import lax
import numpy as np

D_MODEL = 1024
BATCH = 2
SEQ = 16384
DEPTH = 2

N_MIXERS = 2
N_HEADS = 16
HEAD_DIM = D_MODEL // N_HEADS
MOBA_BLOCK = 256
MOBA_TOPK = 3
Q_CHUNK = 64
CONV_WIDTH = 31
D_FF = 2816
N_SUB = 3
N_ATTN = (DEPTH + 1) // 2
N_CONV = DEPTH // 2
EPS = 1e-6

kernel_name = "moba_conformer_conv_hybrid_adaln"


def rms_norm(x, g):
    xf = x.astype(jnp.float32)
    y = xf * lax.rsqrt(jnp.mean(xf * xf, axis=-1, keepdims=True) + EPS)
    return (y * g.astype(jnp.float32)).astype(x.dtype)


def layer_norm(x, g, b):
    xf = x.astype(jnp.float32)
    mu = jnp.mean(xf, axis=-1, keepdims=True)
    var = jnp.mean(jnp.square(xf - mu), axis=-1, keepdims=True)
    y = (xf - mu) * lax.rsqrt(var + EPS)
    return (y * g.astype(jnp.float32) + b.astype(jnp.float32)).astype(x.dtype)


def swiglu_ffn(h, w_in, w_out):
    u = h @ w_in
    a, b = jnp.split(u, 2, axis=-1)
    return (jax.nn.silu(a) * b) @ w_out


def alibi_slopes(n_heads):
    return jnp.asarray([2.0 ** (-8.0 * (h + 1) / n_heads) for h in range(n_heads)], dtype=jnp.float32)


def moba_attention(h, w_qkv, g_q, g_k, w_o):
    B, S, _ = h.shape
    H, Dh, BLK, C = N_HEADS, HEAD_DIM, MOBA_BLOCK, Q_CHUNK
    qkv = (h @ w_qkv).reshape(B, S, 3, H, Dh)
    q = rms_norm(qkv[:, :, 0], g_q).transpose(0, 2, 1, 3)
    k = rms_norm(qkv[:, :, 1], g_k).transpose(0, 2, 1, 3)
    v = qkv[:, :, 2].transpose(0, 2, 1, 3)
    s_pad = ((S + BLK - 1) // BLK) * BLK
    pad = [(0, 0), (0, 0), (0, s_pad - S), (0, 0)]
    q, k, v = jnp.pad(q, pad), jnp.pad(k, pad), jnp.pad(v, pad)
    nb = s_pad // BLK
    k_sel = min(MOBA_TOPK, nb)
    kb = k.reshape(B, H, nb, BLK, Dh)
    vb = v.reshape(B, H, nb, BLK, Dh)
    kbar = jnp.mean(kb.astype(jnp.float32), axis=3)
    slopes = alibi_slopes(H)
    scale = 1.0 / math.sqrt(Dh)
    b_idx = jnp.arange(B)[:, None, None, None]
    h_idx = jnp.arange(H)[None, :, None, None]
    neg = jnp.float32(-jnp.inf)

    def chunk_fn(ci):
        t0 = ci * C
        own = t0 // BLK
        qc = lax.dynamic_slice_in_dim(q, t0, C, axis=2)
        t = t0 + jnp.arange(C)
        gate = jnp.einsum('bhcd,bhnd->bhcn', qc.astype(jnp.float32), kbar)
        past = jnp.arange(nb) < own
        gate = jnp.where(past[None, None, None, :], gate, neg)
        _, idx = lax.top_k(gate, k_sel)
        valid = idx < own
        ks = kb[b_idx, h_idx, idx]
        vs = vb[b_idx, h_idx, idx]
        pos_sel = idx[..., None] * BLK + jnp.arange(BLK)
        dist_sel = (t[None, None, :, None, None] - pos_sel).astype(jnp.float32)
        s_sel = jnp.einsum('bhcd,bhckld->bhckl', qc, ks).astype(jnp.float32) * scale
        s_sel = s_sel - slopes[None, :, None, None, None] * jnp.abs(dist_sel)
        s_sel = jnp.where(valid[..., None], s_sel, neg)
        ko = lax.dynamic_index_in_dim(kb, own, axis=2, keepdims=False)
        vo = lax.dynamic_index_in_dim(vb, own, axis=2, keepdims=False)
        pos_own = own * BLK + jnp.arange(BLK)
        dist_own = (t[:, None] - pos_own[None, :]).astype(jnp.float32)
        s_own = jnp.einsum('bhcd,bhld->bhcl', qc, ko).astype(jnp.float32) * scale
        s_own = s_own - slopes[None, :, None, None] * jnp.abs(dist_own)[None, None]
        s_own = jnp.where((dist_own >= 0)[None, None], s_own, neg)
        s_all = jnp.concatenate([s_sel.reshape(B, H, C, k_sel * BLK), s_own], axis=-1)
        p = jax.nn.softmax(s_all, axis=-1).astype(v.dtype)
        p_sel = p[..., :k_sel * BLK].reshape(B, H, C, k_sel, BLK)
        p_own = p[..., k_sel * BLK:]
        return (jnp.einsum('bhckl,bhckld->bhcd', p_sel, vs)
                + jnp.einsum('bhcl,bhld->bhcd', p_own, vo))

    outs = lax.map(chunk_fn, jnp.arange(s_pad // C))
    o = outs.transpose(1, 0, 3, 2, 4).reshape(B, s_pad, H * Dh)[:, :S]
    return o @ w_o


def conformer_conv(h, w_pw1, b_pw1, w_dw, b_dw, ln_g, ln_b, w_pw2, b_pw2):
    D = h.shape[-1]
    u = h @ w_pw1 + b_pw1
    a, g = jnp.split(u, 2, axis=-1)
    u = a * jax.nn.sigmoid(g)
    u = lax.conv_general_dilated(
        u, w_dw[:, None, :].astype(u.dtype), window_strides=(1,),
        padding=[(CONV_WIDTH - 1, 0)],
        dimension_numbers=('NWC', 'WIO', 'NWC'),
        feature_group_count=D) + b_dw
    u = jax.nn.silu(layer_norm(u, ln_g, ln_b))
    return u @ w_pw2 + b_pw2


def setup_inputs(seed: int = 0) -> dict:
    key = jax.random.key(seed)
    ks = jax.random.split(key, 24)
    D = D_MODEL
    nrm = lambda k, shape, fan_in: jax.random.normal(k, shape, jnp.float32) * (fan_in ** -0.5)
    small = lambda k, shape, s: jax.random.normal(k, shape, jnp.float32) * s
    return {
        "x": jax.random.normal(ks[0], (BATCH, SEQ, D), jnp.float32),
        "c": jax.random.normal(ks[1], (BATCH, D), jnp.float32),
        "norm_g": 1.0 + small(ks[2], (DEPTH, N_SUB, D), 0.02),
        "ada_w": nrm(ks[3], (DEPTH, D, N_SUB * 3 * D), D),
        "ada_b": small(ks[4], (DEPTH, N_SUB * 3 * D), 0.02),
        "ffn_w_in": nrm(ks[5], (DEPTH, 2, D, 2 * D_FF), D),
        "ffn_w_out": nrm(ks[6], (DEPTH, 2, D_FF, D), D_FF),
        "attn_w_qkv": nrm(ks[7], (N_ATTN, D, 3 * N_HEADS * HEAD_DIM), D),
        "attn_g_q": 1.0 + small(ks[8], (N_ATTN, HEAD_DIM), 0.02),
        "attn_g_k": 1.0 + small(ks[9], (N_ATTN, HEAD_DIM), 0.02),
        "attn_w_o": nrm(ks[10], (N_ATTN, N_HEADS * HEAD_DIM, D), N_HEADS * HEAD_DIM),
        "conv_w_pw1": nrm(ks[11], (N_CONV, D, 2 * D), D),
        "conv_b_pw1": small(ks[12], (N_CONV, 2 * D), 0.02),
        "conv_w_dw": nrm(ks[13], (N_CONV, CONV_WIDTH, D), CONV_WIDTH),
        "conv_b_dw": small(ks[14], (N_CONV, D), 0.02),
        "conv_ln_g": 1.0 + small(ks[15], (N_CONV, D), 0.02),
        "conv_ln_b": small(ks[16], (N_CONV, D), 0.02),
        "conv_w_pw2": nrm(ks[17], (N_CONV, D, D), D),
        "conv_b_pw2": small(ks[18], (N_CONV, D), 0.02),
    }


def reference(x, c, norm_g, ada_w, ada_b, ffn_w_in, ffn_w_out,
              attn_w_qkv, attn_g_q, attn_g_k, attn_w_o,
              conv_w_pw1, conv_b_pw1, conv_w_dw, conv_b_dw, conv_ln_g, conv_ln_b,
              conv_w_pw2, conv_b_pw2):
    B = x.shape[0]
    c_act = jax.nn.silu(c)
    for i in range(DEPTH):
        mod = (c_act @ ada_w[i] + ada_b[i]).reshape(B, N_SUB, 3, D_MODEL)
        shift, scl, gate = mod[:, :, 0, None, :], mod[:, :, 1, None, :], mod[:, :, 2, None, :]

        def pre(z, j):
            return rms_norm(z, norm_g[i, j]) * (1.0 + scl[:, j]) + shift[:, j]

        x = x + 0.5 * gate[:, 0] * swiglu_ffn(pre(x, 0), ffn_w_in[i, 0], ffn_w_out[i, 0])
        h = pre(x, 1)
        m = i // N_MIXERS
        if i % N_MIXERS == 0:
            y = moba_attention(h, attn_w_qkv[m], attn_g_q[m], attn_g_k[m], attn_w_o[m])
        else:
            y = conformer_conv(h, conv_w_pw1[m], conv_b_pw1[m], conv_w_dw[m], conv_b_dw[m],
                               conv_ln_g[m], conv_ln_b[m], conv_w_pw2[m], conv_b_pw2[m])
        x = x + gate[:, 1] * y
        x = x + 0.5 * gate[:, 2] * swiglu_ffn(pre(x, 2), ffn_w_in[i, 1], ffn_w_out[i, 1])
    return x
```

```cpp
#include <hip/hip_runtime.h>
#include <cstdio>
#include <cstdint>
#include <cmath>
namespace pg8 {
#define PG8_LAS __attribute__((address_space(3)))
typedef unsigned short bf16_t;
typedef short bf16x8 __attribute__((ext_vector_type(8)));
typedef float f32x4 __attribute__((ext_vector_type(4)));
typedef unsigned u32x4 __attribute__((ext_vector_type(4)));
constexpr int BM = 256, BK = 64, HALF = 128, HTB = HALF * BK * 2  , STAGE_BYTES = 8 * HTB, NXCD = 8, WGM = 8;

__host__ __device__ __forceinline__ int lds_byte(int r, int c) { const int st = (r >> 4) * 2 + (c >> 5), rr = r & 15, cc = c & 31, ob = rr * 64 + cc * 2; return st * 1024 + (ob ^ (((ob >> 9) & 1) << 5)); }
__host__ __device__ __forceinline__ void stage_rc(int b, int& R, int& C) { const int st = b / 1024, sb = b % 1024, swz = sb ^ (((sb >> 9) & 1) << 5); R = (st >> 1) * 16 + swz / 64; C = (st & 1) * 32 + (swz % 64) / 2; }
__host__ __device__ __forceinline__ int perm32(int rho) { const int n = rho >> 4, i = rho & 15; return 8 * (i >> 2) + 4 * n + (i & 3); }

struct Unit { int pm, pn; };
struct Gemm { const bf16_t* A; const bf16_t* Bt; int M, N, K; long bb; };

struct StaticOrder {
    int nM, nN, nwg, G, c;
    __host__ __device__ void init(int M, int N, int G_, int c_) { nM = M / BM; nN = N / BM; nwg = nM * nN; G = G_; c = c_; }
    __host__ __device__ bool next(int i, Unit& u) const {
        const long L = (long)i * G + c; if (L >= nwg) return false;
        int wgid = (int)L; { const int q = nwg / NXCD, r = nwg % NXCD, xcd = wgid % NXCD, off = wgid / NXCD; wgid = (xcd < r ? xcd * (q + 1) : r * (q + 1) + (xcd - r) * q) + off; }
        const int nig = WGM * nN, gid = wgid / nig, fm = gid * WGM, gsz = (nM - fm) < WGM ? (nM - fm) : WGM;
        u.pm = fm + ((wgid % nig) % gsz); u.pn = (wgid % nig) / gsz; return true;
    }
    __device__ __forceinline__ void a_ready(const Unit&) const {}
    __device__ __forceinline__ void done(const Unit&) const {}
};

__device__ __forceinline__ unsigned cvt_pk_bf16(float lo, float hi) { unsigned r; asm volatile("v_cvt_pk_bf16_f32 %0, %1, %2" : "=v"(r) : "v"(lo), "v"(hi)); return r; }
typedef float f32x2 __attribute__((ext_vector_type(2)));
template <class Epi, class Sched, bool ALIGN_EPI = false, bool SP2 = false>
__device__ __forceinline__ void gemm_phase(PG8_LAS unsigned char* lds, const Gemm g, const Sched& S, const Epi& E, const int tid_in) {
    const int tid = tid_in, wid = __builtin_amdgcn_readfirstlane(tid >> 6), lane = tid & 63, wr = wid >> 2, wc = wid & 3, fr = lane & 15, fq = lane >> 4;
    const int K = g.K, nt = K / BK;
    unsigned voffA[2], voffB[2];
#pragma unroll
    for (int i = 0; i < 2; ++i) { int R, C; stage_rc(tid * 16 + i * 8192, R, C); const int Rb = Epi::PERM ? ((R & ~31) + perm32(R & 31)) : R;
        voffA[i] = (unsigned)(R * K + C) * 2u; voffB[i] = (unsigned)(Rb * K + C) * 2u; }
    const __amdgpu_buffer_rsrc_t rs_voffA = __builtin_amdgcn_make_buffer_rsrc((void*)g.A, 0, -1, 0x00020000), rs_voffB = __builtin_amdgcn_make_buffer_rsrc((void*)g.Bt, 0, -1, 0x00020000);
    const unsigned kstep = (unsigned)(BK * 2);
    const unsigned hstep = (unsigned)(HALF * K * 2);
    const unsigned tstep = 2u * hstep;
    const unsigned ldsw = (unsigned)wid * 1024u;
    const int aoff = lds_byte(wr * 64 + fr, fq * 8), boff = lds_byte(wc * 32 + fr, fq * 8);
#define PG8_SA(b, h) (((b) * 2 + (h)) * HTB)
#define PG8_SB(b, h) ((4 + (b) * 2 + (h)) * HTB)
#define PG8_STAGE(bufoff, soff, voff) do { _Pragma("unroll") for (int _i = 0; _i < 2; ++_i) \
        __builtin_amdgcn_raw_ptr_buffer_load_lds(rs_##voff, (PG8_LAS void*)(lds + (bufoff) + ldsw + _i * 8192), 16, (int)(voff)[_i], (int)(soff), 0, 0); } while (0)
#define PG8_LDA(dst, b, h) do { _Pragma("unroll") for (int m = 0; m < 4; ++m) _Pragma("unroll") for (int k = 0; k < 2; ++k) dst[m][k] = *(const PG8_LAS bf16x8*)(lds + PG8_SA(b, h) + aoff + m * 2048 + k * 1024); } while (0)
#define PG8_LDB(dst, b, h) do { _Pragma("unroll") for (int n = 0; n < 2; ++n) _Pragma("unroll") for (int k = 0; k < 2; ++k) dst[n][k] = *(const PG8_LAS bf16x8*)(lds + PG8_SB(b, h) + boff + n * 2048 + k * 1024); } while (0)
#define PG8_MMA(ai, bj, At, Bt) do { __builtin_amdgcn_s_setprio(3); _Pragma("unroll") for (int m = 0; m < 4; ++m) _Pragma("unroll") for (int n = 0; n < 2; ++n) _Pragma("unroll") for (int k = 0; k < 2; ++k) \
        acc[ai][bj][m][n] = __builtin_amdgcn_mfma_f32_16x16x32_bf16(Bt[n][k], At[m][k], acc[ai][bj][m][n], 0, 0, 0); __builtin_amdgcn_s_setprio(0); } while (0)
#define PG8_WAIT_V(n) asm volatile("s_waitcnt vmcnt(" #n ")" ::: "memory")
#define PG8_WAIT_L(n) asm volatile("s_waitcnt lgkmcnt(" #n ")" ::: "memory")
#define PG8_BAR __builtin_amdgcn_s_barrier()
#define PG8_SCHED __builtin_amdgcn_sched_barrier(0)
    Unit cur, nxt; int ui = 0;
    if (!S.next(0, cur)) return;
    f32x4 acc[2][2][4][2];
#pragma unroll
    for (int a = 0; a < 2; ++a)
#pragma unroll
        for (int b = 0; b < 2; ++b)
#pragma unroll
            for (int m = 0; m < 4; ++m)
#pragma unroll
                for (int n = 0; n < 2; ++n) acc[a][b][m][n] = (f32x4){0.f, 0.f, 0.f, 0.f};
    bf16x8 At[4][2], B0[2][2], B1[2][2];
    unsigned cA = (unsigned)cur.pm * tstep, cB = (unsigned)cur.pn * tstep + (unsigned)(cur.pm >> 6) * (unsigned)g.bb;
    S.a_ready(cur);
    if constexpr (SP2) {
        PG8_STAGE(PG8_SB(0, 0), cB, voffB); PG8_STAGE(PG8_SB(0, 1), cB + hstep, voffB); PG8_STAGE(PG8_SA(0, 0), cA, voffA); PG8_STAGE(PG8_SA(0, 1), cA + hstep, voffA);
        if (wr == 1) PG8_BAR;
        PG8_WAIT_V(2); PG8_BAR;
        PG8_STAGE(PG8_SB(1, 0), cB + kstep, voffB); PG8_STAGE(PG8_SA(1, 0), cA + kstep, voffA); PG8_STAGE(PG8_SB(1, 1), cB + hstep + kstep, voffB);
        PG8_WAIT_V(6); PG8_BAR;
    } else {
        PG8_STAGE(PG8_SB(0, 0), cB, voffB); PG8_STAGE(PG8_SA(0, 0), cA, voffA); PG8_STAGE(PG8_SB(0, 1), cB + hstep, voffB); PG8_STAGE(PG8_SA(0, 1), cA + hstep, voffA);
        if (wr == 1) PG8_BAR;
        PG8_WAIT_V(4); PG8_BAR;
        PG8_STAGE(PG8_SB(1, 0), cB + kstep, voffB); PG8_STAGE(PG8_SA(1, 0), cA + kstep, voffA); PG8_STAGE(PG8_SB(1, 1), cB + hstep + kstep, voffB);
        PG8_WAIT_V(6); PG8_BAR;
    }
    for (;;) {
        const bool has_next = S.next(ui + 1, nxt);
        const unsigned nA = has_next ? (unsigned)nxt.pm * tstep : cA, nB = has_next ? (unsigned)nxt.pn * tstep + (unsigned)(nxt.pm >> 6) * (unsigned)g.bb : cB;
        for (int t = 0; t < nt; t += 2) {
            const bool last = (t == nt - 2);
            const unsigned a1 = cA + (unsigned)(t + 1) * kstep;
            const unsigned a2 = last ? nA : cA + (unsigned)(t + 2) * kstep, b2 = last ? nB : cB + (unsigned)(t + 2) * kstep;
            const unsigned a3 = a2 + kstep, b3 = b2 + kstep;
            if (last && has_next) S.a_ready(nxt);
            if constexpr (SP2) {
            PG8_STAGE(PG8_SA(1, 1), a1 + hstep, voffA); PG8_SCHED; PG8_LDB(B0, 0, 0); PG8_LDB(B1, 0, 1); PG8_SCHED; PG8_LDA(At, 0, 0);
            PG8_WAIT_V(8); PG8_WAIT_L(0); PG8_BAR; PG8_MMA(0, 0, At, B0); PG8_MMA(0, 1, At, B1); PG8_BAR; PG8_SCHED;
            PG8_STAGE(PG8_SB(0, 0), b2, voffB); PG8_STAGE(PG8_SB(0, 1), b2 + hstep, voffB); PG8_STAGE(PG8_SA(0, 0), a2, voffA); PG8_SCHED; PG8_LDA(At, 0, 1);
            PG8_WAIT_V(8); PG8_WAIT_L(0); PG8_BAR; PG8_MMA(1, 0, At, B0); PG8_MMA(1, 1, At, B1); PG8_BAR; PG8_SCHED;
            PG8_STAGE(PG8_SA(0, 1), a2 + hstep, voffA); PG8_SCHED; PG8_LDB(B0, 1, 0); PG8_LDB(B1, 1, 1); PG8_SCHED; PG8_LDA(At, 1, 0);
            PG8_WAIT_V(8); PG8_WAIT_L(0); PG8_BAR; PG8_MMA(0, 0, At, B0); PG8_MMA(0, 1, At, B1); PG8_BAR; PG8_SCHED;
            PG8_STAGE(PG8_SB(1, 0), b3, voffB); PG8_STAGE(PG8_SB(1, 1), b3 + hstep, voffB); PG8_STAGE(PG8_SA(1, 0), a3, voffA); PG8_SCHED; PG8_LDA(At, 1, 1);
            PG8_WAIT_V(8); PG8_WAIT_L(0); PG8_BAR; PG8_MMA(1, 0, At, B0); PG8_MMA(1, 1, At, B1); PG8_BAR; PG8_SCHED;
            } else {
            PG8_LDB(B0, 0, 0); PG8_SCHED; PG8_LDA(At, 0, 0); PG8_STAGE(PG8_SA(1, 1), a1 + hstep, voffA);
            PG8_WAIT_L(8); PG8_BAR; PG8_WAIT_L(0); PG8_MMA(0, 0, At, B0); PG8_BAR; PG8_SCHED;
            PG8_LDB(B1, 0, 1); PG8_STAGE(PG8_SB(0, 0), b2, voffB);
            PG8_BAR; PG8_WAIT_L(0); PG8_MMA(0, 1, At, B1); PG8_BAR;
            PG8_LDA(At, 0, 1); PG8_STAGE(PG8_SA(0, 0), a2, voffA);
            PG8_BAR; PG8_WAIT_L(0); PG8_MMA(1, 0, At, B0); PG8_BAR; PG8_SCHED;
            PG8_STAGE(PG8_SB(0, 1), b2 + hstep, voffB);
            PG8_WAIT_V(6); PG8_BAR; PG8_MMA(1, 1, At, B1); PG8_BAR;
            PG8_LDB(B0, 1, 0); PG8_SCHED; PG8_LDA(At, 1, 0); PG8_STAGE(PG8_SA(0, 1), a2 + hstep, voffA);
            PG8_WAIT_L(8); PG8_BAR; PG8_WAIT_L(0); PG8_MMA(0, 0, At, B0); PG8_BAR; PG8_SCHED;
            PG8_LDB(B1, 1, 1); PG8_STAGE(PG8_SB(1, 0), b3, voffB);
            PG8_BAR; PG8_WAIT_L(0); PG8_MMA(0, 1, At, B1); PG8_BAR;
            PG8_LDA(At, 1, 1); PG8_STAGE(PG8_SA(1, 0), a3, voffA);
            PG8_BAR; PG8_WAIT_L(0); PG8_MMA(1, 0, At, B0); PG8_BAR; PG8_SCHED;
            PG8_STAGE(PG8_SB(1, 1), b3 + hstep, voffB);
            PG8_WAIT_V(6); PG8_BAR; PG8_MMA(1, 1, At, B1); PG8_BAR;
            }
        }
        if constexpr (ALIGN_EPI) { if (wr == 0) PG8_BAR; }
        if constexpr (!Epi::AFTER_DRAIN) { E(acc, cur, wr, wc, fr, fq); S.done(cur); }
        if (!has_next) break;
#pragma unroll
        for (int a = 0; a < 2; ++a)
#pragma unroll
            for (int b = 0; b < 2; ++b)
#pragma unroll
                for (int m = 0; m < 4; ++m)
#pragma unroll
                    for (int n = 0; n < 2; ++n) acc[a][b][m][n] = (f32x4){0.f, 0.f, 0.f, 0.f};
        cur = nxt; cA = nA; cB = nB; ++ui;
        if constexpr (ALIGN_EPI) { if (wr == 1) PG8_BAR; }
    }
    PG8_WAIT_V(0);
    if constexpr (!ALIGN_EPI) { if (wr == 0) PG8_BAR; }
    PG8_BAR;
    if constexpr (Epi::AFTER_DRAIN) { E.fused(acc, cur, wr, wc, fr, fq, lds, wid, lane); S.done(cur); }
#undef PG8_SA
#undef PG8_SB
#undef PG8_STAGE
#undef PG8_LDA
#undef PG8_LDB
#undef PG8_MMA
#undef PG8_WAIT_V
#undef PG8_WAIT_L
#undef PG8_BAR
#undef PG8_SCHED
}
}
constexpr int NB_ = 2, S_ = 16384, D_ = 1024, M_ = NB_ * S_, H_ = 16, HD_ = 64, FF_ = 2816, NBLK_ = 64;
constexpr float LOG2E_ = 1.4426950408889634f;
constexpr float C2_ = 0.125f * LOG2E_;
constexpr float EPS_ = 1e-6f;

constexpr size_t MiB = 1u << 20;
constexpr size_t WS_CTL = 0, CTL_ZERO_BYTES = 64 * 1024;
constexpr size_t WS_MOD  = 1 * MiB;
constexpr size_t WS_GM   = WS_MOD + 256 * 1024;
constexpr size_t WS_COEF = WS_GM + 64 * 1024;
constexpr size_t WS_BFFN = WS_COEF + 64 * 1024;
constexpr size_t WS_BQKV = WS_BFFN + 192 * 1024;
constexpr size_t WS_BPW1 = WS_BQKV + 32 * 1024;
constexpr size_t WS_SSQ  = 4 * MiB;
constexpr size_t WS_KBAR = 6 * MiB;
constexpr size_t WS_SEL  = 7 * MiB;
constexpr size_t WS_LP   = 9 * MiB;
constexpr size_t WS_WIN  = 16 * MiB;
constexpr size_t WS_WQKV = 104 * MiB;
constexpr size_t WS_WPW1 = 116 * MiB;
constexpr size_t WS_WOUT = 124 * MiB;
constexpr size_t WS_WO   = 146 * MiB;
constexpr size_t WS_WPW2 = 148 * MiB;
constexpr size_t WS_XB   = 152 * MiB;
constexpr size_t WS_BIG  = 216 * MiB;
constexpr size_t WS_ACT  = WS_BIG;
constexpr size_t WS_Q = WS_BIG, WS_K = WS_BIG + 64 * MiB, WS_V = WS_BIG + 128 * MiB;
constexpr size_t WS_OP3 = 408 * MiB;
constexpr size_t WS_U = WS_BIG, WS_CV = WS_BIG + 64 * MiB;
constexpr size_t WS_END = 472 * MiB;
constexpr int CW_BAR = 1024;

constexpr int RING_BYTES = 131072;
constexpr int LDSCTL_OFF = RING_BYTES, MISC_OFF = LDSCTL_OFF + 320;
constexpr int LDS_BYTES = 160768;
constexpr int LT_PM = LDSCTL_OFF + 896, LT_RSTD = LDSCTL_OFF + 1024, LT_VEC = LDSCTL_OFF + 3072;

#define GAS __attribute__((address_space(1)))
#define LAS __attribute__((address_space(3)))
typedef unsigned short bf16;
typedef float f32x4 __attribute__((ext_vector_type(4)));
typedef unsigned u32x4 __attribute__((ext_vector_type(4)));
typedef unsigned u32x2 __attribute__((ext_vector_type(2)));
typedef short bf16x8 __attribute__((ext_vector_type(8)));
typedef float f32x16 __attribute__((ext_vector_type(16)));
#define LDS_WAIT() asm volatile("s_waitcnt lgkmcnt(0)" ::: "memory")
#define VM_WAIT() asm volatile("s_waitcnt vmcnt(0)" ::: "memory")
#define LDS_BARRIER() do { asm volatile("s_waitcnt lgkmcnt(0)" ::: "memory"); __builtin_amdgcn_s_barrier(); asm volatile("" ::: "memory"); } while (0)
__device__ __forceinline__ unsigned f2bf(float f) { unsigned u = __builtin_bit_cast(unsigned, f); return (u + 0x7fffu + ((u >> 16) & 1u)) >> 16; }
__device__ __forceinline__ unsigned pk2(float lo, float hi) { return f2bf(lo) | (f2bf(hi) << 16); }
typedef __bf16 bf16x2_t __attribute__((ext_vector_type(2))); typedef float f32x2_t __attribute__((ext_vector_type(2)));
__device__ __forceinline__ unsigned cvtpk(float lo, float hi) { const f32x2_t v = {lo, hi}; const bf16x2_t b = __builtin_convertvector(v, bf16x2_t); return __builtin_bit_cast(unsigned, b); }
__device__ __forceinline__ float bf2f(unsigned h) { return __builtin_bit_cast(float, h << 16); }
__device__ __forceinline__ float bflo(unsigned w) { return __builtin_bit_cast(float, w << 16); }
__device__ __forceinline__ float bfhi(unsigned w) { return __builtin_bit_cast(float, w & 0xffff0000u); }
template <int CTRL> __device__ __forceinline__ float dppf(float v) { return __builtin_bit_cast(float, __builtin_amdgcn_mov_dpp(__builtin_bit_cast(int, v), CTRL, 0xF, 0xF, true)); }
typedef unsigned u32x2v __attribute__((ext_vector_type(2)));
__device__ __forceinline__ float u2f(unsigned u) { return __builtin_bit_cast(float, u); }
__device__ __forceinline__ unsigned f2u(float f) { return __builtin_bit_cast(unsigned, f); }
__device__ __forceinline__ float sum16(float v) { const auto r = __builtin_amdgcn_permlane16_swap(f2u(v), f2u(v), false, false); const unsigned r0 = r[0], r1 = r[1]; return u2f(r0) + u2f(r1); }
__device__ __forceinline__ float sum32(float v) { const auto r = __builtin_amdgcn_permlane32_swap(f2u(v), f2u(v), false, false); const unsigned r0 = r[0], r1 = r[1]; return u2f(r0) + u2f(r1); }
__device__ __forceinline__ float max16(float v) { const auto r = __builtin_amdgcn_permlane16_swap(f2u(v), f2u(v), false, false); const unsigned r0 = r[0], r1 = r[1]; return fmaxf(u2f(r0), u2f(r1)); }
__device__ __forceinline__ float max32(float v) { const auto r = __builtin_amdgcn_permlane32_swap(f2u(v), f2u(v), false, false); const unsigned r0 = r[0], r1 = r[1]; return fmaxf(u2f(r0), u2f(r1)); }
__device__ __forceinline__ float row_sum16(float v) { v += dppf<0xB1>(v); v += dppf<0x4E>(v); v += dppf<0x141>(v); v += dppf<0x140>(v); return v; }
__device__ __forceinline__ float wave_sum(float v) { v = row_sum16(v); v = sum16(v); return sum32(v); }
__device__ __forceinline__ float wave_max(float v) { v = fmaxf(v, dppf<0xB1>(v)); v = fmaxf(v, dppf<0x4E>(v)); v = fmaxf(v, dppf<0x141>(v)); v = fmaxf(v, dppf<0x140>(v)); v = max16(v); return max32(v); }
__device__ __forceinline__ unsigned other32(unsigned v, int hi) { const auto r = __builtin_amdgcn_permlane32_swap(v, v, false, false); const unsigned r0 = r[0], r1 = r[1]; return hi ? r0 : r1; }
#define XB_TMO      128
#define XB_XCNT(j)  (256  + 64 * (j))
#define XB_XSUB(j)  (1280 + 64 * (j))
#define XB_XGEN(j)  (2304 + 64 * (j))
#define XB_TOP      3328
#define XB_TOPGEN   3392
#define XCD_BAR_WORDS 3456
#define XB_SPIN_CAP (1u << 18)

__device__ __forceinline__ unsigned xb_ld(unsigned* p)              { return __hip_atomic_load(p, __ATOMIC_RELAXED, __HIP_MEMORY_SCOPE_AGENT); }
__device__ __forceinline__ unsigned xb_add(unsigned* p, unsigned v) { return __hip_atomic_fetch_add(p, v, __ATOMIC_RELAXED, __HIP_MEMORY_SCOPE_AGENT); }
__device__ __forceinline__ unsigned xb_xcc_id() { return (unsigned)__builtin_amdgcn_s_getreg((3 << 11) | 20) & 0xFu; }
#define XB_SPIN(cond, bar) do { unsigned _sp = 0; while (cond) { __builtin_amdgcn_s_sleep(1); \
    if ((++_sp & 255u) == 0u) { if (xb_ld(&(bar)[XB_TMO])) break; if (_sp > XB_SPIN_CAP) { atomicAdd(&(bar)[XB_TMO], 1u); break; } } } } while (0)

struct XcdBarrier {
    unsigned* bar; unsigned x;
    volatile LAS unsigned* st;
};

__device__ __forceinline__ XcdBarrier xcd_barrier_post(unsigned* bar, volatile LAS unsigned* st) {
    XcdBarrier b; b.bar = bar; b.x = xb_xcc_id(); b.st = st;
    if (threadIdx.x == 0) (void)xb_add(&bar[XB_XCNT(b.x)], 1u);
    return b;
}
__device__ __forceinline__ void xcd_barrier_complete(unsigned* bar, unsigned x, unsigned& nloc, unsigned& nx) {
    const unsigned G = gridDim.x * gridDim.y * gridDim.z;
    unsigned sum, cnt, mine, sp = 0u;
    for (;;) {
        sum = 0u; cnt = 0u; mine = 0u;
#pragma unroll
        for (unsigned j = 0; j < 16; ++j) { const unsigned c = xb_ld(&bar[XB_XCNT(j)]); sum += c; cnt += (c > 0u) ? 1u : 0u; mine = (j == x) ? c : mine; }
        if (sum == G) break;
        __builtin_amdgcn_s_sleep(1);
        if ((++sp & 255u) == 0u) { if (xb_ld(&bar[XB_TMO])) break; if (sp > XB_SPIN_CAP) { atomicAdd(&bar[XB_TMO], 1u); break; } }
    }
    nloc = mine > 0u ? mine : 1u; nx = cnt > 0u ? cnt : 1u;
}

__device__ __forceinline__ void xcd_barrier(const XcdBarrier& b) {
    asm volatile("s_waitcnt vmcnt(0)" ::: "memory");
    __syncthreads();
    if (threadIdx.x == 0) {
        unsigned* bar = b.bar;
        __builtin_amdgcn_s_waitcnt(0);
        unsigned nloc = b.st[0], nx = b.st[1];
        if (nloc == 0u) { xcd_barrier_complete(bar, b.x, nloc, nx); b.st[0] = nloc; b.st[1] = nx; }
        const unsigned old = xb_add(&bar[XB_XSUB(b.x)], 1u);
        const unsigned gen = old / nloc;
        if (old + 1u == (gen + 1u) * nloc) {
            __builtin_amdgcn_fence(__ATOMIC_RELEASE, "agent");
            asm volatile("s_waitcnt vmcnt(0)" ::: "memory");
            const unsigned og = xb_add(&bar[XB_TOP], 1u);
            const unsigned tg = og / nx;
            if (og + 1u == (tg + 1u) * nx) xb_add(&bar[XB_TOPGEN], 1u);
            else XB_SPIN(xb_ld(&bar[XB_TOPGEN]) == tg, bar);
            __builtin_amdgcn_fence(__ATOMIC_ACQUIRE, "agent");
            xb_add(&bar[XB_XGEN(b.x)], 1u);
            asm volatile("s_waitcnt vmcnt(0)" ::: "memory");
        } else {
            XB_SPIN(xb_ld(&bar[XB_XGEN(b.x)]) == gen, bar);
            __builtin_amdgcn_fence(__ATOMIC_ACQUIRE, "agent");
            asm volatile("s_waitcnt vmcnt(0)" ::: "memory");
        }
    }
    __syncthreads();
}
__device__ __forceinline__ int epi_tables_pm(LAS unsigned char* lds, const pg8::StaticOrder& S, int tid, int& pmA_out, int& pmB_out) {
    int pmA = -1, pmB = -1, ok = 1; pg8::Unit u;
    for (int i = 0; S.next(i, u); ++i) { if (pmA < 0) pmA = u.pm; else if (u.pm != pmA) { if (pmB < 0) pmB = u.pm; else if (u.pm != pmB) ok = 0; } }
    if (pmA < 0) pmA = 0;
    if (pmB < 0) pmB = pmA;
    if ((pmA >> 6) != (pmB >> 6)) ok = 0;
    if (tid == 0) { ((LAS int*)(lds + LT_PM))[0] = pmA; ((LAS int*)(lds + LT_PM))[1] = pmB; }
    pmA_out = pmA; pmB_out = pmB; return ok;
}
__device__ __forceinline__ void epi_tables_rstd(LAS unsigned char* lds, const float* ssq, int pmA, int pmB, int ok, int tid) {
    const int slot = tid >> 8, r = tid & 255, row = (slot ? pmB : pmA) * 256 + r;
    const f32x4 p0 = *(const f32x4*)(ssq + (size_t)row * 16), p1 = *(const f32x4*)(ssq + (size_t)row * 16 + 4), p2 = *(const f32x4*)(ssq + (size_t)row * 16 + 8), p3 = *(const f32x4*)(ssq + (size_t)row * 16 + 12);
    const float sm = (((p0.x + p0.y) + (p0.z + p0.w)) + ((p1.x + p1.y) + (p1.z + p1.w))) + (((p2.x + p2.y) + (p2.z + p2.w)) + ((p3.x + p3.y) + (p3.z + p3.w)));
    ((LAS float*)(lds + LT_RSTD))[tid] = ok ? rsqrtf(sm * (1.0f / D_) + EPS_) : __builtin_nanf("");
}
__device__ __forceinline__ void epi_tables_vec(LAS unsigned char* lds, int dst_off, const float* src, int n, int tid) {
    for (int i = tid * 4; i < n; i += 2048) *(LAS f32x4*)(lds + LT_VEC + (dst_off + i) * 4) = src ? *(const f32x4*)(src + i) : (f32x4){0.f, 0.f, 0.f, 0.f};
}
__device__ __forceinline__ int lane_id() { return (int)__builtin_amdgcn_mbcnt_hi(~0u, __builtin_amdgcn_mbcnt_lo(~0u, 0u)); }
__device__ __forceinline__ float sigm(float v) { return __builtin_amdgcn_rcpf(1.0f + __builtin_amdgcn_exp2f(-LOG2E_ * v)); }

template <int ACT> struct EpiGated {
    static constexpr bool PERM = true, AFTER_DRAIN = false;
    bf16* O; int ldo; const float* bias; int N; const float* ssq; LAS unsigned char* lds;
    __device__ __forceinline__ void preload(const pg8::StaticOrder& S, int tid) const {
        int pmA, pmB; const int ok = epi_tables_pm(lds, S, tid, pmA, pmB);
        epi_tables_rstd(lds, ssq, pmA, pmB, ok, tid);
        epi_tables_vec(lds, 0, bias + (size_t)(pmA >> 6) * N, N, tid);
    }
    __device__ __forceinline__ void operator()(const f32x4 (&acc)[2][2][4][2], const pg8::Unit& u, int wr, int wc, int fr, int fq) const {
        const LAS float* bp = (const LAS float*)(lds + LT_VEC) + u.pn * 256 + wc * 32 + 8 * fq;
        const LAS float* rt = (const LAS float*)(lds + LT_RSTD) + ((u.pm == ((const LAS int*)(lds + LT_PM))[0]) ? 0 : 256) + wr * 64 + fr;
        f32x4 bv[2][2];
#pragma unroll
        for (int bj = 0; bj < 2; ++bj)
#pragma unroll
            for (int n = 0; n < 2; ++n) bv[bj][n] = *(const LAS f32x4*)(bp + bj * 128 + 4 * n);
        float rsv[8];
#pragma unroll
        for (int k = 0; k < 8; ++k) rsv[k] = rt[(k >> 2) * 128 + (k & 3) * 16];
#pragma unroll
        for (int ai = 0; ai < 2; ++ai)
#pragma unroll
            for (int m = 0; m < 4; ++m) {
                const int row = u.pm * 256 + ai * 128 + wr * 64 + m * 16 + fr;
                const float rs = rsv[ai * 4 + m];
                typedef float f2 __attribute__((ext_vector_type(2)));
                f2 a[4], g[4], t[4], e[4], d[4], r[4], v[4];
#pragma unroll
                for (int i = 0; i < 4; ++i) { const int n = i >> 1; const f32x4 a4 = acc[ai][0][m][n], g4 = acc[ai][1][m][n], ba4 = bv[0][n], bg4 = bv[1][n];
                    a[i] = ((i & 1) == 0 ? (f2){a4.x, a4.y} : (f2){a4.z, a4.w}) * rs + ((i & 1) == 0 ? (f2){ba4.x, ba4.y} : (f2){ba4.z, ba4.w});
                    g[i] = ((i & 1) == 0 ? (f2){g4.x, g4.y} : (f2){g4.z, g4.w}) * rs + ((i & 1) == 0 ? (f2){bg4.x, bg4.y} : (f2){bg4.z, bg4.w});
                    t[i] = ((ACT == 0) ? a[i] : g[i]) * (-LOG2E_); }
#pragma unroll
                for (int i = 0; i < 4; ++i) { e[i].x = __builtin_amdgcn_exp2f(t[i].x); e[i].y = __builtin_amdgcn_exp2f(t[i].y); }
#pragma unroll
                for (int i = 0; i < 4; ++i) d[i] = e[i] + 1.0f;
#pragma unroll
                for (int i = 0; i < 4; ++i) { r[i].x = __builtin_amdgcn_rcpf(d[i].x); r[i].y = __builtin_amdgcn_rcpf(d[i].y); }
#pragma unroll
                for (int i = 0; i < 4; ++i) v[i] = (ACT == 0) ? (a[i] * r[i]) * g[i] : a[i] * r[i];
                u32x4 w; w.x = cvtpk(v[0].x, v[0].y); w.y = cvtpk(v[1].x, v[1].y); w.z = cvtpk(v[2].x, v[2].y); w.w = cvtpk(v[3].x, v[3].y);
                *(u32x4*)(O + (size_t)row * ldo + u.pn * 128 + wc * 32 + 8 * fq) = w;
            }
    }
};

struct EpiRes {
    static constexpr bool PERM = true, AFTER_DRAIN = false;
    bf16* xb; float* out; const float* bias2; const float* coef; float* ssq; int last; LAS unsigned char* lds;
    __device__ __forceinline__ void preload(const pg8::StaticOrder& S, int tid) const {
        int pmA, pmB; const int ok = epi_tables_pm(lds, S, tid, pmA, pmB);
        epi_tables_vec(lds, 0, ok ? coef + (size_t)(pmA >> 6) * D_ : nullptr, D_, tid);
        epi_tables_vec(lds, D_, bias2, D_, tid);
    }
    __device__ __forceinline__ void operator()(const f32x4 (&acc)[2][2][4][2], const pg8::Unit& u, int wr, int wc, int fr, int fq) const {
        const int col0 = u.pn * 256 + wc * 32 + 8 * fq;
        const size_t ro0 = (size_t)(u.pm * 256 + wr * 64 + fr) * D_ + col0;
        u32x4 xr[8][2];
#define EPIRES_LOAD(k) do { const bf16* xp_ = xb + ro0 + (size_t)(((k) >> 2) * 128 + ((k) & 3) * 16) * D_; xr[k][0] = *(const u32x4*)(xp_); xr[k][1] = *(const u32x4*)(xp_ + 128); } while (0)
        EPIRES_LOAD(0); EPIRES_LOAD(1); EPIRES_LOAD(2); EPIRES_LOAD(3);
        f32x4 cf[2][2], b2[2][2];
#pragma unroll
        for (int bj = 0; bj < 2; ++bj)
#pragma unroll
            for (int n = 0; n < 2; ++n) { const int c = col0 + bj * 128 + 4 * n;
                cf[bj][n] = *(const LAS f32x4*)(lds + LT_VEC + c * 4);
                b2[bj][n] = *(const LAS f32x4*)(lds + LT_VEC + (D_ + c) * 4); }
#pragma unroll
        for (int k = 0; k < 8; ++k) {
            const int ai = k >> 2, m = k & 3;
            if (k < 4) { switch (k) { case 0: EPIRES_LOAD(4); break; case 1: EPIRES_LOAD(5); break; case 2: EPIRES_LOAD(6); break; default: EPIRES_LOAD(7); break; } }
            const int row = u.pm * 256 + ai * 128 + wr * 64 + m * 16 + fr; const size_t ro = (size_t)row * D_;
            float ss = 0.f;
#pragma unroll
            for (int bj = 0; bj < 2; ++bj) {
                const u32x4 xw = xr[k][bj];
                const f32x4 x0 = (f32x4){bflo(xw.x), bfhi(xw.x), bflo(xw.y), bfhi(xw.y)}, x1 = (f32x4){bflo(xw.z), bfhi(xw.z), bflo(xw.w), bfhi(xw.w)};
                const f32x4 n0 = x0 + cf[bj][0] * (acc[ai][bj][m][0] + b2[bj][0]), n1 = x1 + cf[bj][1] * (acc[ai][bj][m][1] + b2[bj][1]);
                ss += ((n0[0] * n0[0] + n0[1] * n0[1]) + (n0[2] * n0[2] + n0[3] * n0[3])) + ((n1[0] * n1[0] + n1[1] * n1[1]) + (n1[2] * n1[2] + n1[3] * n1[3]));
                if (!last) { u32x4 w; w.x = cvtpk(n0[0], n0[1]); w.y = cvtpk(n0[2], n0[3]); w.z = cvtpk(n1[0], n1[1]); w.w = cvtpk(n1[2], n1[3]);
                    *(u32x4*)(xb + ro + col0 + bj * 128) = w; }
                else { *(f32x4*)(out + ro + col0 + bj * 128) = n0; *(f32x4*)(out + ro + col0 + bj * 128 + 4) = n1; }
            }
            if (!last) { ss = sum32(sum16(ss)); if (fq == 0) ssq[(size_t)row * 16 + u.pn * 4 + wc] = ss; }
        }
#undef EPIRES_LOAD
    }
};

struct EpiQKV {
    static constexpr bool PERM = true, AFTER_DRAIN = false;
    bf16* Q;   const float* bias; const float* ssq; const float* gq; const float* gk; float* kbarp; LAS unsigned char* lds;
    __device__ __forceinline__ void preload(const pg8::StaticOrder& S, int tid) const {
        int pmA, pmB; const int ok = epi_tables_pm(lds, S, tid, pmA, pmB);
        epi_tables_rstd(lds, ssq, pmA, pmB, ok, tid);
        epi_tables_vec(lds, 0, bias + (size_t)(pmA >> 6) * 3072, 3072, tid);
        epi_tables_vec(lds, 3072, gq, 64, tid); epi_tables_vec(lds, 3072 + 64, gk, 64, tid);
    }
    __device__ __forceinline__ void operator()(const f32x4 (&acc)[2][2][4][2], const pg8::Unit& u, int wr, int wc, int fr, int fq) const {
        const int b = u.pm >> 6, part = u.pn >> 2, head = ((u.pn & 3) << 2) + wc;
        const LAS float* bp = (const LAS float*)(lds + LT_VEC) + u.pn * 256 + wc * 32 + 8 * fq;
        const LAS float* gsrc = (const LAS float*)(lds + LT_VEC) + 3072 + ((part == 0) ? 0 : 64); const float gs = (part == 0) ? C2_ : 1.0f;
        const LAS float* rt = (const LAS float*)(lds + LT_RSTD) + ((u.pm == ((const LAS int*)(lds + LT_PM))[0]) ? 0 : 256) + wr * 64 + fr;
        f32x4 bv[2][2], gv[2][2], ks[2][2];
#pragma unroll
        for (int bj = 0; bj < 2; ++bj)
#pragma unroll
            for (int n = 0; n < 2; ++n) { bv[bj][n] = *(const LAS f32x4*)(bp + bj * 128 + 4 * n); gv[bj][n] = *(const LAS f32x4*)(gsrc + 32 * bj + 8 * fq + 4 * n) * gs; ks[bj][n] = (f32x4){0.f, 0.f, 0.f, 0.f}; }
        bf16* dst = Q + (size_t)part * ((size_t)M_ * D_);
        float rsv[8];
#pragma unroll
        for (int k = 0; k < 8; ++k) rsv[k] = rt[(k >> 2) * 128 + (k & 3) * 16];
#pragma unroll
        for (int ai = 0; ai < 2; ++ai)
#pragma unroll
            for (int m = 0; m < 4; ++m) {
                const int row = u.pm * 256 + ai * 128 + wr * 64 + m * 16 + fr;
                const float rs = rsv[ai * 4 + m];
                f32x4 v[2][2]; float ss = 0.f;
#pragma unroll
                for (int bj = 0; bj < 2; ++bj)
#pragma unroll
                    for (int n = 0; n < 2; ++n) { v[bj][n] = acc[ai][bj][m][n] * rs + bv[bj][n]; const f32x4 t = v[bj][n]; ss += (t[0] * t[0] + t[1] * t[1]) + (t[2] * t[2] + t[3] * t[3]); }
                if (part < 2) {
                    ss = sum32(sum16(ss));
                    const float r = rsqrtf(ss * (1.0f / HD_) + EPS_);
#pragma unroll
                    for (int bj = 0; bj < 2; ++bj)
#pragma unroll
                        for (int n = 0; n < 2; ++n) v[bj][n] = v[bj][n] * r * gv[bj][n];
                }
                if (part == 1) {
#pragma unroll
                    for (int bj = 0; bj < 2; ++bj)
#pragma unroll
                        for (int n = 0; n < 2; ++n) ks[bj][n] += v[bj][n];
                }
#pragma unroll
                for (int bj = 0; bj < 2; ++bj) {
                    u32x4 w; w.x = cvtpk(v[bj][0][0], v[bj][0][1]); w.y = cvtpk(v[bj][0][2], v[bj][0][3]); w.z = cvtpk(v[bj][1][0], v[bj][1][1]); w.w = cvtpk(v[bj][1][2], v[bj][1][3]);
                    *(u32x4*)(dst + (size_t)row * D_ + head * 64 + 32 * bj + 8 * fq) = w; }
            }
        if (part == 1) {
            float* kp = kbarp + ((((size_t)(b * 16 + head) * 64 + (u.pm & 63)) * 2 + wr) * 64);
#pragma unroll
            for (int bj = 0; bj < 2; ++bj)
#pragma unroll
                for (int n = 0; n < 2; ++n) { f32x4 t = ks[bj][n];
#pragma unroll
                    for (int j = 0; j < 4; ++j) { t[j] = row_sum16(t[j]); }
                    if (fr == 0) *(f32x4*)(kp + 32 * bj + 8 * fq + 4 * n) = t; }
        }
    }
};

template <class Epi> __device__ __forceinline__ void run_gemm(LAS unsigned char* lds, const bf16* A, const bf16* Bt, long bb, int N, int K, int G, const Epi& E, int wave_in) {
    int t = lane_id(); asm volatile("" : "+v"(t)); t += 64 * wave_in;
    int bid = (int)blockIdx.x, Gq = G; asm volatile("" : "+s"(bid), "+s"(Gq));
    pg8::Gemm g{A, Bt, M_, N, K, bb}; pg8::StaticOrder S; S.init(M_, N, Gq, bid);
    E.preload(S, t);
    __syncthreads();
    pg8::gemm_phase<Epi, pg8::StaticOrder, true, true>(lds, g, S, E, t);
}

__device__ __forceinline__ void tile_load(float (&w)[32], const float* W, int N, int k0, int n0, int lane) {
    const float* p = W + (size_t)(k0 + (lane >> 5)) * N + n0 + (lane & 31);
#pragma unroll
    for (int i = 0; i < 32; ++i) w[i] = p[(size_t)(2 * i) * N];
}
__device__ __forceinline__ void tile_to_lds(const float (&w)[32], LAS float* scr, int lane) {
#pragma unroll
    for (int i = 0; i < 32; ++i) scr[(2 * i + (lane >> 5)) * 33 + (lane & 31)] = w[i];
}
__device__ __forceinline__ void transpose_finish(int K, bf16* WT, int k0, int dst0, LAS float* scr, int lane) {
    LDS_WAIT(); asm volatile("" ::: "memory");
    const int c = lane & 7;
#pragma unroll
    for (int j = 0; j < 4; ++j) { const int n = (lane >> 3) + 8 * j; const LAS float* s = scr + (8 * c) * 33 + n;
        u32x4 o; o.x = cvtpk(s[0 * 33], s[1 * 33]); o.y = cvtpk(s[2 * 33], s[3 * 33]); o.z = cvtpk(s[4 * 33], s[5 * 33]); o.w = cvtpk(s[6 * 33], s[7 * 33]);
        *(GAS u32x4*)(WT + (size_t)(dst0 + n) * K + k0 + 8 * c) = o; }
    LDS_WAIT(); asm volatile("" ::: "memory");
}
__device__ __forceinline__ int gated_dst(int n0, int half) { const int c = (n0 < half) ? n0 : n0 - half; return 256 * (c >> 7) + (c & 127) + ((n0 < half) ? 0 : 128); }

constexpr int PT_OFF = MISC_OFF + 128;
__device__ __forceinline__ unsigned long long pt_get(LAS unsigned char* lds, int i) {
    const unsigned long long v = ((volatile LAS unsigned long long*)(lds + PT_OFF))[i];
    return ((unsigned long long)(unsigned)__builtin_amdgcn_readfirstlane((int)(v >> 32)) << 32) | (unsigned long long)(unsigned)__builtin_amdgcn_readfirstlane((int)(unsigned)v);
}
#define PIN(i) ((const float*)(const GAS float*)pt_get(lds, (i)))
#define POUT ((float*)(GAS float*)pt_get(lds, 19))
#define PWS ((unsigned char*)(GAS unsigned char*)pt_get(lds, 20))

__device__ __forceinline__ void inweight_item(const float* W, int N, bf16* WT, size_t wt_bstride, int kh, int n0, int dst0, const float* ng, const float* mod0,
                                              float* bias, int bias_bstride, const float* extra, LAS float* scr, int lane) {
    const int c = lane & 7;
    float dacc[4][2];
#pragma unroll
    for (int j = 0; j < 4; ++j) { dacc[j][0] = 0.f; dacc[j][1] = 0.f; }
    float w[32]; tile_load(w, W, N, 64 * 8 * kh, n0, lane);
    f32x4 gq[2], s0q[2], s1q[2], h0q[2], h1q[2];
#define INW_VECS(kq_) do { _Pragma("unroll") for (int q4 = 0; q4 < 2; ++q4) { gq[q4] = *(const f32x4*)(ng + (kq_) + 4 * q4); s0q[q4] = *(const f32x4*)(mod0 + 1024 + (kq_) + 4 * q4); \
        s1q[q4] = *(const f32x4*)(mod0 + 9216 + 1024 + (kq_) + 4 * q4); h0q[q4] = *(const f32x4*)(mod0 + (kq_) + 4 * q4); h1q[q4] = *(const f32x4*)(mod0 + 9216 + (kq_) + 4 * q4); } } while (0)
    INW_VECS(64 * 8 * kh + 8 * c);
#pragma unroll 1
    for (int kb = 8 * kh; kb < 8 * kh + 8; ++kb) {
        const int k0 = 64 * kb, kq = k0 + 8 * c;
        tile_to_lds(w, scr, lane);
        float gm0[8], gm1[8], sh0[8], sh1[8];
#pragma unroll
        for (int q4 = 0; q4 < 2; ++q4)
#pragma unroll
            for (int e = 0; e < 4; ++e) { gm0[4 * q4 + e] = gq[q4][e] * (1.0f + s0q[q4][e]); gm1[4 * q4 + e] = gq[q4][e] * (1.0f + s1q[q4][e]); sh0[4 * q4 + e] = h0q[q4][e]; sh1[4 * q4 + e] = h1q[q4][e]; }
        if (kb + 1 < 8 * kh + 8) { tile_load(w, W, N, k0 + 64, n0, lane); INW_VECS(kq + 64); }
        LDS_WAIT(); asm volatile("" ::: "memory");
#pragma unroll
        for (int j = 0; j < 4; ++j) { const int n = (lane >> 3) + 8 * j; const LAS float* sp = scr + (8 * c) * 33 + n;
            float v[8];
#pragma unroll
            for (int e = 0; e < 8; ++e) v[e] = sp[e * 33];
            u32x4 o0, o1;
            o0.x = cvtpk(v[0] * gm0[0], v[1] * gm0[1]); o0.y = cvtpk(v[2] * gm0[2], v[3] * gm0[3]); o0.z = cvtpk(v[4] * gm0[4], v[5] * gm0[5]); o0.w = cvtpk(v[6] * gm0[6], v[7] * gm0[7]);
            o1.x = cvtpk(v[0] * gm1[0], v[1] * gm1[1]); o1.y = cvtpk(v[2] * gm1[2], v[3] * gm1[3]); o1.z = cvtpk(v[4] * gm1[4], v[5] * gm1[5]); o1.w = cvtpk(v[6] * gm1[6], v[7] * gm1[7]);
            bf16* wp = WT + (size_t)(dst0 + n) * 1024 + kq;
            *(GAS u32x4*)(wp) = o0; *(GAS u32x4*)(wp + wt_bstride) = o1;
            float d0 = 0.f, d1 = 0.f;
#pragma unroll
            for (int e = 0; e < 8; ++e) { d0 += v[e] * sh0[e]; d1 += v[e] * sh1[e]; }
            dacc[j][0] += d0; dacc[j][1] += d1; }
        LDS_WAIT(); asm volatile("" ::: "memory");
    }
#pragma unroll
    for (int j = 0; j < 4; ++j)
#pragma unroll
        for (int bb = 0; bb < 2; ++bb) { float v = dacc[j][bb]; v += dppf<0xB1>(v); v += dppf<0x4E>(v); v += dppf<0x141>(v);
            if (c == 0) { const int n = (lane >> 3) + 8 * j; if (kh == 0 && extra) v += extra[n0 + n];
                __hip_atomic_fetch_add(bias + (size_t)bb * bias_bstride + dst0 + n, v, __ATOMIC_RELAXED, __HIP_MEMORY_SCOPE_AGENT); } }
}

#undef INW_VECS
__device__ __forceinline__ void phase_p0(LAS unsigned char* lds, int vcu, int G, int wave_in) {
    int tid = lane_id(); asm volatile("" : "+v"(tid)); tid += 64 * wave_in;
    const int lane = tid & 63, wave = __builtin_amdgcn_readfirstlane(tid >> 6);
    LAS float* cs = (LAS float*)lds;
    LAS float* red = (LAS float*)(lds + 8192);
    LAS float* scr = (LAS float*)(lds + 16384 + wave * 8704);
    unsigned char* const ws = PWS;
    float* MOD = (float*)(ws + WS_MOD);
    { const float* cin = PIN(1); for (int i = tid; i < 2048; i += 512) { const float v = cin[i]; cs[i] = v / (1.0f + expf(-v)); } }
    { float* bz = (float*)(ws + WS_BFFN); for (int i = vcu * 512 + tid; i < (192 + 32 + 16) * 256; i += G * 512) bz[i] = 0.f; }
    __syncthreads();
    for (int it = blockIdx.x; it < 288; it += G) {
        const int li = it / 144, cg = it % 144;
        const float* W = PIN(3) + (size_t)li * 1024 * 9216 + cg * 64 + lane; const float* adab = PIN(4);
        float a0 = 0.f, a1 = 0.f;
#pragma unroll 64
        for (int k = wave * 128; k < wave * 128 + 128; ++k) { const float w = W[(size_t)k * 9216]; a0 += cs[k] * w; a1 += cs[1024 + k] * w; }
        red[(wave * 2 + 0) * 64 + lane] = a0; red[(wave * 2 + 1) * 64 + lane] = a1;
        __syncthreads();
        if (tid < 128) { const int b = tid >> 6, l = tid & 63; float s = 0.f;
#pragma unroll
            for (int w = 0; w < 8; ++w) s += red[(w * 2 + b) * 64 + l];
            MOD[(size_t)(li * 2 + b) * 9216 + cg * 64 + l] = s + adab[li * 9216 + cg * 64 + l]; }
        __syncthreads();
    }
    const int gw = vcu * 8 + wave, NGW = G * 8;
    bf16* WOUT = (bf16*)(ws + WS_WOUT); bf16* WO = (bf16*)(ws + WS_WO); bf16* WPW2 = (bf16*)(ws + WS_WPW2);
    constexpr int I_OUT = 44 * 32, I_O = 16 * 32, I_PW2 = 16 * 32;
    constexpr int NITEMS = 4 * I_OUT + I_O + I_PW2;
    {
        const float* w6 = PIN(6); const float* w10 = PIN(10); const float* w17 = PIN(17);
#define OUTW_DECODE(it_, W_, K_, WT_, k0_, n0_) do { int r_ = (it_); \
            if (r_ < 4 * I_OUT) { const int f_ = r_ / I_OUT; r_ %= I_OUT; W_ = w6 + (size_t)f_ * 2816 * 1024; K_ = 2816; WT_ = WOUT + (size_t)f_ * 1024 * 2816; } \
            else if (r_ < 4 * I_OUT + I_O) { r_ -= 4 * I_OUT; W_ = w10; K_ = 1024; WT_ = WO; } \
            else { r_ -= 4 * I_OUT + I_O; W_ = w17; K_ = 1024; WT_ = WPW2; } \
            k0_ = 64 * (r_ / 32); n0_ = 32 * (r_ % 32); } while (0)
        float w[32]; const float* Wc; int Kc, k0c, n0c; bf16* WTc;
        if (gw < NITEMS) { OUTW_DECODE(gw, Wc, Kc, WTc, k0c, n0c); tile_load(w, Wc, 1024, k0c, n0c, lane); }
        for (int it = gw; it < NITEMS; it += NGW) {
            tile_to_lds(w, scr, lane);
            const float* Wn = Wc; int Kn = Kc, k0n = k0c, n0n = n0c; bf16* WTn = WTc;
            if (it + NGW < NITEMS) { OUTW_DECODE(it + NGW, Wn, Kn, WTn, k0n, n0n); tile_load(w, Wn, 1024, k0n, n0n, lane); }
            transpose_finish(Kc, WTc, k0c, n0c, scr, lane);
            Wc = Wn; Kc = Kn; k0c = k0n; n0c = n0n; WTc = WTn;
        }
#undef OUTW_DECODE
    }
    const float* x = PIN(0); bf16* XB = (bf16*)(ws + WS_XB); float* SSQ = (float*)(ws + WS_SSQ);
    {
        f32x4 v[2][4], vn[2][4];
#define XROWS_LOAD(dst, r0_) do { _Pragma("unroll") for (int r = 0; r < 2; ++r) _Pragma("unroll") for (int jj = 0; jj < 4; ++jj) \
            dst[r][jj] = ((r0_) + r * NGW < M_) ? *(const f32x4*)(x + (size_t)((r0_) + r * NGW) * D_ + 4 * lane + 256 * jj) : (f32x4){0.f, 0.f, 0.f, 0.f}; } while (0)
        XROWS_LOAD(vn, gw);
        for (int row0 = gw; row0 < M_; row0 += 2 * NGW) {
#pragma unroll
            for (int r = 0; r < 2; ++r)
#pragma unroll
                for (int jj = 0; jj < 4; ++jj) v[r][jj] = vn[r][jj];
            if (row0 + 2 * NGW < M_) XROWS_LOAD(vn, row0 + 2 * NGW);
#pragma unroll
            for (int r = 0; r < 2; ++r) { const int row = row0 + r * NGW; if (row >= M_) break; float ss = 0.f;
#pragma unroll
                for (int jj = 0; jj < 4; ++jj) { const int c = 4 * lane + 256 * jj; const f32x4 t = v[r][jj];
                    ss += (t[0] * t[0] + t[1] * t[1]) + (t[2] * t[2] + t[3] * t[3]);
                    u32x2 w; w.x = cvtpk(t[0], t[1]); w.y = cvtpk(t[2], t[3]);
                    *(u32x2*)(XB + (size_t)row * D_ + c) = w; }
                ss = wave_sum(ss);
                if (lane < 4) *(f32x4*)(SSQ + (size_t)row * 16 + 4 * lane) = (f32x4){lane == 0 ? ss : 0.f, 0.f, 0.f, 0.f}; }
        }
#undef XROWS_LOAD
    }
}

__device__ __forceinline__ void phase_p1(LAS unsigned char* lds, int vcu, int G, int wave_in) {
    int tid = lane_id(); asm volatile("" : "+v"(tid)); tid += 64 * wave_in;
    const int lane = tid & 63, wave = __builtin_amdgcn_readfirstlane(tid >> 6);
    LAS float* scr = (LAS float*)(lds + 16384 + wave * 8704);
    unsigned char* const ws = PWS; const float* ng = PIN(2);
    const float* MOD = (const float*)(ws + WS_MOD);
    float* COEF = (float*)(ws + WS_COEF);
    for (int i = vcu * 512 + tid; i < 6 * 2 * 1024; i += G * 512) {
        const int sl = i >> 11, b = (i >> 10) & 1, d = i & 1023, li = sl / 3, j = sl % 3;
        const float* mod = MOD + (size_t)(li * 2 + b) * 9216 + j * 3 * 1024;
        COEF[i] = ((j == 1) ? 1.0f : 0.5f) * mod[2048 + d];
    }
    const int gw = vcu * 8 + wave, NGW = G * 8;
    constexpr int I_IN = 176 * 2, I_QKV = 96 * 2, I_PW1 = 64 * 2;
    for (int it = gw; it < 4 * I_IN + I_QKV + I_PW1; it += NGW) {
        int r = it;
        if (r < 4 * I_IN) { const int f = r / I_IN; r %= I_IN; const int kh = (r >> 3) & 1, n0 = 32 * ((r >> 4) * 8 + (r & 7)), sl = (f >> 1) * 3 + (f & 1) * 2;
            inweight_item(PIN(5) + (size_t)f * 1024 * 5632, 5632, (bf16*)(ws + WS_WIN) + (size_t)f * 2 * 5632 * 1024, (size_t)5632 * 1024, kh, n0, gated_dst(n0, FF_),
                          ng + sl * 1024, MOD + (size_t)((sl / 3) * 2) * 9216 + (sl % 3) * 3 * 1024, (float*)(ws + WS_BFFN) + (size_t)f * 2 * 5632, 5632, nullptr, scr, lane); continue; }
        r -= 4 * I_IN;
        if (r < I_QKV) { const int kh = (r >> 3) & 1, n0 = 32 * ((r >> 4) * 8 + (r & 7)); const int part = n0 >> 10, head = (n0 & 1023) >> 6, e0 = n0 & 63;
            const int dst0 = 256 * (part * 4 + (head >> 2)) + 128 * (e0 >> 5) + 32 * (head & 3);
            inweight_item(PIN(7), 3072, (bf16*)(ws + WS_WQKV), (size_t)3072 * 1024, kh, n0, dst0, ng + 1 * 1024, MOD + 1 * 3 * 1024, (float*)(ws + WS_BQKV), 3072, nullptr, scr, lane); continue; }
        r -= I_QKV;
        { const int kh = (r >> 3) & 1, n0 = 32 * ((r >> 4) * 8 + (r & 7));
            inweight_item(PIN(11), 2048, (bf16*)(ws + WS_WPW1), (size_t)2048 * 1024, kh, n0, gated_dst(n0, 1024), ng + 4 * 1024, MOD + (size_t)2 * 9216 + 1 * 3 * 1024, (float*)(ws + WS_BPW1), 2048, PIN(12), scr, lane); }
    }
}

typedef float f32x2 __attribute__((ext_vector_type(2)));
__device__ __forceinline__ f32x2 bfpair(unsigned v) { return (f32x2){bflo(v), bfhi(v)}; }
__device__ __forceinline__ void conv_phase(LAS unsigned char* lds, int vcu, int G, int wave_in) {
    int tid = lane_id(); asm volatile("" : "+v"(tid)); tid += 64 * wave_in;
    const int lane = tid & 63, wave = __builtin_amdgcn_readfirstlane(tid >> 6), c0 = 2 * tid;
    LAS float* part = (LAS float*)lds;
    unsigned char* const ws = PWS;
    const bf16* U = (const bf16*)(ws + WS_U); bf16* CV = (bf16*)(ws + WS_CV);
    f32x2 w[31];
    { const float* wdw = PIN(13);
#pragma unroll
    for (int j = 0; j < 31; ++j) w[j] = *(const f32x2*)(wdw + j * D_ + c0); }
    f32x2 bd, lg, lb;
    { const float* p = PIN(14); bd = *(const f32x2*)(p + c0); p = PIN(15); lg = *(const f32x2*)(p + c0); p = PIN(16); lb = *(const f32x2*)(p + c0); }
    for (int un = vcu; un < 256; un += G) {
        const int b = un >> 7, t0 = (un & 127) * 128;
        const unsigned* Up = (const unsigned*)(U + (size_t)b * S_ * D_ + c0);
        unsigned* Op = (unsigned*)(CV + (size_t)b * S_ * D_ + c0);
        f32x2 hist[38];
        unsigned nx0[8], nx1[8];
#pragma unroll
        for (int i = 0; i < 8; ++i) { nx0[i] = Up[(size_t)(t0 + i) * 512]; nx1[i] = Up[(size_t)(t0 + 8 + i) * 512]; }
#pragma unroll
        for (int i = 0; i < 30; ++i) { const int tt = t0 - 30 + i; const unsigned v = (tt >= 0) ? Up[(size_t)tt * 512] : 0u; hist[i] = bfpair(v); }
        int pb = 0;
#pragma unroll 1
        for (int st = 0; st < 16; ++st) {
#pragma unroll
            for (int i = 0; i < 8; ++i) { hist[30 + i] = bfpair(nx0[i]); nx0[i] = nx1[i]; }
            if (st < 14) {
#pragma unroll
                for (int i = 0; i < 8; ++i) nx1[i] = Up[(size_t)(t0 + (st + 2) * 8 + i) * 512];
            }
            f32x2 y[8]; float stat[16];
#pragma unroll
            for (int tt = 0; tt < 8; ++tt) { f32x2 a = bd;
#pragma unroll
                for (int j = 0; j < 31; ++j) a += w[j] * hist[tt + j];
                y[tt] = a; stat[2 * tt] = a.x + a.y; stat[2 * tt + 1] = a.x * a.x + a.y * a.y; }
            float s1[8], s2[4];
#pragma unroll
            for (int k = 0; k < 8; ++k) { const auto r = __builtin_amdgcn_permlane32_swap(f2u(stat[k]), f2u(stat[k + 8]), false, false); const unsigned r0 = r[0], r1 = r[1]; s1[k] = u2f(r0) + u2f(r1); }
#pragma unroll
            for (int k = 0; k < 4; ++k) { const auto r = __builtin_amdgcn_permlane16_swap(f2u(s1[k]), f2u(s1[k + 4]), false, false); const unsigned r0 = r[0], r1 = r[1]; s2[k] = row_sum16(u2f(r0) + u2f(r1)); }
            if ((lane & 15) == 0) *(LAS f32x4*)(part + (pb * 8 + wave) * 16 + 4 * (lane >> 4)) = (f32x4){s2[0], s2[1], s2[2], s2[3]};
            LDS_BARRIER();
            f32x4 tot[4];
#pragma unroll
            for (int k = 0; k < 4; ++k) { tot[k] = (f32x4){0.f, 0.f, 0.f, 0.f};
#pragma unroll
                for (int ww = 0; ww < 8; ++ww) tot[k] += *(const LAS f32x4*)(part + (pb * 8 + ww) * 16 + 4 * k); }
#pragma unroll
            for (int tt = 0; tt < 8; ++tt) {
                const float sum = tot[tt >> 1][(tt & 1) * 2], sq = tot[tt >> 1][(tt & 1) * 2 + 1];
                const float mean = sum * (1.0f / D_), var = sq * (1.0f / D_) - mean * mean, rstd = __builtin_amdgcn_rsqf(var + EPS_);
                const f32x2 z = (y[tt] - mean) * rstd * lg + lb;
                const f32x2 e = z * (-LOG2E_);
                f32x2 d; d.x = __builtin_amdgcn_exp2f(e.x); d.y = __builtin_amdgcn_exp2f(e.y); d = d + 1.0f;
                f32x2 r; r.x = __builtin_amdgcn_rcpf(d.x); r.y = __builtin_amdgcn_rcpf(d.y);
                const f32x2 o = z * r;
                Op[(size_t)(t0 + st * 8 + tt) * 512] = cvtpk(o.x, o.y);
            }
#pragma unroll
            for (int i = 0; i < 30; ++i) hist[i] = hist[i + 8];
            pb ^= 1;
        }
    }
}
constexpr int CW_Q2 = 8192;
constexpr int A_KS = 0, A_VT = 36864, A_LIST = 70656, A_MISC = 103424;
__device__ __forceinline__ float attn_m0(const float* gq, const float* gk, int lane) {
    float a = fabsf(gq[lane]), b = fabsf(gk[lane]); a = wave_max(a); b = wave_max(b);
    return 8.0f * LOG2E_ * a * b * 1.02f + 0.25f;
}
__device__ __forceinline__ void stage_kv_load(u32x4 (&kk)[4], u32x4 (&vv)[4], const bf16* K, const bf16* V, size_t rowbase, int h, int tid) {
    const int r = tid >> 1, hf = tid & 1;
    const bf16* kp = K + (rowbase + r) * D_ + h * 64 + 32 * hf;
#pragma unroll
    for (int c = 0; c < 4; ++c) kk[c] = *(const u32x4*)(kp + 8 * c);
    const int p = tid >> 2, dq = tid & 3;
    const bf16* vp = V + (rowbase + 2 * p) * D_ + h * 64 + 16 * dq;
    vv[0] = *(const u32x4*)(vp); vv[1] = *(const u32x4*)(vp + 8); vv[2] = *(const u32x4*)(vp + D_); vv[3] = *(const u32x4*)(vp + D_ + 8);
}
__device__ __forceinline__ void stage_kv_store(LAS unsigned char* lds, const u32x4 (&kk)[4], const u32x4 (&vv)[4], int tid) {
    const int r = tid >> 1, hf = tid & 1;
#pragma unroll
    for (int c = 0; c < 4; ++c) *(LAS u32x4*)(lds + A_KS + r * 144 + (32 * hf + 8 * c) * 2) = kk[c];
    const int p = tid >> 2, dq = tid & 3;
    LAS unsigned* vt = (LAS unsigned*)(lds + A_VT) + p;
#pragma unroll
    for (int c = 0; c < 2; ++c)
#pragma unroll
        for (int e = 0; e < 4; ++e) { const unsigned a = (e == 0) ? vv[c].x : (e == 1) ? vv[c].y : (e == 2) ? vv[c].z : vv[c].w;
            const unsigned bb = (e == 0) ? vv[2 + c].x : (e == 1) ? vv[2 + c].y : (e == 2) ? vv[2 + c].z : vv[2 + c].w;
            const int d = 16 * dq + 8 * c + 2 * e;
            vt[d * 132] = (a & 0xffffu) | (bb << 16); vt[(d + 1) * 132] = (a >> 16) | (bb & 0xffff0000u); }
}
__device__ __forceinline__ void stage_kv(LAS unsigned char* lds, const bf16* K, const bf16* V, size_t rowbase, int h, int tid) {
    u32x4 kk[4], vv[4]; stage_kv_load(kk, vv, K, V, rowbase, h, tid); stage_kv_store(lds, kk, vv, tid);
}
__device__ __forceinline__ int alibi_dmax(float slope2, float M0) { return (int)fminf((2.0f * M0 + 40.0f) / slope2, 1.0e9f); }
template <bool MASK> __device__ __forceinline__ void attn_tile(LAS unsigned char* lds, int s8, const bf16x8 (&qf)[4], float rowc, float slope2, int lane, f32x16& o0, f32x16& o1, float& lsum, int maskq) {
    const int i = lane & 31, hi = lane >> 5;
    const int prow = (i & ~12) | ((i & 4) << 1) | ((i & 8) >> 1);
    const LAS unsigned char* kp = lds + A_KS + (32 * s8 + prow) * 144 + 16 * hi;
    const float cb = rowc + slope2 * (float)(32 * s8 + 8 * hi);
    f32x16 c;
#pragma unroll
    for (int r = 0; r < 16; ++r) c[r] = cb + slope2 * (float)(16 * (r >> 3) + (r & 7));
#pragma unroll
    for (int d0 = 0; d0 < 4; ++d0) { const bf16x8 kf = *(const LAS bf16x8*)(kp + 32 * d0); c = __builtin_amdgcn_mfma_f32_32x32x16_bf16(kf, qf[d0], c, 0, 0, 0); }
    if (MASK) {
#pragma unroll
        for (int r = 0; r < 16; ++r) if (16 * (r >> 3) + 8 * hi + (r & 7) > maskq) c[r] = -INFINITY;
    }
    float ls = 0.f;
#pragma unroll
    for (int r = 0; r < 16; ++r) { c[r] = __builtin_amdgcn_exp2f(c[r]); ls += c[r]; }
    lsum += ls;
    u32x4 p0, p1;
    p0.x = cvtpk(c[0], c[1]); p0.y = cvtpk(c[2], c[3]); p0.z = cvtpk(c[4], c[5]); p0.w = cvtpk(c[6], c[7]);
    p1.x = cvtpk(c[8], c[9]); p1.y = cvtpk(c[10], c[11]); p1.z = cvtpk(c[12], c[13]); p1.w = cvtpk(c[14], c[15]);
    const bf16x8 pf0 = __builtin_bit_cast(bf16x8, p0), pf1 = __builtin_bit_cast(bf16x8, p1);
    const LAS unsigned char* vp = lds + A_VT + (i * 264 + 32 * s8 + 8 * hi) * 2;
    { const bf16x8 v00 = *(const LAS bf16x8*)(vp), v01 = *(const LAS bf16x8*)(vp + 32), v10 = *(const LAS bf16x8*)(vp + 32 * 528), v11 = *(const LAS bf16x8*)(vp + 32 * 528 + 32);
      o0 = __builtin_amdgcn_mfma_f32_32x32x16_bf16(v00, pf0, o0, 0, 0, 0); o1 = __builtin_amdgcn_mfma_f32_32x32x16_bf16(v10, pf0, o1, 0, 0, 0);
      o0 = __builtin_amdgcn_mfma_f32_32x32x16_bf16(v01, pf1, o0, 0, 0, 0); o1 = __builtin_amdgcn_mfma_f32_32x32x16_bf16(v11, pf1, o1, 0, 0, 0); }
}
__device__ __forceinline__ bf16* op_ptr(unsigned char* ws, float* out, int rank) { return (rank == 2) ? (bf16*)(ws + WS_OP3) : (bf16*)out + (size_t)rank * ((size_t)M_ * D_); }

struct A2Item { int n, bh, b, h, tbeg, tlim, dmax; float slope2; };
__device__ __forceinline__ A2Item a2_decode(int item, float M0) {
    A2Item I; I.n = item >> 5; I.bh = item & 31; I.b = I.bh >> 4; I.h = I.bh & 15;
    I.slope2 = exp2f(-0.5f * (float)(I.h + 1)) * LOG2E_; I.dmax = alibi_dmax(I.slope2, M0);
    I.tbeg = (I.n + 1) * 256; I.tlim = min(S_, 256 * I.n + 256 + I.dmax); return I;
}
__device__ __forceinline__ void a2_load(const A2Item& I, u32x4 (&kk)[4], u32x4 (&vv)[4], u32x4 (&sv)[8], const bf16* K, const bf16* V, const unsigned* sel, int tid) {
    stage_kv_load(kk, vv, K, V, (size_t)I.b * S_ + 256 * I.n, I.h, tid);
    const unsigned* sp = sel + (size_t)I.bh * S_;
#pragma unroll
    for (int c = 0; c < 8; ++c) { const int t0 = I.tbeg + 2048 * c + 4 * tid;
        sv[c] = (u32x4){0xFFFFFFFFu, 0xFFFFFFFFu, 0xFFFFFFFFu, 0xFFFFFFFFu};
        if (I.tbeg + 2048 * c < I.tlim) { if (t0 < S_) sv[c] = *(const u32x4*)(sp + t0); } }
}
__device__ __forceinline__ void a2_phase(LAS unsigned char* lds, int wave_in, int qword) {
    int tid = lane_id(); asm volatile("" : "+v"(tid)); tid += 64 * wave_in;
    const int lane = tid & 63, wave = __builtin_amdgcn_readfirstlane(tid >> 6), q = lane & 31, hi = lane >> 5;
    unsigned char* const ws = PWS;
    const bf16* Q = (const bf16*)(ws + WS_Q); const bf16* K = (const bf16*)(ws + WS_K); const bf16* V = (const bf16*)(ws + WS_V);
    const unsigned* sel = (const unsigned*)(ws + WS_SEL); unsigned* ctl = (unsigned*)(ws + WS_CTL); float* LP = (float*)(ws + WS_LP); float* const outp = POUT;
    const float M0 = attn_m0(PIN(8), PIN(9), lane);
    LAS unsigned short* list = (LAS unsigned short*)(lds + A_LIST); volatile LAS int* misc = (volatile LAS int*)(lds + A_MISC);
    constexpr int NIT = 63 * 32;
    int t_cur = 0, t_nxt = 0;
    if (tid == 0) { t_cur = (int)__hip_atomic_fetch_add(ctl + qword, 1u, __ATOMIC_RELAXED, __HIP_MEMORY_SCOPE_AGENT); t_nxt = (int)__hip_atomic_fetch_add(ctl + qword, 1u, __ATOMIC_RELAXED, __HIP_MEMORY_SCOPE_AGENT); }
    LDS_BARRIER();
    if (tid == 0) { misc[0] = t_cur; misc[2] = t_nxt; misc[1] = 0; }
    LDS_BARRIER();
    int item = __builtin_amdgcn_readfirstlane(misc[0]), item_n = __builtin_amdgcn_readfirstlane(misc[2]);
    u32x4 kk[4], vv[4], sv[8];
    if (item < NIT) { const A2Item I0 = a2_decode(item, M0); a2_load(I0, kk, vv, sv, K, V, sel, tid); }
    while (item < NIT) {
        const A2Item I = a2_decode(item, M0);
        const int n = I.n, b = I.b, h = I.h, dmax = I.dmax; const float slope2 = I.slope2;
        int t_nn = 0;
        if (tid == 0) t_nn = (int)__hip_atomic_fetch_add(ctl + qword, 1u, __ATOMIC_RELAXED, __HIP_MEMORY_SCOPE_AGENT);
        stage_kv_store(lds, kk, vv, tid);
#pragma unroll
        for (int c = 0; c < 8; ++c) {
            if (I.tbeg + 2048 * c < I.tlim) {
#pragma unroll
                for (int e = 0; e < 4; ++e) {
                    const unsigned s = (e == 0) ? sv[c].x : (e == 1) ? sv[c].y : (e == 2) ? sv[c].z : sv[c].w;
                    const int t = I.tbeg + 2048 * c + 4 * tid + e;
                    int rank = ((s & 255u) == (unsigned)n) ? 0 : (((s >> 8) & 255u) == (unsigned)n) ? 1 : (((s >> 16) & 255u) == (unsigned)n) ? 2 : -1;
                    if (t - 256 * n - 255 > dmax) rank = -1;
                    const unsigned long long bal = __ballot(rank >= 0);
                    if (bal) {
                        const int pre = __builtin_amdgcn_mbcnt_hi((unsigned)(bal >> 32), __builtin_amdgcn_mbcnt_lo((unsigned)bal, 0u));
                        int base = 0;
                        if (lane == 0) base = __hip_atomic_fetch_add((LAS int*)(lds + A_MISC) + 1, __popcll(bal), __ATOMIC_RELAXED, __HIP_MEMORY_SCOPE_WORKGROUP);
                        base = __builtin_amdgcn_readfirstlane(base);
                        if (rank >= 0) list[base + pre] = (unsigned short)(t | (rank << 14));
                    }
                }
            }
        }
        if (item_n < NIT) { const A2Item In = a2_decode(item_n, M0); a2_load(In, kk, vv, sv, K, V, sel, tid); }
        LDS_BARRIER();
        const int total = __builtin_amdgcn_readfirstlane(misc[1]);
        const int nr = (total + 255) >> 8;
        bf16x8 qn[4]; unsigned en = 0u;
        if (32 * wave < total) { const int idx = 32 * wave + q; en = list[(idx < total) ? idx : 32 * wave];
            const size_t rown = (size_t)b * S_ + (en & 16383);
#pragma unroll
            for (int d0 = 0; d0 < 4; ++d0) qn[d0] = *(const bf16x8*)(Q + rown * D_ + h * 64 + 16 * d0 + 8 * hi); }
        for (int r = 0; r < nr; ++r) {
            const int i0 = 256 * r + 32 * wave;
            if (i0 < total) {
                const int idx = i0 + q; const bool valid = idx < total;
                const unsigned e = en;
                const int t = e & 16383, rank = e >> 14;
                const size_t row = (size_t)b * S_ + t;
                bf16x8 qf[4];
#pragma unroll
                for (int d0 = 0; d0 < 4; ++d0) qf[d0] = qn[d0];
                if (i0 + 256 < total) { const int idx2 = idx + 256; en = list[(idx2 < total) ? idx2 : i0 + 256];
                    const size_t rown = (size_t)b * S_ + (en & 16383);
#pragma unroll
                    for (int d0 = 0; d0 < 4; ++d0) qn[d0] = *(const bf16x8*)(Q + rown * D_ + h * 64 + 16 * d0 + 8 * hi); }
                const float rowc = -slope2 * (float)(t - 256 * n) - M0;
                f32x16 o0, o1; float lsum = 0.f;
#pragma unroll
                for (int k = 0; k < 16; ++k) { o0[k] = 0.f; o1[k] = 0.f; }
#pragma unroll 2
                for (int s8 = 0; s8 < 8; ++s8) attn_tile<false>(lds, s8, qf, rowc, slope2, lane, o0, o1, lsum, 0);
                lsum = sum32(lsum);
                if (valid) {
                    bf16* op = op_ptr(ws, outp, rank) + row * D_ + h * 64 + 4 * hi;
#pragma unroll
                    for (int g = 0; g < 4; ++g) {
                        u32x2 w0, w1; w0.x = cvtpk(o0[4 * g], o0[4 * g + 1]); w0.y = cvtpk(o0[4 * g + 2], o0[4 * g + 3]);
                        w1.x = cvtpk(o1[4 * g], o1[4 * g + 1]); w1.y = cvtpk(o1[4 * g + 2], o1[4 * g + 3]);
                        *(u32x2*)(op + 8 * g) = w0; *(u32x2*)(op + 32 + 8 * g) = w1; }
                    if (hi == 0) LP[((size_t)rank * M_ + row) * 16 + h] = lsum;
                }
            }
        }
        LDS_BARRIER();
        if (tid == 0) { misc[0] = item_n; misc[2] = t_nn; misc[1] = 0; }
        LDS_BARRIER();
        item = __builtin_amdgcn_readfirstlane(misc[0]); item_n = __builtin_amdgcn_readfirstlane(misc[2]);
    }
}

__device__ __forceinline__ void a3_phase(LAS unsigned char* lds, int vcu, int G, int wave_in) {
    int tid = lane_id(); asm volatile("" : "+v"(tid)); tid += 64 * wave_in;
    const int lane = tid & 63, wave = __builtin_amdgcn_readfirstlane(tid >> 6), q = lane & 31, hi = lane >> 5;
    unsigned char* const ws = PWS;
    bf16* Q = (bf16*)(ws + WS_Q); const bf16* K = (const bf16*)(ws + WS_K); const bf16* V = (const bf16*)(ws + WS_V);
    const unsigned* sel = (const unsigned*)(ws + WS_SEL); const float* LP = (const float*)(ws + WS_LP); float* const outp = POUT;
    const float M0 = attn_m0(PIN(8), PIN(9), lane);
    u32x4 kk[4], vv[4];
    if (vcu < 2048) { const int bh = vcu >> 6, m = vcu & 63; stage_kv_load(kk, vv, K, V, (size_t)(bh >> 4) * S_ + 256 * m, bh & 15, tid); }
    for (int un = vcu; un < 2048; un += G) {
        const int bh = un >> 6, m = un & 63, b = bh >> 4, h = bh & 15;
        const float slope2 = exp2f(-0.5f * (float)(h + 1)) * LOG2E_;
        LDS_BARRIER();
        stage_kv_store(lds, kk, vv, tid);
        { const int un2 = un + G; if (un2 < 2048) { const int bh2 = un2 >> 6, m2 = un2 & 63; stage_kv_load(kk, vv, K, V, (size_t)(bh2 >> 4) * S_ + 256 * m2, bh2 & 15, tid); } }
        const int t = 256 * m + 32 * wave + q; const size_t row = (size_t)b * S_ + t;
        bf16x8 qf[4];
#pragma unroll
        for (int d0 = 0; d0 < 4; ++d0) qf[d0] = *(const bf16x8*)(Q + row * D_ + h * 64 + 16 * d0 + 8 * hi);
        const unsigned s = sel[(size_t)bh * S_ + t];
        float lp[3]; u32x2 pw[3][8];
#pragma unroll
        for (int rank = 0; rank < 3; ++rank) {
            lp[rank] = LP[((size_t)rank * M_ + row) * 16 + h];
            const bf16* op = op_ptr(ws, outp, rank) + row * D_ + h * 64 + 4 * hi;
#pragma unroll
            for (int g = 0; g < 4; ++g) { pw[rank][g] = *(const u32x2*)(op + 8 * g); pw[rank][4 + g] = *(const u32x2*)(op + 32 + 8 * g); }
        }
        LDS_BARRIER();
        const float rowc = -slope2 * (float)(32 * wave + q) - M0;
        f32x16 o0, o1; float lsum = 0.f;
#pragma unroll
        for (int k = 0; k < 16; ++k) { o0[k] = 0.f; o1[k] = 0.f; }
        for (int s8 = 0; s8 < wave; ++s8) attn_tile<false>(lds, s8, qf, rowc, slope2, lane, o0, o1, lsum, 0);
        attn_tile<true>(lds, wave, qf, rowc, slope2, lane, o0, o1, lsum, q);
        float l = sum32(lsum);
        const int dmax = alibi_dmax(slope2, M0);
#pragma unroll
        for (int rank = 0; rank < 3; ++rank) {
            const int nb = (int)((s >> (8 * rank)) & 255u);
            if (nb != 255 && (t - 256 * nb - 255) <= dmax) {
                l += lp[rank];
#pragma unroll
                for (int g = 0; g < 4; ++g) { const u32x2 w0 = pw[rank][g], w1 = pw[rank][4 + g];
                    o0[4 * g] += bflo(w0.x); o0[4 * g + 1] += bfhi(w0.x); o0[4 * g + 2] += bflo(w0.y); o0[4 * g + 3] += bfhi(w0.y);
                    o1[4 * g] += bflo(w1.x); o1[4 * g + 1] += bfhi(w1.x); o1[4 * g + 2] += bflo(w1.y); o1[4 * g + 3] += bfhi(w1.y); }
            }
        }
        const float inv = 1.0f / l;
        bf16* op = Q + row * D_ + h * 64 + 4 * hi;
#pragma unroll
        for (int g = 0; g < 4; ++g) {
            u32x2 w0, w1; w0.x = cvtpk(o0[4 * g] * inv, o0[4 * g + 1] * inv); w0.y = cvtpk(o0[4 * g + 2] * inv, o0[4 * g + 3] * inv);
            w1.x = cvtpk(o1[4 * g] * inv, o1[4 * g + 1] * inv); w1.y = cvtpk(o1[4 * g + 2] * inv, o1[4 * g + 3] * inv);
            *(u32x2*)(op + 8 * g) = w0; *(u32x2*)(op + 32 + 8 * g) = w1; }
    }
}

constexpr int A1_KH = 0, A1_KL = 9216;
__device__ __forceinline__ void top3_ins(float v, int n, float& v0, float& v1, float& v2, int& i0, int& i1, int& i2) {
    const bool c0 = v > v0, c1 = v > v1, c2 = v > v2;
    v2 = c1 ? v1 : (c2 ? v : v2); i2 = c1 ? i1 : (c2 ? n : i2);
    v1 = c0 ? v0 : (c1 ? v : v1); i1 = c0 ? i0 : (c1 ? n : i1);
    v0 = c0 ? v : v0;             i0 = c0 ? n : i0;
}
__device__ __forceinline__ void a1_phase(LAS unsigned char* lds, int vcu, int G, int wave_in) {
    int tid = lane_id(); asm volatile("" : "+v"(tid)); tid += 64 * wave_in;
    const int lane = tid & 63, wave = __builtin_amdgcn_readfirstlane(tid >> 6), q = lane & 31, hi = lane >> 5;
    unsigned char* const ws = PWS;
    const bf16* Q = (const bf16*)(ws + WS_Q); const float* kbarp = (const float*)(ws + WS_KBAR); unsigned* sel = (unsigned*)(ws + WS_SEL);
    for (int un = vcu; un < 256; un += G) {
        const int bh = un >> 3, mg = un & 7, b = bh >> 4, h = bh & 15;
        LDS_BARRIER();
        { const int n = tid >> 3, d0 = (tid & 7) * 8;
          const float* p = kbarp + ((size_t)bh * 64 + n) * 128 + d0;
          const f32x4 a0 = *(const f32x4*)p, a1 = *(const f32x4*)(p + 4), b0 = *(const f32x4*)(p + 64), b1 = *(const f32x4*)(p + 68);
          const f32x4 v0 = (a0 + b0) * (1.0f / 256.0f), v1 = (a1 + b1) * (1.0f / 256.0f);
          unsigned hb[8], lb[8];
#pragma unroll
          for (int e = 0; e < 8; ++e) { const float v = (e < 4) ? v0[e & 3] : v1[e & 3]; hb[e] = f2bf(v); lb[e] = f2bf(v - bf2f(hb[e])); }
          u32x4 wh, wl; wh.x = hb[0] | (hb[1] << 16); wh.y = hb[2] | (hb[3] << 16); wh.z = hb[4] | (hb[5] << 16); wh.w = hb[6] | (hb[7] << 16);
          wl.x = lb[0] | (lb[1] << 16); wl.y = lb[2] | (lb[3] << 16); wl.z = lb[4] | (lb[5] << 16); wl.w = lb[6] | (lb[7] << 16);
          *(LAS u32x4*)(lds + A1_KH + n * 144 + d0 * 2) = wh; *(LAS u32x4*)(lds + A1_KL + n * 144 + d0 * 2) = wl; }
        LDS_BARRIER();
        bf16x8 qn[4];
        { const size_t row0 = (size_t)b * S_ + 256 * (mg * 8) + 32 * wave + q;
#pragma unroll
          for (int d0 = 0; d0 < 4; ++d0) qn[d0] = *(const bf16x8*)(Q + row0 * D_ + h * 64 + 16 * d0 + 8 * hi); }
        for (int mi = 0; mi < 8; ++mi) {
            const int m = mg * 8 + mi, t = 256 * m + 32 * wave + q;
            bf16x8 qf[4];
#pragma unroll
            for (int d0 = 0; d0 < 4; ++d0) qf[d0] = qn[d0];
            if (mi < 7) { const size_t rown = (size_t)b * S_ + t + 256;
#pragma unroll
                for (int d0 = 0; d0 < 4; ++d0) qn[d0] = *(const bf16x8*)(Q + rown * D_ + h * 64 + 16 * d0 + 8 * hi); }
            if (m == 0) { if (hi == 0) sel[(size_t)bh * S_ + t] = 0x00FFFFFFu; continue; }
            f32x16 c0, c1;
#pragma unroll
            for (int k = 0; k < 16; ++k) { c0[k] = 0.f; c1[k] = 0.f; }
            const LAS unsigned char* kp = lds + q * 144 + 16 * hi;
#pragma unroll
            for (int d0 = 0; d0 < 4; ++d0) {
                const bf16x8 h0 = *(const LAS bf16x8*)(kp + A1_KH + 32 * d0), h1 = *(const LAS bf16x8*)(kp + A1_KH + 32 * 144 + 32 * d0);
                const bf16x8 l0 = *(const LAS bf16x8*)(kp + A1_KL + 32 * d0), l1 = *(const LAS bf16x8*)(kp + A1_KL + 32 * 144 + 32 * d0);
                c0 = __builtin_amdgcn_mfma_f32_32x32x16_bf16(h0, qf[d0], c0, 0, 0, 0); c1 = __builtin_amdgcn_mfma_f32_32x32x16_bf16(h1, qf[d0], c1, 0, 0, 0);
                c0 = __builtin_amdgcn_mfma_f32_32x32x16_bf16(l0, qf[d0], c0, 0, 0, 0); c1 = __builtin_amdgcn_mfma_f32_32x32x16_bf16(l1, qf[d0], c1, 0, 0, 0);
            }
            float v0 = -INFINITY, v1 = -INFINITY, v2 = -INFINITY; int i0 = 255, i1 = 255, i2 = 255;
#pragma unroll
            for (int r = 0; r < 16; ++r) { const int n = (r & 3) + 8 * (r >> 2) + 4 * hi; top3_ins((n < m) ? c0[r] : -INFINITY, n, v0, v1, v2, i0, i1, i2); }
#pragma unroll
            for (int r = 0; r < 16; ++r) { const int n = 32 + (r & 3) + 8 * (r >> 2) + 4 * hi; top3_ins((n < m) ? c1[r] : -INFINITY, n, v0, v1, v2, i0, i1, i2); }
            const float pv0 = __builtin_bit_cast(float, other32(__builtin_bit_cast(unsigned, v0), hi)), pv1 = __builtin_bit_cast(float, other32(__builtin_bit_cast(unsigned, v1), hi)), pv2 = __builtin_bit_cast(float, other32(__builtin_bit_cast(unsigned, v2), hi));
            const int pi0 = (int)other32((unsigned)i0, hi), pi1 = (int)other32((unsigned)i1, hi), pi2 = (int)other32((unsigned)i2, hi);
            top3_ins(pv0, pi0, v0, v1, v2, i0, i1, i2); top3_ins(pv1, pi1, v0, v1, v2, i0, i1, i2); top3_ins(pv2, pi2, v0, v1, v2, i0, i1, i2);
            if (hi == 0) sel[(size_t)bh * S_ + t] = (unsigned)i0 | ((unsigned)i1 << 8) | ((unsigned)i2 << 16);
        }
    }
}
#ifndef MK_MULTI
#define MK_MULTI 0
#endif
constexpr int NPH = 18;
struct Args { const float* in[19]; float* out; unsigned char* ws; int lo, hi; };
__global__ void __launch_bounds__(512, 2) fwd(Args a) {
    extern __shared__ __attribute__((aligned(16))) unsigned char lds_raw[];
    LAS unsigned char* lds = (LAS unsigned char*)lds_raw;
    const int tid = threadIdx.x, G = gridDim.x; const int wave = __builtin_amdgcn_readfirstlane(tid >> 6);
    const int vcu = (G % 8 == 0) ? ((int)blockIdx.x % 8) * (G / 8) + (int)blockIdx.x / 8 : (int)blockIdx.x;
    volatile LAS unsigned* MISC = (volatile LAS unsigned*)(lds + MISC_OFF);
    for (int u = tid; u < (LDS_BYTES - LDSCTL_OFF) / 4; u += 512) ((LAS unsigned*)(lds + LDSCTL_OFF))[u] = 0u;
    __syncthreads();
    if (tid == 0) {
        LAS unsigned long long* PT = (LAS unsigned long long*)(lds + PT_OFF);
#pragma unroll
        for (int i = 0; i < 19; ++i) PT[i] = (unsigned long long)a.in[i];
        PT[19] = (unsigned long long)a.out; PT[20] = (unsigned long long)a.ws;
        ((LAS int*)(lds + PT_OFF))[48] = a.lo; ((LAS int*)(lds + PT_OFF))[49] = a.hi;
    }
    __syncthreads();
    if (a.hi - a.lo > 1) (void)xcd_barrier_post((unsigned*)(a.ws + WS_CTL) + CW_BAR, MISC + 8);
#define LO (__builtin_amdgcn_readfirstlane(((volatile LAS int*)(lds + PT_OFF))[48]))
#define HI (__builtin_amdgcn_readfirstlane(((volatile LAS int*)(lds + PT_OFF))[49]))
#define IN(k) (LO <= (k) && (k) < HI)
#define SEAM(k) do { if (IN(k) && IN((k) + 1)) { XcdBarrier bar_; bar_.bar = (unsigned*)(PWS + WS_CTL) + CW_BAR; bar_.x = xb_xcc_id(); bar_.st = MISC + 8; xcd_barrier(bar_); } } while (0)

    if (IN(0)) { __syncthreads(); phase_p0(lds, vcu, G, wave); }
    SEAM(0);
    if (IN(1)) { __syncthreads(); phase_p1(lds, vcu, G, wave); }
    SEAM(1);

    int ph = 2;
#pragma unroll 1
    for (int sl = 0; sl < 6; ++sl) {
        if (sl == 1) {
            if (IN(ph)) { __syncthreads(); unsigned char* const ws = PWS;
                EpiQKV E{(bf16*)(ws + WS_Q), (const float*)(ws + WS_BQKV), (const float*)(ws + WS_SSQ), PIN(8), PIN(9), (float*)(ws + WS_KBAR), lds};
                __syncthreads(); run_gemm(lds, (const bf16*)(ws + WS_XB), (const bf16*)(ws + WS_WQKV), 3072L * 1024 * 2, 3072, 1024, G, E, wave);
            }
            SEAM(ph); ++ph;
            if (IN(ph)) { __syncthreads(); a1_phase(lds, vcu, G, wave); }
            SEAM(ph); ++ph;
            if (IN(ph)) { __syncthreads(); a2_phase(lds, wave, CW_Q2); }
            SEAM(ph); ++ph;
            if (IN(ph)) { __syncthreads(); a3_phase(lds, vcu, G, wave); }
            SEAM(ph); ++ph;
        } else if (sl == 4) {
            if (IN(ph)) { __syncthreads(); unsigned char* const ws = PWS;
                EpiGated<1> E{(bf16*)(ws + WS_U), 1024, (const float*)(ws + WS_BPW1), 2048, (const float*)(ws + WS_SSQ), lds};
                __syncthreads(); run_gemm(lds, (const bf16*)(ws + WS_XB), (const bf16*)(ws + WS_WPW1), 2048L * 1024 * 2, 2048, 1024, G, E, wave);
            }
            SEAM(ph); ++ph;
            if (IN(ph)) { __syncthreads(); conv_phase(lds, vcu, G, wave); }
            SEAM(ph); ++ph;
        } else {
            const int f = (sl / 3) * 2 + ((sl % 3) == 2);
            if (IN(ph)) { __syncthreads(); unsigned char* const ws = PWS;
                EpiGated<0> E{(bf16*)(ws + WS_ACT), FF_, (const float*)(ws + WS_BFFN) + (size_t)f * 2 * 5632, 5632, (const float*)(ws + WS_SSQ), lds};
                __syncthreads(); run_gemm(lds, (const bf16*)(ws + WS_XB), (const bf16*)(ws + WS_WIN) + (size_t)f * 2 * 5632 * 1024, 5632L * 1024 * 2, 5632, 1024, G, E, wave);
            }
            SEAM(ph); ++ph;
        }
        if (IN(ph)) { __syncthreads(); unsigned char* const ws = PWS; float* const out = POUT;
            const bf16* Ares; const bf16* Wres; int Kres; const float* bias2 = nullptr;
            if (sl == 1) { Ares = (const bf16*)(ws + WS_Q); Wres = (const bf16*)(ws + WS_WO); Kres = 1024; }
            else if (sl == 4) { Ares = (const bf16*)(ws + WS_CV); Wres = (const bf16*)(ws + WS_WPW2); Kres = 1024; bias2 = PIN(18); }
            else { const int f = (sl / 3) * 2 + ((sl % 3) == 2); Ares = (const bf16*)(ws + WS_ACT); Wres = (const bf16*)(ws + WS_WOUT) + (size_t)f * 1024 * 2816; Kres = FF_; }
            EpiRes E{(bf16*)(ws + WS_XB), out, bias2, (const float*)(ws + WS_COEF) + (size_t)sl * 2048, (float*)(ws + WS_SSQ), (sl == 5) ? 1 : 0, lds};
            run_gemm(lds, Ares, Wres, 0L, 1024, Kres, G, E, wave);
        }
        SEAM(ph); ++ph;
    }
#undef IN
#undef SEAM
}

extern "C" void kernel_launch(void* const* d_in, const int* in_sizes, int n_in, void* d_out, int out_size, void* d_ws, size_t ws_size, hipStream_t stream) {
    static int grid = 0;
    if (grid == 0) {
        if (n_in != 19 || in_sizes[0] != M_ * D_ || out_size != M_ * D_ || ws_size < WS_END) {
            fprintf(stderr, "kernel_launch: unexpected problem (n_in %d, in0 %d, out %d, ws %zu); nothing launched\n", n_in, n_in > 0 ? in_sizes[0] : -1, out_size, ws_size); grid = -1; return; }
        int dev = 0, cus = 0;
        if (hipGetDevice(&dev) != hipSuccess || hipDeviceGetAttribute(&cus, hipDeviceAttributeMultiprocessorCount, dev) != hipSuccess) { grid = -1; return; }
        if (hipFuncSetAttribute((const void*)fwd, hipFuncAttributeMaxDynamicSharedMemorySize, LDS_BYTES) != hipSuccess) { fprintf(stderr, "kernel_launch: hipFuncSetAttribute failed\n"); grid = -1; return; }
        int per_cu = 0;
        if (hipOccupancyMaxActiveBlocksPerMultiprocessor(&per_cu, (const void*)fwd, 512, LDS_BYTES) != hipSuccess || per_cu < 1) fprintf(stderr, "kernel_launch: occupancy query reports %d blocks per CU\n", per_cu);
        (void)hipGetLastError();
        grid = cus;
    }
    if (grid < 0) return;
    if (hipMemsetAsync((char*)d_ws + WS_CTL, 0, CTL_ZERO_BYTES, stream) != hipSuccess) return;
    Args a{};
    for (int i = 0; i < 19; ++i) a.in[i] = (const float*)d_in[i];
    a.out = (float*)d_out; a.ws = (unsigned char*)d_ws;
#if MK_MULTI
    for (int p = 0; p < NPH; ++p) { a.lo = p; a.hi = p + 1; hipLaunchKernelGGL(fwd, dim3(grid), dim3(512), LDS_BYTES, stream, a); }
#else
    a.lo = 0; a.hi = NPH; hipLaunchKernelGGL(fwd, dim3(grid), dim3(512), LDS_BYTES, stream, a);
#endif
}
```

```cpp
#define F8MASK 8
#include <hip/hip_runtime.h>
#include <cstdio>
#include <cstdint>
#include <cmath>
namespace pg8 {
#define PG8_LAS __attribute__((address_space(3)))
typedef unsigned short bf16_t;
typedef short bf16x8 __attribute__((ext_vector_type(8)));
typedef float f32x4 __attribute__((ext_vector_type(4)));
typedef unsigned u32x4 __attribute__((ext_vector_type(4)));
constexpr int BM = 256, BK = 64, HALF = 128, HTB = HALF * BK * 2  , STAGE_BYTES = 8 * HTB, NXCD = 8, WGM = 8;

__host__ __device__ __forceinline__ int lds_byte(int r, int c) { const int st = (r >> 4) * 2 + (c >> 5), rr = r & 15, cc = c & 31, ob = rr * 64 + cc * 2; return st * 1024 + (ob ^ (((ob >> 9) & 1) << 5)); }
__host__ __device__ __forceinline__ void stage_rc(int b, int& R, int& C) { const int st = b / 1024, sb = b % 1024, swz = sb ^ (((sb >> 9) & 1) << 5); R = (st >> 1) * 16 + swz / 64; C = (st & 1) * 32 + (swz % 64) / 2; }
__host__ __device__ __forceinline__ int perm32(int rho) { const int n = rho >> 4, i = rho & 15; return 8 * (i >> 2) + 4 * n + (i & 3); }

struct Unit { int pm, pn; };
struct Gemm { const bf16_t* A; const bf16_t* Bt; int M, N, K; long bb; };

struct StaticOrder {
    int nM, nN, nwg, G, c;
    __host__ __device__ void init(int M, int N, int G_, int c_) { nM = M / BM; nN = N / BM; nwg = nM * nN; G = G_; c = c_; }
    __host__ __device__ bool next(int i, Unit& u) const {
        const long L = (long)i * G + c; if (L >= nwg) return false;
        int wgid = (int)L; { const int q = nwg / NXCD, r = nwg % NXCD, xcd = wgid % NXCD, off = wgid / NXCD; wgid = (xcd < r ? xcd * (q + 1) : r * (q + 1) + (xcd - r) * q) + off; }
        const int nig = WGM * nN, gid = wgid / nig, fm = gid * WGM, gsz = (nM - fm) < WGM ? (nM - fm) : WGM;
        u.pm = fm + ((wgid % nig) % gsz); u.pn = (wgid % nig) / gsz; return true;
    }
    __device__ __forceinline__ void a_ready(const Unit&) const {}
    __device__ __forceinline__ void done(const Unit&) const {}
};

__device__ __forceinline__ unsigned cvt_pk_bf16(float lo, float hi) { unsigned r; asm volatile("v_cvt_pk_bf16_f32 %0, %1, %2" : "=v"(r) : "v"(lo), "v"(hi)); return r; }
typedef float f32x2 __attribute__((ext_vector_type(2)));
template <class Epi, class Sched, bool ALIGN_EPI = false, bool SP2 = false, bool F8 = false>
__device__ __forceinline__ void gemm_phase(PG8_LAS unsigned char* lds, const Gemm g, const Sched& S, const Epi& E, const int tid_in) {
    typedef int pg8_i32x8 __attribute__((ext_vector_type(8))); typedef int pg8_i32x4 __attribute__((ext_vector_type(4)));
    const int tid = tid_in, wid = __builtin_amdgcn_readfirstlane(tid >> 6), lane = tid & 63, wr = wid >> 2, wc = wid & 3, fr = lane & 15, fq = lane >> 4;
    const int K = g.K, nt = K / BK;
    unsigned voffA[2], voffB[2];
#pragma unroll
    for (int i = 0; i < 2; ++i) { int R, C; stage_rc(tid * 16 + i * 8192, R, C); const int Rb = Epi::PERM ? ((R & ~31) + perm32(R & 31)) : R;
        voffA[i] = (unsigned)(R * K + C) * 2u; voffB[i] = (unsigned)(Rb * K + C) * 2u; }
    const __amdgpu_buffer_rsrc_t rs_voffA = __builtin_amdgcn_make_buffer_rsrc((void*)g.A, 0, -1, 0x00020000), rs_voffB = __builtin_amdgcn_make_buffer_rsrc((void*)g.Bt, 0, -1, 0x00020000);
    const unsigned kstep = (unsigned)(BK * 2);
    const unsigned hstep = (unsigned)(HALF * K * 2);
    const unsigned tstep = 2u * hstep;
    const unsigned ldsw = (unsigned)wid * 1024u;
    const int aoff = lds_byte(wr * 64 + fr, fq * 8), boff = lds_byte(wc * 32 + fr, fq * 8);
#define PG8_SA(b, h) (((b) * 2 + (h)) * HTB)
#define PG8_SB(b, h) ((4 + (b) * 2 + (h)) * HTB)
#define PG8_STAGE(bufoff, soff, voff) do { _Pragma("unroll") for (int _i = 0; _i < 2; ++_i) \
        __builtin_amdgcn_raw_ptr_buffer_load_lds(rs_##voff, (PG8_LAS void*)(lds + (bufoff) + ldsw + _i * 8192), 16, (int)(voff)[_i], (int)(soff), 0, 0); } while (0)
#define PG8_LD8(off) __builtin_shufflevector(*(const PG8_LAS pg8_i32x4*)(lds + (off)), *(const PG8_LAS pg8_i32x4*)(lds + (off) + 1024), 0, 1, 2, 3, 4, 5, 6, 7)
#define PG8_LDA(dst, b, h) do { if constexpr (F8) { _Pragma("unroll") for (int m = 0; m < 4; ++m) dst##8[m] = PG8_LD8(PG8_SA(b, h) + aoff + m * 2048); } else { \
        _Pragma("unroll") for (int m = 0; m < 4; ++m) _Pragma("unroll") for (int k = 0; k < 2; ++k) dst[m][k] = *(const PG8_LAS bf16x8*)(lds + PG8_SA(b, h) + aoff + m * 2048 + k * 1024); } } while (0)
#define PG8_LDB(dst, b, h) do { if constexpr (F8) { _Pragma("unroll") for (int n = 0; n < 2; ++n) dst##8[n] = PG8_LD8(PG8_SB(b, h) + boff + n * 2048); } else { \
        _Pragma("unroll") for (int n = 0; n < 2; ++n) _Pragma("unroll") for (int k = 0; k < 2; ++k) dst[n][k] = *(const PG8_LAS bf16x8*)(lds + PG8_SB(b, h) + boff + n * 2048 + k * 1024); } } while (0)
#ifndef PG8_PRIO_MMA
#define PG8_PRIO_MMA 3
#define PG8_PRIO_LOAD 0
#endif
#define PG8_MMA(ai, bj, At, Bt) do { __builtin_amdgcn_s_setprio(PG8_PRIO_MMA); \
        if constexpr (F8) { _Pragma("unroll") for (int m = 0; m < 4; ++m) _Pragma("unroll") for (int n = 0; n < 2; ++n) \
            asm volatile("v_mfma_scale_f32_16x16x128_f8f6f4 %0, %1, %2, %0, %3, %3 op_sel_hi:[0,0,0]" : "+v"(acc[ai][bj][m][n]) : "v"(Bt##8[n]), "v"(At##8[m]), "v"(sc1)); } \
        else { _Pragma("unroll") for (int m = 0; m < 4; ++m) _Pragma("unroll") for (int n = 0; n < 2; ++n) _Pragma("unroll") for (int k = 0; k < 2; ++k) \
            acc[ai][bj][m][n] = __builtin_amdgcn_mfma_f32_16x16x32_bf16(Bt[n][k], At[m][k], acc[ai][bj][m][n], 0, 0, 0); } \
        __builtin_amdgcn_s_setprio(PG8_PRIO_LOAD); } while (0)
#define PG8_WAIT_V(n) asm volatile("s_waitcnt vmcnt(" #n ")" ::: "memory")
#define PG8_WAIT_L(n) asm volatile("s_waitcnt lgkmcnt(" #n ")" ::: "memory")
#define PG8_BAR __builtin_amdgcn_s_barrier()
#define PG8_SCHED __builtin_amdgcn_sched_barrier(0)
    Unit cur, nxt; int ui = 0;
    if (!S.next(0, cur)) return;
    f32x4 acc[2][2][4][2];
#pragma unroll
    for (int a = 0; a < 2; ++a)
#pragma unroll
        for (int b = 0; b < 2; ++b)
#pragma unroll
            for (int m = 0; m < 4; ++m)
#pragma unroll
                for (int n = 0; n < 2; ++n) acc[a][b][m][n] = (f32x4){0.f, 0.f, 0.f, 0.f};
    bf16x8 At[4][2], B0[2][2], B1[2][2]; pg8_i32x8 At8[4], B08[2], B18[2];
    int sc1 = 0x7F7F7F7F; asm volatile("" : "+v"(sc1));
    unsigned cA = (unsigned)cur.pm * tstep, cB = (unsigned)cur.pn * tstep + (unsigned)(cur.pm >> 6) * (unsigned)g.bb;
    S.a_ready(cur);
    if constexpr (SP2) {
        PG8_STAGE(PG8_SB(0, 0), cB, voffB); PG8_STAGE(PG8_SB(0, 1), cB + hstep, voffB); PG8_STAGE(PG8_SA(0, 0), cA, voffA); PG8_STAGE(PG8_SA(0, 1), cA + hstep, voffA);
        if (wr == 1) PG8_BAR;
        PG8_WAIT_V(2); PG8_BAR;
        PG8_STAGE(PG8_SB(1, 0), cB + kstep, voffB); PG8_STAGE(PG8_SA(1, 0), cA + kstep, voffA); PG8_STAGE(PG8_SB(1, 1), cB + hstep + kstep, voffB);
        PG8_WAIT_V(6); PG8_BAR;
    } else {
        PG8_STAGE(PG8_SB(0, 0), cB, voffB); PG8_STAGE(PG8_SA(0, 0), cA, voffA); PG8_STAGE(PG8_SB(0, 1), cB + hstep, voffB); PG8_STAGE(PG8_SA(0, 1), cA + hstep, voffA);
        if (wr == 1) PG8_BAR;
        PG8_WAIT_V(4); PG8_BAR;
        PG8_STAGE(PG8_SB(1, 0), cB + kstep, voffB); PG8_STAGE(PG8_SA(1, 0), cA + kstep, voffA); PG8_STAGE(PG8_SB(1, 1), cB + hstep + kstep, voffB);
        PG8_WAIT_V(6); PG8_BAR;
    }
    for (;;) {
        const bool has_next = S.next(ui + 1, nxt);
        const unsigned nA = has_next ? (unsigned)nxt.pm * tstep : cA, nB = has_next ? (unsigned)nxt.pn * tstep + (unsigned)(nxt.pm >> 6) * (unsigned)g.bb : cB;
        for (int t = 0; t < nt; t += 2) {
            const bool last = (t == nt - 2);
            const unsigned a1 = cA + (unsigned)(t + 1) * kstep;
            const unsigned a2 = last ? nA : cA + (unsigned)(t + 2) * kstep, b2 = last ? nB : cB + (unsigned)(t + 2) * kstep;
            const unsigned a3 = a2 + kstep, b3 = b2 + kstep;
            if (last && has_next) S.a_ready(nxt);
            if constexpr (SP2) {
            PG8_STAGE(PG8_SA(1, 1), a1 + hstep, voffA); PG8_SCHED; PG8_LDB(B0, 0, 0); PG8_LDB(B1, 0, 1); PG8_SCHED; PG8_LDA(At, 0, 0);
            PG8_WAIT_V(8); PG8_WAIT_L(0); PG8_BAR; PG8_MMA(0, 0, At, B0); PG8_MMA(0, 1, At, B1); PG8_BAR; PG8_SCHED;
            PG8_STAGE(PG8_SB(0, 0), b2, voffB); PG8_STAGE(PG8_SB(0, 1), b2 + hstep, voffB); PG8_STAGE(PG8_SA(0, 0), a2, voffA); PG8_SCHED; PG8_LDA(At, 0, 1);
            PG8_WAIT_V(8); PG8_WAIT_L(0); PG8_BAR; PG8_MMA(1, 0, At, B0); PG8_MMA(1, 1, At, B1); PG8_BAR; PG8_SCHED;
            PG8_STAGE(PG8_SA(0, 1), a2 + hstep, voffA); PG8_SCHED; PG8_LDB(B0, 1, 0); PG8_LDB(B1, 1, 1); PG8_SCHED; PG8_LDA(At, 1, 0);
            PG8_WAIT_V(8); PG8_WAIT_L(0); PG8_BAR; PG8_MMA(0, 0, At, B0); PG8_MMA(0, 1, At, B1); PG8_BAR; PG8_SCHED;
            PG8_STAGE(PG8_SB(1, 0), b3, voffB); PG8_STAGE(PG8_SB(1, 1), b3 + hstep, voffB); PG8_STAGE(PG8_SA(1, 0), a3, voffA); PG8_SCHED; PG8_LDA(At, 1, 1);
            PG8_WAIT_V(8); PG8_WAIT_L(0); PG8_BAR; PG8_MMA(1, 0, At, B0); PG8_MMA(1, 1, At, B1); PG8_BAR; PG8_SCHED;
            } else {
            PG8_LDB(B0, 0, 0); PG8_SCHED; PG8_LDA(At, 0, 0); PG8_STAGE(PG8_SA(1, 1), a1 + hstep, voffA);
            PG8_WAIT_L(8); PG8_BAR; PG8_WAIT_L(0); PG8_MMA(0, 0, At, B0); PG8_BAR; PG8_SCHED;
            PG8_LDB(B1, 0, 1); PG8_STAGE(PG8_SB(0, 0), b2, voffB);
            PG8_BAR; PG8_WAIT_L(0); PG8_MMA(0, 1, At, B1); PG8_BAR;
            PG8_LDA(At, 0, 1); PG8_STAGE(PG8_SA(0, 0), a2, voffA);
            PG8_BAR; PG8_WAIT_L(0); PG8_MMA(1, 0, At, B0); PG8_BAR; PG8_SCHED;
            PG8_STAGE(PG8_SB(0, 1), b2 + hstep, voffB);
            PG8_WAIT_V(6); PG8_BAR; PG8_MMA(1, 1, At, B1); PG8_BAR;
            PG8_LDB(B0, 1, 0); PG8_SCHED; PG8_LDA(At, 1, 0); PG8_STAGE(PG8_SA(0, 1), a2 + hstep, voffA);
            PG8_WAIT_L(8); PG8_BAR; PG8_WAIT_L(0); PG8_MMA(0, 0, At, B0); PG8_BAR; PG8_SCHED;
            PG8_LDB(B1, 1, 1); PG8_STAGE(PG8_SB(1, 0), b3, voffB);
            PG8_BAR; PG8_WAIT_L(0); PG8_MMA(0, 1, At, B1); PG8_BAR;
            PG8_LDA(At, 1, 1); PG8_STAGE(PG8_SA(1, 0), a3, voffA);
            PG8_BAR; PG8_WAIT_L(0); PG8_MMA(1, 0, At, B0); PG8_BAR; PG8_SCHED;
            PG8_STAGE(PG8_SB(1, 1), b3 + hstep, voffB);
            PG8_WAIT_V(6); PG8_BAR; PG8_MMA(1, 1, At, B1); PG8_BAR;
            }
        }
        if constexpr (ALIGN_EPI) { if (wr == 0) PG8_BAR; }
        if constexpr (!Epi::AFTER_DRAIN) { E(acc, cur, wr, wc, fr, fq); S.done(cur); }
        if (!has_next) break;
#pragma unroll
        for (int a = 0; a < 2; ++a)
#pragma unroll
            for (int b = 0; b < 2; ++b)
#pragma unroll
                for (int m = 0; m < 4; ++m)
#pragma unroll
                    for (int n = 0; n < 2; ++n) acc[a][b][m][n] = (f32x4){0.f, 0.f, 0.f, 0.f};
        cur = nxt; cA = nA; cB = nB; ++ui;
        if constexpr (ALIGN_EPI) { if (wr == 1) PG8_BAR; }
    }
    PG8_WAIT_V(0);
    if constexpr (!ALIGN_EPI) { if (wr == 0) PG8_BAR; }
    PG8_BAR;
    if constexpr (Epi::AFTER_DRAIN) { E.fused(acc, cur, wr, wc, fr, fq, lds, wid, lane); S.done(cur); }
#undef PG8_SA
#undef PG8_SB
#undef PG8_STAGE
#undef PG8_LDA
#undef PG8_LD8
#undef PG8_LDB
#undef PG8_MMA
#undef PG8_WAIT_V
#undef PG8_WAIT_L
#undef PG8_BAR
#undef PG8_SCHED
}
}
constexpr int NB_ = 2, S_ = 16384, D_ = 1024, M_ = NB_ * S_, H_ = 16, HD_ = 64, FF_ = 2816, NBLK_ = 64;
constexpr float LOG2E_ = 1.4426950408889634f;
constexpr float C2_ = 0.125f * LOG2E_;
constexpr float EPS_ = 1e-6f;

constexpr size_t MiB = 1u << 20;
constexpr size_t WS_CTL = 0, CTL_ZERO_BYTES = 64 * 1024;
constexpr size_t WS_MOD  = 1 * MiB;
constexpr size_t WS_GM   = WS_MOD + 256 * 1024;
constexpr size_t WS_COEF = WS_GM + 64 * 1024;
constexpr size_t WS_BFFN = WS_COEF + 64 * 1024;
constexpr size_t WS_BQKV = WS_BFFN + 192 * 1024;
constexpr size_t WS_BPW1 = WS_BQKV + 32 * 1024;
constexpr size_t WS_SSQ  = 4 * MiB;
constexpr size_t WS_KBAR = 6 * MiB;
constexpr size_t WS_SEL  = 7 * MiB;
constexpr size_t WS_LP   = 9 * MiB;
constexpr size_t WS_WIN  = 16 * MiB;
constexpr size_t WS_WQKV = 104 * MiB;
constexpr size_t WS_WPW1 = 116 * MiB;
constexpr size_t WS_WOUT = 124 * MiB;
constexpr size_t WS_WO   = 146 * MiB;
constexpr size_t WS_WPW2 = 148 * MiB;
constexpr size_t WS_XB   = 152 * MiB;
constexpr size_t WS_BIG  = 216 * MiB;
constexpr size_t WS_ACT  = WS_BIG;
constexpr size_t WS_Q = WS_BIG, WS_K = WS_BIG + 64 * MiB, WS_V = WS_BIG + 128 * MiB;
constexpr size_t WS_OP3 = 408 * MiB;
constexpr size_t WS_U = WS_BIG, WS_CV = WS_BIG + 64 * MiB;
constexpr size_t WS_X8  = 472 * MiB;
constexpr size_t WS_END = 504 * MiB;
constexpr float W8_SCALE = 64.0f;
#ifndef F8MASK
#define F8MASK 0
#endif
constexpr int CW_BAR = 1024;

constexpr int RING_BYTES = 131072;
constexpr int LDSCTL_OFF = RING_BYTES, MISC_OFF = LDSCTL_OFF + 320;
constexpr int LDS_BYTES = 160768;
constexpr int LT_PM = LDSCTL_OFF + 896, LT_RSTD = LDSCTL_OFF + 1024, LT_VEC = LDSCTL_OFF + 3072;

#define GAS __attribute__((address_space(1)))
#define LAS __attribute__((address_space(3)))
typedef unsigned short bf16;
typedef float f32x4 __attribute__((ext_vector_type(4)));
typedef unsigned u32x4 __attribute__((ext_vector_type(4)));
typedef unsigned u32x2 __attribute__((ext_vector_type(2)));
typedef short bf16x8 __attribute__((ext_vector_type(8)));
typedef float f32x16 __attribute__((ext_vector_type(16)));
#define LDS_WAIT() asm volatile("s_waitcnt lgkmcnt(0)" ::: "memory")
#define VM_WAIT() asm volatile("s_waitcnt vmcnt(0)" ::: "memory")
#define LDS_BARRIER() do { asm volatile("s_waitcnt lgkmcnt(0)" ::: "memory"); __builtin_amdgcn_s_barrier(); asm volatile("" ::: "memory"); } while (0)
__device__ __forceinline__ unsigned f2bf(float f) { unsigned u = __builtin_bit_cast(unsigned, f); return (u + 0x7fffu + ((u >> 16) & 1u)) >> 16; }
__device__ __forceinline__ unsigned pk2(float lo, float hi) { return f2bf(lo) | (f2bf(hi) << 16); }
typedef __bf16 bf16x2_t __attribute__((ext_vector_type(2))); typedef float f32x2_t __attribute__((ext_vector_type(2)));
__device__ __forceinline__ unsigned cvtpk(float lo, float hi) { const f32x2_t v = {lo, hi}; const bf16x2_t b = __builtin_convertvector(v, bf16x2_t); return __builtin_bit_cast(unsigned, b); }
__device__ __forceinline__ float bf2f(unsigned h) { return __builtin_bit_cast(float, h << 16); }
__device__ __forceinline__ float bflo(unsigned w) { return __builtin_bit_cast(float, w << 16); }
__device__ __forceinline__ float bfhi(unsigned w) { return __builtin_bit_cast(float, w & 0xffff0000u); }
template <int CTRL> __device__ __forceinline__ float dppf(float v) { return __builtin_bit_cast(float, __builtin_amdgcn_mov_dpp(__builtin_bit_cast(int, v), CTRL, 0xF, 0xF, true)); }
typedef unsigned u32x2v __attribute__((ext_vector_type(2)));
__device__ __forceinline__ float u2f(unsigned u) { return __builtin_bit_cast(float, u); }
__device__ __forceinline__ unsigned f2u(float f) { return __builtin_bit_cast(unsigned, f); }
__device__ __forceinline__ float sum16(float v) { const auto r = __builtin_amdgcn_permlane16_swap(f2u(v), f2u(v), false, false); const unsigned r0 = r[0], r1 = r[1]; return u2f(r0) + u2f(r1); }
__device__ __forceinline__ float sum32(float v) { const auto r = __builtin_amdgcn_permlane32_swap(f2u(v), f2u(v), false, false); const unsigned r0 = r[0], r1 = r[1]; return u2f(r0) + u2f(r1); }
__device__ __forceinline__ float max16(float v) { const auto r = __builtin_amdgcn_permlane16_swap(f2u(v), f2u(v), false, false); const unsigned r0 = r[0], r1 = r[1]; return fmaxf(u2f(r0), u2f(r1)); }
__device__ __forceinline__ float max32(float v) { const auto r = __builtin_amdgcn_permlane32_swap(f2u(v), f2u(v), false, false); const unsigned r0 = r[0], r1 = r[1]; return fmaxf(u2f(r0), u2f(r1)); }
__device__ __forceinline__ float row_sum16(float v) { v += dppf<0xB1>(v); v += dppf<0x4E>(v); v += dppf<0x141>(v); v += dppf<0x140>(v); return v; }
__device__ __forceinline__ float wave_sum(float v) { v = row_sum16(v); v = sum16(v); return sum32(v); }
__device__ __forceinline__ float wave_max(float v) { v = fmaxf(v, dppf<0xB1>(v)); v = fmaxf(v, dppf<0x4E>(v)); v = fmaxf(v, dppf<0x141>(v)); v = fmaxf(v, dppf<0x140>(v)); v = max16(v); return max32(v); }
__device__ __forceinline__ unsigned other32(unsigned v, int hi) { const auto r = __builtin_amdgcn_permlane32_swap(v, v, false, false); const unsigned r0 = r[0], r1 = r[1]; return hi ? r0 : r1; }
#define XB_TMO      128
#define XB_XCNT(j)  (256  + 64 * (j))
#define XB_XSUB(j)  (1280 + 64 * (j))
#define XB_XGEN(j)  (2304 + 64 * (j))
#define XB_TOP      3328
#define XB_TOPGEN   3392
#define XCD_BAR_WORDS 3456
#define XB_SPIN_CAP (1u << 18)

__device__ __forceinline__ unsigned xb_ld(unsigned* p)              { return __hip_atomic_load(p, __ATOMIC_RELAXED, __HIP_MEMORY_SCOPE_AGENT); }
__device__ __forceinline__ unsigned xb_add(unsigned* p, unsigned v) { return __hip_atomic_fetch_add(p, v, __ATOMIC_RELAXED, __HIP_MEMORY_SCOPE_AGENT); }
__device__ __forceinline__ unsigned xb_xcc_id() { return (unsigned)__builtin_amdgcn_s_getreg((3 << 11) | 20) & 0xFu; }
#define XB_SPIN(cond, bar) do { unsigned _sp = 0; while (cond) { __builtin_amdgcn_s_sleep(1); \
    if ((++_sp & 255u) == 0u) { if (xb_ld(&(bar)[XB_TMO])) break; if (_sp > XB_SPIN_CAP) { atomicAdd(&(bar)[XB_TMO], 1u); break; } } } } while (0)

struct XcdBarrier {
    unsigned* bar; unsigned x;
    volatile LAS unsigned* st;
};

__device__ __forceinline__ XcdBarrier xcd_barrier_post(unsigned* bar, volatile LAS unsigned* st) {
    XcdBarrier b; b.bar = bar; b.x = xb_xcc_id(); b.st = st;
    if (threadIdx.x == 0) (void)xb_add(&bar[XB_XCNT(b.x)], 1u);
    return b;
}
__device__ __forceinline__ void xcd_barrier_complete(unsigned* bar, unsigned x, unsigned& nloc, unsigned& nx) {
    const unsigned G = gridDim.x * gridDim.y * gridDim.z;
    unsigned sum, cnt, mine, sp = 0u;
    for (;;) {
        sum = 0u; cnt = 0u; mine = 0u;
#pragma unroll
        for (unsigned j = 0; j < 16; ++j) { const unsigned c = xb_ld(&bar[XB_XCNT(j)]); sum += c; cnt += (c > 0u) ? 1u : 0u; mine = (j == x) ? c : mine; }
        if (sum == G) break;
        __builtin_amdgcn_s_sleep(1);
        if ((++sp & 255u) == 0u) { if (xb_ld(&bar[XB_TMO])) break; if (sp > XB_SPIN_CAP) { atomicAdd(&bar[XB_TMO], 1u); break; } }
    }
    nloc = mine > 0u ? mine : 1u; nx = cnt > 0u ? cnt : 1u;
}

__device__ __forceinline__ void xcd_barrier(const XcdBarrier& b) {
    asm volatile("s_waitcnt vmcnt(0)" ::: "memory");
    __syncthreads();
    if (threadIdx.x == 0) {
        unsigned* bar = b.bar;
        __builtin_amdgcn_s_waitcnt(0);
        unsigned nloc = b.st[0], nx = b.st[1];
        if (nloc == 0u) { xcd_barrier_complete(bar, b.x, nloc, nx); b.st[0] = nloc; b.st[1] = nx; }
        const unsigned old = xb_add(&bar[XB_XSUB(b.x)], 1u);
        const unsigned gen = old / nloc;
        if (old + 1u == (gen + 1u) * nloc) {
            __builtin_amdgcn_fence(__ATOMIC_RELEASE, "agent");
            asm volatile("s_waitcnt vmcnt(0)" ::: "memory");
            const unsigned og = xb_add(&bar[XB_TOP], 1u);
            const unsigned tg = og / nx;
            if (og + 1u == (tg + 1u) * nx) xb_add(&bar[XB_TOPGEN], 1u);
            else XB_SPIN(xb_ld(&bar[XB_TOPGEN]) == tg, bar);
            __builtin_amdgcn_fence(__ATOMIC_ACQUIRE, "agent");
            xb_add(&bar[XB_XGEN(b.x)], 1u);
            asm volatile("s_waitcnt vmcnt(0)" ::: "memory");
        } else {
            XB_SPIN(xb_ld(&bar[XB_XGEN(b.x)]) == gen, bar);
            __builtin_amdgcn_fence(__ATOMIC_ACQUIRE, "agent");
            asm volatile("s_waitcnt vmcnt(0)" ::: "memory");
        }
    }
    __syncthreads();
}
__device__ __forceinline__ int epi_tables_pm(LAS unsigned char* lds, const pg8::StaticOrder& S, int tid, int& pmA_out, int& pmB_out) {
    int pmA = -1, pmB = -1, ok = 1; pg8::Unit u;
    for (int i = 0; S.next(i, u); ++i) { if (pmA < 0) pmA = u.pm; else if (u.pm != pmA) { if (pmB < 0) pmB = u.pm; else if (u.pm != pmB) ok = 0; } }
    if (pmA < 0) pmA = 0;
    if (pmB < 0) pmB = pmA;
    if ((pmA >> 6) != (pmB >> 6)) ok = 0;
    if (tid == 0) { ((LAS int*)(lds + LT_PM))[0] = pmA; ((LAS int*)(lds + LT_PM))[1] = pmB; }
    pmA_out = pmA; pmB_out = pmB; return ok;
}
__device__ __forceinline__ void epi_tables_rstd(LAS unsigned char* lds, const float* ssq, int pmA, int pmB, int ok, int tid, float scale = 1.0f) {
    const int slot = tid >> 8, r = tid & 255, row = (slot ? pmB : pmA) * 256 + r;
    const f32x4 p0 = *(const f32x4*)(ssq + (size_t)row * 16), p1 = *(const f32x4*)(ssq + (size_t)row * 16 + 4), p2 = *(const f32x4*)(ssq + (size_t)row * 16 + 8), p3 = *(const f32x4*)(ssq + (size_t)row * 16 + 12);
    const float sm = (((p0.x + p0.y) + (p0.z + p0.w)) + ((p1.x + p1.y) + (p1.z + p1.w))) + (((p2.x + p2.y) + (p2.z + p2.w)) + ((p3.x + p3.y) + (p3.z + p3.w)));
    ((LAS float*)(lds + LT_RSTD))[tid] = ok ? rsqrtf(sm * (1.0f / D_) + EPS_) * scale : __builtin_nanf("");
}
__device__ __forceinline__ void epi_tables_vec(LAS unsigned char* lds, int dst_off, const float* src, int n, int tid) {
    for (int i = tid * 4; i < n; i += 2048) *(LAS f32x4*)(lds + LT_VEC + (dst_off + i) * 4) = src ? *(const f32x4*)(src + i) : (f32x4){0.f, 0.f, 0.f, 0.f};
}
__device__ __forceinline__ unsigned pk4_fp8(float a, float b, float c, float d) {
    unsigned w = 0u; w = (unsigned)__builtin_amdgcn_cvt_pk_fp8_f32(a, b, (int)w, false); w = (unsigned)__builtin_amdgcn_cvt_pk_fp8_f32(c, d, (int)w, true); return w; }
__device__ __forceinline__ int lane_id() { return (int)__builtin_amdgcn_mbcnt_hi(~0u, __builtin_amdgcn_mbcnt_lo(~0u, 0u)); }
__device__ __forceinline__ float sigm(float v) { return __builtin_amdgcn_rcpf(1.0f + __builtin_amdgcn_exp2f(-LOG2E_ * v)); }

template <int ACT> struct EpiGated {
    static constexpr bool PERM = true, AFTER_DRAIN = false;
    bf16* O; int ldo; const float* bias; int N; const float* ssq; LAS unsigned char* lds; float rscale;
    __device__ __forceinline__ void preload(const pg8::StaticOrder& S, int tid) const {
        int pmA, pmB; const int ok = epi_tables_pm(lds, S, tid, pmA, pmB);
        epi_tables_rstd(lds, ssq, pmA, pmB, ok, tid, rscale);
        epi_tables_vec(lds, 0, bias + (size_t)(pmA >> 6) * N, N, tid);
    }
    __device__ __forceinline__ void operator()(const f32x4 (&acc)[2][2][4][2], const pg8::Unit& u, int wr, int wc, int fr, int fq) const {
        const LAS float* bp = (const LAS float*)(lds + LT_VEC) + u.pn * 256 + wc * 32 + 8 * fq;
        const LAS float* rt = (const LAS float*)(lds + LT_RSTD) + ((u.pm == ((const LAS int*)(lds + LT_PM))[0]) ? 0 : 256) + wr * 64 + fr;
        f32x4 bv[2][2];
#pragma unroll
        for (int bj = 0; bj < 2; ++bj)
#pragma unroll
            for (int n = 0; n < 2; ++n) bv[bj][n] = *(const LAS f32x4*)(bp + bj * 128 + 4 * n);
        float rsv[8];
#pragma unroll
        for (int k = 0; k < 8; ++k) rsv[k] = rt[(k >> 2) * 128 + (k & 3) * 16];
#pragma unroll
        for (int ai = 0; ai < 2; ++ai)
#pragma unroll
            for (int m = 0; m < 4; ++m) {
                const int row = u.pm * 256 + ai * 128 + wr * 64 + m * 16 + fr;
                const float rs = rsv[ai * 4 + m];
                typedef float f2 __attribute__((ext_vector_type(2)));
                f2 a[4], g[4], t[4], e[4], d[4], r[4], v[4];
#pragma unroll
                for (int i = 0; i < 4; ++i) { const int n = i >> 1; const f32x4 a4 = acc[ai][0][m][n], g4 = acc[ai][1][m][n], ba4 = bv[0][n], bg4 = bv[1][n];
                    a[i] = ((i & 1) == 0 ? (f2){a4.x, a4.y} : (f2){a4.z, a4.w}) * rs + ((i & 1) == 0 ? (f2){ba4.x, ba4.y} : (f2){ba4.z, ba4.w});
                    g[i] = ((i & 1) == 0 ? (f2){g4.x, g4.y} : (f2){g4.z, g4.w}) * rs + ((i & 1) == 0 ? (f2){bg4.x, bg4.y} : (f2){bg4.z, bg4.w});
                    t[i] = ((ACT == 0) ? a[i] : g[i]) * (-LOG2E_); }
#pragma unroll
                for (int i = 0; i < 4; ++i) { e[i].x = __builtin_amdgcn_exp2f(t[i].x); e[i].y = __builtin_amdgcn_exp2f(t[i].y); }
#pragma unroll
                for (int i = 0; i < 4; ++i) d[i] = e[i] + 1.0f;
#pragma unroll
                for (int i = 0; i < 4; ++i) { r[i].x = __builtin_amdgcn_rcpf(d[i].x); r[i].y = __builtin_amdgcn_rcpf(d[i].y); }
#pragma unroll
                for (int i = 0; i < 4; ++i) v[i] = (ACT == 0) ? (a[i] * r[i]) * g[i] : a[i] * r[i];
                u32x4 w; w.x = cvtpk(v[0].x, v[0].y); w.y = cvtpk(v[1].x, v[1].y); w.z = cvtpk(v[2].x, v[2].y); w.w = cvtpk(v[3].x, v[3].y);
                *(u32x4*)(O + (size_t)row * ldo + u.pn * 128 + wc * 32 + 8 * fq) = w;
            }
    }
};

struct EpiRes {
    static constexpr bool PERM = true, AFTER_DRAIN = false;
    bf16* xb; float* out; const float* bias2; const float* coef; float* ssq; int last; LAS unsigned char* lds; unsigned char* x8;
    __device__ __forceinline__ void preload(const pg8::StaticOrder& S, int tid) const {
        int pmA, pmB; const int ok = epi_tables_pm(lds, S, tid, pmA, pmB);
        epi_tables_vec(lds, 0, ok ? coef + (size_t)(pmA >> 6) * D_ : nullptr, D_, tid);
        epi_tables_vec(lds, D_, bias2, D_, tid);
    }
    __device__ __forceinline__ void operator()(const f32x4 (&acc)[2][2][4][2], const pg8::Unit& u, int wr, int wc, int fr, int fq) const {
        const int col0 = u.pn * 256 + wc * 32 + 8 * fq;
        const size_t ro0 = (size_t)(u.pm * 256 + wr * 64 + fr) * D_ + col0;
        u32x4 xr[8][2];
#define EPIRES_LOAD(k) do { const bf16* xp_ = xb + ro0 + (size_t)(((k) >> 2) * 128 + ((k) & 3) * 16) * D_; xr[k][0] = *(const u32x4*)(xp_); xr[k][1] = *(const u32x4*)(xp_ + 128); } while (0)
        EPIRES_LOAD(0); EPIRES_LOAD(1); EPIRES_LOAD(2); EPIRES_LOAD(3);
        f32x4 cf[2][2], b2[2][2];
#pragma unroll
        for (int bj = 0; bj < 2; ++bj)
#pragma unroll
            for (int n = 0; n < 2; ++n) { const int c = col0 + bj * 128 + 4 * n;
                cf[bj][n] = *(const LAS f32x4*)(lds + LT_VEC + c * 4);
                b2[bj][n] = *(const LAS f32x4*)(lds + LT_VEC + (D_ + c) * 4); }
#pragma unroll
        for (int k = 0; k < 8; ++k) {
            const int ai = k >> 2, m = k & 3;
            if (k < 4) { switch (k) { case 0: EPIRES_LOAD(4); break; case 1: EPIRES_LOAD(5); break; case 2: EPIRES_LOAD(6); break; default: EPIRES_LOAD(7); break; } }
            const int row = u.pm * 256 + ai * 128 + wr * 64 + m * 16 + fr; const size_t ro = (size_t)row * D_;
            float ss = 0.f;
#pragma unroll
            for (int bj = 0; bj < 2; ++bj) {
                const u32x4 xw = xr[k][bj];
                const f32x4 x0 = (f32x4){bflo(xw.x), bfhi(xw.x), bflo(xw.y), bfhi(xw.y)}, x1 = (f32x4){bflo(xw.z), bfhi(xw.z), bflo(xw.w), bfhi(xw.w)};
                const f32x4 n0 = x0 + cf[bj][0] * (acc[ai][bj][m][0] + b2[bj][0]), n1 = x1 + cf[bj][1] * (acc[ai][bj][m][1] + b2[bj][1]);
                ss += ((n0[0] * n0[0] + n0[1] * n0[1]) + (n0[2] * n0[2] + n0[3] * n0[3])) + ((n1[0] * n1[0] + n1[1] * n1[1]) + (n1[2] * n1[2] + n1[3] * n1[3]));
                if (!last) { u32x4 w; w.x = cvtpk(n0[0], n0[1]); w.y = cvtpk(n0[2], n0[3]); w.z = cvtpk(n1[0], n1[1]); w.w = cvtpk(n1[2], n1[3]);
                    *(u32x4*)(xb + ro + col0 + bj * 128) = w;
                    if (x8) { u32x2 w8; w8.x = pk4_fp8(n0[0], n0[1], n0[2], n0[3]); w8.y = pk4_fp8(n1[0], n1[1], n1[2], n1[3]); *(u32x2*)(x8 + ro + col0 + bj * 128) = w8; } }
                else { *(f32x4*)(out + ro + col0 + bj * 128) = n0; *(f32x4*)(out + ro + col0 + bj * 128 + 4) = n1; }
            }
            if (!last) { ss = sum32(sum16(ss)); if (fq == 0) ssq[(size_t)row * 16 + u.pn * 4 + wc] = ss; }
        }
#undef EPIRES_LOAD
    }
};

struct EpiQKV {
    static constexpr bool PERM = true, AFTER_DRAIN = false;
    bf16* Q;   const float* bias; const float* ssq; const float* gq; const float* gk; float* kbarp; LAS unsigned char* lds;
    __device__ __forceinline__ void preload(const pg8::StaticOrder& S, int tid) const {
        int pmA, pmB; const int ok = epi_tables_pm(lds, S, tid, pmA, pmB);
        epi_tables_rstd(lds, ssq, pmA, pmB, ok, tid);
        epi_tables_vec(lds, 0, bias + (size_t)(pmA >> 6) * 3072, 3072, tid);
        epi_tables_vec(lds, 3072, gq, 64, tid); epi_tables_vec(lds, 3072 + 64, gk, 64, tid);
    }
    __device__ __forceinline__ void operator()(const f32x4 (&acc)[2][2][4][2], const pg8::Unit& u, int wr, int wc, int fr, int fq) const {
        const int b = u.pm >> 6, part = u.pn >> 2, head = ((u.pn & 3) << 2) + wc;
        const LAS float* bp = (const LAS float*)(lds + LT_VEC) + u.pn * 256 + wc * 32 + 8 * fq;
        const LAS float* gsrc = (const LAS float*)(lds + LT_VEC) + 3072 + ((part == 0) ? 0 : 64); const float gs = (part == 0) ? C2_ : 1.0f;
        const LAS float* rt = (const LAS float*)(lds + LT_RSTD) + ((u.pm == ((const LAS int*)(lds + LT_PM))[0]) ? 0 : 256) + wr * 64 + fr;
        f32x4 bv[2][2], gv[2][2], ks[2][2];
#pragma unroll
        for (int bj = 0; bj < 2; ++bj)
#pragma unroll
            for (int n = 0; n < 2; ++n) { bv[bj][n] = *(const LAS f32x4*)(bp + bj * 128 + 4 * n); gv[bj][n] = *(const LAS f32x4*)(gsrc + 32 * bj + 8 * fq + 4 * n) * gs; ks[bj][n] = (f32x4){0.f, 0.f, 0.f, 0.f}; }
        bf16* dst = Q + (size_t)part * ((size_t)M_ * D_);
        float rsv[8];
#pragma unroll
        for (int k = 0; k < 8; ++k) rsv[k] = rt[(k >> 2) * 128 + (k & 3) * 16];
#pragma unroll
        for (int ai = 0; ai < 2; ++ai)
#pragma unroll
            for (int m = 0; m < 4; ++m) {
                const int row = u.pm * 256 + ai * 128 + wr * 64 + m * 16 + fr;
                const float rs = rsv[ai * 4 + m];
                f32x4 v[2][2]; float ss = 0.f;
#pragma unroll
                for (int bj = 0; bj < 2; ++bj)
#pragma unroll
                    for (int n = 0; n < 2; ++n) { v[bj][n] = acc[ai][bj][m][n] * rs + bv[bj][n]; const f32x4 t = v[bj][n]; ss += (t[0] * t[0] + t[1] * t[1]) + (t[2] * t[2] + t[3] * t[3]); }
                if (part < 2) {
                    ss = sum32(sum16(ss));
                    const float r = rsqrtf(ss * (1.0f / HD_) + EPS_);
#pragma unroll
                    for (int bj = 0; bj < 2; ++bj)
#pragma unroll
                        for (int n = 0; n < 2; ++n) v[bj][n] = v[bj][n] * r * gv[bj][n];
                }
                if (part == 1) {
#pragma unroll
                    for (int bj = 0; bj < 2; ++bj)
#pragma unroll
                        for (int n = 0; n < 2; ++n) ks[bj][n] += v[bj][n];
                }
#pragma unroll
                for (int bj = 0; bj < 2; ++bj) {
                    u32x4 w; w.x = cvtpk(v[bj][0][0], v[bj][0][1]); w.y = cvtpk(v[bj][0][2], v[bj][0][3]); w.z = cvtpk(v[bj][1][0], v[bj][1][1]); w.w = cvtpk(v[bj][1][2], v[bj][1][3]);
                    *(u32x4*)(dst + (size_t)row * D_ + head * 64 + 32 * bj + 8 * fq) = w; }
            }
        if (part == 1) {
            float* kp = kbarp + ((((size_t)(b * 16 + head) * 64 + (u.pm & 63)) * 2 + wr) * 64);
#pragma unroll
            for (int bj = 0; bj < 2; ++bj)
#pragma unroll
                for (int n = 0; n < 2; ++n) { f32x4 t = ks[bj][n];
#pragma unroll
                    for (int j = 0; j < 4; ++j) { t[j] = row_sum16(t[j]); }
                    if (fr == 0) *(f32x4*)(kp + 32 * bj + 8 * fq + 4 * n) = t; }
        }
    }
};

template <class Epi, bool F8 = false> __device__ __forceinline__ void run_gemm(LAS unsigned char* lds, const bf16* A, const bf16* Bt, long bb, int N, int K, int G, const Epi& E, int wave_in) {
    int t = lane_id(); asm volatile("" : "+v"(t)); t += 64 * wave_in;
    int bid = (int)blockIdx.x, Gq = G; asm volatile("" : "+s"(bid), "+s"(Gq));
    pg8::Gemm g{A, Bt, M_, N, K, bb}; pg8::StaticOrder S; S.init(M_, N, Gq, bid);
    E.preload(S, t);
    __syncthreads();
    pg8::gemm_phase<Epi, pg8::StaticOrder, true, true, F8>(lds, g, S, E, t);
}

__device__ __forceinline__ void tile_load(float (&w)[32], const float* W, int N, int k0, int n0, int lane) {
    const float* p = W + (size_t)(k0 + (lane >> 5)) * N + n0 + (lane & 31);
#pragma unroll
    for (int i = 0; i < 32; ++i) w[i] = p[(size_t)(2 * i) * N];
}
__device__ __forceinline__ void tile_to_lds(const float (&w)[32], LAS float* scr, int lane) {
#pragma unroll
    for (int i = 0; i < 32; ++i) scr[(2 * i + (lane >> 5)) * 33 + (lane & 31)] = w[i];
}
__device__ __forceinline__ void transpose_finish(int K, bf16* WT, int k0, int dst0, LAS float* scr, int lane) {
    LDS_WAIT(); asm volatile("" ::: "memory");
    const int c = lane & 7;
#pragma unroll
    for (int j = 0; j < 4; ++j) { const int n = (lane >> 3) + 8 * j; const LAS float* s = scr + (8 * c) * 33 + n;
        u32x4 o; o.x = cvtpk(s[0 * 33], s[1 * 33]); o.y = cvtpk(s[2 * 33], s[3 * 33]); o.z = cvtpk(s[4 * 33], s[5 * 33]); o.w = cvtpk(s[6 * 33], s[7 * 33]);
        *(GAS u32x4*)(WT + (size_t)(dst0 + n) * K + k0 + 8 * c) = o; }
    LDS_WAIT(); asm volatile("" ::: "memory");
}
__device__ __forceinline__ int gated_dst(int n0, int half) { const int c = (n0 < half) ? n0 : n0 - half; return 256 * (c >> 7) + (c & 127) + ((n0 < half) ? 0 : 128); }

constexpr int PT_OFF = MISC_OFF + 128;
__device__ __forceinline__ unsigned long long pt_get(LAS unsigned char* lds, int i) {
    const unsigned long long v = ((volatile LAS unsigned long long*)(lds + PT_OFF))[i];
    return ((unsigned long long)(unsigned)__builtin_amdgcn_readfirstlane((int)(v >> 32)) << 32) | (unsigned long long)(unsigned)__builtin_amdgcn_readfirstlane((int)(unsigned)v);
}
#define PIN(i) ((const float*)(const GAS float*)pt_get(lds, (i)))
#define POUT ((float*)(GAS float*)pt_get(lds, 19))
#define PWS ((unsigned char*)(GAS unsigned char*)pt_get(lds, 20))

__device__ __forceinline__ void inweight_item(const float* W, int N, bf16* WT, size_t wt_bstride, int kh, int n0, int dst0, const float* ng, const float* mod0,
                                              float* bias, int bias_bstride, const float* extra, LAS float* scr, int lane, int f8out = 0) {
    const int c = lane & 7;
    float dacc[4][2];
#pragma unroll
    for (int j = 0; j < 4; ++j) { dacc[j][0] = 0.f; dacc[j][1] = 0.f; }
    float w[32]; tile_load(w, W, N, 64 * 8 * kh, n0, lane);
    f32x4 gq[2], s0q[2], s1q[2], h0q[2], h1q[2];
#define INW_VECS(kq_) do { _Pragma("unroll") for (int q4 = 0; q4 < 2; ++q4) { gq[q4] = *(const f32x4*)(ng + (kq_) + 4 * q4); s0q[q4] = *(const f32x4*)(mod0 + 1024 + (kq_) + 4 * q4); \
        s1q[q4] = *(const f32x4*)(mod0 + 9216 + 1024 + (kq_) + 4 * q4); h0q[q4] = *(const f32x4*)(mod0 + (kq_) + 4 * q4); h1q[q4] = *(const f32x4*)(mod0 + 9216 + (kq_) + 4 * q4); } } while (0)
    INW_VECS(64 * 8 * kh + 8 * c);
#pragma unroll 1
    for (int kb = 8 * kh; kb < 8 * kh + 8; ++kb) {
        const int k0 = 64 * kb, kq = k0 + 8 * c;
        tile_to_lds(w, scr, lane);
        float gm0[8], gm1[8], sh0[8], sh1[8];
#pragma unroll
        for (int q4 = 0; q4 < 2; ++q4)
#pragma unroll
            for (int e = 0; e < 4; ++e) { gm0[4 * q4 + e] = gq[q4][e] * (1.0f + s0q[q4][e]); gm1[4 * q4 + e] = gq[q4][e] * (1.0f + s1q[q4][e]); sh0[4 * q4 + e] = h0q[q4][e]; sh1[4 * q4 + e] = h1q[q4][e]; }
        if (kb + 1 < 8 * kh + 8) { tile_load(w, W, N, k0 + 64, n0, lane); INW_VECS(kq + 64); }
        LDS_WAIT(); asm volatile("" ::: "memory");
#pragma unroll
        for (int j = 0; j < 4; ++j) { const int n = (lane >> 3) + 8 * j; const LAS float* sp = scr + (8 * c) * 33 + n;
            float v[8];
#pragma unroll
            for (int e = 0; e < 8; ++e) v[e] = sp[e * 33];
            if (f8out) {
                u32x2 o0, o1;
                o0.x = pk4_fp8(v[0] * gm0[0] * W8_SCALE, v[1] * gm0[1] * W8_SCALE, v[2] * gm0[2] * W8_SCALE, v[3] * gm0[3] * W8_SCALE); o0.y = pk4_fp8(v[4] * gm0[4] * W8_SCALE, v[5] * gm0[5] * W8_SCALE, v[6] * gm0[6] * W8_SCALE, v[7] * gm0[7] * W8_SCALE);
                o1.x = pk4_fp8(v[0] * gm1[0] * W8_SCALE, v[1] * gm1[1] * W8_SCALE, v[2] * gm1[2] * W8_SCALE, v[3] * gm1[3] * W8_SCALE); o1.y = pk4_fp8(v[4] * gm1[4] * W8_SCALE, v[5] * gm1[5] * W8_SCALE, v[6] * gm1[6] * W8_SCALE, v[7] * gm1[7] * W8_SCALE);
                unsigned char* wp = (unsigned char*)WT + (size_t)(dst0 + n) * 1024 + kq;
                *(GAS u32x2*)(wp) = o0; *(GAS u32x2*)(wp + wt_bstride) = o1;
            } else {
            u32x4 o0, o1;
            o0.x = cvtpk(v[0] * gm0[0], v[1] * gm0[1]); o0.y = cvtpk(v[2] * gm0[2], v[3] * gm0[3]); o0.z = cvtpk(v[4] * gm0[4], v[5] * gm0[5]); o0.w = cvtpk(v[6] * gm0[6], v[7] * gm0[7]);
            o1.x = cvtpk(v[0] * gm1[0], v[1] * gm1[1]); o1.y = cvtpk(v[2] * gm1[2], v[3] * gm1[3]); o1.z = cvtpk(v[4] * gm1[4], v[5] * gm1[5]); o1.w = cvtpk(v[6] * gm1[6], v[7] * gm1[7]);
            bf16* wp = WT + (size_t)(dst0 + n) * 1024 + kq;
            *(GAS u32x4*)(wp) = o0; *(GAS u32x4*)(wp + wt_bstride) = o1;
            }
            float d0 = 0.f, d1 = 0.f;
#pragma unroll
            for (int e = 0; e < 8; ++e) { d0 += v[e] * sh0[e]; d1 += v[e] * sh1[e]; }
            dacc[j][0] += d0; dacc[j][1] += d1; }
        LDS_WAIT(); asm volatile("" ::: "memory");
    }
#pragma unroll
    for (int j = 0; j < 4; ++j)
#pragma unroll
        for (int bb = 0; bb < 2; ++bb) { float v = dacc[j][bb]; v += dppf<0xB1>(v); v += dppf<0x4E>(v); v += dppf<0x141>(v);
            if (c == 0) { const int n = (lane >> 3) + 8 * j; if (kh == 0 && extra) v += extra[n0 + n];
                __hip_atomic_fetch_add(bias + (size_t)bb * bias_bstride + dst0 + n, v, __ATOMIC_RELAXED, __HIP_MEMORY_SCOPE_AGENT); } }
}

#undef INW_VECS
__device__ __forceinline__ void phase_p0(LAS unsigned char* lds, int vcu, int G, int wave_in) {
    int tid = lane_id(); asm volatile("" : "+v"(tid)); tid += 64 * wave_in;
    const int lane = tid & 63, wave = __builtin_amdgcn_readfirstlane(tid >> 6);
    LAS float* cs = (LAS float*)lds;
    LAS float* red = (LAS float*)(lds + 8192);
    LAS float* scr = (LAS float*)(lds + 16384 + wave * 8704);
    unsigned char* const ws = PWS;
    float* MOD = (float*)(ws + WS_MOD);
    { const float* cin = PIN(1); for (int i = tid; i < 2048; i += 512) { const float v = cin[i]; cs[i] = v / (1.0f + expf(-v)); } }
    { float* bz = (float*)(ws + WS_BFFN); for (int i = vcu * 512 + tid; i < (192 + 32 + 16) * 256; i += G * 512) bz[i] = 0.f; }
    __syncthreads();
    for (int it = blockIdx.x; it < 288; it += G) {
        const int li = it / 144, cg = it % 144;
        const float* W = PIN(3) + (size_t)li * 1024 * 9216 + cg * 64 + lane; const float* adab = PIN(4);
        float a0 = 0.f, a1 = 0.f;
#pragma unroll 64
        for (int k = wave * 128; k < wave * 128 + 128; ++k) { const float w = W[(size_t)k * 9216]; a0 += cs[k] * w; a1 += cs[1024 + k] * w; }
        red[(wave * 2 + 0) * 64 + lane] = a0; red[(wave * 2 + 1) * 64 + lane] = a1;
        __syncthreads();
        if (tid < 128) { const int b = tid >> 6, l = tid & 63; float s = 0.f;
#pragma unroll
            for (int w = 0; w < 8; ++w) s += red[(w * 2 + b) * 64 + l];
            MOD[(size_t)(li * 2 + b) * 9216 + cg * 64 + l] = s + adab[li * 9216 + cg * 64 + l]; }
        __syncthreads();
    }
    const int gw = vcu * 8 + wave, NGW = G * 8;
    bf16* WOUT = (bf16*)(ws + WS_WOUT); bf16* WO = (bf16*)(ws + WS_WO); bf16* WPW2 = (bf16*)(ws + WS_WPW2);
    constexpr int I_OUT = 44 * 32, I_O = 16 * 32, I_PW2 = 16 * 32;
    constexpr int NITEMS = 4 * I_OUT + I_O + I_PW2;
    {
        const float* w6 = PIN(6); const float* w10 = PIN(10); const float* w17 = PIN(17);
#define OUTW_DECODE(it_, W_, K_, WT_, k0_, n0_) do { int r_ = (it_); \
            if (r_ < 4 * I_OUT) { const int f_ = r_ / I_OUT; r_ %= I_OUT; W_ = w6 + (size_t)f_ * 2816 * 1024; K_ = 2816; WT_ = WOUT + (size_t)f_ * 1024 * 2816; } \
            else if (r_ < 4 * I_OUT + I_O) { r_ -= 4 * I_OUT; W_ = w10; K_ = 1024; WT_ = WO; } \
            else { r_ -= 4 * I_OUT + I_O; W_ = w17; K_ = 1024; WT_ = WPW2; } \
            k0_ = 64 * (r_ / 32); n0_ = 32 * (r_ % 32); } while (0)
        float w[32]; const float* Wc; int Kc, k0c, n0c; bf16* WTc;
        if (gw < NITEMS) { OUTW_DECODE(gw, Wc, Kc, WTc, k0c, n0c); tile_load(w, Wc, 1024, k0c, n0c, lane); }
        for (int it = gw; it < NITEMS; it += NGW) {
            tile_to_lds(w, scr, lane);
            const float* Wn = Wc; int Kn = Kc, k0n = k0c, n0n = n0c; bf16* WTn = WTc;
            if (it + NGW < NITEMS) { OUTW_DECODE(it + NGW, Wn, Kn, WTn, k0n, n0n); tile_load(w, Wn, 1024, k0n, n0n, lane); }
            transpose_finish(Kc, WTc, k0c, n0c, scr, lane);
            Wc = Wn; Kc = Kn; k0c = k0n; n0c = n0n; WTc = WTn;
        }
#undef OUTW_DECODE
    }
    const float* x = PIN(0); bf16* XB = (bf16*)(ws + WS_XB); float* SSQ = (float*)(ws + WS_SSQ);
    {
        f32x4 v[2][4], vn[2][4];
#define XROWS_LOAD(dst, r0_) do { _Pragma("unroll") for (int r = 0; r < 2; ++r) _Pragma("unroll") for (int jj = 0; jj < 4; ++jj) \
            dst[r][jj] = ((r0_) + r * NGW < M_) ? *(const f32x4*)(x + (size_t)((r0_) + r * NGW) * D_ + 4 * lane + 256 * jj) : (f32x4){0.f, 0.f, 0.f, 0.f}; } while (0)
        XROWS_LOAD(vn, gw);
        for (int row0 = gw; row0 < M_; row0 += 2 * NGW) {
#pragma unroll
            for (int r = 0; r < 2; ++r)
#pragma unroll
                for (int jj = 0; jj < 4; ++jj) v[r][jj] = vn[r][jj];
            if (row0 + 2 * NGW < M_) XROWS_LOAD(vn, row0 + 2 * NGW);
#pragma unroll
            for (int r = 0; r < 2; ++r) { const int row = row0 + r * NGW; if (row >= M_) break; float ss = 0.f;
#pragma unroll
                for (int jj = 0; jj < 4; ++jj) { const int c = 4 * lane + 256 * jj; const f32x4 t = v[r][jj];
                    ss += (t[0] * t[0] + t[1] * t[1]) + (t[2] * t[2] + t[3] * t[3]);
                    u32x2 w; w.x = cvtpk(t[0], t[1]); w.y = cvtpk(t[2], t[3]);
                    *(u32x2*)(XB + (size_t)row * D_ + c) = w; }
                ss = wave_sum(ss);
                if (lane < 4) *(f32x4*)(SSQ + (size_t)row * 16 + 4 * lane) = (f32x4){lane == 0 ? ss : 0.f, 0.f, 0.f, 0.f}; }
        }
#undef XROWS_LOAD
    }
}

__device__ __forceinline__ void phase_p1(LAS unsigned char* lds, int vcu, int G, int wave_in) {
    int tid = lane_id(); asm volatile("" : "+v"(tid)); tid += 64 * wave_in;
    const int lane = tid & 63, wave = __builtin_amdgcn_readfirstlane(tid >> 6);
    LAS float* scr = (LAS float*)(lds + 16384 + wave * 8704);
    unsigned char* const ws = PWS; const float* ng = PIN(2);
    const float* MOD = (const float*)(ws + WS_MOD);
    float* COEF = (float*)(ws + WS_COEF);
    for (int i = vcu * 512 + tid; i < 6 * 2 * 1024; i += G * 512) {
        const int sl = i >> 11, b = (i >> 10) & 1, d = i & 1023, li = sl / 3, j = sl % 3;
        const float* mod = MOD + (size_t)(li * 2 + b) * 9216 + j * 3 * 1024;
        COEF[i] = ((j == 1) ? 1.0f : 0.5f) * mod[2048 + d];
    }
    const int gw = vcu * 8 + wave, NGW = G * 8;
    constexpr int I_IN = 176 * 2, I_QKV = 96 * 2, I_PW1 = 64 * 2;
    for (int it = gw; it < 4 * I_IN + I_QKV + I_PW1; it += NGW) {
        int r = it;
        if (r < 4 * I_IN) { const int f = r / I_IN; r %= I_IN; const int kh = (r >> 3) & 1, n0 = 32 * ((r >> 4) * 8 + (r & 7)), sl = (f >> 1) * 3 + (f & 1) * 2;
            inweight_item(PIN(5) + (size_t)f * 1024 * 5632, 5632, (bf16*)(ws + WS_WIN) + (size_t)f * 2 * 5632 * 1024, (size_t)5632 * 1024, kh, n0, gated_dst(n0, FF_),
                          ng + sl * 1024, MOD + (size_t)((sl / 3) * 2) * 9216 + (sl % 3) * 3 * 1024, (float*)(ws + WS_BFFN) + (size_t)f * 2 * 5632, 5632, nullptr, scr, lane, (F8MASK >> f) & 1); continue; }
        r -= 4 * I_IN;
        if (r < I_QKV) { const int kh = (r >> 3) & 1, n0 = 32 * ((r >> 4) * 8 + (r & 7)); const int part = n0 >> 10, head = (n0 & 1023) >> 6, e0 = n0 & 63;
            const int dst0 = 256 * (part * 4 + (head >> 2)) + 128 * (e0 >> 5) + 32 * (head & 3);
            inweight_item(PIN(7), 3072, (bf16*)(ws + WS_WQKV), (size_t)3072 * 1024, kh, n0, dst0, ng + 1 * 1024, MOD + 1 * 3 * 1024, (float*)(ws + WS_BQKV), 3072, nullptr, scr, lane); continue; }
        r -= I_QKV;
        { const int kh = (r >> 3) & 1, n0 = 32 * ((r >> 4) * 8 + (r & 7));
            inweight_item(PIN(11), 2048, (bf16*)(ws + WS_WPW1), (size_t)2048 * 1024, kh, n0, gated_dst(n0, 1024), ng + 4 * 1024, MOD + (size_t)2 * 9216 + 1 * 3 * 1024, (float*)(ws + WS_BPW1), 2048, PIN(12), scr, lane); }
    }
}

typedef float f32x2 __attribute__((ext_vector_type(2)));
__device__ __forceinline__ f32x2 bfpair(unsigned v) { return (f32x2){bflo(v), bfhi(v)}; }
__device__ __forceinline__ void conv_phase(LAS unsigned char* lds, int vcu, int G, int wave_in) {
    int tid = lane_id(); asm volatile("" : "+v"(tid)); tid += 64 * wave_in;
    const int lane = tid & 63, wave = __builtin_amdgcn_readfirstlane(tid >> 6), c0 = 2 * tid;
    LAS float* part = (LAS float*)lds;
    unsigned char* const ws = PWS;
    const bf16* U = (const bf16*)(ws + WS_U); bf16* CV = (bf16*)(ws + WS_CV);
    f32x2 w[31];
    { const float* wdw = PIN(13);
#pragma unroll
    for (int j = 0; j < 31; ++j) w[j] = *(const f32x2*)(wdw + j * D_ + c0); }
    f32x2 bd, lg, lb;
    { const float* p = PIN(14); bd = *(const f32x2*)(p + c0); p = PIN(15); lg = *(const f32x2*)(p + c0); p = PIN(16); lb = *(const f32x2*)(p + c0); }
    for (int un = vcu; un < 256; un += G) {
        const int b = un >> 7, t0 = (un & 127) * 128;
        const unsigned* Up = (const unsigned*)(U + (size_t)b * S_ * D_ + c0);
        unsigned* Op = (unsigned*)(CV + (size_t)b * S_ * D_ + c0);
        f32x2 hist[38];
        unsigned nx0[8], nx1[8];
#pragma unroll
        for (int i = 0; i < 8; ++i) { nx0[i] = Up[(size_t)(t0 + i) * 512]; nx1[i] = Up[(size_t)(t0 + 8 + i) * 512]; }
#pragma unroll
        for (int i = 0; i < 30; ++i) { const int tt = t0 - 30 + i; const unsigned v = (tt >= 0) ? Up[(size_t)tt * 512] : 0u; hist[i] = bfpair(v); }
        int pb = 0;
#pragma unroll 1
        for (int st = 0; st < 16; ++st) {
#pragma unroll
            for (int i = 0; i < 8; ++i) { hist[30 + i] = bfpair(nx0[i]); nx0[i] = nx1[i]; }
            if (st < 14) {
#pragma unroll
                for (int i = 0; i < 8; ++i) nx1[i] = Up[(size_t)(t0 + (st + 2) * 8 + i) * 512];
            }
            f32x2 y[8]; float stat[16];
#pragma unroll
            for (int tt = 0; tt < 8; ++tt) { f32x2 a = bd;
#pragma unroll
                for (int j = 0; j < 31; ++j) a += w[j] * hist[tt + j];
                y[tt] = a; stat[2 * tt] = a.x + a.y; stat[2 * tt + 1] = a.x * a.x + a.y * a.y; }
            float s1[8], s2[4];
#pragma unroll
            for (int k = 0; k < 8; ++k) { const auto r = __builtin_amdgcn_permlane32_swap(f2u(stat[k]), f2u(stat[k + 8]), false, false); const unsigned r0 = r[0], r1 = r[1]; s1[k] = u2f(r0) + u2f(r1); }
#pragma unroll
            for (int k = 0; k < 4; ++k) { const auto r = __builtin_amdgcn_permlane16_swap(f2u(s1[k]), f2u(s1[k + 4]), false, false); const unsigned r0 = r[0], r1 = r[1]; s2[k] = row_sum16(u2f(r0) + u2f(r1)); }
            if ((lane & 15) == 0) *(LAS f32x4*)(part + (pb * 8 + wave) * 16 + 4 * (lane >> 4)) = (f32x4){s2[0], s2[1], s2[2], s2[3]};
            LDS_BARRIER();
            f32x4 tot[4];
#pragma unroll
            for (int k = 0; k < 4; ++k) { tot[k] = (f32x4){0.f, 0.f, 0.f, 0.f};
#pragma unroll
                for (int ww = 0; ww < 8; ++ww) tot[k] += *(const LAS f32x4*)(part + (pb * 8 + ww) * 16 + 4 * k); }
#pragma unroll
            for (int tt = 0; tt < 8; ++tt) {
                const float sum = tot[tt >> 1][(tt & 1) * 2], sq = tot[tt >> 1][(tt & 1) * 2 + 1];
                const float mean = sum * (1.0f / D_), var = sq * (1.0f / D_) - mean * mean, rstd = __builtin_amdgcn_rsqf(var + EPS_);
                const f32x2 z = (y[tt] - mean) * rstd * lg + lb;
                const f32x2 e = z * (-LOG2E_);
                f32x2 d; d.x = __builtin_amdgcn_exp2f(e.x); d.y = __builtin_amdgcn_exp2f(e.y); d = d + 1.0f;
                f32x2 r; r.x = __builtin_amdgcn_rcpf(d.x); r.y = __builtin_amdgcn_rcpf(d.y);
                const f32x2 o = z * r;
                Op[(size_t)(t0 + st * 8 + tt) * 512] = cvtpk(o.x, o.y);
            }
#pragma unroll
            for (int i = 0; i < 30; ++i) hist[i] = hist[i + 8];
            pb ^= 1;
        }
    }
}
constexpr int CW_Q2 = 8192;
constexpr int A_KS = 0, A_VT = 36864, A_LIST = 70656, A_MISC = 103424;
__device__ __forceinline__ float attn_m0(const float* gq, const float* gk, int lane) {
    float a = fabsf(gq[lane]), b = fabsf(gk[lane]); a = wave_max(a); b = wave_max(b);
    return 8.0f * LOG2E_ * a * b * 1.02f + 0.25f;
}
__device__ __forceinline__ void stage_kv_load(u32x4 (&kk)[4], u32x4 (&vv)[4], const bf16* K, const bf16* V, size_t rowbase, int h, int tid) {
    const int r = tid >> 1, hf = tid & 1;
    const bf16* kp = K + (rowbase + r) * D_ + h * 64 + 32 * hf;
#pragma unroll
    for (int c = 0; c < 4; ++c) kk[c] = *(const u32x4*)(kp + 8 * c);
    const int p = tid >> 2, dq = tid & 3;
    const bf16* vp = V + (rowbase + 2 * p) * D_ + h * 64 + 16 * dq;
    vv[0] = *(const u32x4*)(vp); vv[1] = *(const u32x4*)(vp + 8); vv[2] = *(const u32x4*)(vp + D_); vv[3] = *(const u32x4*)(vp + D_ + 8);
}
__device__ __forceinline__ void stage_kv_store(LAS unsigned char* lds, const u32x4 (&kk)[4], const u32x4 (&vv)[4], int tid) {
    const int r = tid >> 1, hf = tid & 1;
#pragma unroll
    for (int c = 0; c < 4; ++c) *(LAS u32x4*)(lds + A_KS + r * 144 + (32 * hf + 8 * c) * 2) = kk[c];
    const int p = tid >> 2, dq = tid & 3;
    LAS unsigned* vt = (LAS unsigned*)(lds + A_VT) + p;
#pragma unroll
    for (int c = 0; c < 2; ++c)
#pragma unroll
        for (int e = 0; e < 4; ++e) { const unsigned a = (e == 0) ? vv[c].x : (e == 1) ? vv[c].y : (e == 2) ? vv[c].z : vv[c].w;
            const unsigned bb = (e == 0) ? vv[2 + c].x : (e == 1) ? vv[2 + c].y : (e == 2) ? vv[2 + c].z : vv[2 + c].w;
            const int d = 16 * dq + 8 * c + 2 * e;
            vt[d * 132] = (a & 0xffffu) | (bb << 16); vt[(d + 1) * 132] = (a >> 16) | (bb & 0xffff0000u); }
}
__device__ __forceinline__ void stage_kv(LAS unsigned char* lds, const bf16* K, const bf16* V, size_t rowbase, int h, int tid) {
    u32x4 kk[4], vv[4]; stage_kv_load(kk, vv, K, V, rowbase, h, tid); stage_kv_store(lds, kk, vv, tid);
}
__device__ __forceinline__ int alibi_dmax(float slope2, float M0) { return (int)fminf((2.0f * M0 + 40.0f) / slope2, 1.0e9f); }
template <bool MASK> __device__ __forceinline__ void attn_tile(LAS unsigned char* lds, int s8, const bf16x8 (&qf)[4], float rowc, float slope2, int lane, f32x16& o0, f32x16& o1, float& lsum, int maskq) {
    const int i = lane & 31, hi = lane >> 5;
    const int prow = (i & ~12) | ((i & 4) << 1) | ((i & 8) >> 1);
    const LAS unsigned char* kp = lds + A_KS + (32 * s8 + prow) * 144 + 16 * hi;
    const float cb = rowc + slope2 * (float)(32 * s8 + 8 * hi);
    f32x16 c;
#pragma unroll
    for (int r = 0; r < 16; ++r) c[r] = cb + slope2 * (float)(16 * (r >> 3) + (r & 7));
#pragma unroll
    for (int d0 = 0; d0 < 4; ++d0) { const bf16x8 kf = *(const LAS bf16x8*)(kp + 32 * d0); c = __builtin_amdgcn_mfma_f32_32x32x16_bf16(kf, qf[d0], c, 0, 0, 0); }
    if (MASK) {
#pragma unroll
        for (int r = 0; r < 16; ++r) if (16 * (r >> 3) + 8 * hi + (r & 7) > maskq) c[r] = -INFINITY;
    }
    float ls = 0.f;
#pragma unroll
    for (int r = 0; r < 16; ++r) { c[r] = __builtin_amdgcn_exp2f(c[r]); ls += c[r]; }
    lsum += ls;
    u32x4 p0, p1;
    p0.x = cvtpk(c[0], c[1]); p0.y = cvtpk(c[2], c[3]); p0.z = cvtpk(c[4], c[5]); p0.w = cvtpk(c[6], c[7]);
    p1.x = cvtpk(c[8], c[9]); p1.y = cvtpk(c[10], c[11]); p1.z = cvtpk(c[12], c[13]); p1.w = cvtpk(c[14], c[15]);
    const bf16x8 pf0 = __builtin_bit_cast(bf16x8, p0), pf1 = __builtin_bit_cast(bf16x8, p1);
    const LAS unsigned char* vp = lds + A_VT + (i * 264 + 32 * s8 + 8 * hi) * 2;
    { const bf16x8 v00 = *(const LAS bf16x8*)(vp), v01 = *(const LAS bf16x8*)(vp + 32), v10 = *(const LAS bf16x8*)(vp + 32 * 528), v11 = *(const LAS bf16x8*)(vp + 32 * 528 + 32);
      o0 = __builtin_amdgcn_mfma_f32_32x32x16_bf16(v00, pf0, o0, 0, 0, 0); o1 = __builtin_amdgcn_mfma_f32_32x32x16_bf16(v10, pf0, o1, 0, 0, 0);
      o0 = __builtin_amdgcn_mfma_f32_32x32x16_bf16(v01, pf1, o0, 0, 0, 0); o1 = __builtin_amdgcn_mfma_f32_32x32x16_bf16(v11, pf1, o1, 0, 0, 0); }
}
__device__ __forceinline__ bf16* op_ptr(unsigned char* ws, float* out, int rank) { return (rank == 2) ? (bf16*)(ws + WS_OP3) : (bf16*)out + (size_t)rank * ((size_t)M_ * D_); }

struct A2Item { int n, bh, b, h, tbeg, tlim, dmax; float slope2; };
__device__ __forceinline__ A2Item a2_decode(int item, float M0) {
    A2Item I; I.n = item >> 5; I.bh = item & 31; I.b = I.bh >> 4; I.h = I.bh & 15;
    I.slope2 = exp2f(-0.5f * (float)(I.h + 1)) * LOG2E_; I.dmax = alibi_dmax(I.slope2, M0);
    I.tbeg = (I.n + 1) * 256; I.tlim = min(S_, 256 * I.n + 256 + I.dmax); return I;
}
__device__ __forceinline__ void a2_load(const A2Item& I, u32x4 (&kk)[4], u32x4 (&vv)[4], u32x4 (&sv)[8], const bf16* K, const bf16* V, const unsigned* sel, int tid) {
    stage_kv_load(kk, vv, K, V, (size_t)I.b * S_ + 256 * I.n, I.h, tid);
    const unsigned* sp = sel + (size_t)I.bh * S_;
#pragma unroll
    for (int c = 0; c < 8; ++c) { const int t0 = I.tbeg + 2048 * c + 4 * tid;
        sv[c] = (u32x4){0xFFFFFFFFu, 0xFFFFFFFFu, 0xFFFFFFFFu, 0xFFFFFFFFu};
        if (I.tbeg + 2048 * c < I.tlim) { if (t0 < S_) sv[c] = *(const u32x4*)(sp + t0); } }
}
__device__ __forceinline__ void a2_phase(LAS unsigned char* lds, int wave_in, int qword) {
    int tid = lane_id(); asm volatile("" : "+v"(tid)); tid += 64 * wave_in;
    const int lane = tid & 63, wave = __builtin_amdgcn_readfirstlane(tid >> 6), q = lane & 31, hi = lane >> 5;
    unsigned char* const ws = PWS;
    const bf16* Q = (const bf16*)(ws + WS_Q); const bf16* K = (const bf16*)(ws + WS_K); const bf16* V = (const bf16*)(ws + WS_V);
    const unsigned* sel = (const unsigned*)(ws + WS_SEL); unsigned* ctl = (unsigned*)(ws + WS_CTL); float* LP = (float*)(ws + WS_LP); float* const outp = POUT;
    const float M0 = attn_m0(PIN(8), PIN(9), lane);
    LAS unsigned short* list = (LAS unsigned short*)(lds + A_LIST); volatile LAS int* misc = (volatile LAS int*)(lds + A_MISC);
    constexpr int NIT = 63 * 32;
    int t_cur = 0, t_nxt = 0;
    if (tid == 0) { t_cur = (int)__hip_atomic_fetch_add(ctl + qword, 1u, __ATOMIC_RELAXED, __HIP_MEMORY_SCOPE_AGENT); t_nxt = (int)__hip_atomic_fetch_add(ctl + qword, 1u, __ATOMIC_RELAXED, __HIP_MEMORY_SCOPE_AGENT); }
    LDS_BARRIER();
    if (tid == 0) { misc[0] = t_cur; misc[2] = t_nxt; misc[1] = 0; }
    LDS_BARRIER();
    int item = __builtin_amdgcn_readfirstlane(misc[0]), item_n = __builtin_amdgcn_readfirstlane(misc[2]);
    u32x4 kk[4], vv[4], sv[8];
    if (item < NIT) { const A2Item I0 = a2_decode(item, M0); a2_load(I0, kk, vv, sv, K, V, sel, tid); }
    while (item < NIT) {
        const A2Item I = a2_decode(item, M0);
        const int n = I.n, b = I.b, h = I.h, dmax = I.dmax; const float slope2 = I.slope2;
        int t_nn = 0;
        if (tid == 0) t_nn = (int)__hip_atomic_fetch_add(ctl + qword, 1u, __ATOMIC_RELAXED, __HIP_MEMORY_SCOPE_AGENT);
        stage_kv_store(lds, kk, vv, tid);
#pragma unroll
        for (int c = 0; c < 8; ++c) {
            if (I.tbeg + 2048 * c < I.tlim) {
#pragma unroll
                for (int e = 0; e < 4; ++e) {
                    const unsigned s = (e == 0) ? sv[c].x : (e == 1) ? sv[c].y : (e == 2) ? sv[c].z : sv[c].w;
                    const int t = I.tbeg + 2048 * c + 4 * tid + e;
                    int rank = ((s & 255u) == (unsigned)n) ? 0 : (((s >> 8) & 255u) == (unsigned)n) ? 1 : (((s >> 16) & 255u) == (unsigned)n) ? 2 : -1;
                    if (t - 256 * n - 255 > dmax) rank = -1;
                    const unsigned long long bal = __ballot(rank >= 0);
                    if (bal) {
                        const int pre = __builtin_amdgcn_mbcnt_hi((unsigned)(bal >> 32), __builtin_amdgcn_mbcnt_lo((unsigned)bal, 0u));
                        int base = 0;
                        if (lane == 0) base = __hip_atomic_fetch_add((LAS int*)(lds + A_MISC) + 1, __popcll(bal), __ATOMIC_RELAXED, __HIP_MEMORY_SCOPE_WORKGROUP);
                        base = __builtin_amdgcn_readfirstlane(base);
                        if (rank >= 0) list[base + pre] = (unsigned short)(t | (rank << 14));
                    }
                }
            }
        }
        if (item_n < NIT) { const A2Item In = a2_decode(item_n, M0); a2_load(In, kk, vv, sv, K, V, sel, tid); }
        LDS_BARRIER();
        const int total = __builtin_amdgcn_readfirstlane(misc[1]);
        const int nr = (total + 255) >> 8;
        bf16x8 qn[4]; unsigned en = 0u;
        if (32 * wave < total) { const int idx = 32 * wave + q; en = list[(idx < total) ? idx : 32 * wave];
            const size_t rown = (size_t)b * S_ + (en & 16383);
#pragma unroll
            for (int d0 = 0; d0 < 4; ++d0) qn[d0] = *(const bf16x8*)(Q + rown * D_ + h * 64 + 16 * d0 + 8 * hi); }
        for (int r = 0; r < nr; ++r) {
            const int i0 = 256 * r + 32 * wave;
            if (i0 < total) {
                const int idx = i0 + q; const bool valid = idx < total;
                const unsigned e = en;
                const int t = e & 16383, rank = e >> 14;
                const size_t row = (size_t)b * S_ + t;
                bf16x8 qf[4];
#pragma unroll
                for (int d0 = 0; d0 < 4; ++d0) qf[d0] = qn[d0];
                if (i0 + 256 < total) { const int idx2 = idx + 256; en = list[(idx2 < total) ? idx2 : i0 + 256];
                    const size_t rown = (size_t)b * S_ + (en & 16383);
#pragma unroll
                    for (int d0 = 0; d0 < 4; ++d0) qn[d0] = *(const bf16x8*)(Q + rown * D_ + h * 64 + 16 * d0 + 8 * hi); }
                const float rowc = -slope2 * (float)(t - 256 * n) - M0;
                f32x16 o0, o1; float lsum = 0.f;
#pragma unroll
                for (int k = 0; k < 16; ++k) { o0[k] = 0.f; o1[k] = 0.f; }
#pragma unroll 2
                for (int s8 = 0; s8 < 8; ++s8) attn_tile<false>(lds, s8, qf, rowc, slope2, lane, o0, o1, lsum, 0);
                lsum = sum32(lsum);
                if (valid) {
                    bf16* op = op_ptr(ws, outp, rank) + row * D_ + h * 64 + 4 * hi;
#pragma unroll
                    for (int g = 0; g < 4; ++g) {
                        u32x2 w0, w1; w0.x = cvtpk(o0[4 * g], o0[4 * g + 1]); w0.y = cvtpk(o0[4 * g + 2], o0[4 * g + 3]);
                        w1.x = cvtpk(o1[4 * g], o1[4 * g + 1]); w1.y = cvtpk(o1[4 * g + 2], o1[4 * g + 3]);
                        *(u32x2*)(op + 8 * g) = w0; *(u32x2*)(op + 32 + 8 * g) = w1; }
                    if (hi == 0) LP[((size_t)rank * M_ + row) * 16 + h] = lsum;
                }
            }
        }
        LDS_BARRIER();
        if (tid == 0) { misc[0] = item_n; misc[2] = t_nn; misc[1] = 0; }
        LDS_BARRIER();
        item = __builtin_amdgcn_readfirstlane(misc[0]); item_n = __builtin_amdgcn_readfirstlane(misc[2]);
    }
}

__device__ __forceinline__ void a3_phase(LAS unsigned char* lds, int vcu, int G, int wave_in) {
    int tid = lane_id(); asm volatile("" : "+v"(tid)); tid += 64 * wave_in;
    const int lane = tid & 63, wave = __builtin_amdgcn_readfirstlane(tid >> 6), q = lane & 31, hi = lane >> 5;
    unsigned char* const ws = PWS;
    bf16* Q = (bf16*)(ws + WS_Q); const bf16* K = (const bf16*)(ws + WS_K); const bf16* V = (const bf16*)(ws + WS_V);
    const unsigned* sel = (const unsigned*)(ws + WS_SEL); const float* LP = (const float*)(ws + WS_LP); float* const outp = POUT;
    const float M0 = attn_m0(PIN(8), PIN(9), lane);
    u32x4 kk[4], vv[4];
    if (vcu < 2048) { const int bh = vcu >> 6, m = vcu & 63; stage_kv_load(kk, vv, K, V, (size_t)(bh >> 4) * S_ + 256 * m, bh & 15, tid); }
    for (int un = vcu; un < 2048; un += G) {
        const int bh = un >> 6, m = un & 63, b = bh >> 4, h = bh & 15;
        const float slope2 = exp2f(-0.5f * (float)(h + 1)) * LOG2E_;
        LDS_BARRIER();
        stage_kv_store(lds, kk, vv, tid);
        { const int un2 = un + G; if (un2 < 2048) { const int bh2 = un2 >> 6, m2 = un2 & 63; stage_kv_load(kk, vv, K, V, (size_t)(bh2 >> 4) * S_ + 256 * m2, bh2 & 15, tid); } }
        const int t = 256 * m + 32 * wave + q; const size_t row = (size_t)b * S_ + t;
        bf16x8 qf[4];
#pragma unroll
        for (int d0 = 0; d0 < 4; ++d0) qf[d0] = *(const bf16x8*)(Q + row * D_ + h * 64 + 16 * d0 + 8 * hi);
        const unsigned s = sel[(size_t)bh * S_ + t];
        float lp[3]; u32x2 pw[3][8];
#pragma unroll
        for (int rank = 0; rank < 3; ++rank) {
            lp[rank] = LP[((size_t)rank * M_ + row) * 16 + h];
            const bf16* op = op_ptr(ws, outp, rank) + row * D_ + h * 64 + 4 * hi;
#pragma unroll
            for (int g = 0; g < 4; ++g) { pw[rank][g] = *(const u32x2*)(op + 8 * g); pw[rank][4 + g] = *(const u32x2*)(op + 32 + 8 * g); }
        }
        LDS_BARRIER();
        const float rowc = -slope2 * (float)(32 * wave + q) - M0;
        f32x16 o0, o1; float lsum = 0.f;
#pragma unroll
        for (int k = 0; k < 16; ++k) { o0[k] = 0.f; o1[k] = 0.f; }
        for (int s8 = 0; s8 < wave; ++s8) attn_tile<false>(lds, s8, qf, rowc, slope2, lane, o0, o1, lsum, 0);
        attn_tile<true>(lds, wave, qf, rowc, slope2, lane, o0, o1, lsum, q);
        float l = sum32(lsum);
        const int dmax = alibi_dmax(slope2, M0);
#pragma unroll
        for (int rank = 0; rank < 3; ++rank) {
            const int nb = (int)((s >> (8 * rank)) & 255u);
            if (nb != 255 && (t - 256 * nb - 255) <= dmax) {
                l += lp[rank];
#pragma unroll
                for (int g = 0; g < 4; ++g) { const u32x2 w0 = pw[rank][g], w1 = pw[rank][4 + g];
                    o0[4 * g] += bflo(w0.x); o0[4 * g + 1] += bfhi(w0.x); o0[4 * g + 2] += bflo(w0.y); o0[4 * g + 3] += bfhi(w0.y);
                    o1[4 * g] += bflo(w1.x); o1[4 * g + 1] += bfhi(w1.x); o1[4 * g + 2] += bflo(w1.y); o1[4 * g + 3] += bfhi(w1.y); }
            }
        }
        const float inv = 1.0f / l;
        bf16* op = Q + row * D_ + h * 64 + 4 * hi;
#pragma unroll
        for (int g = 0; g < 4; ++g) {
            u32x2 w0, w1; w0.x = cvtpk(o0[4 * g] * inv, o0[4 * g + 1] * inv); w0.y = cvtpk(o0[4 * g + 2] * inv, o0[4 * g + 3] * inv);
            w1.x = cvtpk(o1[4 * g] * inv, o1[4 * g + 1] * inv); w1.y = cvtpk(o1[4 * g + 2] * inv, o1[4 * g + 3] * inv);
            *(u32x2*)(op + 8 * g) = w0; *(u32x2*)(op + 32 + 8 * g) = w1; }
    }
}

constexpr int A1_KH = 0, A1_KL = 9216;
__device__ __forceinline__ void top3_ins(float v, int n, float& v0, float& v1, float& v2, int& i0, int& i1, int& i2) {
    const bool c0 = v > v0, c1 = v > v1, c2 = v > v2;
    v2 = c1 ? v1 : (c2 ? v : v2); i2 = c1 ? i1 : (c2 ? n : i2);
    v1 = c0 ? v0 : (c1 ? v : v1); i1 = c0 ? i0 : (c1 ? n : i1);
    v0 = c0 ? v : v0;             i0 = c0 ? n : i0;
}
__device__ __forceinline__ void a1_phase(LAS unsigned char* lds, int vcu, int G, int wave_in) {
    int tid = lane_id(); asm volatile("" : "+v"(tid)); tid += 64 * wave_in;
    const int lane = tid & 63, wave = __builtin_amdgcn_readfirstlane(tid >> 6), q = lane & 31, hi = lane >> 5;
    unsigned char* const ws = PWS;
    const bf16* Q = (const bf16*)(ws + WS_Q); const float* kbarp = (const float*)(ws + WS_KBAR); unsigned* sel = (unsigned*)(ws + WS_SEL);
    for (int un = vcu; un < 256; un += G) {
        const int bh = un >> 3, mg = un & 7, b = bh >> 4, h = bh & 15;
        LDS_BARRIER();
        { const int n = tid >> 3, d0 = (tid & 7) * 8;
          const float* p = kbarp + ((size_t)bh * 64 + n) * 128 + d0;
          const f32x4 a0 = *(const f32x4*)p, a1 = *(const f32x4*)(p + 4), b0 = *(const f32x4*)(p + 64), b1 = *(const f32x4*)(p + 68);
          const f32x4 v0 = (a0 + b0) * (1.0f / 256.0f), v1 = (a1 + b1) * (1.0f / 256.0f);
          unsigned hb[8], lb[8];
#pragma unroll
          for (int e = 0; e < 8; ++e) { const float v = (e < 4) ? v0[e & 3] : v1[e & 3]; hb[e] = f2bf(v); lb[e] = f2bf(v - bf2f(hb[e])); }
          u32x4 wh, wl; wh.x = hb[0] | (hb[1] << 16); wh.y = hb[2] | (hb[3] << 16); wh.z = hb[4] | (hb[5] << 16); wh.w = hb[6] | (hb[7] << 16);
          wl.x = lb[0] | (lb[1] << 16); wl.y = lb[2] | (lb[3] << 16); wl.z = lb[4] | (lb[5] << 16); wl.w = lb[6] | (lb[7] << 16);
          *(LAS u32x4*)(lds + A1_KH + n * 144 + d0 * 2) = wh; *(LAS u32x4*)(lds + A1_KL + n * 144 + d0 * 2) = wl; }
        LDS_BARRIER();
        bf16x8 qn[4];
        { const size_t row0 = (size_t)b * S_ + 256 * (mg * 8) + 32 * wave + q;
#pragma unroll
          for (int d0 = 0; d0 < 4; ++d0) qn[d0] = *(const bf16x8*)(Q + row0 * D_ + h * 64 + 16 * d0 + 8 * hi); }
        for (int mi = 0; mi < 8; ++mi) {
            const int m = mg * 8 + mi, t = 256 * m + 32 * wave + q;
            bf16x8 qf[4];
#pragma unroll
            for (int d0 = 0; d0 < 4; ++d0) qf[d0] = qn[d0];
            if (mi < 7) { const size_t rown = (size_t)b * S_ + t + 256;
#pragma unroll
                for (int d0 = 0; d0 < 4; ++d0) qn[d0] = *(const bf16x8*)(Q + rown * D_ + h * 64 + 16 * d0 + 8 * hi); }
            if (m == 0) { if (hi == 0) sel[(size_t)bh * S_ + t] = 0x00FFFFFFu; continue; }
            f32x16 c0, c1;
#pragma unroll
            for (int k = 0; k < 16; ++k) { c0[k] = 0.f; c1[k] = 0.f; }
            const LAS unsigned char* kp = lds + q * 144 + 16 * hi;
#pragma unroll
            for (int d0 = 0; d0 < 4; ++d0) {
                const bf16x8 h0 = *(const LAS bf16x8*)(kp + A1_KH + 32 * d0), h1 = *(const LAS bf16x8*)(kp + A1_KH + 32 * 144 + 32 * d0);
                const bf16x8 l0 = *(const LAS bf16x8*)(kp + A1_KL + 32 * d0), l1 = *(const LAS bf16x8*)(kp + A1_KL + 32 * 144 + 32 * d0);
                c0 = __builtin_amdgcn_mfma_f32_32x32x16_bf16(h0, qf[d0], c0, 0, 0, 0); c1 = __builtin_amdgcn_mfma_f32_32x32x16_bf16(h1, qf[d0], c1, 0, 0, 0);
                c0 = __builtin_amdgcn_mfma_f32_32x32x16_bf16(l0, qf[d0], c0, 0, 0, 0); c1 = __builtin_amdgcn_mfma_f32_32x32x16_bf16(l1, qf[d0], c1, 0, 0, 0);
            }
            float v0 = -INFINITY, v1 = -INFINITY, v2 = -INFINITY; int i0 = 255, i1 = 255, i2 = 255;
#pragma unroll
            for (int r = 0; r < 16; ++r) { const int n = (r & 3) + 8 * (r >> 2) + 4 * hi; top3_ins((n < m) ? c0[r] : -INFINITY, n, v0, v1, v2, i0, i1, i2); }
#pragma unroll
            for (int r = 0; r < 16; ++r) { const int n = 32 + (r & 3) + 8 * (r >> 2) + 4 * hi; top3_ins((n < m) ? c1[r] : -INFINITY, n, v0, v1, v2, i0, i1, i2); }
            const float pv0 = __builtin_bit_cast(float, other32(__builtin_bit_cast(unsigned, v0), hi)), pv1 = __builtin_bit_cast(float, other32(__builtin_bit_cast(unsigned, v1), hi)), pv2 = __builtin_bit_cast(float, other32(__builtin_bit_cast(unsigned, v2), hi));
            const int pi0 = (int)other32((unsigned)i0, hi), pi1 = (int)other32((unsigned)i1, hi), pi2 = (int)other32((unsigned)i2, hi);
            top3_ins(pv0, pi0, v0, v1, v2, i0, i1, i2); top3_ins(pv1, pi1, v0, v1, v2, i0, i1, i2); top3_ins(pv2, pi2, v0, v1, v2, i0, i1, i2);
            if (hi == 0) sel[(size_t)bh * S_ + t] = (unsigned)i0 | ((unsigned)i1 << 8) | ((unsigned)i2 << 16);
        }
    }
}
#ifndef MK_MULTI
#define MK_MULTI 0
#endif
constexpr int NPH = 18;
struct Args { const float* in[19]; float* out; unsigned char* ws; int lo, hi; };
__global__ void __launch_bounds__(512, 2) fwd(Args a) {
    extern __shared__ __attribute__((aligned(16))) unsigned char lds_raw[];
    LAS unsigned char* lds = (LAS unsigned char*)lds_raw;
    const int tid = threadIdx.x, G = gridDim.x; const int wave = __builtin_amdgcn_readfirstlane(tid >> 6);
    const int vcu = (G % 8 == 0) ? ((int)blockIdx.x % 8) * (G / 8) + (int)blockIdx.x / 8 : (int)blockIdx.x;
    volatile LAS unsigned* MISC = (volatile LAS unsigned*)(lds + MISC_OFF);
    for (int u = tid; u < (LDS_BYTES - LDSCTL_OFF) / 4; u += 512) ((LAS unsigned*)(lds + LDSCTL_OFF))[u] = 0u;
    __syncthreads();
    if (tid == 0) {
        LAS unsigned long long* PT = (LAS unsigned long long*)(lds + PT_OFF);
#pragma unroll
        for (int i = 0; i < 19; ++i) PT[i] = (unsigned long long)a.in[i];
        PT[19] = (unsigned long long)a.out; PT[20] = (unsigned long long)a.ws;
        ((LAS int*)(lds + PT_OFF))[48] = a.lo; ((LAS int*)(lds + PT_OFF))[49] = a.hi;
    }
    __syncthreads();
    if (a.hi - a.lo > 1) (void)xcd_barrier_post((unsigned*)(a.ws + WS_CTL) + CW_BAR, MISC + 8);
#define LO (__builtin_amdgcn_readfirstlane(((volatile LAS int*)(lds + PT_OFF))[48]))
#define HI (__builtin_amdgcn_readfirstlane(((volatile LAS int*)(lds + PT_OFF))[49]))
#define IN(k) (LO <= (k) && (k) < HI)
#define SEAM(k) do { if (IN(k) && IN((k) + 1)) { XcdBarrier bar_; bar_.bar = (unsigned*)(PWS + WS_CTL) + CW_BAR; bar_.x = xb_xcc_id(); bar_.st = MISC + 8; xcd_barrier(bar_); } } while (0)

    if (IN(0)) { __syncthreads(); phase_p0(lds, vcu, G, wave); }
    SEAM(0);
    if (IN(1)) { __syncthreads(); phase_p1(lds, vcu, G, wave); }
    SEAM(1);

    int ph = 2;
#pragma unroll 1
    for (int sl = 0; sl < 6; ++sl) {
        if (sl == 1) {
            if (IN(ph)) { __syncthreads(); unsigned char* const ws = PWS;
                EpiQKV E{(bf16*)(ws + WS_Q), (const float*)(ws + WS_BQKV), (const float*)(ws + WS_SSQ), PIN(8), PIN(9), (float*)(ws + WS_KBAR), lds};
                __syncthreads(); run_gemm(lds, (const bf16*)(ws + WS_XB), (const bf16*)(ws + WS_WQKV), 3072L * 1024 * 2, 3072, 1024, G, E, wave);
            }
            SEAM(ph); ++ph;
            if (IN(ph)) { __syncthreads(); a1_phase(lds, vcu, G, wave); }
            SEAM(ph); ++ph;
            if (IN(ph)) { __syncthreads(); a2_phase(lds, wave, CW_Q2); }
            SEAM(ph); ++ph;
            if (IN(ph)) { __syncthreads(); a3_phase(lds, vcu, G, wave); }
            SEAM(ph); ++ph;
        } else if (sl == 4) {
            if (IN(ph)) { __syncthreads(); unsigned char* const ws = PWS;
                EpiGated<1> E{(bf16*)(ws + WS_U), 1024, (const float*)(ws + WS_BPW1), 2048, (const float*)(ws + WS_SSQ), lds, 1.0f};
                __syncthreads(); run_gemm(lds, (const bf16*)(ws + WS_XB), (const bf16*)(ws + WS_WPW1), 2048L * 1024 * 2, 2048, 1024, G, E, wave);
            }
            SEAM(ph); ++ph;
            if (IN(ph)) { __syncthreads(); conv_phase(lds, vcu, G, wave); }
            SEAM(ph); ++ph;
        } else {
            const int f = (sl / 3) * 2 + ((sl % 3) == 2);
            if (IN(ph)) { __syncthreads(); unsigned char* const ws = PWS;
                if ((F8MASK >> f) & 1) {
                    EpiGated<0> E{(bf16*)(ws + WS_ACT), FF_, (const float*)(ws + WS_BFFN) + (size_t)f * 2 * 5632, 5632, (const float*)(ws + WS_SSQ), lds, 1.0f / W8_SCALE};
                    __syncthreads(); run_gemm<EpiGated<0>, true>(lds, (const bf16*)(ws + WS_X8), (const bf16*)(ws + WS_WIN) + (size_t)f * 2 * 5632 * 1024, 5632L * 1024, 5632, 512, G, E, wave);
                } else {
                EpiGated<0> E{(bf16*)(ws + WS_ACT), FF_, (const float*)(ws + WS_BFFN) + (size_t)f * 2 * 5632, 5632, (const float*)(ws + WS_SSQ), lds, 1.0f};
                __syncthreads(); run_gemm(lds, (const bf16*)(ws + WS_XB), (const bf16*)(ws + WS_WIN) + (size_t)f * 2 * 5632 * 1024, 5632L * 1024 * 2, 5632, 1024, G, E, wave);
                }
            }
            SEAM(ph); ++ph;
        }
        if (IN(ph)) { __syncthreads(); unsigned char* const ws = PWS; float* const out = POUT;
            const bf16* Ares; const bf16* Wres; int Kres; const float* bias2 = nullptr;
            if (sl == 1) { Ares = (const bf16*)(ws + WS_Q); Wres = (const bf16*)(ws + WS_WO); Kres = 1024; }
            else if (sl == 4) { Ares = (const bf16*)(ws + WS_CV); Wres = (const bf16*)(ws + WS_WPW2); Kres = 1024; bias2 = PIN(18); }
            else { const int f = (sl / 3) * 2 + ((sl % 3) == 2); Ares = (const bf16*)(ws + WS_ACT); Wres = (const bf16*)(ws + WS_WOUT) + (size_t)f * 1024 * 2816; Kres = FF_; }
            const int fnext = (sl == 1) ? 1 : (sl == 2) ? 2 : (sl == 4) ? 3 : -1;
            EpiRes E{(bf16*)(ws + WS_XB), out, bias2, (const float*)(ws + WS_COEF) + (size_t)sl * 2048, (float*)(ws + WS_SSQ), (sl == 5) ? 1 : 0, lds, (fnext >= 0 && ((F8MASK >> fnext) & 1)) ? ws + WS_X8 : nullptr};
            run_gemm(lds, Ares, Wres, 0L, 1024, Kres, G, E, wave);
        }
        SEAM(ph); ++ph;
    }
#undef IN
#undef SEAM
}

extern "C" void kernel_launch(void* const* d_in, const int* in_sizes, int n_in, void* d_out, int out_size, void* d_ws, size_t ws_size, hipStream_t stream) {
    static int grid = 0;
    if (grid == 0) {
        if (n_in != 19 || in_sizes[0] != M_ * D_ || out_size != M_ * D_ || ws_size < WS_END) {
            fprintf(stderr, "kernel_launch: unexpected problem (n_in %d, in0 %d, out %d, ws %zu); nothing launched\n", n_in, n_in > 0 ? in_sizes[0] : -1, out_size, ws_size); grid = -1; return; }
        int dev = 0, cus = 0;
        if (hipGetDevice(&dev) != hipSuccess || hipDeviceGetAttribute(&cus, hipDeviceAttributeMultiprocessorCount, dev) != hipSuccess) { grid = -1; return; }
        if (hipFuncSetAttribute((const void*)fwd, hipFuncAttributeMaxDynamicSharedMemorySize, LDS_BYTES) != hipSuccess) { fprintf(stderr, "kernel_launch: hipFuncSetAttribute failed\n"); grid = -1; return; }
        int per_cu = 0;
        if (hipOccupancyMaxActiveBlocksPerMultiprocessor(&per_cu, (const void*)fwd, 512, LDS_BYTES) != hipSuccess || per_cu < 1) fprintf(stderr, "kernel_launch: occupancy query reports %d blocks per CU\n", per_cu);
        (void)hipGetLastError();
        grid = cus;
    }
    if (grid < 0) return;
    if (hipMemsetAsync((char*)d_ws + WS_CTL, 0, CTL_ZERO_BYTES, stream) != hipSuccess) return;
    Args a{};
    for (int i = 0; i < 19; ++i) a.in[i] = (const float*)d_in[i];
    a.out = (float*)d_out; a.ws = (unsigned char*)d_ws;
#if MK_MULTI
    for (int p = 0; p < NPH; ++p) { a.lo = p; a.hi = p + 1; hipLaunchKernelGGL(fwd, dim3(grid), dim3(512), LDS_BYTES, stream, a); }
#else
    a.lo = 0; a.hi = NPH; hipLaunchKernelGGL(fwd, dim3(grid), dim3(512), LDS_BYTES, stream, a);
#endif
}
```

```cpp
#define F8MASK 12
#include <hip/hip_runtime.h>
#include <cstdio>
#include <cstdint>
#include <cmath>
namespace pg8 {
#define PG8_LAS __attribute__((address_space(3)))
typedef unsigned short bf16_t;
typedef short bf16x8 __attribute__((ext_vector_type(8)));
typedef float f32x4 __attribute__((ext_vector_type(4)));
typedef unsigned u32x4 __attribute__((ext_vector_type(4)));
constexpr int BM = 256, BK = 64, HALF = 128, HTB = HALF * BK * 2  , STAGE_BYTES = 8 * HTB, NXCD = 8, WGM = 8;

__host__ __device__ __forceinline__ int lds_byte(int r, int c) { const int st = (r >> 4) * 2 + (c >> 5), rr = r & 15, cc = c & 31, ob = rr * 64 + cc * 2; return st * 1024 + (ob ^ (((ob >> 9) & 1) << 5)); }
__host__ __device__ __forceinline__ void stage_rc(int b, int& R, int& C) { const int st = b / 1024, sb = b % 1024, swz = sb ^ (((sb >> 9) & 1) << 5); R = (st >> 1) * 16 + swz / 64; C = (st & 1) * 32 + (swz % 64) / 2; }
__host__ __device__ __forceinline__ int perm32(int rho) { const int n = rho >> 4, i = rho & 15; return 8 * (i >> 2) + 4 * n + (i & 3); }

struct Unit { int pm, pn; };
struct Gemm { const bf16_t* A; const bf16_t* Bt; int M, N, K; long bb; };

struct StaticOrder {
    int nM, nN, nwg, G, c;
    __host__ __device__ void init(int M, int N, int G_, int c_) { nM = M / BM; nN = N / BM; nwg = nM * nN; G = G_; c = c_; }
    __host__ __device__ bool next(int i, Unit& u) const {
        const long L = (long)i * G + c; if (L >= nwg) return false;
        int wgid = (int)L; { const int q = nwg / NXCD, r = nwg % NXCD, xcd = wgid % NXCD, off = wgid / NXCD; wgid = (xcd < r ? xcd * (q + 1) : r * (q + 1) + (xcd - r) * q) + off; }
        const int nig = WGM * nN, gid = wgid / nig, fm = gid * WGM, gsz = (nM - fm) < WGM ? (nM - fm) : WGM;
        u.pm = fm + ((wgid % nig) % gsz); u.pn = (wgid % nig) / gsz; return true;
    }
    __device__ __forceinline__ void a_ready(const Unit&) const {}
    __device__ __forceinline__ void done(const Unit&) const {}
};

__device__ __forceinline__ unsigned cvt_pk_bf16(float lo, float hi) { unsigned r; asm volatile("v_cvt_pk_bf16_f32 %0, %1, %2" : "=v"(r) : "v"(lo), "v"(hi)); return r; }
typedef float f32x2 __attribute__((ext_vector_type(2)));
template <class Epi, class Sched, bool ALIGN_EPI = false, bool SP2 = false, bool F8 = false>
__device__ __forceinline__ void gemm_phase(PG8_LAS unsigned char* lds, const Gemm g, const Sched& S, const Epi& E, const int tid_in) {
    typedef int pg8_i32x8 __attribute__((ext_vector_type(8))); typedef int pg8_i32x4 __attribute__((ext_vector_type(4)));
    const int tid = tid_in, wid = __builtin_amdgcn_readfirstlane(tid >> 6), lane = tid & 63, wr = wid >> 2, wc = wid & 3, fr = lane & 15, fq = lane >> 4;
    const int K = g.K, nt = K / BK;
    unsigned voffA[2], voffB[2];
#pragma unroll
    for (int i = 0; i < 2; ++i) { int R, C; stage_rc(tid * 16 + i * 8192, R, C); const int Rb = Epi::PERM ? ((R & ~31) + perm32(R & 31)) : R;
        voffA[i] = (unsigned)(R * K + C) * 2u; voffB[i] = (unsigned)(Rb * K + C) * 2u; }
    const __amdgpu_buffer_rsrc_t rs_voffA = __builtin_amdgcn_make_buffer_rsrc((void*)g.A, 0, -1, 0x00020000), rs_voffB = __builtin_amdgcn_make_buffer_rsrc((void*)g.Bt, 0, -1, 0x00020000);
    const unsigned kstep = (unsigned)(BK * 2);
    const unsigned hstep = (unsigned)(HALF * K * 2);
    const unsigned tstep = 2u * hstep;
    const unsigned ldsw = (unsigned)wid * 1024u;
    const int aoff = lds_byte(wr * 64 + fr, fq * 8), boff = lds_byte(wc * 32 + fr, fq * 8);
#define PG8_SA(b, h) (((b) * 2 + (h)) * HTB)
#define PG8_SB(b, h) ((4 + (b) * 2 + (h)) * HTB)
#define PG8_STAGE(bufoff, soff, voff) do { _Pragma("unroll") for (int _i = 0; _i < 2; ++_i) \
        __builtin_amdgcn_raw_ptr_buffer_load_lds(rs_##voff, (PG8_LAS void*)(lds + (bufoff) + ldsw + _i * 8192), 16, (int)(voff)[_i], (int)(soff), 0, 0); } while (0)
#define PG8_LD8(off) __builtin_shufflevector(*(const PG8_LAS pg8_i32x4*)(lds + (off)), *(const PG8_LAS pg8_i32x4*)(lds + (off) + 1024), 0, 1, 2, 3, 4, 5, 6, 7)
#define PG8_LDA(dst, b, h) do { if constexpr (F8) { _Pragma("unroll") for (int m = 0; m < 4; ++m) dst##8[m] = PG8_LD8(PG8_SA(b, h) + aoff + m * 2048); } else { \
        _Pragma("unroll") for (int m = 0; m < 4; ++m) _Pragma("unroll") for (int k = 0; k < 2; ++k) dst[m][k] = *(const PG8_LAS bf16x8*)(lds + PG8_SA(b, h) + aoff + m * 2048 + k * 1024); } } while (0)
#define PG8_LDB(dst, b, h) do { if constexpr (F8) { _Pragma("unroll") for (int n = 0; n < 2; ++n) dst##8[n] = PG8_LD8(PG8_SB(b, h) + boff + n * 2048); } else { \
        _Pragma("unroll") for (int n = 0; n < 2; ++n) _Pragma("unroll") for (int k = 0; k < 2; ++k) dst[n][k] = *(const PG8_LAS bf16x8*)(lds + PG8_SB(b, h) + boff + n * 2048 + k * 1024); } } while (0)
#ifndef PG8_PRIO_MMA
#define PG8_PRIO_MMA 3
#define PG8_PRIO_LOAD 0
#endif
#define PG8_MMA(ai, bj, At, Bt) do { __builtin_amdgcn_s_setprio(PG8_PRIO_MMA); \
        if constexpr (F8) { _Pragma("unroll") for (int m = 0; m < 4; ++m) _Pragma("unroll") for (int n = 0; n < 2; ++n) \
            asm volatile("v_mfma_scale_f32_16x16x128_f8f6f4 %0, %1, %2, %0, %3, %3 op_sel_hi:[0,0,0]" : "+v"(acc[ai][bj][m][n]) : "v"(Bt##8[n]), "v"(At##8[m]), "v"(sc1)); } \
        else { _Pragma("unroll") for (int m = 0; m < 4; ++m) _Pragma("unroll") for (int n = 0; n < 2; ++n) _Pragma("unroll") for (int k = 0; k < 2; ++k) \
            acc[ai][bj][m][n] = __builtin_amdgcn_mfma_f32_16x16x32_bf16(Bt[n][k], At[m][k], acc[ai][bj][m][n], 0, 0, 0); } \
        __builtin_amdgcn_s_setprio(PG8_PRIO_LOAD); } while (0)
#define PG8_WAIT_V(n) asm volatile("s_waitcnt vmcnt(" #n ")" ::: "memory")
#define PG8_WAIT_L(n) asm volatile("s_waitcnt lgkmcnt(" #n ")" ::: "memory")
#define PG8_BAR __builtin_amdgcn_s_barrier()
#define PG8_SCHED __builtin_amdgcn_sched_barrier(0)
    Unit cur, nxt; int ui = 0;
    if (!S.next(0, cur)) return;
    f32x4 acc[2][2][4][2];
#pragma unroll
    for (int a = 0; a < 2; ++a)
#pragma unroll
        for (int b = 0; b < 2; ++b)
#pragma unroll
            for (int m = 0; m < 4; ++m)
#pragma unroll
                for (int n = 0; n < 2; ++n) acc[a][b][m][n] = (f32x4){0.f, 0.f, 0.f, 0.f};
    bf16x8 At[4][2], B0[2][2], B1[2][2]; pg8_i32x8 At8[4], B08[2], B18[2];
    int sc1 = 0x7F7F7F7F; asm volatile("" : "+v"(sc1));
    unsigned cA = (unsigned)cur.pm * tstep, cB = (unsigned)cur.pn * tstep + (unsigned)(cur.pm >> 6) * (unsigned)g.bb;
    S.a_ready(cur);
    if constexpr (SP2) {
        PG8_STAGE(PG8_SB(0, 0), cB, voffB); PG8_STAGE(PG8_SB(0, 1), cB + hstep, voffB); PG8_STAGE(PG8_SA(0, 0), cA, voffA); PG8_STAGE(PG8_SA(0, 1), cA + hstep, voffA);
        if (wr == 1) PG8_BAR;
        PG8_WAIT_V(2); PG8_BAR;
        PG8_STAGE(PG8_SB(1, 0), cB + kstep, voffB); PG8_STAGE(PG8_SA(1, 0), cA + kstep, voffA); PG8_STAGE(PG8_SB(1, 1), cB + hstep + kstep, voffB);
        PG8_WAIT_V(6); PG8_BAR;
    } else {
        PG8_STAGE(PG8_SB(0, 0), cB, voffB); PG8_STAGE(PG8_SA(0, 0), cA, voffA); PG8_STAGE(PG8_SB(0, 1), cB + hstep, voffB); PG8_STAGE(PG8_SA(0, 1), cA + hstep, voffA);
        if (wr == 1) PG8_BAR;
        PG8_WAIT_V(4); PG8_BAR;
        PG8_STAGE(PG8_SB(1, 0), cB + kstep, voffB); PG8_STAGE(PG8_SA(1, 0), cA + kstep, voffA); PG8_STAGE(PG8_SB(1, 1), cB + hstep + kstep, voffB);
        PG8_WAIT_V(6); PG8_BAR;
    }
    for (;;) {
        const bool has_next = S.next(ui + 1, nxt);
        const unsigned nA = has_next ? (unsigned)nxt.pm * tstep : cA, nB = has_next ? (unsigned)nxt.pn * tstep + (unsigned)(nxt.pm >> 6) * (unsigned)g.bb : cB;
        for (int t = 0; t < nt; t += 2) {
            const bool last = (t == nt - 2);
            const unsigned a1 = cA + (unsigned)(t + 1) * kstep;
            const unsigned a2 = last ? nA : cA + (unsigned)(t + 2) * kstep, b2 = last ? nB : cB + (unsigned)(t + 2) * kstep;
            const unsigned a3 = a2 + kstep, b3 = b2 + kstep;
            if (last && has_next) S.a_ready(nxt);
            if constexpr (SP2) {
            PG8_STAGE(PG8_SA(1, 1), a1 + hstep, voffA); PG8_SCHED; PG8_LDB(B0, 0, 0); PG8_LDB(B1, 0, 1); PG8_SCHED; PG8_LDA(At, 0, 0);
            PG8_WAIT_V(8); PG8_WAIT_L(0); PG8_BAR; PG8_MMA(0, 0, At, B0); PG8_MMA(0, 1, At, B1); PG8_BAR; PG8_SCHED;
            PG8_STAGE(PG8_SB(0, 0), b2, voffB); PG8_STAGE(PG8_SB(0, 1), b2 + hstep, voffB); PG8_STAGE(PG8_SA(0, 0), a2, voffA); PG8_SCHED; PG8_LDA(At, 0, 1);
            PG8_WAIT_V(8); PG8_WAIT_L(0); PG8_BAR; PG8_MMA(1, 0, At, B0); PG8_MMA(1, 1, At, B1); PG8_BAR; PG8_SCHED;
            PG8_STAGE(PG8_SA(0, 1), a2 + hstep, voffA); PG8_SCHED; PG8_LDB(B0, 1, 0); PG8_LDB(B1, 1, 1); PG8_SCHED; PG8_LDA(At, 1, 0);
            PG8_WAIT_V(8); PG8_WAIT_L(0); PG8_BAR; PG8_MMA(0, 0, At, B0); PG8_MMA(0, 1, At, B1); PG8_BAR; PG8_SCHED;
            PG8_STAGE(PG8_SB(1, 0), b3, voffB); PG8_STAGE(PG8_SB(1, 1), b3 + hstep, voffB); PG8_STAGE(PG8_SA(1, 0), a3, voffA); PG8_SCHED; PG8_LDA(At, 1, 1);
            PG8_WAIT_V(8); PG8_WAIT_L(0); PG8_BAR; PG8_MMA(1, 0, At, B0); PG8_MMA(1, 1, At, B1); PG8_BAR; PG8_SCHED;
            } else {
            PG8_LDB(B0, 0, 0); PG8_SCHED; PG8_LDA(At, 0, 0); PG8_STAGE(PG8_SA(1, 1), a1 + hstep, voffA);
            PG8_WAIT_L(8); PG8_BAR; PG8_WAIT_L(0); PG8_MMA(0, 0, At, B0); PG8_BAR; PG8_SCHED;
            PG8_LDB(B1, 0, 1); PG8_STAGE(PG8_SB(0, 0), b2, voffB);
            PG8_BAR; PG8_WAIT_L(0); PG8_MMA(0, 1, At, B1); PG8_BAR;
            PG8_LDA(At, 0, 1); PG8_STAGE(PG8_SA(0, 0), a2, voffA);
            PG8_BAR; PG8_WAIT_L(0); PG8_MMA(1, 0, At, B0); PG8_BAR; PG8_SCHED;
            PG8_STAGE(PG8_SB(0, 1), b2 + hstep, voffB);
            PG8_WAIT_V(6); PG8_BAR; PG8_MMA(1, 1, At, B1); PG8_BAR;
            PG8_LDB(B0, 1, 0); PG8_SCHED; PG8_LDA(At, 1, 0); PG8_STAGE(PG8_SA(0, 1), a2 + hstep, voffA);
            PG8_WAIT_L(8); PG8_BAR; PG8_WAIT_L(0); PG8_MMA(0, 0, At, B0); PG8_BAR; PG8_SCHED;
            PG8_LDB(B1, 1, 1); PG8_STAGE(PG8_SB(1, 0), b3, voffB);
            PG8_BAR; PG8_WAIT_L(0); PG8_MMA(0, 1, At, B1); PG8_BAR;
            PG8_LDA(At, 1, 1); PG8_STAGE(PG8_SA(1, 0), a3, voffA);
            PG8_BAR; PG8_WAIT_L(0); PG8_MMA(1, 0, At, B0); PG8_BAR; PG8_SCHED;
            PG8_STAGE(PG8_SB(1, 1), b3 + hstep, voffB);
            PG8_WAIT_V(6); PG8_BAR; PG8_MMA(1, 1, At, B1); PG8_BAR;
            }
        }
        if constexpr (ALIGN_EPI) { if (wr == 0) PG8_BAR; }
        if constexpr (!Epi::AFTER_DRAIN) { E(acc, cur, wr, wc, fr, fq); S.done(cur); }
        if (!has_next) break;
#pragma unroll
        for (int a = 0; a < 2; ++a)
#pragma unroll
            for (int b = 0; b < 2; ++b)
#pragma unroll
                for (int m = 0; m < 4; ++m)
#pragma unroll
                    for (int n = 0; n < 2; ++n) acc[a][b][m][n] = (f32x4){0.f, 0.f, 0.f, 0.f};
        cur = nxt; cA = nA; cB = nB; ++ui;
        if constexpr (ALIGN_EPI) { if (wr == 1) PG8_BAR; }
    }
    PG8_WAIT_V(0);
    if constexpr (!ALIGN_EPI) { if (wr == 0) PG8_BAR; }
    PG8_BAR;
    if constexpr (Epi::AFTER_DRAIN) { E.fused(acc, cur, wr, wc, fr, fq, lds, wid, lane); S.done(cur); }
#undef PG8_SA
#undef PG8_SB
#undef PG8_STAGE
#undef PG8_LDA
#undef PG8_LD8
#undef PG8_LDB
#undef PG8_MMA
#undef PG8_WAIT_V
#undef PG8_WAIT_L
#undef PG8_BAR
#undef PG8_SCHED
}
}
constexpr int NB_ = 2, S_ = 16384, D_ = 1024, M_ = NB_ * S_, H_ = 16, HD_ = 64, FF_ = 2816, NBLK_ = 64;
constexpr float LOG2E_ = 1.4426950408889634f;
constexpr float C2_ = 0.125f * LOG2E_;
constexpr float EPS_ = 1e-6f;

constexpr size_t MiB = 1u << 20;
constexpr size_t WS_CTL = 0, CTL_ZERO_BYTES = 64 * 1024;
constexpr size_t WS_MOD  = 1 * MiB;
constexpr size_t WS_GM   = WS_MOD + 256 * 1024;
constexpr size_t WS_COEF = WS_GM + 64 * 1024;
constexpr size_t WS_BFFN = WS_COEF + 64 * 1024;
constexpr size_t WS_BQKV = WS_BFFN + 192 * 1024;
constexpr size_t WS_BPW1 = WS_BQKV + 32 * 1024;
constexpr size_t WS_SSQ  = 4 * MiB;
constexpr size_t WS_KBAR = 6 * MiB;
constexpr size_t WS_SEL  = 7 * MiB;
constexpr size_t WS_LP   = 9 * MiB;
constexpr size_t WS_WIN  = 16 * MiB;
constexpr size_t WS_WQKV = 104 * MiB;
constexpr size_t WS_WPW1 = 116 * MiB;
constexpr size_t WS_WOUT = 124 * MiB;
constexpr size_t WS_WO   = 146 * MiB;
constexpr size_t WS_WPW2 = 148 * MiB;
constexpr size_t WS_XB   = 152 * MiB;
constexpr size_t WS_BIG  = 216 * MiB;
constexpr size_t WS_ACT  = WS_BIG;
constexpr size_t WS_Q = WS_BIG, WS_K = WS_BIG + 64 * MiB, WS_V = WS_BIG + 128 * MiB;
constexpr size_t WS_OP3 = 408 * MiB;
constexpr size_t WS_U = WS_BIG, WS_CV = WS_BIG + 64 * MiB;
constexpr size_t WS_X8  = 472 * MiB;
constexpr size_t WS_END = 504 * MiB;
constexpr float W8_SCALE = 64.0f;
#ifndef F8MASK
#define F8MASK 0
#endif
constexpr int CW_BAR = 1024;

constexpr int RING_BYTES = 131072;
constexpr int LDSCTL_OFF = RING_BYTES, MISC_OFF = LDSCTL_OFF + 320;
constexpr int LDS_BYTES = 160768;
constexpr int LT_PM = LDSCTL_OFF + 896, LT_RSTD = LDSCTL_OFF + 1024, LT_VEC = LDSCTL_OFF + 3072;

#define GAS __attribute__((address_space(1)))
#define LAS __attribute__((address_space(3)))
typedef unsigned short bf16;
typedef float f32x4 __attribute__((ext_vector_type(4)));
typedef unsigned u32x4 __attribute__((ext_vector_type(4)));
typedef unsigned u32x2 __attribute__((ext_vector_type(2)));
typedef short bf16x8 __attribute__((ext_vector_type(8)));
typedef float f32x16 __attribute__((ext_vector_type(16)));
#define LDS_WAIT() asm volatile("s_waitcnt lgkmcnt(0)" ::: "memory")
#define VM_WAIT() asm volatile("s_waitcnt vmcnt(0)" ::: "memory")
#define LDS_BARRIER() do { asm volatile("s_waitcnt lgkmcnt(0)" ::: "memory"); __builtin_amdgcn_s_barrier(); asm volatile("" ::: "memory"); } while (0)
__device__ __forceinline__ unsigned f2bf(float f) { unsigned u = __builtin_bit_cast(unsigned, f); return (u + 0x7fffu + ((u >> 16) & 1u)) >> 16; }
__device__ __forceinline__ unsigned pk2(float lo, float hi) { return f2bf(lo) | (f2bf(hi) << 16); }
typedef __bf16 bf16x2_t __attribute__((ext_vector_type(2))); typedef float f32x2_t __attribute__((ext_vector_type(2)));
__device__ __forceinline__ unsigned cvtpk(float lo, float hi) { const f32x2_t v = {lo, hi}; const bf16x2_t b = __builtin_convertvector(v, bf16x2_t); return __builtin_bit_cast(unsigned, b); }
__device__ __forceinline__ float bf2f(unsigned h) { return __builtin_bit_cast(float, h << 16); }
__device__ __forceinline__ float bflo(unsigned w) { return __builtin_bit_cast(float, w << 16); }
__device__ __forceinline__ float bfhi(unsigned w) { return __builtin_bit_cast(float, w & 0xffff0000u); }
template <int CTRL> __device__ __forceinline__ float dppf(float v) { return __builtin_bit_cast(float, __builtin_amdgcn_mov_dpp(__builtin_bit_cast(int, v), CTRL, 0xF, 0xF, true)); }
typedef unsigned u32x2v __attribute__((ext_vector_type(2)));
__device__ __forceinline__ float u2f(unsigned u) { return __builtin_bit_cast(float, u); }
__device__ __forceinline__ unsigned f2u(float f) { return __builtin_bit_cast(unsigned, f); }
__device__ __forceinline__ float sum16(float v) { const auto r = __builtin_amdgcn_permlane16_swap(f2u(v), f2u(v), false, false); const unsigned r0 = r[0], r1 = r[1]; return u2f(r0) + u2f(r1); }
__device__ __forceinline__ float sum32(float v) { const auto r = __builtin_amdgcn_permlane32_swap(f2u(v), f2u(v), false, false); const unsigned r0 = r[0], r1 = r[1]; return u2f(r0) + u2f(r1); }
__device__ __forceinline__ float max16(float v) { const auto r = __builtin_amdgcn_permlane16_swap(f2u(v), f2u(v), false, false); const unsigned r0 = r[0], r1 = r[1]; return fmaxf(u2f(r0), u2f(r1)); }
__device__ __forceinline__ float max32(float v) { const auto r = __builtin_amdgcn_permlane32_swap(f2u(v), f2u(v), false, false); const unsigned r0 = r[0], r1 = r[1]; return fmaxf(u2f(r0), u2f(r1)); }
__device__ __forceinline__ float row_sum16(float v) { v += dppf<0xB1>(v); v += dppf<0x4E>(v); v += dppf<0x141>(v); v += dppf<0x140>(v); return v; }
__device__ __forceinline__ float wave_sum(float v) { v = row_sum16(v); v = sum16(v); return sum32(v); }
__device__ __forceinline__ float wave_max(float v) { v = fmaxf(v, dppf<0xB1>(v)); v = fmaxf(v, dppf<0x4E>(v)); v = fmaxf(v, dppf<0x141>(v)); v = fmaxf(v, dppf<0x140>(v)); v = max16(v); return max32(v); }
__device__ __forceinline__ unsigned other32(unsigned v, int hi) { const auto r = __builtin_amdgcn_permlane32_swap(v, v, false, false); const unsigned r0 = r[0], r1 = r[1]; return hi ? r0 : r1; }
#define XB_TMO      128
#define XB_XCNT(j)  (256  + 64 * (j))
#define XB_XSUB(j)  (1280 + 64 * (j))
#define XB_XGEN(j)  (2304 + 64 * (j))
#define XB_TOP      3328
#define XB_TOPGEN   3392
#define XCD_BAR_WORDS 3456
#define XB_SPIN_CAP (1u << 18)

__device__ __forceinline__ unsigned xb_ld(unsigned* p)              { return __hip_atomic_load(p, __ATOMIC_RELAXED, __HIP_MEMORY_SCOPE_AGENT); }
__device__ __forceinline__ unsigned xb_add(unsigned* p, unsigned v) { return __hip_atomic_fetch_add(p, v, __ATOMIC_RELAXED, __HIP_MEMORY_SCOPE_AGENT); }
__device__ __forceinline__ unsigned xb_xcc_id() { return (unsigned)__builtin_amdgcn_s_getreg((3 << 11) | 20) & 0xFu; }
#define XB_SPIN(cond, bar) do { unsigned _sp = 0; while (cond) { __builtin_amdgcn_s_sleep(1); \
    if ((++_sp & 255u) == 0u) { if (xb_ld(&(bar)[XB_TMO])) break; if (_sp > XB_SPIN_CAP) { atomicAdd(&(bar)[XB_TMO], 1u); break; } } } } while (0)

struct XcdBarrier {
    unsigned* bar; unsigned x;
    volatile LAS unsigned* st;
};

__device__ __forceinline__ XcdBarrier xcd_barrier_post(unsigned* bar, volatile LAS unsigned* st) {
    XcdBarrier b; b.bar = bar; b.x = xb_xcc_id(); b.st = st;
    if (threadIdx.x == 0) (void)xb_add(&bar[XB_XCNT(b.x)], 1u);
    return b;
}
__device__ __forceinline__ void xcd_barrier_complete(unsigned* bar, unsigned x, unsigned& nloc, unsigned& nx) {
    const unsigned G = gridDim.x * gridDim.y * gridDim.z;
    unsigned sum, cnt, mine, sp = 0u;
    for (;;) {
        sum = 0u; cnt = 0u; mine = 0u;
#pragma unroll
        for (unsigned j = 0; j < 16; ++j) { const unsigned c = xb_ld(&bar[XB_XCNT(j)]); sum += c; cnt += (c > 0u) ? 1u : 0u; mine = (j == x) ? c : mine; }
        if (sum == G) break;
        __builtin_amdgcn_s_sleep(1);
        if ((++sp & 255u) == 0u) { if (xb_ld(&bar[XB_TMO])) break; if (sp > XB_SPIN_CAP) { atomicAdd(&bar[XB_TMO], 1u); break; } }
    }
    nloc = mine > 0u ? mine : 1u; nx = cnt > 0u ? cnt : 1u;
}

__device__ __forceinline__ void xcd_barrier(const XcdBarrier& b) {
    asm volatile("s_waitcnt vmcnt(0)" ::: "memory");
    __syncthreads();
    if (threadIdx.x == 0) {
        unsigned* bar = b.bar;
        __builtin_amdgcn_s_waitcnt(0);
        unsigned nloc = b.st[0], nx = b.st[1];
        if (nloc == 0u) { xcd_barrier_complete(bar, b.x, nloc, nx); b.st[0] = nloc; b.st[1] = nx; }
        const unsigned old = xb_add(&bar[XB_XSUB(b.x)], 1u);
        const unsigned gen = old / nloc;
        if (old + 1u == (gen + 1u) * nloc) {
            __builtin_amdgcn_fence(__ATOMIC_RELEASE, "agent");
            asm volatile("s_waitcnt vmcnt(0)" ::: "memory");
            const unsigned og = xb_add(&bar[XB_TOP], 1u);
            const unsigned tg = og / nx;
            if (og + 1u == (tg + 1u) * nx) xb_add(&bar[XB_TOPGEN], 1u);
            else XB_SPIN(xb_ld(&bar[XB_TOPGEN]) == tg, bar);
            __builtin_amdgcn_fence(__ATOMIC_ACQUIRE, "agent");
            xb_add(&bar[XB_XGEN(b.x)], 1u);
            asm volatile("s_waitcnt vmcnt(0)" ::: "memory");
        } else {
            XB_SPIN(xb_ld(&bar[XB_XGEN(b.x)]) == gen, bar);
            __builtin_amdgcn_fence(__ATOMIC_ACQUIRE, "agent");
            asm volatile("s_waitcnt vmcnt(0)" ::: "memory");
        }
    }
    __syncthreads();
}
__device__ __forceinline__ int epi_tables_pm(LAS unsigned char* lds, const pg8::StaticOrder& S, int tid, int& pmA_out, int& pmB_out) {
    int pmA = -1, pmB = -1, ok = 1; pg8::Unit u;
    for (int i = 0; S.next(i, u); ++i) { if (pmA < 0) pmA = u.pm; else if (u.pm != pmA) { if (pmB < 0) pmB = u.pm; else if (u.pm != pmB) ok = 0; } }
    if (pmA < 0) pmA = 0;
    if (pmB < 0) pmB = pmA;
    if ((pmA >> 6) != (pmB >> 6)) ok = 0;
    if (tid == 0) { ((LAS int*)(lds + LT_PM))[0] = pmA; ((LAS int*)(lds + LT_PM))[1] = pmB; }
    pmA_out = pmA; pmB_out = pmB; return ok;
}
__device__ __forceinline__ void epi_tables_rstd(LAS unsigned char* lds, const float* ssq, int pmA, int pmB, int ok, int tid, float scale = 1.0f) {
    const int slot = tid >> 8, r = tid & 255, row = (slot ? pmB : pmA) * 256 + r;
    const f32x4 p0 = *(const f32x4*)(ssq + (size_t)row * 16), p1 = *(const f32x4*)(ssq + (size_t)row * 16 + 4), p2 = *(const f32x4*)(ssq + (size_t)row * 16 + 8), p3 = *(const f32x4*)(ssq + (size_t)row * 16 + 12);
    const float sm = (((p0.x + p0.y) + (p0.z + p0.w)) + ((p1.x + p1.y) + (p1.z + p1.w))) + (((p2.x + p2.y) + (p2.z + p2.w)) + ((p3.x + p3.y) + (p3.z + p3.w)));
    ((LAS float*)(lds + LT_RSTD))[tid] = ok ? rsqrtf(sm * (1.0f / D_) + EPS_) * scale : __builtin_nanf("");
}
__device__ __forceinline__ void epi_tables_vec(LAS unsigned char* lds, int dst_off, const float* src, int n, int tid) {
    for (int i = tid * 4; i < n; i += 2048) *(LAS f32x4*)(lds + LT_VEC + (dst_off + i) * 4) = src ? *(const f32x4*)(src + i) : (f32x4){0.f, 0.f, 0.f, 0.f};
}
__device__ __forceinline__ unsigned pk4_fp8(float a, float b, float c, float d) {
    unsigned w = 0u; w = (unsigned)__builtin_amdgcn_cvt_pk_fp8_f32(a, b, (int)w, false); w = (unsigned)__builtin_amdgcn_cvt_pk_fp8_f32(c, d, (int)w, true); return w; }
__device__ __forceinline__ int lane_id() { return (int)__builtin_amdgcn_mbcnt_hi(~0u, __builtin_amdgcn_mbcnt_lo(~0u, 0u)); }
__device__ __forceinline__ float sigm(float v) { return __builtin_amdgcn_rcpf(1.0f + __builtin_amdgcn_exp2f(-LOG2E_ * v)); }

template <int ACT> struct EpiGated {
    static constexpr bool PERM = true, AFTER_DRAIN = false;
    bf16* O; int ldo; const float* bias; int N; const float* ssq; LAS unsigned char* lds; float rscale;
    __device__ __forceinline__ void preload(const pg8::StaticOrder& S, int tid) const {
        int pmA, pmB; const int ok = epi_tables_pm(lds, S, tid, pmA, pmB);
        epi_tables_rstd(lds, ssq, pmA, pmB, ok, tid, rscale);
        epi_tables_vec(lds, 0, bias + (size_t)(pmA >> 6) * N, N, tid);
    }
    __device__ __forceinline__ void operator()(const f32x4 (&acc)[2][2][4][2], const pg8::Unit& u, int wr, int wc, int fr, int fq) const {
        const LAS float* bp = (const LAS float*)(lds + LT_VEC) + u.pn * 256 + wc * 32 + 8 * fq;
        const LAS float* rt = (const LAS float*)(lds + LT_RSTD) + ((u.pm == ((const LAS int*)(lds + LT_PM))[0]) ? 0 : 256) + wr * 64 + fr;
        f32x4 bv[2][2];
#pragma unroll
        for (int bj = 0; bj < 2; ++bj)
#pragma unroll
            for (int n = 0; n < 2; ++n) bv[bj][n] = *(const LAS f32x4*)(bp + bj * 128 + 4 * n);
        float rsv[8];
#pragma unroll
        for (int k = 0; k < 8; ++k) rsv[k] = rt[(k >> 2) * 128 + (k & 3) * 16];
#pragma unroll
        for (int ai = 0; ai < 2; ++ai)
#pragma unroll
            for (int m = 0; m < 4; ++m) {
                const int row = u.pm * 256 + ai * 128 + wr * 64 + m * 16 + fr;
                const float rs = rsv[ai * 4 + m];
                typedef float f2 __attribute__((ext_vector_type(2)));
                f2 a[4], g[4], t[4], e[4], d[4], r[4], v[4];
#pragma unroll
                for (int i = 0; i < 4; ++i) { const int n = i >> 1; const f32x4 a4 = acc[ai][0][m][n], g4 = acc[ai][1][m][n], ba4 = bv[0][n], bg4 = bv[1][n];
                    a[i] = ((i & 1) == 0 ? (f2){a4.x, a4.y} : (f2){a4.z, a4.w}) * rs + ((i & 1) == 0 ? (f2){ba4.x, ba4.y} : (f2){ba4.z, ba4.w});
                    g[i] = ((i & 1) == 0 ? (f2){g4.x, g4.y} : (f2){g4.z, g4.w}) * rs + ((i & 1) == 0 ? (f2){bg4.x, bg4.y} : (f2){bg4.z, bg4.w});
                    t[i] = ((ACT == 0) ? a[i] : g[i]) * (-LOG2E_); }
#pragma unroll
                for (int i = 0; i < 4; ++i) { e[i].x = __builtin_amdgcn_exp2f(t[i].x); e[i].y = __builtin_amdgcn_exp2f(t[i].y); }
#pragma unroll
                for (int i = 0; i < 4; ++i) d[i] = e[i] + 1.0f;
#pragma unroll
                for (int i = 0; i < 4; ++i) { r[i].x = __builtin_amdgcn_rcpf(d[i].x); r[i].y = __builtin_amdgcn_rcpf(d[i].y); }
#pragma unroll
                for (int i = 0; i < 4; ++i) v[i] = (ACT == 0) ? (a[i] * r[i]) * g[i] : a[i] * r[i];
                u32x4 w; w.x = cvtpk(v[0].x, v[0].y); w.y = cvtpk(v[1].x, v[1].y); w.z = cvtpk(v[2].x, v[2].y); w.w = cvtpk(v[3].x, v[3].y);
                *(u32x4*)(O + (size_t)row * ldo + u.pn * 128 + wc * 32 + 8 * fq) = w;
            }
    }
};

struct EpiRes {
    static constexpr bool PERM = true, AFTER_DRAIN = false;
    bf16* xb; float* out; const float* bias2; const float* coef; float* ssq; int last; LAS unsigned char* lds; unsigned char* x8;
    __device__ __forceinline__ void preload(const pg8::StaticOrder& S, int tid) const {
        int pmA, pmB; const int ok = epi_tables_pm(lds, S, tid, pmA, pmB);
        epi_tables_vec(lds, 0, ok ? coef + (size_t)(pmA >> 6) * D_ : nullptr, D_, tid);
        epi_tables_vec(lds, D_, bias2, D_, tid);
    }
    __device__ __forceinline__ void operator()(const f32x4 (&acc)[2][2][4][2], const pg8::Unit& u, int wr, int wc, int fr, int fq) const {
        const int col0 = u.pn * 256 + wc * 32 + 8 * fq;
        const size_t ro0 = (size_t)(u.pm * 256 + wr * 64 + fr) * D_ + col0;
        u32x4 xr[8][2];
#define EPIRES_LOAD(k) do { const bf16* xp_ = xb + ro0 + (size_t)(((k) >> 2) * 128 + ((k) & 3) * 16) * D_; xr[k][0] = *(const u32x4*)(xp_); xr[k][1] = *(const u32x4*)(xp_ + 128); } while (0)
        EPIRES_LOAD(0); EPIRES_LOAD(1); EPIRES_LOAD(2); EPIRES_LOAD(3);
        f32x4 cf[2][2], b2[2][2];
#pragma unroll
        for (int bj = 0; bj < 2; ++bj)
#pragma unroll
            for (int n = 0; n < 2; ++n) { const int c = col0 + bj * 128 + 4 * n;
                cf[bj][n] = *(const LAS f32x4*)(lds + LT_VEC + c * 4);
                b2[bj][n] = *(const LAS f32x4*)(lds + LT_VEC + (D_ + c) * 4); }
#pragma unroll
        for (int k = 0; k < 8; ++k) {
            const int ai = k >> 2, m = k & 3;
            if (k < 4) { switch (k) { case 0: EPIRES_LOAD(4); break; case 1: EPIRES_LOAD(5); break; case 2: EPIRES_LOAD(6); break; default: EPIRES_LOAD(7); break; } }
            const int row = u.pm * 256 + ai * 128 + wr * 64 + m * 16 + fr; const size_t ro = (size_t)row * D_;
            float ss = 0.f;
#pragma unroll
            for (int bj = 0; bj < 2; ++bj) {
                const u32x4 xw = xr[k][bj];
                const f32x4 x0 = (f32x4){bflo(xw.x), bfhi(xw.x), bflo(xw.y), bfhi(xw.y)}, x1 = (f32x4){bflo(xw.z), bfhi(xw.z), bflo(xw.w), bfhi(xw.w)};
                const f32x4 n0 = x0 + cf[bj][0] * (acc[ai][bj][m][0] + b2[bj][0]), n1 = x1 + cf[bj][1] * (acc[ai][bj][m][1] + b2[bj][1]);
                ss += ((n0[0] * n0[0] + n0[1] * n0[1]) + (n0[2] * n0[2] + n0[3] * n0[3])) + ((n1[0] * n1[0] + n1[1] * n1[1]) + (n1[2] * n1[2] + n1[3] * n1[3]));
                if (!last) { u32x4 w; w.x = cvtpk(n0[0], n0[1]); w.y = cvtpk(n0[2], n0[3]); w.z = cvtpk(n1[0], n1[1]); w.w = cvtpk(n1[2], n1[3]);
                    *(u32x4*)(xb + ro + col0 + bj * 128) = w;
                    if (x8) { u32x2 w8; w8.x = pk4_fp8(n0[0], n0[1], n0[2], n0[3]); w8.y = pk4_fp8(n1[0], n1[1], n1[2], n1[3]); *(u32x2*)(x8 + ro + col0 + bj * 128) = w8; } }
                else { *(f32x4*)(out + ro + col0 + bj * 128) = n0; *(f32x4*)(out + ro + col0 + bj * 128 + 4) = n1; }
            }
            if (!last) { ss = sum32(sum16(ss)); if (fq == 0) ssq[(size_t)row * 16 + u.pn * 4 + wc] = ss; }
        }
#undef EPIRES_LOAD
    }
};

struct EpiQKV {
    static constexpr bool PERM = true, AFTER_DRAIN = false;
    bf16* Q;   const float* bias; const float* ssq; const float* gq; const float* gk; float* kbarp; LAS unsigned char* lds;
    __device__ __forceinline__ void preload(const pg8::StaticOrder& S, int tid) const {
        int pmA, pmB; const int ok = epi_tables_pm(lds, S, tid, pmA, pmB);
        epi_tables_rstd(lds, ssq, pmA, pmB, ok, tid);
        epi_tables_vec(lds, 0, bias + (size_t)(pmA >> 6) * 3072, 3072, tid);
        epi_tables_vec(lds, 3072, gq, 64, tid); epi_tables_vec(lds, 3072 + 64, gk, 64, tid);
    }
    __device__ __forceinline__ void operator()(const f32x4 (&acc)[2][2][4][2], const pg8::Unit& u, int wr, int wc, int fr, int fq) const {
        const int b = u.pm >> 6, part = u.pn >> 2, head = ((u.pn & 3) << 2) + wc;
        const LAS float* bp = (const LAS float*)(lds + LT_VEC) + u.pn * 256 + wc * 32 + 8 * fq;
        const LAS float* gsrc = (const LAS float*)(lds + LT_VEC) + 3072 + ((part == 0) ? 0 : 64); const float gs = (part == 0) ? C2_ : 1.0f;
        const LAS float* rt = (const LAS float*)(lds + LT_RSTD) + ((u.pm == ((const LAS int*)(lds + LT_PM))[0]) ? 0 : 256) + wr * 64 + fr;
        f32x4 bv[2][2], gv[2][2], ks[2][2];
#pragma unroll
        for (int bj = 0; bj < 2; ++bj)
#pragma unroll
            for (int n = 0; n < 2; ++n) { bv[bj][n] = *(const LAS f32x4*)(bp + bj * 128 + 4 * n); gv[bj][n] = *(const LAS f32x4*)(gsrc + 32 * bj + 8 * fq + 4 * n) * gs; ks[bj][n] = (f32x4){0.f, 0.f, 0.f, 0.f}; }
        bf16* dst = Q + (size_t)part * ((size_t)M_ * D_);
        float rsv[8];
#pragma unroll
        for (int k = 0; k < 8; ++k) rsv[k] = rt[(k >> 2) * 128 + (k & 3) * 16];
#pragma unroll
        for (int ai = 0; ai < 2; ++ai)
#pragma unroll
            for (int m = 0; m < 4; ++m) {
                const int row = u.pm * 256 + ai * 128 + wr * 64 + m * 16 + fr;
                const float rs = rsv[ai * 4 + m];
                f32x4 v[2][2]; float ss = 0.f;
#pragma unroll
                for (int bj = 0; bj < 2; ++bj)
#pragma unroll
                    for (int n = 0; n < 2; ++n) { v[bj][n] = acc[ai][bj][m][n] * rs + bv[bj][n]; const f32x4 t = v[bj][n]; ss += (t[0] * t[0] + t[1] * t[1]) + (t[2] * t[2] + t[3] * t[3]); }
                if (part < 2) {
                    ss = sum32(sum16(ss));
                    const float r = rsqrtf(ss * (1.0f / HD_) + EPS_);
#pragma unroll
                    for (int bj = 0; bj < 2; ++bj)
#pragma unroll
                        for (int n = 0; n < 2; ++n) v[bj][n] = v[bj][n] * r * gv[bj][n];
                }
                if (part == 1) {
#pragma unroll
                    for (int bj = 0; bj < 2; ++bj)
#pragma unroll
                        for (int n = 0; n < 2; ++n) ks[bj][n] += v[bj][n];
                }
#pragma unroll
                for (int bj = 0; bj < 2; ++bj) {
                    u32x4 w; w.x = cvtpk(v[bj][0][0], v[bj][0][1]); w.y = cvtpk(v[bj][0][2], v[bj][0][3]); w.z = cvtpk(v[bj][1][0], v[bj][1][1]); w.w = cvtpk(v[bj][1][2], v[bj][1][3]);
                    *(u32x4*)(dst + (size_t)row * D_ + head * 64 + 32 * bj + 8 * fq) = w; }
            }
        if (part == 1) {
            float* kp = kbarp + ((((size_t)(b * 16 + head) * 64 + (u.pm & 63)) * 2 + wr) * 64);
#pragma unroll
            for (int bj = 0; bj < 2; ++bj)
#pragma unroll
                for (int n = 0; n < 2; ++n) { f32x4 t = ks[bj][n];
#pragma unroll
                    for (int j = 0; j < 4; ++j) { t[j] = row_sum16(t[j]); }
                    if (fr == 0) *(f32x4*)(kp + 32 * bj + 8 * fq + 4 * n) = t; }
        }
    }
};

template <class Epi, bool F8 = false> __device__ __forceinline__ void run_gemm(LAS unsigned char* lds, const bf16* A, const bf16* Bt, long bb, int N, int K, int G, const Epi& E, int wave_in) {
    int t = lane_id(); asm volatile("" : "+v"(t)); t += 64 * wave_in;
    int bid = (int)blockIdx.x, Gq = G; asm volatile("" : "+s"(bid), "+s"(Gq));
    pg8::Gemm g{A, Bt, M_, N, K, bb}; pg8::StaticOrder S; S.init(M_, N, Gq, bid);
    E.preload(S, t);
    __syncthreads();
    pg8::gemm_phase<Epi, pg8::StaticOrder, true, true, F8>(lds, g, S, E, t);
}

__device__ __forceinline__ void tile_load(float (&w)[32], const float* W, int N, int k0, int n0, int lane) {
    const float* p = W + (size_t)(k0 + (lane >> 5)) * N + n0 + (lane & 31);
#pragma unroll
    for (int i = 0; i < 32; ++i) w[i] = p[(size_t)(2 * i) * N];
}
__device__ __forceinline__ void tile_to_lds(const float (&w)[32], LAS float* scr, int lane) {
#pragma unroll
    for (int i = 0; i < 32; ++i) scr[(2 * i + (lane >> 5)) * 33 + (lane & 31)] = w[i];
}
__device__ __forceinline__ void transpose_finish(int K, bf16* WT, int k0, int dst0, LAS float* scr, int lane) {
    LDS_WAIT(); asm volatile("" ::: "memory");
    const int c = lane & 7;
#pragma unroll
    for (int j = 0; j < 4; ++j) { const int n = (lane >> 3) + 8 * j; const LAS float* s = scr + (8 * c) * 33 + n;
        u32x4 o; o.x = cvtpk(s[0 * 33], s[1 * 33]); o.y = cvtpk(s[2 * 33], s[3 * 33]); o.z = cvtpk(s[4 * 33], s[5 * 33]); o.w = cvtpk(s[6 * 33], s[7 * 33]);
        *(GAS u32x4*)(WT + (size_t)(dst0 + n) * K + k0 + 8 * c) = o; }
    LDS_WAIT(); asm volatile("" ::: "memory");
}
__device__ __forceinline__ int gated_dst(int n0, int half) { const int c = (n0 < half) ? n0 : n0 - half; return 256 * (c >> 7) + (c & 127) + ((n0 < half) ? 0 : 128); }

constexpr int PT_OFF = MISC_OFF + 128;
__device__ __forceinline__ unsigned long long pt_get(LAS unsigned char* lds, int i) {
    const unsigned long long v = ((volatile LAS unsigned long long*)(lds + PT_OFF))[i];
    return ((unsigned long long)(unsigned)__builtin_amdgcn_readfirstlane((int)(v >> 32)) << 32) | (unsigned long long)(unsigned)__builtin_amdgcn_readfirstlane((int)(unsigned)v);
}
#define PIN(i) ((const float*)(const GAS float*)pt_get(lds, (i)))
#define POUT ((float*)(GAS float*)pt_get(lds, 19))
#define PWS ((unsigned char*)(GAS unsigned char*)pt_get(lds, 20))

__device__ __forceinline__ void inweight_item(const float* W, int N, bf16* WT, size_t wt_bstride, int kh, int n0, int dst0, const float* ng, const float* mod0,
                                              float* bias, int bias_bstride, const float* extra, LAS float* scr, int lane, int f8out = 0) {
    const int c = lane & 7;
    float dacc[4][2];
#pragma unroll
    for (int j = 0; j < 4; ++j) { dacc[j][0] = 0.f; dacc[j][1] = 0.f; }
    float w[32]; tile_load(w, W, N, 64 * 8 * kh, n0, lane);
    f32x4 gq[2], s0q[2], s1q[2], h0q[2], h1q[2];
#define INW_VECS(kq_) do { _Pragma("unroll") for (int q4 = 0; q4 < 2; ++q4) { gq[q4] = *(const f32x4*)(ng + (kq_) + 4 * q4); s0q[q4] = *(const f32x4*)(mod0 + 1024 + (kq_) + 4 * q4); \
        s1q[q4] = *(const f32x4*)(mod0 + 9216 + 1024 + (kq_) + 4 * q4); h0q[q4] = *(const f32x4*)(mod0 + (kq_) + 4 * q4); h1q[q4] = *(const f32x4*)(mod0 + 9216 + (kq_) + 4 * q4); } } while (0)
    INW_VECS(64 * 8 * kh + 8 * c);
#pragma unroll 1
    for (int kb = 8 * kh; kb < 8 * kh + 8; ++kb) {
        const int k0 = 64 * kb, kq = k0 + 8 * c;
        tile_to_lds(w, scr, lane);
        float gm0[8], gm1[8], sh0[8], sh1[8];
#pragma unroll
        for (int q4 = 0; q4 < 2; ++q4)
#pragma unroll
            for (int e = 0; e < 4; ++e) { gm0[4 * q4 + e] = gq[q4][e] * (1.0f + s0q[q4][e]); gm1[4 * q4 + e] = gq[q4][e] * (1.0f + s1q[q4][e]); sh0[4 * q4 + e] = h0q[q4][e]; sh1[4 * q4 + e] = h1q[q4][e]; }
        if (kb + 1 < 8 * kh + 8) { tile_load(w, W, N, k0 + 64, n0, lane); INW_VECS(kq + 64); }
        LDS_WAIT(); asm volatile("" ::: "memory");
#pragma unroll
        for (int j = 0; j < 4; ++j) { const int n = (lane >> 3) + 8 * j; const LAS float* sp = scr + (8 * c) * 33 + n;
            float v[8];
#pragma unroll
            for (int e = 0; e < 8; ++e) v[e] = sp[e * 33];
            if (f8out) {
                u32x2 o0, o1;
                o0.x = pk4_fp8(v[0] * gm0[0] * W8_SCALE, v[1] * gm0[1] * W8_SCALE, v[2] * gm0[2] * W8_SCALE, v[3] * gm0[3] * W8_SCALE); o0.y = pk4_fp8(v[4] * gm0[4] * W8_SCALE, v[5] * gm0[5] * W8_SCALE, v[6] * gm0[6] * W8_SCALE, v[7] * gm0[7] * W8_SCALE);
                o1.x = pk4_fp8(v[0] * gm1[0] * W8_SCALE, v[1] * gm1[1] * W8_SCALE, v[2] * gm1[2] * W8_SCALE, v[3] * gm1[3] * W8_SCALE); o1.y = pk4_fp8(v[4] * gm1[4] * W8_SCALE, v[5] * gm1[5] * W8_SCALE, v[6] * gm1[6] * W8_SCALE, v[7] * gm1[7] * W8_SCALE);
                unsigned char* wp = (unsigned char*)WT + (size_t)(dst0 + n) * 1024 + kq;
                *(GAS u32x2*)(wp) = o0; *(GAS u32x2*)(wp + wt_bstride) = o1;
            } else {
            u32x4 o0, o1;
            o0.x = cvtpk(v[0] * gm0[0], v[1] * gm0[1]); o0.y = cvtpk(v[2] * gm0[2], v[3] * gm0[3]); o0.z = cvtpk(v[4] * gm0[4], v[5] * gm0[5]); o0.w = cvtpk(v[6] * gm0[6], v[7] * gm0[7]);
            o1.x = cvtpk(v[0] * gm1[0], v[1] * gm1[1]); o1.y = cvtpk(v[2] * gm1[2], v[3] * gm1[3]); o1.z = cvtpk(v[4] * gm1[4], v[5] * gm1[5]); o1.w = cvtpk(v[6] * gm1[6], v[7] * gm1[7]);
            bf16* wp = WT + (size_t)(dst0 + n) * 1024 + kq;
            *(GAS u32x4*)(wp) = o0; *(GAS u32x4*)(wp + wt_bstride) = o1;
            }
            float d0 = 0.f, d1 = 0.f;
#pragma unroll
            for (int e = 0; e < 8; ++e) { d0 += v[e] * sh0[e]; d1 += v[e] * sh1[e]; }
            dacc[j][0] += d0; dacc[j][1] += d1; }
        LDS_WAIT(); asm volatile("" ::: "memory");
    }
#pragma unroll
    for (int j = 0; j < 4; ++j)
#pragma unroll
        for (int bb = 0; bb < 2; ++bb) { float v = dacc[j][bb]; v += dppf<0xB1>(v); v += dppf<0x4E>(v); v += dppf<0x141>(v);
            if (c == 0) { const int n = (lane >> 3) + 8 * j; if (kh == 0 && extra) v += extra[n0 + n];
                __hip_atomic_fetch_add(bias + (size_t)bb * bias_bstride + dst0 + n, v, __ATOMIC_RELAXED, __HIP_MEMORY_SCOPE_AGENT); } }
}

#undef INW_VECS
__device__ __forceinline__ void phase_p0(LAS unsigned char* lds, int vcu, int G, int wave_in) {
    int tid = lane_id(); asm volatile("" : "+v"(tid)); tid += 64 * wave_in;
    const int lane = tid & 63, wave = __builtin_amdgcn_readfirstlane(tid >> 6);
    LAS float* cs = (LAS float*)lds;
    LAS float* red = (LAS float*)(lds + 8192);
    LAS float* scr = (LAS float*)(lds + 16384 + wave * 8704);
    unsigned char* const ws = PWS;
    float* MOD = (float*)(ws + WS_MOD);
    { const float* cin = PIN(1); for (int i = tid; i < 2048; i += 512) { const float v = cin[i]; cs[i] = v / (1.0f + expf(-v)); } }
    { float* bz = (float*)(ws + WS_BFFN); for (int i = vcu * 512 + tid; i < (192 + 32 + 16) * 256; i += G * 512) bz[i] = 0.f; }
    __syncthreads();
    for (int it = blockIdx.x; it < 288; it += G) {
        const int li = it / 144, cg = it % 144;
        const float* W = PIN(3) + (size_t)li * 1024 * 9216 + cg * 64 + lane; const float* adab = PIN(4);
        float a0 = 0.f, a1 = 0.f;
#pragma unroll 64
        for (int k = wave * 128; k < wave * 128 + 128; ++k) { const float w = W[(size_t)k * 9216]; a0 += cs[k] * w; a1 += cs[1024 + k] * w; }
        red[(wave * 2 + 0) * 64 + lane] = a0; red[(wave * 2 + 1) * 64 + lane] = a1;
        __syncthreads();
        if (tid < 128) { const int b = tid >> 6, l = tid & 63; float s = 0.f;
#pragma unroll
            for (int w = 0; w < 8; ++w) s += red[(w * 2 + b) * 64 + l];
            MOD[(size_t)(li * 2 + b) * 9216 + cg * 64 + l] = s + adab[li * 9216 + cg * 64 + l]; }
        __syncthreads();
    }
    const int gw = vcu * 8 + wave, NGW = G * 8;
    bf16* WOUT = (bf16*)(ws + WS_WOUT); bf16* WO = (bf16*)(ws + WS_WO); bf16* WPW2 = (bf16*)(ws + WS_WPW2);
    constexpr int I_OUT = 44 * 32, I_O = 16 * 32, I_PW2 = 16 * 32;
    constexpr int NITEMS = 4 * I_OUT + I_O + I_PW2;
    {
        const float* w6 = PIN(6); const float* w10 = PIN(10); const float* w17 = PIN(17);
#define OUTW_DECODE(it_, W_, K_, WT_, k0_, n0_) do { int r_ = (it_); \
            if (r_ < 4 * I_OUT) { const int f_ = r_ / I_OUT; r_ %= I_OUT; W_ = w6 + (size_t)f_ * 2816 * 1024; K_ = 2816; WT_ = WOUT + (size_t)f_ * 1024 * 2816; } \
            else if (r_ < 4 * I_OUT + I_O) { r_ -= 4 * I_OUT; W_ = w10; K_ = 1024; WT_ = WO; } \
            else { r_ -= 4 * I_OUT + I_O; W_ = w17; K_ = 1024; WT_ = WPW2; } \
            k0_ = 64 * (r_ / 32); n0_ = 32 * (r_ % 32); } while (0)
        float w[32]; const float* Wc; int Kc, k0c, n0c; bf16* WTc;
        if (gw < NITEMS) { OUTW_DECODE(gw, Wc, Kc, WTc, k0c, n0c); tile_load(w, Wc, 1024, k0c, n0c, lane); }
        for (int it = gw; it < NITEMS; it += NGW) {
            tile_to_lds(w, scr, lane);
            const float* Wn = Wc; int Kn = Kc, k0n = k0c, n0n = n0c; bf16* WTn = WTc;
            if (it + NGW < NITEMS) { OUTW_DECODE(it + NGW, Wn, Kn, WTn, k0n, n0n); tile_load(w, Wn, 1024, k0n, n0n, lane); }
            transpose_finish(Kc, WTc, k0c, n0c, scr, lane);
            Wc = Wn; Kc = Kn; k0c = k0n; n0c = n0n; WTc = WTn;
        }
#undef OUTW_DECODE
    }
    const float* x = PIN(0); bf16* XB = (bf16*)(ws + WS_XB); float* SSQ = (float*)(ws + WS_SSQ);
    {
        f32x4 v[2][4], vn[2][4];
#define XROWS_LOAD(dst, r0_) do { _Pragma("unroll") for (int r = 0; r < 2; ++r) _Pragma("unroll") for (int jj = 0; jj < 4; ++jj) \
            dst[r][jj] = ((r0_) + r * NGW < M_) ? *(const f32x4*)(x + (size_t)((r0_) + r * NGW) * D_ + 4 * lane + 256 * jj) : (f32x4){0.f, 0.f, 0.f, 0.f}; } while (0)
        XROWS_LOAD(vn, gw);
        for (int row0 = gw; row0 < M_; row0 += 2 * NGW) {
#pragma unroll
            for (int r = 0; r < 2; ++r)
#pragma unroll
                for (int jj = 0; jj < 4; ++jj) v[r][jj] = vn[r][jj];
            if (row0 + 2 * NGW < M_) XROWS_LOAD(vn, row0 + 2 * NGW);
#pragma unroll
            for (int r = 0; r < 2; ++r) { const int row = row0 + r * NGW; if (row >= M_) break; float ss = 0.f;
#pragma unroll
                for (int jj = 0; jj < 4; ++jj) { const int c = 4 * lane + 256 * jj; const f32x4 t = v[r][jj];
                    ss += (t[0] * t[0] + t[1] * t[1]) + (t[2] * t[2] + t[3] * t[3]);
                    u32x2 w; w.x = cvtpk(t[0], t[1]); w.y = cvtpk(t[2], t[3]);
                    *(u32x2*)(XB + (size_t)row * D_ + c) = w; }
                ss = wave_sum(ss);
                if (lane < 4) *(f32x4*)(SSQ + (size_t)row * 16 + 4 * lane) = (f32x4){lane == 0 ? ss : 0.f, 0.f, 0.f, 0.f}; }
        }
#undef XROWS_LOAD
    }
}

__device__ __forceinline__ void phase_p1(LAS unsigned char* lds, int vcu, int G, int wave_in) {
    int tid = lane_id(); asm volatile("" : "+v"(tid)); tid += 64 * wave_in;
    const int lane = tid & 63, wave = __builtin_amdgcn_readfirstlane(tid >> 6);
    LAS float* scr = (LAS float*)(lds + 16384 + wave * 8704);
    unsigned char* const ws = PWS; const float* ng = PIN(2);
    const float* MOD = (const float*)(ws + WS_MOD);
    float* COEF = (float*)(ws + WS_COEF);
    for (int i = vcu * 512 + tid; i < 6 * 2 * 1024; i += G * 512) {
        const int sl = i >> 11, b = (i >> 10) & 1, d = i & 1023, li = sl / 3, j = sl % 3;
        const float* mod = MOD + (size_t)(li * 2 + b) * 9216 + j * 3 * 1024;
        COEF[i] = ((j == 1) ? 1.0f : 0.5f) * mod[2048 + d];
    }
    const int gw = vcu * 8 + wave, NGW = G * 8;
    constexpr int I_IN = 176 * 2, I_QKV = 96 * 2, I_PW1 = 64 * 2;
    for (int it = gw; it < 4 * I_IN + I_QKV + I_PW1; it += NGW) {
        int r = it;
        if (r < 4 * I_IN) { const int f = r / I_IN; r %= I_IN; const int kh = (r >> 3) & 1, n0 = 32 * ((r >> 4) * 8 + (r & 7)), sl = (f >> 1) * 3 + (f & 1) * 2;
            inweight_item(PIN(5) + (size_t)f * 1024 * 5632, 5632, (bf16*)(ws + WS_WIN) + (size_t)f * 2 * 5632 * 1024, (size_t)5632 * 1024, kh, n0, gated_dst(n0, FF_),
                          ng + sl * 1024, MOD + (size_t)((sl / 3) * 2) * 9216 + (sl % 3) * 3 * 1024, (float*)(ws + WS_BFFN) + (size_t)f * 2 * 5632, 5632, nullptr, scr, lane, (F8MASK >> f) & 1); continue; }
        r -= 4 * I_IN;
        if (r < I_QKV) { const int kh = (r >> 3) & 1, n0 = 32 * ((r >> 4) * 8 + (r & 7)); const int part = n0 >> 10, head = (n0 & 1023) >> 6, e0 = n0 & 63;
            const int dst0 = 256 * (part * 4 + (head >> 2)) + 128 * (e0 >> 5) + 32 * (head & 3);
            inweight_item(PIN(7), 3072, (bf16*)(ws + WS_WQKV), (size_t)3072 * 1024, kh, n0, dst0, ng + 1 * 1024, MOD + 1 * 3 * 1024, (float*)(ws + WS_BQKV), 3072, nullptr, scr, lane); continue; }
        r -= I_QKV;
        { const int kh = (r >> 3) & 1, n0 = 32 * ((r >> 4) * 8 + (r & 7));
            inweight_item(PIN(11), 2048, (bf16*)(ws + WS_WPW1), (size_t)2048 * 1024, kh, n0, gated_dst(n0, 1024), ng + 4 * 1024, MOD + (size_t)2 * 9216 + 1 * 3 * 1024, (float*)(ws + WS_BPW1), 2048, PIN(12), scr, lane); }
    }
}

typedef float f32x2 __attribute__((ext_vector_type(2)));
__device__ __forceinline__ f32x2 bfpair(unsigned v) { return (f32x2){bflo(v), bfhi(v)}; }
__device__ __forceinline__ void conv_phase(LAS unsigned char* lds, int vcu, int G, int wave_in) {
    int tid = lane_id(); asm volatile("" : "+v"(tid)); tid += 64 * wave_in;
    const int lane = tid & 63, wave = __builtin_amdgcn_readfirstlane(tid >> 6), c0 = 2 * tid;
    LAS float* part = (LAS float*)lds;
    unsigned char* const ws = PWS;
    const bf16* U = (const bf16*)(ws + WS_U); bf16* CV = (bf16*)(ws + WS_CV);
    f32x2 w[31];
    { const float* wdw = PIN(13);
#pragma unroll
    for (int j = 0; j < 31; ++j) w[j] = *(const f32x2*)(wdw + j * D_ + c0); }
    f32x2 bd, lg, lb;
    { const float* p = PIN(14); bd = *(const f32x2*)(p + c0); p = PIN(15); lg = *(const f32x2*)(p + c0); p = PIN(16); lb = *(const f32x2*)(p + c0); }
    for (int un = vcu; un < 256; un += G) {
        const int b = un >> 7, t0 = (un & 127) * 128;
        const unsigned* Up = (const unsigned*)(U + (size_t)b * S_ * D_ + c0);
        unsigned* Op = (unsigned*)(CV + (size_t)b * S_ * D_ + c0);
        f32x2 hist[38];
        unsigned nx0[8], nx1[8];
#pragma unroll
        for (int i = 0; i < 8; ++i) { nx0[i] = Up[(size_t)(t0 + i) * 512]; nx1[i] = Up[(size_t)(t0 + 8 + i) * 512]; }
#pragma unroll
        for (int i = 0; i < 30; ++i) { const int tt = t0 - 30 + i; const unsigned v = (tt >= 0) ? Up[(size_t)tt * 512] : 0u; hist[i] = bfpair(v); }
        int pb = 0;
#pragma unroll 1
        for (int st = 0; st < 16; ++st) {
#pragma unroll
            for (int i = 0; i < 8; ++i) { hist[30 + i] = bfpair(nx0[i]); nx0[i] = nx1[i]; }
            if (st < 14) {
#pragma unroll
                for (int i = 0; i < 8; ++i) nx1[i] = Up[(size_t)(t0 + (st + 2) * 8 + i) * 512];
            }
            f32x2 y[8]; float stat[16];
#pragma unroll
            for (int tt = 0; tt < 8; ++tt) { f32x2 a = bd;
#pragma unroll
                for (int j = 0; j < 31; ++j) a += w[j] * hist[tt + j];
                y[tt] = a; stat[2 * tt] = a.x + a.y; stat[2 * tt + 1] = a.x * a.x + a.y * a.y; }
            float s1[8], s2[4];
#pragma unroll
            for (int k = 0; k < 8; ++k) { const auto r = __builtin_amdgcn_permlane32_swap(f2u(stat[k]), f2u(stat[k + 8]), false, false); const unsigned r0 = r[0], r1 = r[1]; s1[k] = u2f(r0) + u2f(r1); }
#pragma unroll
            for (int k = 0; k < 4; ++k) { const auto r = __builtin_amdgcn_permlane16_swap(f2u(s1[k]), f2u(s1[k + 4]), false, false); const unsigned r0 = r[0], r1 = r[1]; s2[k] = row_sum16(u2f(r0) + u2f(r1)); }
            if ((lane & 15) == 0) *(LAS f32x4*)(part + (pb * 8 + wave) * 16 + 4 * (lane >> 4)) = (f32x4){s2[0], s2[1], s2[2], s2[3]};
            LDS_BARRIER();
            f32x4 tot[4];
#pragma unroll
            for (int k = 0; k < 4; ++k) { tot[k] = (f32x4){0.f, 0.f, 0.f, 0.f};
#pragma unroll
                for (int ww = 0; ww < 8; ++ww) tot[k] += *(const LAS f32x4*)(part + (pb * 8 + ww) * 16 + 4 * k); }
#pragma unroll
            for (int tt = 0; tt < 8; ++tt) {
                const float sum = tot[tt >> 1][(tt & 1) * 2], sq = tot[tt >> 1][(tt & 1) * 2 + 1];
                const float mean = sum * (1.0f / D_), var = sq * (1.0f / D_) - mean * mean, rstd = __builtin_amdgcn_rsqf(var + EPS_);
                const f32x2 z = (y[tt] - mean) * rstd * lg + lb;
                const f32x2 e = z * (-LOG2E_);
                f32x2 d; d.x = __builtin_amdgcn_exp2f(e.x); d.y = __builtin_amdgcn_exp2f(e.y); d = d + 1.0f;
                f32x2 r; r.x = __builtin_amdgcn_rcpf(d.x); r.y = __builtin_amdgcn_rcpf(d.y);
                const f32x2 o = z * r;
                Op[(size_t)(t0 + st * 8 + tt) * 512] = cvtpk(o.x, o.y);
            }
#pragma unroll
            for (int i = 0; i < 30; ++i) hist[i] = hist[i + 8];
            pb ^= 1;
        }
    }
}
constexpr int CW_Q2 = 8192;
constexpr int A_KS = 0, A_VT = 36864, A_LIST = 70656, A_MISC = 103424;
__device__ __forceinline__ float attn_m0(const float* gq, const float* gk, int lane) {
    float a = fabsf(gq[lane]), b = fabsf(gk[lane]); a = wave_max(a); b = wave_max(b);
    return 8.0f * LOG2E_ * a * b * 1.02f + 0.25f;
}
__device__ __forceinline__ void stage_kv_load(u32x4 (&kk)[4], u32x4 (&vv)[4], const bf16* K, const bf16* V, size_t rowbase, int h, int tid) {
    const int r = tid >> 1, hf = tid & 1;
    const bf16* kp = K + (rowbase + r) * D_ + h * 64 + 32 * hf;
#pragma unroll
    for (int c = 0; c < 4; ++c) kk[c] = *(const u32x4*)(kp + 8 * c);
    const int p = tid >> 2, dq = tid & 3;
    const bf16* vp = V + (rowbase + 2 * p) * D_ + h * 64 + 16 * dq;
    vv[0] = *(const u32x4*)(vp); vv[1] = *(const u32x4*)(vp + 8); vv[2] = *(const u32x4*)(vp + D_); vv[3] = *(const u32x4*)(vp + D_ + 8);
}
__device__ __forceinline__ void stage_kv_store(LAS unsigned char* lds, const u32x4 (&kk)[4], const u32x4 (&vv)[4], int tid) {
    const int r = tid >> 1, hf = tid & 1;
#pragma unroll
    for (int c = 0; c < 4; ++c) *(LAS u32x4*)(lds + A_KS + r * 144 + (32 * hf + 8 * c) * 2) = kk[c];
    const int p = tid >> 2, dq = tid & 3;
    LAS unsigned* vt = (LAS unsigned*)(lds + A_VT) + p;
#pragma unroll
    for (int c = 0; c < 2; ++c)
#pragma unroll
        for (int e = 0; e < 4; ++e) { const unsigned a = (e == 0) ? vv[c].x : (e == 1) ? vv[c].y : (e == 2) ? vv[c].z : vv[c].w;
            const unsigned bb = (e == 0) ? vv[2 + c].x : (e == 1) ? vv[2 + c].y : (e == 2) ? vv[2 + c].z : vv[2 + c].w;
            const int d = 16 * dq + 8 * c + 2 * e;
            vt[d * 132] = (a & 0xffffu) | (bb << 16); vt[(d + 1) * 132] = (a >> 16) | (bb & 0xffff0000u); }
}
__device__ __forceinline__ void stage_kv(LAS unsigned char* lds, const bf16* K, const bf16* V, size_t rowbase, int h, int tid) {
    u32x4 kk[4], vv[4]; stage_kv_load(kk, vv, K, V, rowbase, h, tid); stage_kv_store(lds, kk, vv, tid);
}
__device__ __forceinline__ int alibi_dmax(float slope2, float M0) { return (int)fminf((2.0f * M0 + 40.0f) / slope2, 1.0e9f); }
template <bool MASK> __device__ __forceinline__ void attn_tile(LAS unsigned char* lds, int s8, const bf16x8 (&qf)[4], float rowc, float slope2, int lane, f32x16& o0, f32x16& o1, float& lsum, int maskq) {
    const int i = lane & 31, hi = lane >> 5;
    const int prow = (i & ~12) | ((i & 4) << 1) | ((i & 8) >> 1);
    const LAS unsigned char* kp = lds + A_KS + (32 * s8 + prow) * 144 + 16 * hi;
    const float cb = rowc + slope2 * (float)(32 * s8 + 8 * hi);
    f32x16 c;
#pragma unroll
    for (int r = 0; r < 16; ++r) c[r] = cb + slope2 * (float)(16 * (r >> 3) + (r & 7));
#pragma unroll
    for (int d0 = 0; d0 < 4; ++d0) { const bf16x8 kf = *(const LAS bf16x8*)(kp + 32 * d0); c = __builtin_amdgcn_mfma_f32_32x32x16_bf16(kf, qf[d0], c, 0, 0, 0); }
    if (MASK) {
#pragma unroll
        for (int r = 0; r < 16; ++r) if (16 * (r >> 3) + 8 * hi + (r & 7) > maskq) c[r] = -INFINITY;
    }
    float ls = 0.f;
#pragma unroll
    for (int r = 0; r < 16; ++r) { c[r] = __builtin_amdgcn_exp2f(c[r]); ls += c[r]; }
    lsum += ls;
    u32x4 p0, p1;
    p0.x = cvtpk(c[0], c[1]); p0.y = cvtpk(c[2], c[3]); p0.z = cvtpk(c[4], c[5]); p0.w = cvtpk(c[6], c[7]);
    p1.x = cvtpk(c[8], c[9]); p1.y = cvtpk(c[10], c[11]); p1.z = cvtpk(c[12], c[13]); p1.w = cvtpk(c[14], c[15]);
    const bf16x8 pf0 = __builtin_bit_cast(bf16x8, p0), pf1 = __builtin_bit_cast(bf16x8, p1);
    const LAS unsigned char* vp = lds + A_VT + (i * 264 + 32 * s8 + 8 * hi) * 2;
    { const bf16x8 v00 = *(const LAS bf16x8*)(vp), v01 = *(const LAS bf16x8*)(vp + 32), v10 = *(const LAS bf16x8*)(vp + 32 * 528), v11 = *(const LAS bf16x8*)(vp + 32 * 528 + 32);
      o0 = __builtin_amdgcn_mfma_f32_32x32x16_bf16(v00, pf0, o0, 0, 0, 0); o1 = __builtin_amdgcn_mfma_f32_32x32x16_bf16(v10, pf0, o1, 0, 0, 0);
      o0 = __builtin_amdgcn_mfma_f32_32x32x16_bf16(v01, pf1, o0, 0, 0, 0); o1 = __builtin_amdgcn_mfma_f32_32x32x16_bf16(v11, pf1, o1, 0, 0, 0); }
}
__device__ __forceinline__ bf16* op_ptr(unsigned char* ws, float* out, int rank) { return (rank == 2) ? (bf16*)(ws + WS_OP3) : (bf16*)out + (size_t)rank * ((size_t)M_ * D_); }

struct A2Item { int n, bh, b, h, tbeg, tlim, dmax; float slope2; };
__device__ __forceinline__ A2Item a2_decode(int item, float M0) {
    A2Item I; I.n = item >> 5; I.bh = item & 31; I.b = I.bh >> 4; I.h = I.bh & 15;
    I.slope2 = exp2f(-0.5f * (float)(I.h + 1)) * LOG2E_; I.dmax = alibi_dmax(I.slope2, M0);
    I.tbeg = (I.n + 1) * 256; I.tlim = min(S_, 256 * I.n + 256 + I.dmax); return I;
}
__device__ __forceinline__ void a2_load(const A2Item& I, u32x4 (&kk)[4], u32x4 (&vv)[4], u32x4 (&sv)[8], const bf16* K, const bf16* V, const unsigned* sel, int tid) {
    stage_kv_load(kk, vv, K, V, (size_t)I.b * S_ + 256 * I.n, I.h, tid);
    const unsigned* sp = sel + (size_t)I.bh * S_;
#pragma unroll
    for (int c = 0; c < 8; ++c) { const int t0 = I.tbeg + 2048 * c + 4 * tid;
        sv[c] = (u32x4){0xFFFFFFFFu, 0xFFFFFFFFu, 0xFFFFFFFFu, 0xFFFFFFFFu};
        if (I.tbeg + 2048 * c < I.tlim) { if (t0 < S_) sv[c] = *(const u32x4*)(sp + t0); } }
}
__device__ __forceinline__ void a2_phase(LAS unsigned char* lds, int wave_in, int qword) {
    int tid = lane_id(); asm volatile("" : "+v"(tid)); tid += 64 * wave_in;
    const int lane = tid & 63, wave = __builtin_amdgcn_readfirstlane(tid >> 6), q = lane & 31, hi = lane >> 5;
    unsigned char* const ws = PWS;
    const bf16* Q = (const bf16*)(ws + WS_Q); const bf16* K = (const bf16*)(ws + WS_K); const bf16* V = (const bf16*)(ws + WS_V);
    const unsigned* sel = (const unsigned*)(ws + WS_SEL); unsigned* ctl = (unsigned*)(ws + WS_CTL); float* LP = (float*)(ws + WS_LP); float* const outp = POUT;
    const float M0 = attn_m0(PIN(8), PIN(9), lane);
    LAS unsigned short* list = (LAS unsigned short*)(lds + A_LIST); volatile LAS int* misc = (volatile LAS int*)(lds + A_MISC);
    constexpr int NIT = 63 * 32;
    int t_cur = 0, t_nxt = 0;
    if (tid == 0) { t_cur = (int)__hip_atomic_fetch_add(ctl + qword, 1u, __ATOMIC_RELAXED, __HIP_MEMORY_SCOPE_AGENT); t_nxt = (int)__hip_atomic_fetch_add(ctl + qword, 1u, __ATOMIC_RELAXED, __HIP_MEMORY_SCOPE_AGENT); }
    LDS_BARRIER();
    if (tid == 0) { misc[0] = t_cur; misc[2] = t_nxt; misc[1] = 0; }
    LDS_BARRIER();
    int item = __builtin_amdgcn_readfirstlane(misc[0]), item_n = __builtin_amdgcn_readfirstlane(misc[2]);
    u32x4 kk[4], vv[4], sv[8];
    if (item < NIT) { const A2Item I0 = a2_decode(item, M0); a2_load(I0, kk, vv, sv, K, V, sel, tid); }
    while (item < NIT) {
        const A2Item I = a2_decode(item, M0);
        const int n = I.n, b = I.b, h = I.h, dmax = I.dmax; const float slope2 = I.slope2;
        int t_nn = 0;
        if (tid == 0) t_nn = (int)__hip_atomic_fetch_add(ctl + qword, 1u, __ATOMIC_RELAXED, __HIP_MEMORY_SCOPE_AGENT);
        stage_kv_store(lds, kk, vv, tid);
#pragma unroll
        for (int c = 0; c < 8; ++c) {
            if (I.tbeg + 2048 * c < I.tlim) {
#pragma unroll
                for (int e = 0; e < 4; ++e) {
                    const unsigned s = (e == 0) ? sv[c].x : (e == 1) ? sv[c].y : (e == 2) ? sv[c].z : sv[c].w;
                    const int t = I.tbeg + 2048 * c + 4 * tid + e;
                    int rank = ((s & 255u) == (unsigned)n) ? 0 : (((s >> 8) & 255u) == (unsigned)n) ? 1 : (((s >> 16) & 255u) == (unsigned)n) ? 2 : -1;
                    if (t - 256 * n - 255 > dmax) rank = -1;
                    const unsigned long long bal = __ballot(rank >= 0);
                    if (bal) {
                        const int pre = __builtin_amdgcn_mbcnt_hi((unsigned)(bal >> 32), __builtin_amdgcn_mbcnt_lo((unsigned)bal, 0u));
                        int base = 0;
                        if (lane == 0) base = __hip_atomic_fetch_add((LAS int*)(lds + A_MISC) + 1, __popcll(bal), __ATOMIC_RELAXED, __HIP_MEMORY_SCOPE_WORKGROUP);
                        base = __builtin_amdgcn_readfirstlane(base);
                        if (rank >= 0) list[base + pre] = (unsigned short)(t | (rank << 14));
                    }
                }
            }
        }
        if (item_n < NIT) { const A2Item In = a2_decode(item_n, M0); a2_load(In, kk, vv, sv, K, V, sel, tid); }
        LDS_BARRIER();
        const int total = __builtin_amdgcn_readfirstlane(misc[1]);
        const int nr = (total + 255) >> 8;
        bf16x8 qn[4]; unsigned en = 0u;
        if (32 * wave < total) { const int idx = 32 * wave + q; en = list[(idx < total) ? idx : 32 * wave];
            const size_t rown = (size_t)b * S_ + (en & 16383);
#pragma unroll
            for (int d0 = 0; d0 < 4; ++d0) qn[d0] = *(const bf16x8*)(Q + rown * D_ + h * 64 + 16 * d0 + 8 * hi); }
        for (int r = 0; r < nr; ++r) {
            const int i0 = 256 * r + 32 * wave;
            if (i0 < total) {
                const int idx = i0 + q; const bool valid = idx < total;
                const unsigned e = en;
                const int t = e & 16383, rank = e >> 14;
                const size_t row = (size_t)b * S_ + t;
                bf16x8 qf[4];
#pragma unroll
                for (int d0 = 0; d0 < 4; ++d0) qf[d0] = qn[d0];
                if (i0 + 256 < total) { const int idx2 = idx + 256; en = list[(idx2 < total) ? idx2 : i0 + 256];
                    const size_t rown = (size_t)b * S_ + (en & 16383);
#pragma unroll
                    for (int d0 = 0; d0 < 4; ++d0) qn[d0] = *(const bf16x8*)(Q + rown * D_ + h * 64 + 16 * d0 + 8 * hi); }
                const float rowc = -slope2 * (float)(t - 256 * n) - M0;
                f32x16 o0, o1; float lsum = 0.f;
#pragma unroll
                for (int k = 0; k < 16; ++k) { o0[k] = 0.f; o1[k] = 0.f; }
#pragma unroll 2
                for (int s8 = 0; s8 < 8; ++s8) attn_tile<false>(lds, s8, qf, rowc, slope2, lane, o0, o1, lsum, 0);
                lsum = sum32(lsum);
                if (valid) {
                    bf16* op = op_ptr(ws, outp, rank) + row * D_ + h * 64 + 4 * hi;
#pragma unroll
                    for (int g = 0; g < 4; ++g) {
                        u32x2 w0, w1; w0.x = cvtpk(o0[4 * g], o0[4 * g + 1]); w0.y = cvtpk(o0[4 * g + 2], o0[4 * g + 3]);
                        w1.x = cvtpk(o1[4 * g], o1[4 * g + 1]); w1.y = cvtpk(o1[4 * g + 2], o1[4 * g + 3]);
                        *(u32x2*)(op + 8 * g) = w0; *(u32x2*)(op + 32 + 8 * g) = w1; }
                    if (hi == 0) LP[((size_t)rank * M_ + row) * 16 + h] = lsum;
                }
            }
        }
        LDS_BARRIER();
        if (tid == 0) { misc[0] = item_n; misc[2] = t_nn; misc[1] = 0; }
        LDS_BARRIER();
        item = __builtin_amdgcn_readfirstlane(misc[0]); item_n = __builtin_amdgcn_readfirstlane(misc[2]);
    }
}

__device__ __forceinline__ void a3_phase(LAS unsigned char* lds, int vcu, int G, int wave_in) {
    int tid = lane_id(); asm volatile("" : "+v"(tid)); tid += 64 * wave_in;
    const int lane = tid & 63, wave = __builtin_amdgcn_readfirstlane(tid >> 6), q = lane & 31, hi = lane >> 5;
    unsigned char* const ws = PWS;
    bf16* Q = (bf16*)(ws + WS_Q); const bf16* K = (const bf16*)(ws + WS_K); const bf16* V = (const bf16*)(ws + WS_V);
    const unsigned* sel = (const unsigned*)(ws + WS_SEL); const float* LP = (const float*)(ws + WS_LP); float* const outp = POUT;
    const float M0 = attn_m0(PIN(8), PIN(9), lane);
    u32x4 kk[4], vv[4];
    if (vcu < 2048) { const int bh = vcu >> 6, m = vcu & 63; stage_kv_load(kk, vv, K, V, (size_t)(bh >> 4) * S_ + 256 * m, bh & 15, tid); }
    for (int un = vcu; un < 2048; un += G) {
        const int bh = un >> 6, m = un & 63, b = bh >> 4, h = bh & 15;
        const float slope2 = exp2f(-0.5f * (float)(h + 1)) * LOG2E_;
        LDS_BARRIER();
        stage_kv_store(lds, kk, vv, tid);
        { const int un2 = un + G; if (un2 < 2048) { const int bh2 = un2 >> 6, m2 = un2 & 63; stage_kv_load(kk, vv, K, V, (size_t)(bh2 >> 4) * S_ + 256 * m2, bh2 & 15, tid); } }
        const int t = 256 * m + 32 * wave + q; const size_t row = (size_t)b * S_ + t;
        bf16x8 qf[4];
#pragma unroll
        for (int d0 = 0; d0 < 4; ++d0) qf[d0] = *(const bf16x8*)(Q + row * D_ + h * 64 + 16 * d0 + 8 * hi);
        const unsigned s = sel[(size_t)bh * S_ + t];
        float lp[3]; u32x2 pw[3][8];
#pragma unroll
        for (int rank = 0; rank < 3; ++rank) {
            lp[rank] = LP[((size_t)rank * M_ + row) * 16 + h];
            const bf16* op = op_ptr(ws, outp, rank) + row * D_ + h * 64 + 4 * hi;
#pragma unroll
            for (int g = 0; g < 4; ++g) { pw[rank][g] = *(const u32x2*)(op + 8 * g); pw[rank][4 + g] = *(const u32x2*)(op + 32 + 8 * g); }
        }
        LDS_BARRIER();
        const float rowc = -slope2 * (float)(32 * wave + q) - M0;
        f32x16 o0, o1; float lsum = 0.f;
#pragma unroll
        for (int k = 0; k < 16; ++k) { o0[k] = 0.f; o1[k] = 0.f; }
        for (int s8 = 0; s8 < wave; ++s8) attn_tile<false>(lds, s8, qf, rowc, slope2, lane, o0, o1, lsum, 0);
        attn_tile<true>(lds, wave, qf, rowc, slope2, lane, o0, o1, lsum, q);
        float l = sum32(lsum);
        const int dmax = alibi_dmax(slope2, M0);
#pragma unroll
        for (int rank = 0; rank < 3; ++rank) {
            const int nb = (int)((s >> (8 * rank)) & 255u);
            if (nb != 255 && (t - 256 * nb - 255) <= dmax) {
                l += lp[rank];
#pragma unroll
                for (int g = 0; g < 4; ++g) { const u32x2 w0 = pw[rank][g], w1 = pw[rank][4 + g];
                    o0[4 * g] += bflo(w0.x); o0[4 * g + 1] += bfhi(w0.x); o0[4 * g + 2] += bflo(w0.y); o0[4 * g + 3] += bfhi(w0.y);
                    o1[4 * g] += bflo(w1.x); o1[4 * g + 1] += bfhi(w1.x); o1[4 * g + 2] += bflo(w1.y); o1[4 * g + 3] += bfhi(w1.y); }
            }
        }
        const float inv = 1.0f / l;
        bf16* op = Q + row * D_ + h * 64 + 4 * hi;
#pragma unroll
        for (int g = 0; g < 4; ++g) {
            u32x2 w0, w1; w0.x = cvtpk(o0[4 * g] * inv, o0[4 * g + 1] * inv); w0.y = cvtpk(o0[4 * g + 2] * inv, o0[4 * g + 3] * inv);
            w1.x = cvtpk(o1[4 * g] * inv, o1[4 * g + 1] * inv); w1.y = cvtpk(o1[4 * g + 2] * inv, o1[4 * g + 3] * inv);
            *(u32x2*)(op + 8 * g) = w0; *(u32x2*)(op + 32 + 8 * g) = w1; }
    }
}

constexpr int A1_KH = 0, A1_KL = 9216;
__device__ __forceinline__ void top3_ins(float v, int n, float& v0, float& v1, float& v2, int& i0, int& i1, int& i2) {
    const bool c0 = v > v0, c1 = v > v1, c2 = v > v2;
    v2 = c1 ? v1 : (c2 ? v : v2); i2 = c1 ? i1 : (c2 ? n : i2);
    v1 = c0 ? v0 : (c1 ? v : v1); i1 = c0 ? i0 : (c1 ? n : i1);
    v0 = c0 ? v : v0;             i0 = c0 ? n : i0;
}
__device__ __forceinline__ void a1_phase(LAS unsigned char* lds, int vcu, int G, int wave_in) {
    int tid = lane_id(); asm volatile("" : "+v"(tid)); tid += 64 * wave_in;
    const int lane = tid & 63, wave = __builtin_amdgcn_readfirstlane(tid >> 6), q = lane & 31, hi = lane >> 5;
    unsigned char* const ws = PWS;
    const bf16* Q = (const bf16*)(ws + WS_Q); const float* kbarp = (const float*)(ws + WS_KBAR); unsigned* sel = (unsigned*)(ws + WS_SEL);
    for (int un = vcu; un < 256; un += G) {
        const int bh = un >> 3, mg = un & 7, b = bh >> 4, h = bh & 15;
        LDS_BARRIER();
        { const int n = tid >> 3, d0 = (tid & 7) * 8;
          const float* p = kbarp + ((size_t)bh * 64 + n) * 128 + d0;
          const f32x4 a0 = *(const f32x4*)p, a1 = *(const f32x4*)(p + 4), b0 = *(const f32x4*)(p + 64), b1 = *(const f32x4*)(p + 68);
          const f32x4 v0 = (a0 + b0) * (1.0f / 256.0f), v1 = (a1 + b1) * (1.0f / 256.0f);
          unsigned hb[8], lb[8];
#pragma unroll
          for (int e = 0; e < 8; ++e) { const float v = (e < 4) ? v0[e & 3] : v1[e & 3]; hb[e] = f2bf(v); lb[e] = f2bf(v - bf2f(hb[e])); }
          u32x4 wh, wl; wh.x = hb[0] | (hb[1] << 16); wh.y = hb[2] | (hb[3] << 16); wh.z = hb[4] | (hb[5] << 16); wh.w = hb[6] | (hb[7] << 16);
          wl.x = lb[0] | (lb[1] << 16); wl.y = lb[2] | (lb[3] << 16); wl.z = lb[4] | (lb[5] << 16); wl.w = lb[6] | (lb[7] << 16);
          *(LAS u32x4*)(lds + A1_KH + n * 144 + d0 * 2) = wh; *(LAS u32x4*)(lds + A1_KL + n * 144 + d0 * 2) = wl; }
        LDS_BARRIER();
        bf16x8 qn[4];
        { const size_t row0 = (size_t)b * S_ + 256 * (mg * 8) + 32 * wave + q;
#pragma unroll
          for (int d0 = 0; d0 < 4; ++d0) qn[d0] = *(const bf16x8*)(Q + row0 * D_ + h * 64 + 16 * d0 + 8 * hi); }
        for (int mi = 0; mi < 8; ++mi) {
            const int m = mg * 8 + mi, t = 256 * m + 32 * wave + q;
            bf16x8 qf[4];
#pragma unroll
            for (int d0 = 0; d0 < 4; ++d0) qf[d0] = qn[d0];
            if (mi < 7) { const size_t rown = (size_t)b * S_ + t + 256;
#pragma unroll
                for (int d0 = 0; d0 < 4; ++d0) qn[d0] = *(const bf16x8*)(Q + rown * D_ + h * 64 + 16 * d0 + 8 * hi); }
            if (m == 0) { if (hi == 0) sel[(size_t)bh * S_ + t] = 0x00FFFFFFu; continue; }
            f32x16 c0, c1;
#pragma unroll
            for (int k = 0; k < 16; ++k) { c0[k] = 0.f; c1[k] = 0.f; }
            const LAS unsigned char* kp = lds + q * 144 + 16 * hi;
#pragma unroll
            for (int d0 = 0; d0 < 4; ++d0) {
                const bf16x8 h0 = *(const LAS bf16x8*)(kp + A1_KH + 32 * d0), h1 = *(const LAS bf16x8*)(kp + A1_KH + 32 * 144 + 32 * d0);
                const bf16x8 l0 = *(const LAS bf16x8*)(kp + A1_KL + 32 * d0), l1 = *(const LAS bf16x8*)(kp + A1_KL + 32 * 144 + 32 * d0);
                c0 = __builtin_amdgcn_mfma_f32_32x32x16_bf16(h0, qf[d0], c0, 0, 0, 0); c1 = __builtin_amdgcn_mfma_f32_32x32x16_bf16(h1, qf[d0], c1, 0, 0, 0);
                c0 = __builtin_amdgcn_mfma_f32_32x32x16_bf16(l0, qf[d0], c0, 0, 0, 0); c1 = __builtin_amdgcn_mfma_f32_32x32x16_bf16(l1, qf[d0], c1, 0, 0, 0);
            }
            float v0 = -INFINITY, v1 = -INFINITY, v2 = -INFINITY; int i0 = 255, i1 = 255, i2 = 255;
#pragma unroll
            for (int r = 0; r < 16; ++r) { const int n = (r & 3) + 8 * (r >> 2) + 4 * hi; top3_ins((n < m) ? c0[r] : -INFINITY, n, v0, v1, v2, i0, i1, i2); }
#pragma unroll
            for (int r = 0; r < 16; ++r) { const int n = 32 + (r & 3) + 8 * (r >> 2) + 4 * hi; top3_ins((n < m) ? c1[r] : -INFINITY, n, v0, v1, v2, i0, i1, i2); }
            const float pv0 = __builtin_bit_cast(float, other32(__builtin_bit_cast(unsigned, v0), hi)), pv1 = __builtin_bit_cast(float, other32(__builtin_bit_cast(unsigned, v1), hi)), pv2 = __builtin_bit_cast(float, other32(__builtin_bit_cast(unsigned, v2), hi));
            const int pi0 = (int)other32((unsigned)i0, hi), pi1 = (int)other32((unsigned)i1, hi), pi2 = (int)other32((unsigned)i2, hi);
            top3_ins(pv0, pi0, v0, v1, v2, i0, i1, i2); top3_ins(pv1, pi1, v0, v1, v2, i0, i1, i2); top3_ins(pv2, pi2, v0, v1, v2, i0, i1, i2);
            if (hi == 0) sel[(size_t)bh * S_ + t] = (unsigned)i0 | ((unsigned)i1 << 8) | ((unsigned)i2 << 16);
        }
    }
}
#ifndef MK_MULTI
#define MK_MULTI 0
#endif
constexpr int NPH = 18;
struct Args { const float* in[19]; float* out; unsigned char* ws; int lo, hi; };
__global__ void __launch_bounds__(512, 2) fwd(Args a) {
    extern __shared__ __attribute__((aligned(16))) unsigned char lds_raw[];
    LAS unsigned char* lds = (LAS unsigned char*)lds_raw;
    const int tid = threadIdx.x, G = gridDim.x; const int wave = __builtin_amdgcn_readfirstlane(tid >> 6);
    const int vcu = (G % 8 == 0) ? ((int)blockIdx.x % 8) * (G / 8) + (int)blockIdx.x / 8 : (int)blockIdx.x;
    volatile LAS unsigned* MISC = (volatile LAS unsigned*)(lds + MISC_OFF);
    for (int u = tid; u < (LDS_BYTES - LDSCTL_OFF) / 4; u += 512) ((LAS unsigned*)(lds + LDSCTL_OFF))[u] = 0u;
    __syncthreads();
    if (tid == 0) {
        LAS unsigned long long* PT = (LAS unsigned long long*)(lds + PT_OFF);
#pragma unroll
        for (int i = 0; i < 19; ++i) PT[i] = (unsigned long long)a.in[i];
        PT[19] = (unsigned long long)a.out; PT[20] = (unsigned long long)a.ws;
        ((LAS int*)(lds + PT_OFF))[48] = a.lo; ((LAS int*)(lds + PT_OFF))[49] = a.hi;
    }
    __syncthreads();
    if (a.hi - a.lo > 1) (void)xcd_barrier_post((unsigned*)(a.ws + WS_CTL) + CW_BAR, MISC + 8);
#define LO (__builtin_amdgcn_readfirstlane(((volatile LAS int*)(lds + PT_OFF))[48]))
#define HI (__builtin_amdgcn_readfirstlane(((volatile LAS int*)(lds + PT_OFF))[49]))
#define IN(k) (LO <= (k) && (k) < HI)
#define SEAM(k) do { if (IN(k) && IN((k) + 1)) { XcdBarrier bar_; bar_.bar = (unsigned*)(PWS + WS_CTL) + CW_BAR; bar_.x = xb_xcc_id(); bar_.st = MISC + 8; xcd_barrier(bar_); } } while (0)

    if (IN(0)) { __syncthreads(); phase_p0(lds, vcu, G, wave); }
    SEAM(0);
    if (IN(1)) { __syncthreads(); phase_p1(lds, vcu, G, wave); }
    SEAM(1);

    int ph = 2;
#pragma unroll 1
    for (int sl = 0; sl < 6; ++sl) {
        if (sl == 1) {
            if (IN(ph)) { __syncthreads(); unsigned char* const ws = PWS;
                EpiQKV E{(bf16*)(ws + WS_Q), (const float*)(ws + WS_BQKV), (const float*)(ws + WS_SSQ), PIN(8), PIN(9), (float*)(ws + WS_KBAR), lds};
                __syncthreads(); run_gemm(lds, (const bf16*)(ws + WS_XB), (const bf16*)(ws + WS_WQKV), 3072L * 1024 * 2, 3072, 1024, G, E, wave);
            }
            SEAM(ph); ++ph;
            if (IN(ph)) { __syncthreads(); a1_phase(lds, vcu, G, wave); }
            SEAM(ph); ++ph;
            if (IN(ph)) { __syncthreads(); a2_phase(lds, wave, CW_Q2); }
            SEAM(ph); ++ph;
            if (IN(ph)) { __syncthreads(); a3_phase(lds, vcu, G, wave); }
            SEAM(ph); ++ph;
        } else if (sl == 4) {
            if (IN(ph)) { __syncthreads(); unsigned char* const ws = PWS;
                EpiGated<1> E{(bf16*)(ws + WS_U), 1024, (const float*)(ws + WS_BPW1), 2048, (const float*)(ws + WS_SSQ), lds, 1.0f};
                __syncthreads(); run_gemm(lds, (const bf16*)(ws + WS_XB), (const bf16*)(ws + WS_WPW1), 2048L * 1024 * 2, 2048, 1024, G, E, wave);
            }
            SEAM(ph); ++ph;
            if (IN(ph)) { __syncthreads(); conv_phase(lds, vcu, G, wave); }
            SEAM(ph); ++ph;
        } else {
            const int f = (sl / 3) * 2 + ((sl % 3) == 2);
            if (IN(ph)) { __syncthreads(); unsigned char* const ws = PWS;
                if ((F8MASK >> f) & 1) {
                    EpiGated<0> E{(bf16*)(ws + WS_ACT), FF_, (const float*)(ws + WS_BFFN) + (size_t)f * 2 * 5632, 5632, (const float*)(ws + WS_SSQ), lds, 1.0f / W8_SCALE};
                    __syncthreads(); run_gemm<EpiGated<0>, true>(lds, (const bf16*)(ws + WS_X8), (const bf16*)(ws + WS_WIN) + (size_t)f * 2 * 5632 * 1024, 5632L * 1024, 5632, 512, G, E, wave);
                } else {
                EpiGated<0> E{(bf16*)(ws + WS_ACT), FF_, (const float*)(ws + WS_BFFN) + (size_t)f * 2 * 5632, 5632, (const float*)(ws + WS_SSQ), lds, 1.0f};
                __syncthreads(); run_gemm(lds, (const bf16*)(ws + WS_XB), (const bf16*)(ws + WS_WIN) + (size_t)f * 2 * 5632 * 1024, 5632L * 1024 * 2, 5632, 1024, G, E, wave);
                }
            }
            SEAM(ph); ++ph;
        }
        if (IN(ph)) { __syncthreads(); unsigned char* const ws = PWS; float* const out = POUT;
            const bf16* Ares; const bf16* Wres; int Kres; const float* bias2 = nullptr;
            if (sl == 1) { Ares = (const bf16*)(ws + WS_Q); Wres = (const bf16*)(ws + WS_WO); Kres = 1024; }
            else if (sl == 4) { Ares = (const bf16*)(ws + WS_CV); Wres = (const bf16*)(ws + WS_WPW2); Kres = 1024; bias2 = PIN(18); }
            else { const int f = (sl / 3) * 2 + ((sl % 3) == 2); Ares = (const bf16*)(ws + WS_ACT); Wres = (const bf16*)(ws + WS_WOUT) + (size_t)f * 1024 * 2816; Kres = FF_; }
            const int fnext = (sl == 1) ? 1 : (sl == 2) ? 2 : (sl == 4) ? 3 : -1;
            EpiRes E{(bf16*)(ws + WS_XB), out, bias2, (const float*)(ws + WS_COEF) + (size_t)sl * 2048, (float*)(ws + WS_SSQ), (sl == 5) ? 1 : 0, lds, (fnext >= 0 && ((F8MASK >> fnext) & 1)) ? ws + WS_X8 : nullptr};
            run_gemm(lds, Ares, Wres, 0L, 1024, Kres, G, E, wave);
        }
        SEAM(ph); ++ph;
    }
#undef IN
#undef SEAM
}

extern "C" void kernel_launch(void* const* d_in, const int* in_sizes, int n_in, void* d_out, int out_size, void* d_ws, size_t ws_size, hipStream_t stream) {
    static int grid = 0;
    if (grid == 0) {
        if (n_in != 19 || in_sizes[0] != M_ * D_ || out_size != M_ * D_ || ws_size < WS_END) {
            fprintf(stderr, "kernel_launch: unexpected problem (n_in %d, in0 %d, out %d, ws %zu); nothing launched\n", n_in, n_in > 0 ? in_sizes[0] : -1, out_size, ws_size); grid = -1; return; }
        int dev = 0, cus = 0;
        if (hipGetDevice(&dev) != hipSuccess || hipDeviceGetAttribute(&cus, hipDeviceAttributeMultiprocessorCount, dev) != hipSuccess) { grid = -1; return; }
        if (hipFuncSetAttribute((const void*)fwd, hipFuncAttributeMaxDynamicSharedMemorySize, LDS_BYTES) != hipSuccess) { fprintf(stderr, "kernel_launch: hipFuncSetAttribute failed\n"); grid = -1; return; }
        int per_cu = 0;
        if (hipOccupancyMaxActiveBlocksPerMultiprocessor(&per_cu, (const void*)fwd, 512, LDS_BYTES) != hipSuccess || per_cu < 1) fprintf(stderr, "kernel_launch: occupancy query reports %d blocks per CU\n", per_cu);
        (void)hipGetLastError();
        grid = cus;
    }
    if (grid < 0) return;
    if (hipMemsetAsync((char*)d_ws + WS_CTL, 0, CTL_ZERO_BYTES, stream) != hipSuccess) return;
    Args a{};
    for (int i = 0; i < 19; ++i) a.in[i] = (const float*)d_in[i];
    a.out = (float*)d_out; a.ws = (unsigned char*)d_ws;
#if MK_MULTI
    for (int p = 0; p < NPH; ++p) { a.lo = p; a.hi = p + 1; hipLaunchKernelGGL(fwd, dim3(grid), dim3(512), LDS_BYTES, stream, a); }
#else
    a.lo = 0; a.hi = NPH; hipLaunchKernelGGL(fwd, dim3(grid), dim3(512), LDS_BYTES, stream, a);
#endif
}
```

```cpp
#define I8MASK 14
#include <hip/hip_runtime.h>
#include <cstdio>
#include <cstdint>
#include <cmath>
namespace pg8 {
#define PG8_LAS __attribute__((address_space(3)))
typedef unsigned short bf16_t;
typedef short bf16x8 __attribute__((ext_vector_type(8)));
typedef float f32x4 __attribute__((ext_vector_type(4)));
typedef unsigned u32x4 __attribute__((ext_vector_type(4)));
constexpr int BM = 256, BK = 64, HALF = 128, HTB = HALF * BK * 2  , STAGE_BYTES = 8 * HTB, NXCD = 8, WGM = 8;

__host__ __device__ __forceinline__ int lds_byte(int r, int c) { const int st = (r >> 4) * 2 + (c >> 5), rr = r & 15, cc = c & 31, ob = rr * 64 + cc * 2; return st * 1024 + (ob ^ (((ob >> 9) & 1) << 5)); }
__host__ __device__ __forceinline__ void stage_rc(int b, int& R, int& C) { const int st = b / 1024, sb = b % 1024, swz = sb ^ (((sb >> 9) & 1) << 5); R = (st >> 1) * 16 + swz / 64; C = (st & 1) * 32 + (swz % 64) / 2; }
__host__ __device__ __forceinline__ int perm32(int rho) { const int n = rho >> 4, i = rho & 15; return 8 * (i >> 2) + 4 * n + (i & 3); }

struct Unit { int pm, pn; };
struct Gemm { const bf16_t* A; const bf16_t* Bt; int M, N, K; long bb; };

struct StaticOrder {
    int nM, nN, nwg, G, c;
    __host__ __device__ void init(int M, int N, int G_, int c_) { nM = M / BM; nN = N / BM; nwg = nM * nN; G = G_; c = c_; }
    __host__ __device__ bool next(int i, Unit& u) const {
        const long L = (long)i * G + c; if (L >= nwg) return false;
        int wgid = (int)L; { const int q = nwg / NXCD, r = nwg % NXCD, xcd = wgid % NXCD, off = wgid / NXCD; wgid = (xcd < r ? xcd * (q + 1) : r * (q + 1) + (xcd - r) * q) + off; }
        const int nig = WGM * nN, gid = wgid / nig, fm = gid * WGM, gsz = (nM - fm) < WGM ? (nM - fm) : WGM;
        u.pm = fm + ((wgid % nig) % gsz); u.pn = (wgid % nig) / gsz; return true;
    }
    __device__ __forceinline__ void a_ready(const Unit&) const {}
    __device__ __forceinline__ void done(const Unit&) const {}
};

__device__ __forceinline__ unsigned cvt_pk_bf16(float lo, float hi) { unsigned r; asm volatile("v_cvt_pk_bf16_f32 %0, %1, %2" : "=v"(r) : "v"(lo), "v"(hi)); return r; }
typedef float f32x2 __attribute__((ext_vector_type(2)));
template <class Epi, class Sched, bool ALIGN_EPI = false, bool SP2 = false, bool F8 = false>
__device__ __forceinline__ void gemm_phase(PG8_LAS unsigned char* lds, const Gemm g, const Sched& S, const Epi& E, const int tid_in) {
    typedef int pg8_i32x8 __attribute__((ext_vector_type(8))); typedef int pg8_i32x4 __attribute__((ext_vector_type(4)));
    const int tid = tid_in, wid = __builtin_amdgcn_readfirstlane(tid >> 6), lane = tid & 63, wr = wid >> 2, wc = wid & 3, fr = lane & 15, fq = lane >> 4;
    const int K = g.K, nt = K / BK;
    unsigned voffA[2], voffB[2];
#pragma unroll
    for (int i = 0; i < 2; ++i) { int R, C; stage_rc(tid * 16 + i * 8192, R, C); const int Rb = Epi::PERM ? ((R & ~31) + perm32(R & 31)) : R;
        voffA[i] = (unsigned)(R * K + C) * 2u; voffB[i] = (unsigned)(Rb * K + C) * 2u; }
    const __amdgpu_buffer_rsrc_t rs_voffA = __builtin_amdgcn_make_buffer_rsrc((void*)g.A, 0, -1, 0x00020000), rs_voffB = __builtin_amdgcn_make_buffer_rsrc((void*)g.Bt, 0, -1, 0x00020000);
    const unsigned kstep = (unsigned)(BK * 2);
    const unsigned hstep = (unsigned)(HALF * K * 2);
    const unsigned tstep = 2u * hstep;
    const unsigned ldsw = (unsigned)wid * 1024u;
    const int aoff = lds_byte(wr * 64 + fr, fq * 8), boff = lds_byte(wc * 32 + fr, fq * 8);
#define PG8_SA(b, h) (((b) * 2 + (h)) * HTB)
#define PG8_SB(b, h) ((4 + (b) * 2 + (h)) * HTB)
#define PG8_STAGE(bufoff, soff, voff) do { _Pragma("unroll") for (int _i = 0; _i < 2; ++_i) \
        __builtin_amdgcn_raw_ptr_buffer_load_lds(rs_##voff, (PG8_LAS void*)(lds + (bufoff) + ldsw + _i * 8192), 16, (int)(voff)[_i], (int)(soff), 0, 0); } while (0)
#define PG8_LDA(dst, b, h) do { _Pragma("unroll") for (int m = 0; m < 4; ++m) _Pragma("unroll") for (int k = 0; k < 2; ++k) dst[m][k] = *(const PG8_LAS bf16x8*)(lds + PG8_SA(b, h) + aoff + m * 2048 + k * 1024); } while (0)
#define PG8_LDB(dst, b, h) do { _Pragma("unroll") for (int n = 0; n < 2; ++n) _Pragma("unroll") for (int k = 0; k < 2; ++k) dst[n][k] = *(const PG8_LAS bf16x8*)(lds + PG8_SB(b, h) + boff + n * 2048 + k * 1024); } while (0)
#ifndef PG8_PRIO_MMA
#define PG8_PRIO_MMA 3
#define PG8_PRIO_LOAD 0
#endif
#define PG8_MMA(ai, bj, At, Bt) do { __builtin_amdgcn_s_setprio(PG8_PRIO_MMA); \
        if constexpr (F8) { _Pragma("unroll") for (int m = 0; m < 4; ++m) _Pragma("unroll") for (int n = 0; n < 2; ++n) _Pragma("unroll") for (int k = 0; k < 2; ++k) \
            acc[ai][bj][m][n] = __builtin_bit_cast(f32x4, __builtin_amdgcn_mfma_i32_16x16x64_i8(__builtin_bit_cast(pg8_i32x4, Bt[n][k]), __builtin_bit_cast(pg8_i32x4, At[m][k]), __builtin_bit_cast(pg8_i32x4, acc[ai][bj][m][n]), 0, 0, 0)); } \
        else { _Pragma("unroll") for (int m = 0; m < 4; ++m) _Pragma("unroll") for (int n = 0; n < 2; ++n) _Pragma("unroll") for (int k = 0; k < 2; ++k) \
            acc[ai][bj][m][n] = __builtin_amdgcn_mfma_f32_16x16x32_bf16(Bt[n][k], At[m][k], acc[ai][bj][m][n], 0, 0, 0); } \
        __builtin_amdgcn_s_setprio(PG8_PRIO_LOAD); } while (0)
#define PG8_WAIT_V(n) asm volatile("s_waitcnt vmcnt(" #n ")" ::: "memory")
#define PG8_WAIT_L(n) asm volatile("s_waitcnt lgkmcnt(" #n ")" ::: "memory")
#define PG8_BAR __builtin_amdgcn_s_barrier()
#define PG8_SCHED __builtin_amdgcn_sched_barrier(0)
    Unit cur, nxt; int ui = 0;
    if (!S.next(0, cur)) return;
    f32x4 acc[2][2][4][2];
#pragma unroll
    for (int a = 0; a < 2; ++a)
#pragma unroll
        for (int b = 0; b < 2; ++b)
#pragma unroll
            for (int m = 0; m < 4; ++m)
#pragma unroll
                for (int n = 0; n < 2; ++n) acc[a][b][m][n] = (f32x4){0.f, 0.f, 0.f, 0.f};
    bf16x8 At[4][2], B0[2][2], B1[2][2];
    unsigned cA = (unsigned)cur.pm * tstep, cB = (unsigned)cur.pn * tstep + (unsigned)(cur.pm >> 6) * (unsigned)g.bb;
    S.a_ready(cur);
    if constexpr (SP2) {
        PG8_STAGE(PG8_SB(0, 0), cB, voffB); PG8_STAGE(PG8_SB(0, 1), cB + hstep, voffB); PG8_STAGE(PG8_SA(0, 0), cA, voffA); PG8_STAGE(PG8_SA(0, 1), cA + hstep, voffA);
        if (wr == 1) PG8_BAR;
        PG8_WAIT_V(2); PG8_BAR;
        PG8_STAGE(PG8_SB(1, 0), cB + kstep, voffB); PG8_STAGE(PG8_SA(1, 0), cA + kstep, voffA); PG8_STAGE(PG8_SB(1, 1), cB + hstep + kstep, voffB);
        PG8_WAIT_V(6); PG8_BAR;
    } else {
        PG8_STAGE(PG8_SB(0, 0), cB, voffB); PG8_STAGE(PG8_SA(0, 0), cA, voffA); PG8_STAGE(PG8_SB(0, 1), cB + hstep, voffB); PG8_STAGE(PG8_SA(0, 1), cA + hstep, voffA);
        if (wr == 1) PG8_BAR;
        PG8_WAIT_V(4); PG8_BAR;
        PG8_STAGE(PG8_SB(1, 0), cB + kstep, voffB); PG8_STAGE(PG8_SA(1, 0), cA + kstep, voffA); PG8_STAGE(PG8_SB(1, 1), cB + hstep + kstep, voffB);
        PG8_WAIT_V(6); PG8_BAR;
    }
    for (;;) {
        const bool has_next = S.next(ui + 1, nxt);
        const unsigned nA = has_next ? (unsigned)nxt.pm * tstep : cA, nB = has_next ? (unsigned)nxt.pn * tstep + (unsigned)(nxt.pm >> 6) * (unsigned)g.bb : cB;
        for (int t = 0; t < nt; t += 2) {
            const bool last = (t == nt - 2);
            const unsigned a1 = cA + (unsigned)(t + 1) * kstep;
            const unsigned a2 = last ? nA : cA + (unsigned)(t + 2) * kstep, b2 = last ? nB : cB + (unsigned)(t + 2) * kstep;
            const unsigned a3 = a2 + kstep, b3 = b2 + kstep;
            if (last && has_next) S.a_ready(nxt);
            if constexpr (SP2) {
            PG8_STAGE(PG8_SA(1, 1), a1 + hstep, voffA); PG8_SCHED; PG8_LDB(B0, 0, 0); PG8_LDB(B1, 0, 1); PG8_SCHED; PG8_LDA(At, 0, 0);
            PG8_WAIT_V(8); PG8_WAIT_L(0); PG8_BAR; PG8_MMA(0, 0, At, B0); PG8_MMA(0, 1, At, B1); PG8_BAR; PG8_SCHED;
            PG8_STAGE(PG8_SB(0, 0), b2, voffB); PG8_STAGE(PG8_SB(0, 1), b2 + hstep, voffB); PG8_STAGE(PG8_SA(0, 0), a2, voffA); PG8_SCHED; PG8_LDA(At, 0, 1);
            PG8_WAIT_V(8); PG8_WAIT_L(0); PG8_BAR; PG8_MMA(1, 0, At, B0); PG8_MMA(1, 1, At, B1); PG8_BAR; PG8_SCHED;
            PG8_STAGE(PG8_SA(0, 1), a2 + hstep, voffA); PG8_SCHED; PG8_LDB(B0, 1, 0); PG8_LDB(B1, 1, 1); PG8_SCHED; PG8_LDA(At, 1, 0);
            PG8_WAIT_V(8); PG8_WAIT_L(0); PG8_BAR; PG8_MMA(0, 0, At, B0); PG8_MMA(0, 1, At, B1); PG8_BAR; PG8_SCHED;
            PG8_STAGE(PG8_SB(1, 0), b3, voffB); PG8_STAGE(PG8_SB(1, 1), b3 + hstep, voffB); PG8_STAGE(PG8_SA(1, 0), a3, voffA); PG8_SCHED; PG8_LDA(At, 1, 1);
            PG8_WAIT_V(8); PG8_WAIT_L(0); PG8_BAR; PG8_MMA(1, 0, At, B0); PG8_MMA(1, 1, At, B1); PG8_BAR; PG8_SCHED;
            } else {
            PG8_LDB(B0, 0, 0); PG8_SCHED; PG8_LDA(At, 0, 0); PG8_STAGE(PG8_SA(1, 1), a1 + hstep, voffA);
            PG8_WAIT_L(8); PG8_BAR; PG8_WAIT_L(0); PG8_MMA(0, 0, At, B0); PG8_BAR; PG8_SCHED;
            PG8_LDB(B1, 0, 1); PG8_STAGE(PG8_SB(0, 0), b2, voffB);
            PG8_BAR; PG8_WAIT_L(0); PG8_MMA(0, 1, At, B1); PG8_BAR;
            PG8_LDA(At, 0, 1); PG8_STAGE(PG8_SA(0, 0), a2, voffA);
            PG8_BAR; PG8_WAIT_L(0); PG8_MMA(1, 0, At, B0); PG8_BAR; PG8_SCHED;
            PG8_STAGE(PG8_SB(0, 1), b2 + hstep, voffB);
            PG8_WAIT_V(6); PG8_BAR; PG8_MMA(1, 1, At, B1); PG8_BAR;
            PG8_LDB(B0, 1, 0); PG8_SCHED; PG8_LDA(At, 1, 0); PG8_STAGE(PG8_SA(0, 1), a2 + hstep, voffA);
            PG8_WAIT_L(8); PG8_BAR; PG8_WAIT_L(0); PG8_MMA(0, 0, At, B0); PG8_BAR; PG8_SCHED;
            PG8_LDB(B1, 1, 1); PG8_STAGE(PG8_SB(1, 0), b3, voffB);
            PG8_BAR; PG8_WAIT_L(0); PG8_MMA(0, 1, At, B1); PG8_BAR;
            PG8_LDA(At, 1, 1); PG8_STAGE(PG8_SA(1, 0), a3, voffA);
            PG8_BAR; PG8_WAIT_L(0); PG8_MMA(1, 0, At, B0); PG8_BAR; PG8_SCHED;
            PG8_STAGE(PG8_SB(1, 1), b3 + hstep, voffB);
            PG8_WAIT_V(6); PG8_BAR; PG8_MMA(1, 1, At, B1); PG8_BAR;
            }
        }
        if constexpr (ALIGN_EPI) { if (wr == 0) PG8_BAR; }
        if constexpr (F8) { _Pragma("unroll") for (int a = 0; a < 2; ++a) _Pragma("unroll") for (int b = 0; b < 2; ++b) _Pragma("unroll") for (int m = 0; m < 4; ++m) _Pragma("unroll") for (int n = 0; n < 2; ++n)
            acc[a][b][m][n] = __builtin_convertvector(__builtin_bit_cast(pg8_i32x4, acc[a][b][m][n]), f32x4); }
        if constexpr (!Epi::AFTER_DRAIN) { E(acc, cur, wr, wc, fr, fq); S.done(cur); }
        if (!has_next) break;
#pragma unroll
        for (int a = 0; a < 2; ++a)
#pragma unroll
            for (int b = 0; b < 2; ++b)
#pragma unroll
                for (int m = 0; m < 4; ++m)
#pragma unroll
                    for (int n = 0; n < 2; ++n) acc[a][b][m][n] = (f32x4){0.f, 0.f, 0.f, 0.f};
        cur = nxt; cA = nA; cB = nB; ++ui;
        if constexpr (ALIGN_EPI) { if (wr == 1) PG8_BAR; }
    }
    PG8_WAIT_V(0);
    if constexpr (!ALIGN_EPI) { if (wr == 0) PG8_BAR; }
    PG8_BAR;
    if constexpr (Epi::AFTER_DRAIN) { E.fused(acc, cur, wr, wc, fr, fq, lds, wid, lane); S.done(cur); }
#undef PG8_SA
#undef PG8_SB
#undef PG8_STAGE
#undef PG8_LDA
#undef PG8_LDB
#undef PG8_MMA
#undef PG8_WAIT_V
#undef PG8_WAIT_L
#undef PG8_BAR
#undef PG8_SCHED
}
}
constexpr int NB_ = 2, S_ = 16384, D_ = 1024, M_ = NB_ * S_, H_ = 16, HD_ = 64, FF_ = 2816, NBLK_ = 64;
constexpr float LOG2E_ = 1.4426950408889634f;
constexpr float C2_ = 0.125f * LOG2E_;
constexpr float EPS_ = 1e-6f;

constexpr size_t MiB = 1u << 20;
constexpr size_t WS_CTL = 0, CTL_ZERO_BYTES = 256 * 1024;
constexpr size_t WS_CMAX = 128 * 1024;
constexpr size_t WS_MOD  = 1 * MiB;
constexpr size_t WS_GM   = WS_MOD + 256 * 1024, WS_WEXP = WS_GM;
constexpr size_t WS_COEF = WS_GM + 64 * 1024;
constexpr size_t WS_BFFN = WS_COEF + 64 * 1024;
constexpr size_t WS_BQKV = WS_BFFN + 192 * 1024;
constexpr size_t WS_BPW1 = WS_BQKV + 32 * 1024;
constexpr size_t WS_SSQ  = 4 * MiB;
constexpr size_t WS_KBAR = 6 * MiB;
constexpr size_t WS_SEL  = 7 * MiB;
constexpr size_t WS_LP   = 9 * MiB;
constexpr size_t WS_WIN  = 16 * MiB;
constexpr size_t WS_WQKV = 104 * MiB;
constexpr size_t WS_WPW1 = 116 * MiB;
constexpr size_t WS_WOUT = 124 * MiB;
constexpr size_t WS_WO   = 146 * MiB;
constexpr size_t WS_WPW2 = 148 * MiB;
constexpr size_t WS_XB   = 152 * MiB;
constexpr size_t WS_BIG  = 216 * MiB;
constexpr size_t WS_ACT  = WS_BIG;
constexpr size_t WS_Q = WS_BIG, WS_K = WS_BIG + 64 * MiB, WS_V = WS_BIG + 128 * MiB;
constexpr size_t WS_OP3 = 408 * MiB;
constexpr size_t WS_U = WS_BIG, WS_CV = WS_BIG + 64 * MiB;
constexpr size_t WS_X8  = 472 * MiB;
constexpr size_t WS_SSQ1 = 504 * MiB;
constexpr size_t WS_END = 506 * MiB;
constexpr float CQ_ = 8.0f;
#ifndef I8MASK
#define I8MASK 0
#endif
static_assert((I8MASK & 1) == 0, "FFN 0 follows the prologue, which has no adaLN vectors yet: it stays bf16");
constexpr int CW_BAR = 1024;

constexpr int RING_BYTES = 131072;
constexpr int LDSCTL_OFF = RING_BYTES, MISC_OFF = LDSCTL_OFF + 320;
constexpr int LDS_BYTES = 163840;
constexpr int LT_PM = LDSCTL_OFF + 896, LT_RSTD = LDSCTL_OFF + 1024, LT_VEC = LDSCTL_OFF + 3072, LT_EXP = LT_VEC + 22528;

#define GAS __attribute__((address_space(1)))
#define LAS __attribute__((address_space(3)))
typedef unsigned short bf16;
typedef float f32x4 __attribute__((ext_vector_type(4)));
typedef unsigned u32x4 __attribute__((ext_vector_type(4)));
typedef unsigned u32x2 __attribute__((ext_vector_type(2)));
typedef short bf16x8 __attribute__((ext_vector_type(8)));
typedef float f32x16 __attribute__((ext_vector_type(16)));
#define LDS_WAIT() asm volatile("s_waitcnt lgkmcnt(0)" ::: "memory")
#define VM_WAIT() asm volatile("s_waitcnt vmcnt(0)" ::: "memory")
#define LDS_BARRIER() do { asm volatile("s_waitcnt lgkmcnt(0)" ::: "memory"); __builtin_amdgcn_s_barrier(); asm volatile("" ::: "memory"); } while (0)
__device__ __forceinline__ unsigned f2bf(float f) { unsigned u = __builtin_bit_cast(unsigned, f); return (u + 0x7fffu + ((u >> 16) & 1u)) >> 16; }
__device__ __forceinline__ unsigned pk2(float lo, float hi) { return f2bf(lo) | (f2bf(hi) << 16); }
typedef __bf16 bf16x2_t __attribute__((ext_vector_type(2))); typedef float f32x2_t __attribute__((ext_vector_type(2)));
__device__ __forceinline__ unsigned cvtpk(float lo, float hi) { const f32x2_t v = {lo, hi}; const bf16x2_t b = __builtin_convertvector(v, bf16x2_t); return __builtin_bit_cast(unsigned, b); }
__device__ __forceinline__ float bf2f(unsigned h) { return __builtin_bit_cast(float, h << 16); }
__device__ __forceinline__ float bflo(unsigned w) { return __builtin_bit_cast(float, w << 16); }
__device__ __forceinline__ float bfhi(unsigned w) { return __builtin_bit_cast(float, w & 0xffff0000u); }
template <int CTRL> __device__ __forceinline__ float dppf(float v) { return __builtin_bit_cast(float, __builtin_amdgcn_mov_dpp(__builtin_bit_cast(int, v), CTRL, 0xF, 0xF, true)); }
typedef unsigned u32x2v __attribute__((ext_vector_type(2)));
__device__ __forceinline__ float u2f(unsigned u) { return __builtin_bit_cast(float, u); }
__device__ __forceinline__ unsigned f2u(float f) { return __builtin_bit_cast(unsigned, f); }
__device__ __forceinline__ float sum16(float v) { const auto r = __builtin_amdgcn_permlane16_swap(f2u(v), f2u(v), false, false); const unsigned r0 = r[0], r1 = r[1]; return u2f(r0) + u2f(r1); }
__device__ __forceinline__ float sum32(float v) { const auto r = __builtin_amdgcn_permlane32_swap(f2u(v), f2u(v), false, false); const unsigned r0 = r[0], r1 = r[1]; return u2f(r0) + u2f(r1); }
__device__ __forceinline__ float max16(float v) { const auto r = __builtin_amdgcn_permlane16_swap(f2u(v), f2u(v), false, false); const unsigned r0 = r[0], r1 = r[1]; return fmaxf(u2f(r0), u2f(r1)); }
__device__ __forceinline__ float max32(float v) { const auto r = __builtin_amdgcn_permlane32_swap(f2u(v), f2u(v), false, false); const unsigned r0 = r[0], r1 = r[1]; return fmaxf(u2f(r0), u2f(r1)); }
__device__ __forceinline__ float row_sum16(float v) { v += dppf<0xB1>(v); v += dppf<0x4E>(v); v += dppf<0x141>(v); v += dppf<0x140>(v); return v; }
__device__ __forceinline__ float wave_sum(float v) { v = row_sum16(v); v = sum16(v); return sum32(v); }
__device__ __forceinline__ float wave_max(float v) { v = fmaxf(v, dppf<0xB1>(v)); v = fmaxf(v, dppf<0x4E>(v)); v = fmaxf(v, dppf<0x141>(v)); v = fmaxf(v, dppf<0x140>(v)); v = max16(v); return max32(v); }
__device__ __forceinline__ unsigned other32(unsigned v, int hi) { const auto r = __builtin_amdgcn_permlane32_swap(v, v, false, false); const unsigned r0 = r[0], r1 = r[1]; return hi ? r0 : r1; }
#define XB_TMO      128
#define XB_XCNT(j)  (256  + 64 * (j))
#define XB_XSUB(j)  (1280 + 64 * (j))
#define XB_XGEN(j)  (2304 + 64 * (j))
#define XB_TOP      3328
#define XB_TOPGEN   3392
#define XCD_BAR_WORDS 3456
#define XB_SPIN_CAP (1u << 18)

__device__ __forceinline__ unsigned xb_ld(unsigned* p)              { return __hip_atomic_load(p, __ATOMIC_RELAXED, __HIP_MEMORY_SCOPE_AGENT); }
__device__ __forceinline__ unsigned xb_add(unsigned* p, unsigned v) { return __hip_atomic_fetch_add(p, v, __ATOMIC_RELAXED, __HIP_MEMORY_SCOPE_AGENT); }
__device__ __forceinline__ unsigned xb_xcc_id() { return (unsigned)__builtin_amdgcn_s_getreg((3 << 11) | 20) & 0xFu; }
#define XB_SPIN(cond, bar) do { unsigned _sp = 0; while (cond) { __builtin_amdgcn_s_sleep(1); \
    if ((++_sp & 255u) == 0u) { if (xb_ld(&(bar)[XB_TMO])) break; if (_sp > XB_SPIN_CAP) { atomicAdd(&(bar)[XB_TMO], 1u); break; } } } } while (0)

struct XcdBarrier {
    unsigned* bar; unsigned x;
    volatile LAS unsigned* st;
};

__device__ __forceinline__ XcdBarrier xcd_barrier_post(unsigned* bar, volatile LAS unsigned* st) {
    XcdBarrier b; b.bar = bar; b.x = xb_xcc_id(); b.st = st;
    if (threadIdx.x == 0) (void)xb_add(&bar[XB_XCNT(b.x)], 1u);
    return b;
}
__device__ __forceinline__ void xcd_barrier_complete(unsigned* bar, unsigned x, unsigned& nloc, unsigned& nx) {
    const unsigned G = gridDim.x * gridDim.y * gridDim.z;
    unsigned sum, cnt, mine, sp = 0u;
    for (;;) {
        sum = 0u; cnt = 0u; mine = 0u;
#pragma unroll
        for (unsigned j = 0; j < 16; ++j) { const unsigned c = xb_ld(&bar[XB_XCNT(j)]); sum += c; cnt += (c > 0u) ? 1u : 0u; mine = (j == x) ? c : mine; }
        if (sum == G) break;
        __builtin_amdgcn_s_sleep(1);
        if ((++sp & 255u) == 0u) { if (xb_ld(&bar[XB_TMO])) break; if (sp > XB_SPIN_CAP) { atomicAdd(&bar[XB_TMO], 1u); break; } }
    }
    nloc = mine > 0u ? mine : 1u; nx = cnt > 0u ? cnt : 1u;
}

__device__ __forceinline__ void xcd_barrier(const XcdBarrier& b) {
    asm volatile("s_waitcnt vmcnt(0)" ::: "memory");
    __syncthreads();
    if (threadIdx.x == 0) {
        unsigned* bar = b.bar;
        __builtin_amdgcn_s_waitcnt(0);
        unsigned nloc = b.st[0], nx = b.st[1];
        if (nloc == 0u) { xcd_barrier_complete(bar, b.x, nloc, nx); b.st[0] = nloc; b.st[1] = nx; }
        const unsigned old = xb_add(&bar[XB_XSUB(b.x)], 1u);
        const unsigned gen = old / nloc;
        if (old + 1u == (gen + 1u) * nloc) {
            __builtin_amdgcn_fence(__ATOMIC_RELEASE, "agent");
            asm volatile("s_waitcnt vmcnt(0)" ::: "memory");
            const unsigned og = xb_add(&bar[XB_TOP], 1u);
            const unsigned tg = og / nx;
            if (og + 1u == (tg + 1u) * nx) xb_add(&bar[XB_TOPGEN], 1u);
            else XB_SPIN(xb_ld(&bar[XB_TOPGEN]) == tg, bar);
            __builtin_amdgcn_fence(__ATOMIC_ACQUIRE, "agent");
            xb_add(&bar[XB_XGEN(b.x)], 1u);
            asm volatile("s_waitcnt vmcnt(0)" ::: "memory");
        } else {
            XB_SPIN(xb_ld(&bar[XB_XGEN(b.x)]) == gen, bar);
            __builtin_amdgcn_fence(__ATOMIC_ACQUIRE, "agent");
            asm volatile("s_waitcnt vmcnt(0)" ::: "memory");
        }
    }
    __syncthreads();
}
__device__ __forceinline__ int epi_tables_pm(LAS unsigned char* lds, const pg8::StaticOrder& S, int tid, int& pmA_out, int& pmB_out) {
    int pmA = -1, pmB = -1, ok = 1; pg8::Unit u;
    for (int i = 0; S.next(i, u); ++i) { if (pmA < 0) pmA = u.pm; else if (u.pm != pmA) { if (pmB < 0) pmB = u.pm; else if (u.pm != pmB) ok = 0; } }
    if (pmA < 0) pmA = 0;
    if (pmB < 0) pmB = pmA;
    if ((pmA >> 6) != (pmB >> 6)) ok = 0;
    if (tid == 0) { ((LAS int*)(lds + LT_PM))[0] = pmA; ((LAS int*)(lds + LT_PM))[1] = pmB; }
    pmA_out = pmA; pmB_out = pmB; return ok;
}
__device__ __forceinline__ float ssq_row(const float* ssq, int row) {
    const f32x4 p0 = *(const f32x4*)(ssq + (size_t)row * 16), p1 = *(const f32x4*)(ssq + (size_t)row * 16 + 4), p2 = *(const f32x4*)(ssq + (size_t)row * 16 + 8), p3 = *(const f32x4*)(ssq + (size_t)row * 16 + 12);
    return (((p0.x + p0.y) + (p0.z + p0.w)) + ((p1.x + p1.y) + (p1.z + p1.w))) + (((p2.x + p2.y) + (p2.z + p2.w)) + ((p3.x + p3.y) + (p3.z + p3.w)));
}
__device__ __forceinline__ void epi_tables_rstd(LAS unsigned char* lds, const float* ssq, int pmA, int pmB, int ok, int tid, float scale = 1.0f, const float* ssq_prev = nullptr) {
    const int slot = tid >> 8, r = tid & 255, row = (slot ? pmB : pmA) * 256 + r;
    float v = rsqrtf(ssq_row(ssq, row) * (1.0f / D_) + EPS_) * scale;
    if (ssq_prev) v *= sqrtf(ssq_row(ssq_prev, row) * (1.0f / D_) + EPS_);
    ((LAS float*)(lds + LT_RSTD))[tid] = ok ? v : __builtin_nanf("");
}
__device__ __forceinline__ float gm_rms(const float* ng, const float* scl, int lane) {
    float s = 0.f;
#pragma unroll
    for (int i = 0; i < 4; ++i) { const f32x4 g = *(const f32x4*)(ng + 256 * i + 4 * lane), c = *(const f32x4*)(scl + 256 * i + 4 * lane);
#pragma unroll
        for (int e = 0; e < 4; ++e) { const float t = g[e] * (1.0f + c[e]); s += t * t; } }
    return sqrtf(wave_sum(s) * (1.0f / D_));
}
__device__ __forceinline__ void epi_tables_vec(LAS unsigned char* lds, int dst_off, const float* src, int n, int tid) {
    for (int i = tid * 4; i < n; i += 2048) *(LAS f32x4*)(lds + LT_VEC + (dst_off + i) * 4) = src ? *(const f32x4*)(src + i) : (f32x4){0.f, 0.f, 0.f, 0.f};
}
__device__ __forceinline__ unsigned pk4_i8(float a, float b, float c, float d) {
    const float M = 12582912.0f;
    const unsigned ua = f2u(__builtin_amdgcn_fmed3f(a, -127.0f, 127.0f) + M), ub = f2u(__builtin_amdgcn_fmed3f(b, -127.0f, 127.0f) + M), uc = f2u(__builtin_amdgcn_fmed3f(c, -127.0f, 127.0f) + M), ud = f2u(__builtin_amdgcn_fmed3f(d, -127.0f, 127.0f) + M);
    const unsigned lo = __builtin_amdgcn_perm(ub, ua, 0x0c0c0400u), hi = __builtin_amdgcn_perm(ud, uc, 0x0c0c0400u);
    return lo | (hi << 16);
}
__device__ __forceinline__ int lane_id() { return (int)__builtin_amdgcn_mbcnt_hi(~0u, __builtin_amdgcn_mbcnt_lo(~0u, 0u)); }
__device__ __forceinline__ float sigm(float v) { return __builtin_amdgcn_rcpf(1.0f + __builtin_amdgcn_exp2f(-LOG2E_ * v)); }

template <int ACT, bool I8 = false> struct EpiGated {
    static constexpr bool PERM = true, AFTER_DRAIN = false;
    bf16* O; int ldo; const float* bias; int N; const float* ssq; LAS unsigned char* lds;
    const float* ssq_prev; const signed char* wexp; const float* ng; const float* scl;
    __device__ __forceinline__ void preload(const pg8::StaticOrder& S, int tid) const {
        int pmA, pmB; const int ok = epi_tables_pm(lds, S, tid, pmA, pmB);
        if constexpr (I8) {
            const float G = gm_rms(ng, scl + (size_t)(pmA >> 6) * 9216, tid & 63);
            epi_tables_rstd(lds, ssq, pmA, pmB, ok, tid, CQ_ * G * (1.0f / 127.0f), ssq_prev);
            for (int i = tid; i < N / 4; i += 512) ((LAS unsigned*)(lds + LT_EXP))[i] = ((const unsigned*)wexp)[i];
        } else epi_tables_rstd(lds, ssq, pmA, pmB, ok, tid);
        epi_tables_vec(lds, 0, bias + (size_t)(pmA >> 6) * N, N, tid);
    }
    __device__ __forceinline__ void operator()(const f32x4 (&acc)[2][2][4][2], const pg8::Unit& u, int wr, int wc, int fr, int fq) const {
        const LAS float* bp = (const LAS float*)(lds + LT_VEC) + u.pn * 256 + wc * 32 + 8 * fq;
        const LAS float* rt = (const LAS float*)(lds + LT_RSTD) + ((u.pm == ((const LAS int*)(lds + LT_PM))[0]) ? 0 : 256) + wr * 64 + fr;
        f32x4 bv[2][2];
#pragma unroll
        for (int bj = 0; bj < 2; ++bj)
#pragma unroll
            for (int n = 0; n < 2; ++n) bv[bj][n] = *(const LAS f32x4*)(bp + bj * 128 + 4 * n);
        float rsv[8];
#pragma unroll
        for (int k = 0; k < 8; ++k) rsv[k] = rt[(k >> 2) * 128 + (k & 3) * 16];
        f32x4 cs[2][2];
        if constexpr (I8) {
#pragma unroll
            for (int bj = 0; bj < 2; ++bj) { const u32x2 eb = *(const LAS u32x2*)(lds + LT_EXP + u.pn * 256 + bj * 128 + wc * 32 + 8 * fq);
#pragma unroll
                for (int n = 0; n < 2; ++n) { const unsigned w = n ? eb.y : eb.x;
#pragma unroll
                    for (int j = 0; j < 4; ++j) { const int e = (int)(signed char)(w >> (8 * j)); cs[bj][n][j] = u2f((unsigned)(e + 127) << 23); } } }
        }
#pragma unroll
        for (int ai = 0; ai < 2; ++ai)
#pragma unroll
            for (int m = 0; m < 4; ++m) {
                const int row = u.pm * 256 + ai * 128 + wr * 64 + m * 16 + fr;
                const float rs = rsv[ai * 4 + m];
                typedef float f2 __attribute__((ext_vector_type(2)));
                f2 a[4], g[4], t[4], e[4], d[4], r[4], v[4];
#pragma unroll
                for (int i = 0; i < 4; ++i) { const int n = i >> 1; const f32x4 a4 = I8 ? acc[ai][0][m][n] * cs[0][n] : acc[ai][0][m][n], g4 = I8 ? acc[ai][1][m][n] * cs[1][n] : acc[ai][1][m][n], ba4 = bv[0][n], bg4 = bv[1][n];
                    a[i] = ((i & 1) == 0 ? (f2){a4.x, a4.y} : (f2){a4.z, a4.w}) * rs + ((i & 1) == 0 ? (f2){ba4.x, ba4.y} : (f2){ba4.z, ba4.w});
                    g[i] = ((i & 1) == 0 ? (f2){g4.x, g4.y} : (f2){g4.z, g4.w}) * rs + ((i & 1) == 0 ? (f2){bg4.x, bg4.y} : (f2){bg4.z, bg4.w});
                    t[i] = ((ACT == 0) ? a[i] : g[i]) * (-LOG2E_); }
#pragma unroll
                for (int i = 0; i < 4; ++i) { e[i].x = __builtin_amdgcn_exp2f(t[i].x); e[i].y = __builtin_amdgcn_exp2f(t[i].y); }
#pragma unroll
                for (int i = 0; i < 4; ++i) d[i] = e[i] + 1.0f;
#pragma unroll
                for (int i = 0; i < 4; ++i) { r[i].x = __builtin_amdgcn_rcpf(d[i].x); r[i].y = __builtin_amdgcn_rcpf(d[i].y); }
#pragma unroll
                for (int i = 0; i < 4; ++i) v[i] = (ACT == 0) ? (a[i] * r[i]) * g[i] : a[i] * r[i];
                u32x4 w; w.x = cvtpk(v[0].x, v[0].y); w.y = cvtpk(v[1].x, v[1].y); w.z = cvtpk(v[2].x, v[2].y); w.w = cvtpk(v[3].x, v[3].y);
                *(u32x4*)(O + (size_t)row * ldo + u.pn * 128 + wc * 32 + 8 * fq) = w;
            }
    }
};

struct EpiRes {
    static constexpr bool PERM = true, AFTER_DRAIN = false;
    bf16* xb; float* out; const float* bias2; const float* coef; float* ssq; int last; LAS unsigned char* lds;
    unsigned char* x8; const float* ssq_prev; const float* ng_next; const float* scl_next;
    __device__ __forceinline__ void preload(const pg8::StaticOrder& S, int tid) const {
        int pmA, pmB; const int ok = epi_tables_pm(lds, S, tid, pmA, pmB);
        epi_tables_vec(lds, 0, ok ? coef + (size_t)(pmA >> 6) * D_ : nullptr, D_, tid);
        epi_tables_vec(lds, D_, bias2, D_, tid);
        if (x8) {
            const float* sc = scl_next + (size_t)(pmA >> 6) * 9216;
            const float G = gm_rms(ng_next, sc, tid & 63);
            epi_tables_rstd(lds, ssq_prev, pmA, pmB, ok, tid, 127.0f / (CQ_ * G));
            if (tid < 256) { const f32x4 g = *(const f32x4*)(ng_next + 4 * tid), c = *(const f32x4*)(sc + 4 * tid);
                *(LAS f32x4*)(lds + LT_VEC + (2 * D_ + 4 * tid) * 4) = (f32x4){g.x * (1.0f + c.x), g.y * (1.0f + c.y), g.z * (1.0f + c.z), g.w * (1.0f + c.w)}; }
        }
    }
    __device__ __forceinline__ void operator()(const f32x4 (&acc)[2][2][4][2], const pg8::Unit& u, int wr, int wc, int fr, int fq) const {
        const int col0 = u.pn * 256 + wc * 32 + 8 * fq;
        const size_t ro0 = (size_t)(u.pm * 256 + wr * 64 + fr) * D_ + col0;
        u32x4 xr[8][2];
#define EPIRES_LOAD(k) do { const bf16* xp_ = xb + ro0 + (size_t)(((k) >> 2) * 128 + ((k) & 3) * 16) * D_; xr[k][0] = *(const u32x4*)(xp_); xr[k][1] = *(const u32x4*)(xp_ + 128); } while (0)
        EPIRES_LOAD(0); EPIRES_LOAD(1); EPIRES_LOAD(2); EPIRES_LOAD(3);
        f32x4 cf[2][2], b2[2][2];
#pragma unroll
        for (int bj = 0; bj < 2; ++bj)
#pragma unroll
            for (int n = 0; n < 2; ++n) { const int c = col0 + bj * 128 + 4 * n;
                cf[bj][n] = *(const LAS f32x4*)(lds + LT_VEC + c * 4);
                b2[bj][n] = *(const LAS f32x4*)(lds + LT_VEC + (D_ + c) * 4); }
#pragma unroll
        for (int k = 0; k < 8; ++k) {
            const int ai = k >> 2, m = k & 3;
            if (k < 4) { switch (k) { case 0: EPIRES_LOAD(4); break; case 1: EPIRES_LOAD(5); break; case 2: EPIRES_LOAD(6); break; default: EPIRES_LOAD(7); break; } }
            const int row = u.pm * 256 + ai * 128 + wr * 64 + m * 16 + fr; const size_t ro = (size_t)row * D_;
            float ss = 0.f;
#pragma unroll
            for (int bj = 0; bj < 2; ++bj) {
                const u32x4 xw = xr[k][bj];
                const f32x4 x0 = (f32x4){bflo(xw.x), bfhi(xw.x), bflo(xw.y), bfhi(xw.y)}, x1 = (f32x4){bflo(xw.z), bfhi(xw.z), bflo(xw.w), bfhi(xw.w)};
                const f32x4 n0 = x0 + cf[bj][0] * (acc[ai][bj][m][0] + b2[bj][0]), n1 = x1 + cf[bj][1] * (acc[ai][bj][m][1] + b2[bj][1]);
                ss += ((n0[0] * n0[0] + n0[1] * n0[1]) + (n0[2] * n0[2] + n0[3] * n0[3])) + ((n1[0] * n1[0] + n1[1] * n1[1]) + (n1[2] * n1[2] + n1[3] * n1[3]));
                if (!last) { u32x4 w; w.x = cvtpk(n0[0], n0[1]); w.y = cvtpk(n0[2], n0[3]); w.z = cvtpk(n1[0], n1[1]); w.w = cvtpk(n1[2], n1[3]);
                    *(u32x4*)(xb + ro + col0 + bj * 128) = w;
                    if (x8) { const float qs = ((const LAS float*)(lds + LT_RSTD))[((u.pm == ((const LAS int*)(lds + LT_PM))[0]) ? 0 : 256) + ai * 128 + wr * 64 + m * 16 + fr];
                        const f32x4 q0 = n0 * *(const LAS f32x4*)(lds + LT_VEC + (2 * D_ + col0 + bj * 128) * 4) * qs, q1 = n1 * *(const LAS f32x4*)(lds + LT_VEC + (2 * D_ + col0 + bj * 128 + 4) * 4) * qs;
                        u32x2 w8; w8.x = pk4_i8(q0[0], q0[1], q0[2], q0[3]); w8.y = pk4_i8(q1[0], q1[1], q1[2], q1[3]); *(u32x2*)(x8 + ro + col0 + bj * 128) = w8; } }
                else { *(f32x4*)(out + ro + col0 + bj * 128) = n0; *(f32x4*)(out + ro + col0 + bj * 128 + 4) = n1; }
            }
            if (!last) { ss = sum32(sum16(ss)); if (fq == 0) ssq[(size_t)row * 16 + u.pn * 4 + wc] = ss; }
        }
#undef EPIRES_LOAD
    }
};

struct EpiQKV {
    static constexpr bool PERM = true, AFTER_DRAIN = false;
    bf16* Q;   const float* bias; const float* ssq; const float* gq; const float* gk; float* kbarp; LAS unsigned char* lds;
    __device__ __forceinline__ void preload(const pg8::StaticOrder& S, int tid) const {
        int pmA, pmB; const int ok = epi_tables_pm(lds, S, tid, pmA, pmB);
        epi_tables_rstd(lds, ssq, pmA, pmB, ok, tid);
        epi_tables_vec(lds, 0, bias + (size_t)(pmA >> 6) * 3072, 3072, tid);
        epi_tables_vec(lds, 3072, gq, 64, tid); epi_tables_vec(lds, 3072 + 64, gk, 64, tid);
    }
    __device__ __forceinline__ void operator()(const f32x4 (&acc)[2][2][4][2], const pg8::Unit& u, int wr, int wc, int fr, int fq) const {
        const int b = u.pm >> 6, part = u.pn >> 2, head = ((u.pn & 3) << 2) + wc;
        const LAS float* bp = (const LAS float*)(lds + LT_VEC) + u.pn * 256 + wc * 32 + 8 * fq;
        const LAS float* gsrc = (const LAS float*)(lds + LT_VEC) + 3072 + ((part == 0) ? 0 : 64); const float gs = (part == 0) ? C2_ : 1.0f;
        const LAS float* rt = (const LAS float*)(lds + LT_RSTD) + ((u.pm == ((const LAS int*)(lds + LT_PM))[0]) ? 0 : 256) + wr * 64 + fr;
        f32x4 bv[2][2], gv[2][2], ks[2][2];
#pragma unroll
        for (int bj = 0; bj < 2; ++bj)
#pragma unroll
            for (int n = 0; n < 2; ++n) { bv[bj][n] = *(const LAS f32x4*)(bp + bj * 128 + 4 * n); gv[bj][n] = *(const LAS f32x4*)(gsrc + 32 * bj + 8 * fq + 4 * n) * gs; ks[bj][n] = (f32x4){0.f, 0.f, 0.f, 0.f}; }
        bf16* dst = Q + (size_t)part * ((size_t)M_ * D_);
        float rsv[8];
#pragma unroll
        for (int k = 0; k < 8; ++k) rsv[k] = rt[(k >> 2) * 128 + (k & 3) * 16];
#pragma unroll
        for (int ai = 0; ai < 2; ++ai)
#pragma unroll
            for (int m = 0; m < 4; ++m) {
                const int row = u.pm * 256 + ai * 128 + wr * 64 + m * 16 + fr;
                const float rs = rsv[ai * 4 + m];
                f32x4 v[2][2]; float ss = 0.f;
#pragma unroll
                for (int bj = 0; bj < 2; ++bj)
#pragma unroll
                    for (int n = 0; n < 2; ++n) { v[bj][n] = acc[ai][bj][m][n] * rs + bv[bj][n]; const f32x4 t = v[bj][n]; ss += (t[0] * t[0] + t[1] * t[1]) + (t[2] * t[2] + t[3] * t[3]); }
                if (part < 2) {
                    ss = sum32(sum16(ss));
                    const float r = rsqrtf(ss * (1.0f / HD_) + EPS_);
#pragma unroll
                    for (int bj = 0; bj < 2; ++bj)
#pragma unroll
                        for (int n = 0; n < 2; ++n) v[bj][n] = v[bj][n] * r * gv[bj][n];
                }
                if (part == 1) {
#pragma unroll
                    for (int bj = 0; bj < 2; ++bj)
#pragma unroll
                        for (int n = 0; n < 2; ++n) ks[bj][n] += v[bj][n];
                }
#pragma unroll
                for (int bj = 0; bj < 2; ++bj) {
                    u32x4 w; w.x = cvtpk(v[bj][0][0], v[bj][0][1]); w.y = cvtpk(v[bj][0][2], v[bj][0][3]); w.z = cvtpk(v[bj][1][0], v[bj][1][1]); w.w = cvtpk(v[bj][1][2], v[bj][1][3]);
                    *(u32x4*)(dst + (size_t)row * D_ + head * 64 + 32 * bj + 8 * fq) = w; }
            }
        if (part == 1) {
            float* kp = kbarp + ((((size_t)(b * 16 + head) * 64 + (u.pm & 63)) * 2 + wr) * 64);
#pragma unroll
            for (int bj = 0; bj < 2; ++bj)
#pragma unroll
                for (int n = 0; n < 2; ++n) { f32x4 t = ks[bj][n];
#pragma unroll
                    for (int j = 0; j < 4; ++j) { t[j] = row_sum16(t[j]); }
                    if (fr == 0) *(f32x4*)(kp + 32 * bj + 8 * fq + 4 * n) = t; }
        }
    }
};

template <class Epi, bool F8 = false> __device__ __forceinline__ void run_gemm(LAS unsigned char* lds, const bf16* A, const bf16* Bt, long bb, int N, int K, int G, const Epi& E, int wave_in) {
    int t = lane_id(); asm volatile("" : "+v"(t)); t += 64 * wave_in;
    int bid = (int)blockIdx.x, Gq = G; asm volatile("" : "+s"(bid), "+s"(Gq));
    pg8::Gemm g{A, Bt, M_, N, K, bb}; pg8::StaticOrder S; S.init(M_, N, Gq, bid);
    E.preload(S, t);
    __syncthreads();
    pg8::gemm_phase<Epi, pg8::StaticOrder, true, true, F8>(lds, g, S, E, t);
}

__device__ __forceinline__ void tile_load(float (&w)[32], const float* W, int N, int k0, int n0, int lane) {
    const float* p = W + (size_t)(k0 + (lane >> 5)) * N + n0 + (lane & 31);
#pragma unroll
    for (int i = 0; i < 32; ++i) w[i] = p[(size_t)(2 * i) * N];
}
__device__ __forceinline__ void tile_to_lds(const float (&w)[32], LAS float* scr, int lane) {
#pragma unroll
    for (int i = 0; i < 32; ++i) scr[(2 * i + (lane >> 5)) * 33 + (lane & 31)] = w[i];
}
__device__ __forceinline__ void transpose_finish(int K, bf16* WT, int k0, int dst0, LAS float* scr, int lane) {
    LDS_WAIT(); asm volatile("" ::: "memory");
    const int c = lane & 7;
#pragma unroll
    for (int j = 0; j < 4; ++j) { const int n = (lane >> 3) + 8 * j; const LAS float* s = scr + (8 * c) * 33 + n;
        u32x4 o; o.x = cvtpk(s[0 * 33], s[1 * 33]); o.y = cvtpk(s[2 * 33], s[3 * 33]); o.z = cvtpk(s[4 * 33], s[5 * 33]); o.w = cvtpk(s[6 * 33], s[7 * 33]);
        *(GAS u32x4*)(WT + (size_t)(dst0 + n) * K + k0 + 8 * c) = o; }
    LDS_WAIT(); asm volatile("" ::: "memory");
}
__device__ __forceinline__ int gated_dst(int n0, int half) { const int c = (n0 < half) ? n0 : n0 - half; return 256 * (c >> 7) + (c & 127) + ((n0 < half) ? 0 : 128); }

constexpr int PT_OFF = MISC_OFF + 128;
__device__ __forceinline__ unsigned long long pt_get(LAS unsigned char* lds, int i) {
    const unsigned long long v = ((volatile LAS unsigned long long*)(lds + PT_OFF))[i];
    return ((unsigned long long)(unsigned)__builtin_amdgcn_readfirstlane((int)(v >> 32)) << 32) | (unsigned long long)(unsigned)__builtin_amdgcn_readfirstlane((int)(unsigned)v);
}
#define PIN(i) ((const float*)(const GAS float*)pt_get(lds, (i)))
#define POUT ((float*)(GAS float*)pt_get(lds, 19))
#define PWS ((unsigned char*)(GAS unsigned char*)pt_get(lds, 20))

__device__ __forceinline__ void inweight_item(const float* W, int N, bf16* WT, size_t wt_bstride, int kh, int n0, int dst0, const float* ng, const float* mod0,
                                              float* bias, int bias_bstride, const float* extra, LAS float* scr, int lane, int i8out = 0, const unsigned* cmax = nullptr, signed char* wexp = nullptr) {
    const int c = lane & 7;
    float dacc[4][2];
#pragma unroll
    for (int j = 0; j < 4; ++j) { dacc[j][0] = 0.f; dacc[j][1] = 0.f; }
    float qinv[4]; int qex[4];
#pragma unroll
    for (int j = 0; j < 4; ++j) { qinv[j] = 0.f; qex[j] = 0; }
    if (i8out) {
#pragma unroll
        for (int j = 0; j < 4; ++j) { const unsigned mb = f2u(u2f(cmax[n0 + (lane >> 3) + 8 * j]) * (1.0f / 127.0f));
            int e = (int)((mb >> 23) & 255u) - 127 + ((mb & 0x7fffffu) ? 1 : 0); e = e < -100 ? -100 : e; qex[j] = e; qinv[j] = u2f((unsigned)(127 - e) << 23); }
    }
    float w[32]; tile_load(w, W, N, 64 * 8 * kh, n0, lane);
    f32x4 gq[2], s0q[2], s1q[2], h0q[2], h1q[2];
#define INW_VECS(kq_) do { _Pragma("unroll") for (int q4 = 0; q4 < 2; ++q4) { gq[q4] = *(const f32x4*)(ng + (kq_) + 4 * q4); s0q[q4] = *(const f32x4*)(mod0 + 1024 + (kq_) + 4 * q4); \
        s1q[q4] = *(const f32x4*)(mod0 + 9216 + 1024 + (kq_) + 4 * q4); h0q[q4] = *(const f32x4*)(mod0 + (kq_) + 4 * q4); h1q[q4] = *(const f32x4*)(mod0 + 9216 + (kq_) + 4 * q4); } } while (0)
    INW_VECS(64 * 8 * kh + 8 * c);
#pragma unroll 1
    for (int kb = 8 * kh; kb < 8 * kh + 8; ++kb) {
        const int k0 = 64 * kb, kq = k0 + 8 * c;
        tile_to_lds(w, scr, lane);
        float gm0[8], gm1[8], sh0[8], sh1[8];
#pragma unroll
        for (int q4 = 0; q4 < 2; ++q4)
#pragma unroll
            for (int e = 0; e < 4; ++e) { gm0[4 * q4 + e] = gq[q4][e] * (1.0f + s0q[q4][e]); gm1[4 * q4 + e] = gq[q4][e] * (1.0f + s1q[q4][e]); sh0[4 * q4 + e] = h0q[q4][e]; sh1[4 * q4 + e] = h1q[q4][e]; }
        if (kb + 1 < 8 * kh + 8) { tile_load(w, W, N, k0 + 64, n0, lane); INW_VECS(kq + 64); }
        LDS_WAIT(); asm volatile("" ::: "memory");
#pragma unroll
        for (int j = 0; j < 4; ++j) { const int n = (lane >> 3) + 8 * j; const LAS float* sp = scr + (8 * c) * 33 + n;
            float v[8];
#pragma unroll
            for (int e = 0; e < 8; ++e) v[e] = sp[e * 33];
            if (i8out) {
                u32x2 o; const float qi = qinv[j];
                o.x = pk4_i8(v[0] * qi, v[1] * qi, v[2] * qi, v[3] * qi); o.y = pk4_i8(v[4] * qi, v[5] * qi, v[6] * qi, v[7] * qi);
                *(GAS u32x2*)((unsigned char*)WT + (size_t)(dst0 + n) * 1024 + kq) = o;
            } else {
            u32x4 o0, o1;
            o0.x = cvtpk(v[0] * gm0[0], v[1] * gm0[1]); o0.y = cvtpk(v[2] * gm0[2], v[3] * gm0[3]); o0.z = cvtpk(v[4] * gm0[4], v[5] * gm0[5]); o0.w = cvtpk(v[6] * gm0[6], v[7] * gm0[7]);
            o1.x = cvtpk(v[0] * gm1[0], v[1] * gm1[1]); o1.y = cvtpk(v[2] * gm1[2], v[3] * gm1[3]); o1.z = cvtpk(v[4] * gm1[4], v[5] * gm1[5]); o1.w = cvtpk(v[6] * gm1[6], v[7] * gm1[7]);
            bf16* wp = WT + (size_t)(dst0 + n) * 1024 + kq;
            *(GAS u32x4*)(wp) = o0; *(GAS u32x4*)(wp + wt_bstride) = o1;
            }
            float d0 = 0.f, d1 = 0.f;
#pragma unroll
            for (int e = 0; e < 8; ++e) { d0 += v[e] * sh0[e]; d1 += v[e] * sh1[e]; }
            dacc[j][0] += d0; dacc[j][1] += d1; }
        LDS_WAIT(); asm volatile("" ::: "memory");
    }
    if (i8out && kh == 0 && c == 0) {
#pragma unroll
        for (int j = 0; j < 4; ++j) wexp[dst0 + (lane >> 3) + 8 * j] = (signed char)qex[j]; }
#pragma unroll
    for (int j = 0; j < 4; ++j)
#pragma unroll
        for (int bb = 0; bb < 2; ++bb) { float v = dacc[j][bb]; v += dppf<0xB1>(v); v += dppf<0x4E>(v); v += dppf<0x141>(v);
            if (c == 0) { const int n = (lane >> 3) + 8 * j; if (kh == 0 && extra) v += extra[n0 + n];
                __hip_atomic_fetch_add(bias + (size_t)bb * bias_bstride + dst0 + n, v, __ATOMIC_RELAXED, __HIP_MEMORY_SCOPE_AGENT); } }
}

#undef INW_VECS
__device__ __forceinline__ void phase_p0(LAS unsigned char* lds, int vcu, int G, int wave_in) {
    int tid = lane_id(); asm volatile("" : "+v"(tid)); tid += 64 * wave_in;
    const int lane = tid & 63, wave = __builtin_amdgcn_readfirstlane(tid >> 6);
    LAS float* cs = (LAS float*)lds;
    LAS float* red = (LAS float*)(lds + 8192);
    LAS float* scr = (LAS float*)(lds + 16384 + wave * 8704);
    unsigned char* const ws = PWS;
    float* MOD = (float*)(ws + WS_MOD);
    { const float* cin = PIN(1); for (int i = tid; i < 2048; i += 512) { const float v = cin[i]; cs[i] = v / (1.0f + expf(-v)); } }
    { float* bz = (float*)(ws + WS_BFFN); for (int i = vcu * 512 + tid; i < (192 + 32 + 16) * 256; i += G * 512) bz[i] = 0.f; }
    __syncthreads();
    for (int it = blockIdx.x; it < 288; it += G) {
        const int li = it / 144, cg = it % 144;
        const float* W = PIN(3) + (size_t)li * 1024 * 9216 + cg * 64 + lane; const float* adab = PIN(4);
        float a0 = 0.f, a1 = 0.f;
#pragma unroll 64
        for (int k = wave * 128; k < wave * 128 + 128; ++k) { const float w = W[(size_t)k * 9216]; a0 += cs[k] * w; a1 += cs[1024 + k] * w; }
        red[(wave * 2 + 0) * 64 + lane] = a0; red[(wave * 2 + 1) * 64 + lane] = a1;
        __syncthreads();
        if (tid < 128) { const int b = tid >> 6, l = tid & 63; float s = 0.f;
#pragma unroll
            for (int w = 0; w < 8; ++w) s += red[(w * 2 + b) * 64 + l];
            MOD[(size_t)(li * 2 + b) * 9216 + cg * 64 + l] = s + adab[li * 9216 + cg * 64 + l]; }
        __syncthreads();
    }
    const int gw = vcu * 8 + wave, NGW = G * 8;
    bf16* WOUT = (bf16*)(ws + WS_WOUT); bf16* WO = (bf16*)(ws + WS_WO); bf16* WPW2 = (bf16*)(ws + WS_WPW2);
    constexpr int I_OUT = 44 * 32, I_O = 16 * 32, I_PW2 = 16 * 32;
    constexpr int NITEMS = 4 * I_OUT + I_O + I_PW2;
    {
        const float* w6 = PIN(6); const float* w10 = PIN(10); const float* w17 = PIN(17);
#define OUTW_DECODE(it_, W_, K_, WT_, k0_, n0_) do { int r_ = (it_); \
            if (r_ < 4 * I_OUT) { const int f_ = r_ / I_OUT; r_ %= I_OUT; W_ = w6 + (size_t)f_ * 2816 * 1024; K_ = 2816; WT_ = WOUT + (size_t)f_ * 1024 * 2816; } \
            else if (r_ < 4 * I_OUT + I_O) { r_ -= 4 * I_OUT; W_ = w10; K_ = 1024; WT_ = WO; } \
            else { r_ -= 4 * I_OUT + I_O; W_ = w17; K_ = 1024; WT_ = WPW2; } \
            k0_ = 64 * (r_ / 32); n0_ = 32 * (r_ % 32); } while (0)
        float w[32]; const float* Wc; int Kc, k0c, n0c; bf16* WTc;
        if (gw < NITEMS) { OUTW_DECODE(gw, Wc, Kc, WTc, k0c, n0c); tile_load(w, Wc, 1024, k0c, n0c, lane); }
        for (int it = gw; it < NITEMS; it += NGW) {
            tile_to_lds(w, scr, lane);
            const float* Wn = Wc; int Kn = Kc, k0n = k0c, n0n = n0c; bf16* WTn = WTc;
            if (it + NGW < NITEMS) { OUTW_DECODE(it + NGW, Wn, Kn, WTn, k0n, n0n); tile_load(w, Wn, 1024, k0n, n0n, lane); }
            transpose_finish(Kc, WTc, k0c, n0c, scr, lane);
            Wc = Wn; Kc = Kn; k0c = k0n; n0c = n0n; WTc = WTn;
        }
#undef OUTW_DECODE
    }
    if (I8MASK) {
        const float* w5 = PIN(5); unsigned* CM = (unsigned*)(ws + WS_CMAX);
        for (int it = gw; it < 4 * 352; it += NGW) {
            const int f = it / 352, r = it % 352, seg = r % 22, rb = r / 22;
            if (!((I8MASK >> f) & 1)) continue;
            const float* p = w5 + (size_t)f * 1024 * 5632 + (size_t)(64 * rb) * 5632 + 256 * seg + 4 * lane;
            float m0 = 0.f, m1 = 0.f, m2 = 0.f, m3 = 0.f;
#pragma unroll 16
            for (int k = 0; k < 64; ++k) { const f32x4 v = *(const f32x4*)(p + (size_t)k * 5632); m0 = fmaxf(m0, fabsf(v.x)); m1 = fmaxf(m1, fabsf(v.y)); m2 = fmaxf(m2, fabsf(v.z)); m3 = fmaxf(m3, fabsf(v.w)); }
            unsigned* d = CM + f * 5632 + 256 * seg + 4 * lane;
            __hip_atomic_fetch_max(d + 0, f2u(m0), __ATOMIC_RELAXED, __HIP_MEMORY_SCOPE_AGENT); __hip_atomic_fetch_max(d + 1, f2u(m1), __ATOMIC_RELAXED, __HIP_MEMORY_SCOPE_AGENT);
            __hip_atomic_fetch_max(d + 2, f2u(m2), __ATOMIC_RELAXED, __HIP_MEMORY_SCOPE_AGENT); __hip_atomic_fetch_max(d + 3, f2u(m3), __ATOMIC_RELAXED, __HIP_MEMORY_SCOPE_AGENT);
        }
    }
    const float* x = PIN(0); bf16* XB = (bf16*)(ws + WS_XB); float* SSQ = (float*)(ws + WS_SSQ);
    {
        f32x4 v[2][4], vn[2][4];
#define XROWS_LOAD(dst, r0_) do { _Pragma("unroll") for (int r = 0; r < 2; ++r) _Pragma("unroll") for (int jj = 0; jj < 4; ++jj) \
            dst[r][jj] = ((r0_) + r * NGW < M_) ? *(const f32x4*)(x + (size_t)((r0_) + r * NGW) * D_ + 4 * lane + 256 * jj) : (f32x4){0.f, 0.f, 0.f, 0.f}; } while (0)
        XROWS_LOAD(vn, gw);
        for (int row0 = gw; row0 < M_; row0 += 2 * NGW) {
#pragma unroll
            for (int r = 0; r < 2; ++r)
#pragma unroll
                for (int jj = 0; jj < 4; ++jj) v[r][jj] = vn[r][jj];
            if (row0 + 2 * NGW < M_) XROWS_LOAD(vn, row0 + 2 * NGW);
#pragma unroll
            for (int r = 0; r < 2; ++r) { const int row = row0 + r * NGW; if (row >= M_) break; float ss = 0.f;
#pragma unroll
                for (int jj = 0; jj < 4; ++jj) { const int c = 4 * lane + 256 * jj; const f32x4 t = v[r][jj];
                    ss += (t[0] * t[0] + t[1] * t[1]) + (t[2] * t[2] + t[3] * t[3]);
                    u32x2 w; w.x = cvtpk(t[0], t[1]); w.y = cvtpk(t[2], t[3]);
                    *(u32x2*)(XB + (size_t)row * D_ + c) = w; }
                ss = wave_sum(ss);
                if (lane < 4) *(f32x4*)(SSQ + (size_t)row * 16 + 4 * lane) = (f32x4){lane == 0 ? ss : 0.f, 0.f, 0.f, 0.f}; }
        }
#undef XROWS_LOAD
    }
}

__device__ __forceinline__ void phase_p1(LAS unsigned char* lds, int vcu, int G, int wave_in) {
    int tid = lane_id(); asm volatile("" : "+v"(tid)); tid += 64 * wave_in;
    const int lane = tid & 63, wave = __builtin_amdgcn_readfirstlane(tid >> 6);
    LAS float* scr = (LAS float*)(lds + 16384 + wave * 8704);
    unsigned char* const ws = PWS; const float* ng = PIN(2);
    const float* MOD = (const float*)(ws + WS_MOD);
    float* COEF = (float*)(ws + WS_COEF);
    for (int i = vcu * 512 + tid; i < 6 * 2 * 1024; i += G * 512) {
        const int sl = i >> 11, b = (i >> 10) & 1, d = i & 1023, li = sl / 3, j = sl % 3;
        const float* mod = MOD + (size_t)(li * 2 + b) * 9216 + j * 3 * 1024;
        COEF[i] = ((j == 1) ? 1.0f : 0.5f) * mod[2048 + d];
    }
    const int gw = vcu * 8 + wave, NGW = G * 8;
    constexpr int I_IN = 176 * 2, I_QKV = 96 * 2, I_PW1 = 64 * 2;
    for (int it = gw; it < 4 * I_IN + I_QKV + I_PW1; it += NGW) {
        int r = it;
        if (r < 4 * I_IN) { const int f = r / I_IN; r %= I_IN; const int kh = (r >> 3) & 1, n0 = 32 * ((r >> 4) * 8 + (r & 7)), sl = (f >> 1) * 3 + (f & 1) * 2;
            inweight_item(PIN(5) + (size_t)f * 1024 * 5632, 5632, (bf16*)(ws + WS_WIN) + (size_t)f * 2 * 5632 * 1024, (size_t)5632 * 1024, kh, n0, gated_dst(n0, FF_),
                          ng + sl * 1024, MOD + (size_t)((sl / 3) * 2) * 9216 + (sl % 3) * 3 * 1024, (float*)(ws + WS_BFFN) + (size_t)f * 2 * 5632, 5632, nullptr, scr, lane, (I8MASK >> f) & 1, (const unsigned*)(ws + WS_CMAX) + f * 5632, (signed char*)(ws + WS_WEXP) + f * 5632); continue; }
        r -= 4 * I_IN;
        if (r < I_QKV) { const int kh = (r >> 3) & 1, n0 = 32 * ((r >> 4) * 8 + (r & 7)); const int part = n0 >> 10, head = (n0 & 1023) >> 6, e0 = n0 & 63;
            const int dst0 = 256 * (part * 4 + (head >> 2)) + 128 * (e0 >> 5) + 32 * (head & 3);
            inweight_item(PIN(7), 3072, (bf16*)(ws + WS_WQKV), (size_t)3072 * 1024, kh, n0, dst0, ng + 1 * 1024, MOD + 1 * 3 * 1024, (float*)(ws + WS_BQKV), 3072, nullptr, scr, lane); continue; }
        r -= I_QKV;
        { const int kh = (r >> 3) & 1, n0 = 32 * ((r >> 4) * 8 + (r & 7));
            inweight_item(PIN(11), 2048, (bf16*)(ws + WS_WPW1), (size_t)2048 * 1024, kh, n0, gated_dst(n0, 1024), ng + 4 * 1024, MOD + (size_t)2 * 9216 + 1 * 3 * 1024, (float*)(ws + WS_BPW1), 2048, PIN(12), scr, lane); }
    }
}

typedef float f32x2 __attribute__((ext_vector_type(2)));
__device__ __forceinline__ f32x2 bfpair(unsigned v) { return (f32x2){bflo(v), bfhi(v)}; }
__device__ __forceinline__ void conv_phase(LAS unsigned char* lds, int vcu, int G, int wave_in) {
    int tid = lane_id(); asm volatile("" : "+v"(tid)); tid += 64 * wave_in;
    const int lane = tid & 63, wave = __builtin_amdgcn_readfirstlane(tid >> 6), c0 = 2 * tid;
    LAS float* part = (LAS float*)lds;
    unsigned char* const ws = PWS;
    const bf16* U = (const bf16*)(ws + WS_U); bf16* CV = (bf16*)(ws + WS_CV);
    f32x2 w[31];
    { const float* wdw = PIN(13);
#pragma unroll
    for (int j = 0; j < 31; ++j) w[j] = *(const f32x2*)(wdw + j * D_ + c0); }
    f32x2 bd, lg, lb;
    { const float* p = PIN(14); bd = *(const f32x2*)(p + c0); p = PIN(15); lg = *(const f32x2*)(p + c0); p = PIN(16); lb = *(const f32x2*)(p + c0); }
    for (int un = vcu; un < 256; un += G) {
        const int b = un >> 7, t0 = (un & 127) * 128;
        const unsigned* Up = (const unsigned*)(U + (size_t)b * S_ * D_ + c0);
        unsigned* Op = (unsigned*)(CV + (size_t)b * S_ * D_ + c0);
        f32x2 hist[38];
        unsigned nx0[8], nx1[8];
#pragma unroll
        for (int i = 0; i < 8; ++i) { nx0[i] = Up[(size_t)(t0 + i) * 512]; nx1[i] = Up[(size_t)(t0 + 8 + i) * 512]; }
#pragma unroll
        for (int i = 0; i < 30; ++i) { const int tt = t0 - 30 + i; const unsigned v = (tt >= 0) ? Up[(size_t)tt * 512] : 0u; hist[i] = bfpair(v); }
        int pb = 0;
#pragma unroll 1
        for (int st = 0; st < 16; ++st) {
#pragma unroll
            for (int i = 0; i < 8; ++i) { hist[30 + i] = bfpair(nx0[i]); nx0[i] = nx1[i]; }
            if (st < 14) {
#pragma unroll
                for (int i = 0; i < 8; ++i) nx1[i] = Up[(size_t)(t0 + (st + 2) * 8 + i) * 512];
            }
            f32x2 y[8]; float stat[16];
#pragma unroll
            for (int tt = 0; tt < 8; ++tt) { f32x2 a = bd;
#pragma unroll
                for (int j = 0; j < 31; ++j) a += w[j] * hist[tt + j];
                y[tt] = a; stat[2 * tt] = a.x + a.y; stat[2 * tt + 1] = a.x * a.x + a.y * a.y; }
            float s1[8], s2[4];
#pragma unroll
            for (int k = 0; k < 8; ++k) { const auto r = __builtin_amdgcn_permlane32_swap(f2u(stat[k]), f2u(stat[k + 8]), false, false); const unsigned r0 = r[0], r1 = r[1]; s1[k] = u2f(r0) + u2f(r1); }
#pragma unroll
            for (int k = 0; k < 4; ++k) { const auto r = __builtin_amdgcn_permlane16_swap(f2u(s1[k]), f2u(s1[k + 4]), false, false); const unsigned r0 = r[0], r1 = r[1]; s2[k] = row_sum16(u2f(r0) + u2f(r1)); }
            if ((lane & 15) == 0) *(LAS f32x4*)(part + (pb * 8 + wave) * 16 + 4 * (lane >> 4)) = (f32x4){s2[0], s2[1], s2[2], s2[3]};
            LDS_BARRIER();
            f32x4 tot[4];
#pragma unroll
            for (int k = 0; k < 4; ++k) { tot[k] = (f32x4){0.f, 0.f, 0.f, 0.f};
#pragma unroll
                for (int ww = 0; ww < 8; ++ww) tot[k] += *(const LAS f32x4*)(part + (pb * 8 + ww) * 16 + 4 * k); }
#pragma unroll
            for (int tt = 0; tt < 8; ++tt) {
                const float sum = tot[tt >> 1][(tt & 1) * 2], sq = tot[tt >> 1][(tt & 1) * 2 + 1];
                const float mean = sum * (1.0f / D_), var = sq * (1.0f / D_) - mean * mean, rstd = __builtin_amdgcn_rsqf(var + EPS_);
                const f32x2 z = (y[tt] - mean) * rstd * lg + lb;
                const f32x2 e = z * (-LOG2E_);
                f32x2 d; d.x = __builtin_amdgcn_exp2f(e.x); d.y = __builtin_amdgcn_exp2f(e.y); d = d + 1.0f;
                f32x2 r; r.x = __builtin_amdgcn_rcpf(d.x); r.y = __builtin_amdgcn_rcpf(d.y);
                const f32x2 o = z * r;
                Op[(size_t)(t0 + st * 8 + tt) * 512] = cvtpk(o.x, o.y);
            }
#pragma unroll
            for (int i = 0; i < 30; ++i) hist[i] = hist[i + 8];
            pb ^= 1;
        }
    }
}
constexpr int CW_Q2 = 8192;
constexpr int A_KS = 0, A_VT = 36864, A_LIST = 70656, A_MISC = 103424;
__device__ __forceinline__ float attn_m0(const float* gq, const float* gk, int lane) {
    float a = fabsf(gq[lane]), b = fabsf(gk[lane]); a = wave_max(a); b = wave_max(b);
    return 8.0f * LOG2E_ * a * b * 1.02f + 0.25f;
}
__device__ __forceinline__ void stage_kv_load(u32x4 (&kk)[4], u32x4 (&vv)[4], const bf16* K, const bf16* V, size_t rowbase, int h, int tid) {
    const int r = tid >> 1, hf = tid & 1;
    const bf16* kp = K + (rowbase + r) * D_ + h * 64 + 32 * hf;
#pragma unroll
    for (int c = 0; c < 4; ++c) kk[c] = *(const u32x4*)(kp + 8 * c);
    const int p = tid >> 2, dq = tid & 3;
    const bf16* vp = V + (rowbase + 2 * p) * D_ + h * 64 + 16 * dq;
    vv[0] = *(const u32x4*)(vp); vv[1] = *(const u32x4*)(vp + 8); vv[2] = *(const u32x4*)(vp + D_); vv[3] = *(const u32x4*)(vp + D_ + 8);
}
__device__ __forceinline__ void stage_kv_store(LAS unsigned char* lds, const u32x4 (&kk)[4], const u32x4 (&vv)[4], int tid) {
    const int r = tid >> 1, hf = tid & 1;
#pragma unroll
    for (int c = 0; c < 4; ++c) *(LAS u32x4*)(lds + A_KS + r * 144 + (32 * hf + 8 * c) * 2) = kk[c];
    const int p = tid >> 2, dq = tid & 3;
    LAS unsigned* vt = (LAS unsigned*)(lds + A_VT) + p;
#pragma unroll
    for (int c = 0; c < 2; ++c)
#pragma unroll
        for (int e = 0; e < 4; ++e) { const unsigned a = (e == 0) ? vv[c].x : (e == 1) ? vv[c].y : (e == 2) ? vv[c].z : vv[c].w;
            const unsigned bb = (e == 0) ? vv[2 + c].x : (e == 1) ? vv[2 + c].y : (e == 2) ? vv[2 + c].z : vv[2 + c].w;
            const int d = 16 * dq + 8 * c + 2 * e;
            vt[d * 132] = (a & 0xffffu) | (bb << 16); vt[(d + 1) * 132] = (a >> 16) | (bb & 0xffff0000u); }
}
__device__ __forceinline__ void stage_kv(LAS unsigned char* lds, const bf16* K, const bf16* V, size_t rowbase, int h, int tid) {
    u32x4 kk[4], vv[4]; stage_kv_load(kk, vv, K, V, rowbase, h, tid); stage_kv_store(lds, kk, vv, tid);
}
__device__ __forceinline__ int alibi_dmax(float slope2, float M0) { return (int)fminf((2.0f * M0 + 40.0f) / slope2, 1.0e9f); }
template <bool MASK> __device__ __forceinline__ void attn_tile(LAS unsigned char* lds, int s8, const bf16x8 (&qf)[4], float rowc, float slope2, int lane, f32x16& o0, f32x16& o1, float& lsum, int maskq) {
    const int i = lane & 31, hi = lane >> 5;
    const int prow = (i & ~12) | ((i & 4) << 1) | ((i & 8) >> 1);
    const LAS unsigned char* kp = lds + A_KS + (32 * s8 + prow) * 144 + 16 * hi;
    const float cb = rowc + slope2 * (float)(32 * s8 + 8 * hi);
    f32x16 c;
#pragma unroll
    for (int r = 0; r < 16; ++r) c[r] = cb + slope2 * (float)(16 * (r >> 3) + (r & 7));
#pragma unroll
    for (int d0 = 0; d0 < 4; ++d0) { const bf16x8 kf = *(const LAS bf16x8*)(kp + 32 * d0); c = __builtin_amdgcn_mfma_f32_32x32x16_bf16(kf, qf[d0], c, 0, 0, 0); }
    if (MASK) {
#pragma unroll
        for (int r = 0; r < 16; ++r) if (16 * (r >> 3) + 8 * hi + (r & 7) > maskq) c[r] = -INFINITY;
    }
    float ls = 0.f;
#pragma unroll
    for (int r = 0; r < 16; ++r) { c[r] = __builtin_amdgcn_exp2f(c[r]); ls += c[r]; }
    lsum += ls;
    u32x4 p0, p1;
    p0.x = cvtpk(c[0], c[1]); p0.y = cvtpk(c[2], c[3]); p0.z = cvtpk(c[4], c[5]); p0.w = cvtpk(c[6], c[7]);
    p1.x = cvtpk(c[8], c[9]); p1.y = cvtpk(c[10], c[11]); p1.z = cvtpk(c[12], c[13]); p1.w = cvtpk(c[14], c[15]);
    const bf16x8 pf0 = __builtin_bit_cast(bf16x8, p0), pf1 = __builtin_bit_cast(bf16x8, p1);
    const LAS unsigned char* vp = lds + A_VT + (i * 264 + 32 * s8 + 8 * hi) * 2;
    { const bf16x8 v00 = *(const LAS bf16x8*)(vp), v01 = *(const LAS bf16x8*)(vp + 32), v10 = *(const LAS bf16x8*)(vp + 32 * 528), v11 = *(const LAS bf16x8*)(vp + 32 * 528 + 32);
      o0 = __builtin_amdgcn_mfma_f32_32x32x16_bf16(v00, pf0, o0, 0, 0, 0); o1 = __builtin_amdgcn_mfma_f32_32x32x16_bf16(v10, pf0, o1, 0, 0, 0);
      o0 = __builtin_amdgcn_mfma_f32_32x32x16_bf16(v01, pf1, o0, 0, 0, 0); o1 = __builtin_amdgcn_mfma_f32_32x32x16_bf16(v11, pf1, o1, 0, 0, 0); }
}
__device__ __forceinline__ bf16* op_ptr(unsigned char* ws, float* out, int rank) { return (rank == 2) ? (bf16*)(ws + WS_OP3) : (bf16*)out + (size_t)rank * ((size_t)M_ * D_); }

struct A2Item { int n, bh, b, h, tbeg, tlim, dmax; float slope2; };
__device__ __forceinline__ A2Item a2_decode(int item, float M0) {
    A2Item I; I.n = item >> 5; I.bh = item & 31; I.b = I.bh >> 4; I.h = I.bh & 15;
    I.slope2 = exp2f(-0.5f * (float)(I.h + 1)) * LOG2E_; I.dmax = alibi_dmax(I.slope2, M0);
    I.tbeg = (I.n + 1) * 256; I.tlim = min(S_, 256 * I.n + 256 + I.dmax); return I;
}
__device__ __forceinline__ void a2_load(const A2Item& I, u32x4 (&kk)[4], u32x4 (&vv)[4], u32x4 (&sv)[8], const bf16* K, const bf16* V, const unsigned* sel, int tid) {
    stage_kv_load(kk, vv, K, V, (size_t)I.b * S_ + 256 * I.n, I.h, tid);
    const unsigned* sp = sel + (size_t)I.bh * S_;
#pragma unroll
    for (int c = 0; c < 8; ++c) { const int t0 = I.tbeg + 2048 * c + 4 * tid;
        sv[c] = (u32x4){0xFFFFFFFFu, 0xFFFFFFFFu, 0xFFFFFFFFu, 0xFFFFFFFFu};
        if (I.tbeg + 2048 * c < I.tlim) { if (t0 < S_) sv[c] = *(const u32x4*)(sp + t0); } }
}
__device__ __forceinline__ void a2_phase(LAS unsigned char* lds, int wave_in, int qword) {
    int tid = lane_id(); asm volatile("" : "+v"(tid)); tid += 64 * wave_in;
    const int lane = tid & 63, wave = __builtin_amdgcn_readfirstlane(tid >> 6), q = lane & 31, hi = lane >> 5;
    unsigned char* const ws = PWS;
    const bf16* Q = (const bf16*)(ws + WS_Q); const bf16* K = (const bf16*)(ws + WS_K); const bf16* V = (const bf16*)(ws + WS_V);
    const unsigned* sel = (const unsigned*)(ws + WS_SEL); unsigned* ctl = (unsigned*)(ws + WS_CTL); float* LP = (float*)(ws + WS_LP); float* const outp = POUT;
    const float M0 = attn_m0(PIN(8), PIN(9), lane);
    LAS unsigned short* list = (LAS unsigned short*)(lds + A_LIST); volatile LAS int* misc = (volatile LAS int*)(lds + A_MISC);
    constexpr int NIT = 63 * 32;
    int t_cur = 0, t_nxt = 0;
    if (tid == 0) { t_cur = (int)__hip_atomic_fetch_add(ctl + qword, 1u, __ATOMIC_RELAXED, __HIP_MEMORY_SCOPE_AGENT); t_nxt = (int)__hip_atomic_fetch_add(ctl + qword, 1u, __ATOMIC_RELAXED, __HIP_MEMORY_SCOPE_AGENT); }
    LDS_BARRIER();
    if (tid == 0) { misc[0] = t_cur; misc[2] = t_nxt; misc[1] = 0; }
    LDS_BARRIER();
    int item = __builtin_amdgcn_readfirstlane(misc[0]), item_n = __builtin_amdgcn_readfirstlane(misc[2]);
    u32x4 kk[4], vv[4], sv[8];
    if (item < NIT) { const A2Item I0 = a2_decode(item, M0); a2_load(I0, kk, vv, sv, K, V, sel, tid); }
    while (item < NIT) {
        const A2Item I = a2_decode(item, M0);
        const int n = I.n, b = I.b, h = I.h, dmax = I.dmax; const float slope2 = I.slope2;
        int t_nn = 0;
        if (tid == 0) t_nn = (int)__hip_atomic_fetch_add(ctl + qword, 1u, __ATOMIC_RELAXED, __HIP_MEMORY_SCOPE_AGENT);
        stage_kv_store(lds, kk, vv, tid);
#pragma unroll
        for (int c = 0; c < 8; ++c) {
            if (I.tbeg + 2048 * c < I.tlim) {
#pragma unroll
                for (int e = 0; e < 4; ++e) {
                    const unsigned s = (e == 0) ? sv[c].x : (e == 1) ? sv[c].y : (e == 2) ? sv[c].z : sv[c].w;
                    const int t = I.tbeg + 2048 * c + 4 * tid + e;
                    int rank = ((s & 255u) == (unsigned)n) ? 0 : (((s >> 8) & 255u) == (unsigned)n) ? 1 : (((s >> 16) & 255u) == (unsigned)n) ? 2 : -1;
                    if (t - 256 * n - 255 > dmax) rank = -1;
                    const unsigned long long bal = __ballot(rank >= 0);
                    if (bal) {
                        const int pre = __builtin_amdgcn_mbcnt_hi((unsigned)(bal >> 32), __builtin_amdgcn_mbcnt_lo((unsigned)bal, 0u));
                        int base = 0;
                        if (lane == 0) base = __hip_atomic_fetch_add((LAS int*)(lds + A_MISC) + 1, __popcll(bal), __ATOMIC_RELAXED, __HIP_MEMORY_SCOPE_WORKGROUP);
                        base = __builtin_amdgcn_readfirstlane(base);
                        if (rank >= 0) list[base + pre] = (unsigned short)(t | (rank << 14));
                    }
                }
            }
        }
        if (item_n < NIT) { const A2Item In = a2_decode(item_n, M0); a2_load(In, kk, vv, sv, K, V, sel, tid); }
        LDS_BARRIER();
        const int total = __builtin_amdgcn_readfirstlane(misc[1]);
        const int nr = (total + 255) >> 8;
        bf16x8 qn[4]; unsigned en = 0u;
        if (32 * wave < total) { const int idx = 32 * wave + q; en = list[(idx < total) ? idx : 32 * wave];
            const size_t rown = (size_t)b * S_ + (en & 16383);
#pragma unroll
            for (int d0 = 0; d0 < 4; ++d0) qn[d0] = *(const bf16x8*)(Q + rown * D_ + h * 64 + 16 * d0 + 8 * hi); }
        for (int r = 0; r < nr; ++r) {
            const int i0 = 256 * r + 32 * wave;
            if (i0 < total) {
                const int idx = i0 + q; const bool valid = idx < total;
                const unsigned e = en;
                const int t = e & 16383, rank = e >> 14;
                const size_t row = (size_t)b * S_ + t;
                bf16x8 qf[4];
#pragma unroll
                for (int d0 = 0; d0 < 4; ++d0) qf[d0] = qn[d0];
                if (i0 + 256 < total) { const int idx2 = idx + 256; en = list[(idx2 < total) ? idx2 : i0 + 256];
                    const size_t rown = (size_t)b * S_ + (en & 16383);
#pragma unroll
                    for (int d0 = 0; d0 < 4; ++d0) qn[d0] = *(const bf16x8*)(Q + rown * D_ + h * 64 + 16 * d0 + 8 * hi); }
                const float rowc = -slope2 * (float)(t - 256 * n) - M0;
                f32x16 o0, o1; float lsum = 0.f;
#pragma unroll
                for (int k = 0; k < 16; ++k) { o0[k] = 0.f; o1[k] = 0.f; }
#pragma unroll 2
                for (int s8 = 0; s8 < 8; ++s8) attn_tile<false>(lds, s8, qf, rowc, slope2, lane, o0, o1, lsum, 0);
                lsum = sum32(lsum);
                if (valid) {
                    bf16* op = op_ptr(ws, outp, rank) + row * D_ + h * 64 + 4 * hi;
#pragma unroll
                    for (int g = 0; g < 4; ++g) {
                        u32x2 w0, w1; w0.x = cvtpk(o0[4 * g], o0[4 * g + 1]); w0.y = cvtpk(o0[4 * g + 2], o0[4 * g + 3]);
                        w1.x = cvtpk(o1[4 * g], o1[4 * g + 1]); w1.y = cvtpk(o1[4 * g + 2], o1[4 * g + 3]);
                        *(u32x2*)(op + 8 * g) = w0; *(u32x2*)(op + 32 + 8 * g) = w1; }
                    if (hi == 0) LP[((size_t)rank * M_ + row) * 16 + h] = lsum;
                }
            }
        }
        LDS_BARRIER();
        if (tid == 0) { misc[0] = item_n; misc[2] = t_nn; misc[1] = 0; }
        LDS_BARRIER();
        item = __builtin_amdgcn_readfirstlane(misc[0]); item_n = __builtin_amdgcn_readfirstlane(misc[2]);
    }
}

__device__ __forceinline__ void a3_phase(LAS unsigned char* lds, int vcu, int G, int wave_in) {
    int tid = lane_id(); asm volatile("" : "+v"(tid)); tid += 64 * wave_in;
    const int lane = tid & 63, wave = __builtin_amdgcn_readfirstlane(tid >> 6), q = lane & 31, hi = lane >> 5;
    unsigned char* const ws = PWS;
    bf16* Q = (bf16*)(ws + WS_Q); const bf16* K = (const bf16*)(ws + WS_K); const bf16* V = (const bf16*)(ws + WS_V);
    const unsigned* sel = (const unsigned*)(ws + WS_SEL); const float* LP = (const float*)(ws + WS_LP); float* const outp = POUT;
    const float M0 = attn_m0(PIN(8), PIN(9), lane);
    u32x4 kk[4], vv[4];
    if (vcu < 2048) { const int bh = vcu >> 6, m = vcu & 63; stage_kv_load(kk, vv, K, V, (size_t)(bh >> 4) * S_ + 256 * m, bh & 15, tid); }
    for (int un = vcu; un < 2048; un += G) {
        const int bh = un >> 6, m = un & 63, b = bh >> 4, h = bh & 15;
        const float slope2 = exp2f(-0.5f * (float)(h + 1)) * LOG2E_;
        LDS_BARRIER();
        stage_kv_store(lds, kk, vv, tid);
        { const int un2 = un + G; if (un2 < 2048) { const int bh2 = un2 >> 6, m2 = un2 & 63; stage_kv_load(kk, vv, K, V, (size_t)(bh2 >> 4) * S_ + 256 * m2, bh2 & 15, tid); } }
        const int t = 256 * m + 32 * wave + q; const size_t row = (size_t)b * S_ + t;
        bf16x8 qf[4];
#pragma unroll
        for (int d0 = 0; d0 < 4; ++d0) qf[d0] = *(const bf16x8*)(Q + row * D_ + h * 64 + 16 * d0 + 8 * hi);
        const unsigned s = sel[(size_t)bh * S_ + t];
        float lp[3]; u32x2 pw[3][8];
#pragma unroll
        for (int rank = 0; rank < 3; ++rank) {
            lp[rank] = LP[((size_t)rank * M_ + row) * 16 + h];
            const bf16* op = op_ptr(ws, outp, rank) + row * D_ + h * 64 + 4 * hi;
#pragma unroll
            for (int g = 0; g < 4; ++g) { pw[rank][g] = *(const u32x2*)(op + 8 * g); pw[rank][4 + g] = *(const u32x2*)(op + 32 + 8 * g); }
        }
        LDS_BARRIER();
        const float rowc = -slope2 * (float)(32 * wave + q) - M0;
        f32x16 o0, o1; float lsum = 0.f;
#pragma unroll
        for (int k = 0; k < 16; ++k) { o0[k] = 0.f; o1[k] = 0.f; }
        for (int s8 = 0; s8 < wave; ++s8) attn_tile<false>(lds, s8, qf, rowc, slope2, lane, o0, o1, lsum, 0);
        attn_tile<true>(lds, wave, qf, rowc, slope2, lane, o0, o1, lsum, q);
        float l = sum32(lsum);
        const int dmax = alibi_dmax(slope2, M0);
#pragma unroll
        for (int rank = 0; rank < 3; ++rank) {
            const int nb = (int)((s >> (8 * rank)) & 255u);
            if (nb != 255 && (t - 256 * nb - 255) <= dmax) {
                l += lp[rank];
#pragma unroll
                for (int g = 0; g < 4; ++g) { const u32x2 w0 = pw[rank][g], w1 = pw[rank][4 + g];
                    o0[4 * g] += bflo(w0.x); o0[4 * g + 1] += bfhi(w0.x); o0[4 * g + 2] += bflo(w0.y); o0[4 * g + 3] += bfhi(w0.y);
                    o1[4 * g] += bflo(w1.x); o1[4 * g + 1] += bfhi(w1.x); o1[4 * g + 2] += bflo(w1.y); o1[4 * g + 3] += bfhi(w1.y); }
            }
        }
        const float inv = 1.0f / l;
        bf16* op = Q + row * D_ + h * 64 + 4 * hi;
#pragma unroll
        for (int g = 0; g < 4; ++g) {
            u32x2 w0, w1; w0.x = cvtpk(o0[4 * g] * inv, o0[4 * g + 1] * inv); w0.y = cvtpk(o0[4 * g + 2] * inv, o0[4 * g + 3] * inv);
            w1.x = cvtpk(o1[4 * g] * inv, o1[4 * g + 1] * inv); w1.y = cvtpk(o1[4 * g + 2] * inv, o1[4 * g + 3] * inv);
            *(u32x2*)(op + 8 * g) = w0; *(u32x2*)(op + 32 + 8 * g) = w1; }
    }
}

constexpr int A1_KH = 0, A1_KL = 9216;
__device__ __forceinline__ void top3_ins(float v, int n, float& v0, float& v1, float& v2, int& i0, int& i1, int& i2) {
    const bool c0 = v > v0, c1 = v > v1, c2 = v > v2;
    v2 = c1 ? v1 : (c2 ? v : v2); i2 = c1 ? i1 : (c2 ? n : i2);
    v1 = c0 ? v0 : (c1 ? v : v1); i1 = c0 ? i0 : (c1 ? n : i1);
    v0 = c0 ? v : v0;             i0 = c0 ? n : i0;
}
__device__ __forceinline__ void a1_phase(LAS unsigned char* lds, int vcu, int G, int wave_in) {
    int tid = lane_id(); asm volatile("" : "+v"(tid)); tid += 64 * wave_in;
    const int lane = tid & 63, wave = __builtin_amdgcn_readfirstlane(tid >> 6), q = lane & 31, hi = lane >> 5;
    unsigned char* const ws = PWS;
    const bf16* Q = (const bf16*)(ws + WS_Q); const float* kbarp = (const float*)(ws + WS_KBAR); unsigned* sel = (unsigned*)(ws + WS_SEL);
    for (int un = vcu; un < 256; un += G) {
        const int bh = un >> 3, mg = un & 7, b = bh >> 4, h = bh & 15;
        LDS_BARRIER();
        { const int n = tid >> 3, d0 = (tid & 7) * 8;
          const float* p = kbarp + ((size_t)bh * 64 + n) * 128 + d0;
          const f32x4 a0 = *(const f32x4*)p, a1 = *(const f32x4*)(p + 4), b0 = *(const f32x4*)(p + 64), b1 = *(const f32x4*)(p + 68);
          const f32x4 v0 = (a0 + b0) * (1.0f / 256.0f), v1 = (a1 + b1) * (1.0f / 256.0f);
          unsigned hb[8], lb[8];
#pragma unroll
          for (int e = 0; e < 8; ++e) { const float v = (e < 4) ? v0[e & 3] : v1[e & 3]; hb[e] = f2bf(v); lb[e] = f2bf(v - bf2f(hb[e])); }
          u32x4 wh, wl; wh.x = hb[0] | (hb[1] << 16); wh.y = hb[2] | (hb[3] << 16); wh.z = hb[4] | (hb[5] << 16); wh.w = hb[6] | (hb[7] << 16);
          wl.x = lb[0] | (lb[1] << 16); wl.y = lb[2] | (lb[3] << 16); wl.z = lb[4] | (lb[5] << 16); wl.w = lb[6] | (lb[7] << 16);
          *(LAS u32x4*)(lds + A1_KH + n * 144 + d0 * 2) = wh; *(LAS u32x4*)(lds + A1_KL + n * 144 + d0 * 2) = wl; }
        LDS_BARRIER();
        bf16x8 qn[4];
        { const size_t row0 = (size_t)b * S_ + 256 * (mg * 8) + 32 * wave + q;
#pragma unroll
          for (int d0 = 0; d0 < 4; ++d0) qn[d0] = *(const bf16x8*)(Q + row0 * D_ + h * 64 + 16 * d0 + 8 * hi); }
        for (int mi = 0; mi < 8; ++mi) {
            const int m = mg * 8 + mi, t = 256 * m + 32 * wave + q;
            bf16x8 qf[4];
#pragma unroll
            for (int d0 = 0; d0 < 4; ++d0) qf[d0] = qn[d0];
            if (mi < 7) { const size_t rown = (size_t)b * S_ + t + 256;
#pragma unroll
                for (int d0 = 0; d0 < 4; ++d0) qn[d0] = *(const bf16x8*)(Q + rown * D_ + h * 64 + 16 * d0 + 8 * hi); }
            if (m == 0) { if (hi == 0) sel[(size_t)bh * S_ + t] = 0x00FFFFFFu; continue; }
            f32x16 c0, c1;
#pragma unroll
            for (int k = 0; k < 16; ++k) { c0[k] = 0.f; c1[k] = 0.f; }
            const LAS unsigned char* kp = lds + q * 144 + 16 * hi;
#pragma unroll
            for (int d0 = 0; d0 < 4; ++d0) {
                const bf16x8 h0 = *(const LAS bf16x8*)(kp + A1_KH + 32 * d0), h1 = *(const LAS bf16x8*)(kp + A1_KH + 32 * 144 + 32 * d0);
                const bf16x8 l0 = *(const LAS bf16x8*)(kp + A1_KL + 32 * d0), l1 = *(const LAS bf16x8*)(kp + A1_KL + 32 * 144 + 32 * d0);
                c0 = __builtin_amdgcn_mfma_f32_32x32x16_bf16(h0, qf[d0], c0, 0, 0, 0); c1 = __builtin_amdgcn_mfma_f32_32x32x16_bf16(h1, qf[d0], c1, 0, 0, 0);
                c0 = __builtin_amdgcn_mfma_f32_32x32x16_bf16(l0, qf[d0], c0, 0, 0, 0); c1 = __builtin_amdgcn_mfma_f32_32x32x16_bf16(l1, qf[d0], c1, 0, 0, 0);
            }
            float v0 = -INFINITY, v1 = -INFINITY, v2 = -INFINITY; int i0 = 255, i1 = 255, i2 = 255;
#pragma unroll
            for (int r = 0; r < 16; ++r) { const int n = (r & 3) + 8 * (r >> 2) + 4 * hi; top3_ins((n < m) ? c0[r] : -INFINITY, n, v0, v1, v2, i0, i1, i2); }
#pragma unroll
            for (int r = 0; r < 16; ++r) { const int n = 32 + (r & 3) + 8 * (r >> 2) + 4 * hi; top3_ins((n < m) ? c1[r] : -INFINITY, n, v0, v1, v2, i0, i1, i2); }
            const float pv0 = __builtin_bit_cast(float, other32(__builtin_bit_cast(unsigned, v0), hi)), pv1 = __builtin_bit_cast(float, other32(__builtin_bit_cast(unsigned, v1), hi)), pv2 = __builtin_bit_cast(float, other32(__builtin_bit_cast(unsigned, v2), hi));
            const int pi0 = (int)other32((unsigned)i0, hi), pi1 = (int)other32((unsigned)i1, hi), pi2 = (int)other32((unsigned)i2, hi);
            top3_ins(pv0, pi0, v0, v1, v2, i0, i1, i2); top3_ins(pv1, pi1, v0, v1, v2, i0, i1, i2); top3_ins(pv2, pi2, v0, v1, v2, i0, i1, i2);
            if (hi == 0) sel[(size_t)bh * S_ + t] = (unsigned)i0 | ((unsigned)i1 << 8) | ((unsigned)i2 << 16);
        }
    }
}
#ifndef MK_MULTI
#define MK_MULTI 0
#endif
constexpr int NPH = 18;
struct Args { const float* in[19]; float* out; unsigned char* ws; int lo, hi; };
__global__ void __launch_bounds__(512, 2) fwd(Args a) {
    extern __shared__ __attribute__((aligned(16))) unsigned char lds_raw[];
    LAS unsigned char* lds = (LAS unsigned char*)lds_raw;
    const int tid = threadIdx.x, G = gridDim.x; const int wave = __builtin_amdgcn_readfirstlane(tid >> 6);
    const int vcu = (G % 8 == 0) ? ((int)blockIdx.x % 8) * (G / 8) + (int)blockIdx.x / 8 : (int)blockIdx.x;
    volatile LAS unsigned* MISC = (volatile LAS unsigned*)(lds + MISC_OFF);
    for (int u = tid; u < (LDS_BYTES - LDSCTL_OFF) / 4; u += 512) ((LAS unsigned*)(lds + LDSCTL_OFF))[u] = 0u;
    __syncthreads();
    if (tid == 0) {
        LAS unsigned long long* PT = (LAS unsigned long long*)(lds + PT_OFF);
#pragma unroll
        for (int i = 0; i < 19; ++i) PT[i] = (unsigned long long)a.in[i];
        PT[19] = (unsigned long long)a.out; PT[20] = (unsigned long long)a.ws;
        ((LAS int*)(lds + PT_OFF))[48] = a.lo; ((LAS int*)(lds + PT_OFF))[49] = a.hi;
    }
    __syncthreads();
    if (a.hi - a.lo > 1) (void)xcd_barrier_post((unsigned*)(a.ws + WS_CTL) + CW_BAR, MISC + 8);
#define LO (__builtin_amdgcn_readfirstlane(((volatile LAS int*)(lds + PT_OFF))[48]))
#define HI (__builtin_amdgcn_readfirstlane(((volatile LAS int*)(lds + PT_OFF))[49]))
#define IN(k) (LO <= (k) && (k) < HI)
#define SEAM(k) do { if (IN(k) && IN((k) + 1)) { XcdBarrier bar_; bar_.bar = (unsigned*)(PWS + WS_CTL) + CW_BAR; bar_.x = xb_xcc_id(); bar_.st = MISC + 8; xcd_barrier(bar_); } } while (0)

    if (IN(0)) { __syncthreads(); phase_p0(lds, vcu, G, wave); }
    SEAM(0);
    if (IN(1)) { __syncthreads(); phase_p1(lds, vcu, G, wave); }
    SEAM(1);

    int ph = 2;
#pragma unroll 1
    for (int sl = 0; sl < 6; ++sl) {
        if (sl == 1) {
            if (IN(ph)) { __syncthreads(); unsigned char* const ws = PWS;
                EpiQKV E{(bf16*)(ws + WS_Q), (const float*)(ws + WS_BQKV), (const float*)(ws + ((sl & 1) ? WS_SSQ1 : WS_SSQ)), PIN(8), PIN(9), (float*)(ws + WS_KBAR), lds};
                __syncthreads(); run_gemm(lds, (const bf16*)(ws + WS_XB), (const bf16*)(ws + WS_WQKV), 3072L * 1024 * 2, 3072, 1024, G, E, wave);
            }
            SEAM(ph); ++ph;
            if (IN(ph)) { __syncthreads(); a1_phase(lds, vcu, G, wave); }
            SEAM(ph); ++ph;
            if (IN(ph)) { __syncthreads(); a2_phase(lds, wave, CW_Q2); }
            SEAM(ph); ++ph;
            if (IN(ph)) { __syncthreads(); a3_phase(lds, vcu, G, wave); }
            SEAM(ph); ++ph;
        } else if (sl == 4) {
            if (IN(ph)) { __syncthreads(); unsigned char* const ws = PWS;
                EpiGated<1> E{(bf16*)(ws + WS_U), 1024, (const float*)(ws + WS_BPW1), 2048, (const float*)(ws + ((sl & 1) ? WS_SSQ1 : WS_SSQ)), lds, nullptr, nullptr, nullptr, nullptr};
                __syncthreads(); run_gemm(lds, (const bf16*)(ws + WS_XB), (const bf16*)(ws + WS_WPW1), 2048L * 1024 * 2, 2048, 1024, G, E, wave);
            }
            SEAM(ph); ++ph;
            if (IN(ph)) { __syncthreads(); conv_phase(lds, vcu, G, wave); }
            SEAM(ph); ++ph;
        } else {
            const int f = (sl / 3) * 2 + ((sl % 3) == 2);
            if (IN(ph)) { __syncthreads(); unsigned char* const ws = PWS;
                const float* ssq_cur = (const float*)(ws + ((sl & 1) ? WS_SSQ1 : WS_SSQ)); const float* ssq_prv = (const float*)(ws + ((sl & 1) ? WS_SSQ : WS_SSQ1));
                if ((I8MASK >> f) & 1) {
                    EpiGated<0, true> E{(bf16*)(ws + WS_ACT), FF_, (const float*)(ws + WS_BFFN) + (size_t)f * 2 * 5632, 5632, ssq_cur, lds, ssq_prv, (const signed char*)(ws + WS_WEXP) + f * 5632,
                                        PIN(2) + sl * 1024, (const float*)(ws + WS_MOD) + (size_t)((sl / 3) * 2) * 9216 + (sl % 3) * 3 * 1024 + 1024};
                    __syncthreads(); run_gemm<EpiGated<0, true>, true>(lds, (const bf16*)(ws + WS_X8), (const bf16*)(ws + WS_WIN) + (size_t)f * 2 * 5632 * 1024, 0L, 5632, 512, G, E, wave);
                } else {
                EpiGated<0> E{(bf16*)(ws + WS_ACT), FF_, (const float*)(ws + WS_BFFN) + (size_t)f * 2 * 5632, 5632, ssq_cur, lds, nullptr, nullptr, nullptr, nullptr};
                __syncthreads(); run_gemm(lds, (const bf16*)(ws + WS_XB), (const bf16*)(ws + WS_WIN) + (size_t)f * 2 * 5632 * 1024, 5632L * 1024 * 2, 5632, 1024, G, E, wave);
                }
            }
            SEAM(ph); ++ph;
        }
        if (IN(ph)) { __syncthreads(); unsigned char* const ws = PWS; float* const out = POUT;
            const bf16* Ares; const bf16* Wres; int Kres; const float* bias2 = nullptr;
            if (sl == 1) { Ares = (const bf16*)(ws + WS_Q); Wres = (const bf16*)(ws + WS_WO); Kres = 1024; }
            else if (sl == 4) { Ares = (const bf16*)(ws + WS_CV); Wres = (const bf16*)(ws + WS_WPW2); Kres = 1024; bias2 = PIN(18); }
            else { const int f = (sl / 3) * 2 + ((sl % 3) == 2); Ares = (const bf16*)(ws + WS_ACT); Wres = (const bf16*)(ws + WS_WOUT) + (size_t)f * 1024 * 2816; Kres = FF_; }
            const int fnext = (sl == 1) ? 1 : (sl == 2) ? 2 : (sl == 4) ? 3 : -1;
            const bool q8 = fnext >= 0 && ((I8MASK >> fnext) & 1); const int sn = sl + 1;
            EpiRes E{(bf16*)(ws + WS_XB), out, bias2, (const float*)(ws + WS_COEF) + (size_t)sl * 2048, (float*)(ws + ((sl & 1) ? WS_SSQ : WS_SSQ1)), (sl == 5) ? 1 : 0, lds,
                     q8 ? ws + WS_X8 : nullptr, (const float*)(ws + ((sl & 1) ? WS_SSQ1 : WS_SSQ)), PIN(2) + sn * 1024, (const float*)(ws + WS_MOD) + (size_t)((sn / 3) * 2) * 9216 + (sn % 3) * 3 * 1024 + 1024};
            run_gemm(lds, Ares, Wres, 0L, 1024, Kres, G, E, wave);
        }
        SEAM(ph); ++ph;
    }
#undef IN
#undef SEAM
}

extern "C" void kernel_launch(void* const* d_in, const int* in_sizes, int n_in, void* d_out, int out_size, void* d_ws, size_t ws_size, hipStream_t stream) {
    static int grid = 0;
    if (grid == 0) {
        if (n_in != 19 || in_sizes[0] != M_ * D_ || out_size != M_ * D_ || ws_size < WS_END) {
            fprintf(stderr, "kernel_launch: unexpected problem (n_in %d, in0 %d, out %d, ws %zu); nothing launched\n", n_in, n_in > 0 ? in_sizes[0] : -1, out_size, ws_size); grid = -1; return; }
        int dev = 0, cus = 0;
        if (hipGetDevice(&dev) != hipSuccess || hipDeviceGetAttribute(&cus, hipDeviceAttributeMultiprocessorCount, dev) != hipSuccess) { grid = -1; return; }
        if (hipFuncSetAttribute((const void*)fwd, hipFuncAttributeMaxDynamicSharedMemorySize, LDS_BYTES) != hipSuccess) { fprintf(stderr, "kernel_launch: hipFuncSetAttribute failed\n"); grid = -1; return; }
        int per_cu = 0;
        if (hipOccupancyMaxActiveBlocksPerMultiprocessor(&per_cu, (const void*)fwd, 512, LDS_BYTES) != hipSuccess || per_cu < 1) fprintf(stderr, "kernel_launch: occupancy query reports %d blocks per CU\n", per_cu);
        (void)hipGetLastError();
        grid = cus;
    }
    if (grid < 0) return;
    if (hipMemsetAsync((char*)d_ws + WS_CTL, 0, CTL_ZERO_BYTES, stream) != hipSuccess) return;
    Args a{};
    for (int i = 0; i < 19; ++i) a.in[i] = (const float*)d_in[i];
    a.out = (float*)d_out; a.ws = (unsigned char*)d_ws;
#if MK_MULTI
    for (int p = 0; p < NPH; ++p) { a.lo = p; a.hi = p + 1; hipLaunchKernelGGL(fwd, dim3(grid), dim3(512), LDS_BYTES, stream, a); }
#else
    a.lo = 0; a.hi = NPH; hipLaunchKernelGGL(fwd, dim3(grid), dim3(512), LDS_BYTES, stream, a);
#endif
}
```

```cpp
#define I8MASK 14
#include <hip/hip_runtime.h>
#include <cstdio>
#include <cstdint>
#include <cmath>
namespace pg8 {
#define PG8_LAS __attribute__((address_space(3)))
typedef unsigned short bf16_t;
typedef short bf16x8 __attribute__((ext_vector_type(8)));
typedef float f32x4 __attribute__((ext_vector_type(4)));
typedef unsigned u32x4 __attribute__((ext_vector_type(4)));
constexpr int BM = 256, BK = 64, HALF = 128, HTB = HALF * BK * 2  , STAGE_BYTES = 8 * HTB, NXCD = 8, WGM = 8;

__host__ __device__ __forceinline__ int lds_byte(int r, int c) { const int st = (r >> 4) * 2 + (c >> 5), rr = r & 15, cc = c & 31, ob = rr * 64 + cc * 2; return st * 1024 + (ob ^ (((ob >> 9) & 1) << 5)); }
__host__ __device__ __forceinline__ void stage_rc(int b, int& R, int& C) { const int st = b / 1024, sb = b % 1024, swz = sb ^ (((sb >> 9) & 1) << 5); R = (st >> 1) * 16 + swz / 64; C = (st & 1) * 32 + (swz % 64) / 2; }
__host__ __device__ __forceinline__ int perm32(int rho) { const int n = rho >> 4, i = rho & 15; return 8 * (i >> 2) + 4 * n + (i & 3); }

struct Unit { int pm, pn; };
struct Gemm { const bf16_t* A; const bf16_t* Bt; int M, N, K; long bb; };

struct StaticOrder {
    int nM, nN, nwg, G, c;
    __host__ __device__ void init(int M, int N, int G_, int c_) { nM = M / BM; nN = N / BM; nwg = nM * nN; G = G_; c = c_; }
    __host__ __device__ bool next(int i, Unit& u) const {
        const long L = (long)i * G + c; if (L >= nwg) return false;
        int wgid = (int)L; { const int q = nwg / NXCD, r = nwg % NXCD, xcd = wgid % NXCD, off = wgid / NXCD; wgid = (xcd < r ? xcd * (q + 1) : r * (q + 1) + (xcd - r) * q) + off; }
        const int nig = WGM * nN, gid = wgid / nig, fm = gid * WGM, gsz = (nM - fm) < WGM ? (nM - fm) : WGM;
        u.pm = fm + ((wgid % nig) % gsz); u.pn = (wgid % nig) / gsz; return true;
    }
    __device__ __forceinline__ void a_ready(const Unit&) const {}
    __device__ __forceinline__ void done(const Unit&) const {}
};

__device__ __forceinline__ unsigned cvt_pk_bf16(float lo, float hi) { unsigned r; asm volatile("v_cvt_pk_bf16_f32 %0, %1, %2" : "=v"(r) : "v"(lo), "v"(hi)); return r; }
typedef float f32x2 __attribute__((ext_vector_type(2)));
template <class Epi, class Sched, bool ALIGN_EPI = false, bool SP2 = false, bool F8 = false>
__device__ __forceinline__ void gemm_phase(PG8_LAS unsigned char* lds, const Gemm g, const Sched& S, const Epi& E, const int tid_in) {
    typedef int pg8_i32x8 __attribute__((ext_vector_type(8))); typedef int pg8_i32x4 __attribute__((ext_vector_type(4)));
    const int tid = tid_in, wid = __builtin_amdgcn_readfirstlane(tid >> 6), lane = tid & 63, wr = wid >> 2, wc = wid & 3, fr = lane & 15, fq = lane >> 4;
    const int K = g.K, nt = K / BK;
    unsigned voffA[2], voffB[2];
#pragma unroll
    for (int i = 0; i < 2; ++i) { int R, C; stage_rc(tid * 16 + i * 8192, R, C); const int Rb = Epi::PERM ? ((R & ~31) + perm32(R & 31)) : R;
        voffA[i] = (unsigned)(R * K + C) * 2u; voffB[i] = (unsigned)(Rb * K + C) * 2u; }
    const unsigned long long pa_ = (unsigned long long)g.A, pb_ = (unsigned long long)g.Bt;
    void* const ua_ = (void*)(((unsigned long long)(unsigned)__builtin_amdgcn_readfirstlane((int)(pa_ >> 32)) << 32) | (unsigned long long)(unsigned)__builtin_amdgcn_readfirstlane((int)(unsigned)pa_));
    void* const ub_ = (void*)(((unsigned long long)(unsigned)__builtin_amdgcn_readfirstlane((int)(pb_ >> 32)) << 32) | (unsigned long long)(unsigned)__builtin_amdgcn_readfirstlane((int)(unsigned)pb_));
    const __amdgpu_buffer_rsrc_t rs_voffA = __builtin_amdgcn_make_buffer_rsrc(ua_, 0, -1, 0x00020000), rs_voffB = __builtin_amdgcn_make_buffer_rsrc(ub_, 0, -1, 0x00020000);
    const unsigned kstep = (unsigned)(BK * 2);
    const unsigned hstep = (unsigned)(HALF * K * 2);
    const unsigned tstep = 2u * hstep;
    const unsigned ldsw = (unsigned)wid * 1024u;
    const int aoff = lds_byte(wr * 64 + fr, fq * 8), boff = lds_byte(wc * 32 + fr, fq * 8);
#define PG8_SA(b, h) (((b) * 2 + (h)) * HTB)
#define PG8_SB(b, h) ((4 + (b) * 2 + (h)) * HTB)
#define PG8_STAGE(bufoff, soff, voff) do { _Pragma("unroll") for (int _i = 0; _i < 2; ++_i) \
        __builtin_amdgcn_raw_ptr_buffer_load_lds(rs_##voff, (PG8_LAS void*)(lds + (bufoff) + ldsw + _i * 8192), 16, (int)(voff)[_i], (int)(soff), 0, 0); } while (0)
#define PG8_LDA(dst, b, h) do { _Pragma("unroll") for (int m = 0; m < 4; ++m) _Pragma("unroll") for (int k = 0; k < 2; ++k) dst[m][k] = *(const PG8_LAS bf16x8*)(lds + PG8_SA(b, h) + aoff + m * 2048 + k * 1024); } while (0)
#define PG8_LDB(dst, b, h) do { _Pragma("unroll") for (int n = 0; n < 2; ++n) _Pragma("unroll") for (int k = 0; k < 2; ++k) dst[n][k] = *(const PG8_LAS bf16x8*)(lds + PG8_SB(b, h) + boff + n * 2048 + k * 1024); } while (0)
#ifndef PG8_PRIO_MMA
#define PG8_PRIO_MMA 3
#define PG8_PRIO_LOAD 0
#endif
#define PG8_MMA(ai, bj, At, Bt) do { __builtin_amdgcn_s_setprio(PG8_PRIO_MMA); \
        if constexpr (F8) { _Pragma("unroll") for (int m = 0; m < 4; ++m) _Pragma("unroll") for (int n = 0; n < 2; ++n) _Pragma("unroll") for (int k = 0; k < 2; ++k) \
            acc[ai][bj][m][n] = __builtin_bit_cast(f32x4, __builtin_amdgcn_mfma_i32_16x16x64_i8(__builtin_bit_cast(pg8_i32x4, Bt[n][k]), __builtin_bit_cast(pg8_i32x4, At[m][k]), __builtin_bit_cast(pg8_i32x4, acc[ai][bj][m][n]), 0, 0, 0)); } \
        else { _Pragma("unroll") for (int m = 0; m < 4; ++m) _Pragma("unroll") for (int n = 0; n < 2; ++n) _Pragma("unroll") for (int k = 0; k < 2; ++k) \
            acc[ai][bj][m][n] = __builtin_amdgcn_mfma_f32_16x16x32_bf16(Bt[n][k], At[m][k], acc[ai][bj][m][n], 0, 0, 0); } \
        __builtin_amdgcn_s_setprio(PG8_PRIO_LOAD); } while (0)
#define PG8_WAIT_V(n) asm volatile("s_waitcnt vmcnt(" #n ")" ::: "memory")
#define PG8_WAIT_L(n) asm volatile("s_waitcnt lgkmcnt(" #n ")" ::: "memory")
#define PG8_BAR __builtin_amdgcn_s_barrier()
#define PG8_SCHED __builtin_amdgcn_sched_barrier(0)
    Unit cur, nxt; int ui = 0;
    if (!S.next(0, cur)) return;
    f32x4 acc[2][2][4][2];
#pragma unroll
    for (int a = 0; a < 2; ++a)
#pragma unroll
        for (int b = 0; b < 2; ++b)
#pragma unroll
            for (int m = 0; m < 4; ++m)
#pragma unroll
                for (int n = 0; n < 2; ++n) acc[a][b][m][n] = (f32x4){0.f, 0.f, 0.f, 0.f};
    bf16x8 At[4][2], B0[2][2], B1[2][2];
    unsigned cA = (unsigned)cur.pm * tstep, cB = (unsigned)cur.pn * tstep + (unsigned)(cur.pm >> 6) * (unsigned)g.bb;
    S.a_ready(cur);
    if constexpr (SP2) {
        PG8_STAGE(PG8_SB(0, 0), cB, voffB); PG8_STAGE(PG8_SB(0, 1), cB + hstep, voffB); PG8_STAGE(PG8_SA(0, 0), cA, voffA); PG8_STAGE(PG8_SA(0, 1), cA + hstep, voffA);
        if (wr == 1) PG8_BAR;
        PG8_WAIT_V(2); PG8_BAR;
        PG8_STAGE(PG8_SB(1, 0), cB + kstep, voffB); PG8_STAGE(PG8_SA(1, 0), cA + kstep, voffA); PG8_STAGE(PG8_SB(1, 1), cB + hstep + kstep, voffB);
        PG8_WAIT_V(6); PG8_BAR;
    } else {
        PG8_STAGE(PG8_SB(0, 0), cB, voffB); PG8_STAGE(PG8_SA(0, 0), cA, voffA); PG8_STAGE(PG8_SB(0, 1), cB + hstep, voffB); PG8_STAGE(PG8_SA(0, 1), cA + hstep, voffA);
        if (wr == 1) PG8_BAR;
        PG8_WAIT_V(4); PG8_BAR;
        PG8_STAGE(PG8_SB(1, 0), cB + kstep, voffB); PG8_STAGE(PG8_SA(1, 0), cA + kstep, voffA); PG8_STAGE(PG8_SB(1, 1), cB + hstep + kstep, voffB);
        PG8_WAIT_V(6); PG8_BAR;
    }
    for (;;) {
        const bool has_next = S.next(ui + 1, nxt);
        const unsigned nA = has_next ? (unsigned)nxt.pm * tstep : cA, nB = has_next ? (unsigned)nxt.pn * tstep + (unsigned)(nxt.pm >> 6) * (unsigned)g.bb : cB;
        for (int t = 0; t < nt; t += 2) {
            const bool last = (t == nt - 2);
            const unsigned a1 = cA + (unsigned)(t + 1) * kstep;
            const unsigned a2 = last ? nA : cA + (unsigned)(t + 2) * kstep, b2 = last ? nB : cB + (unsigned)(t + 2) * kstep;
            const unsigned a3 = a2 + kstep, b3 = b2 + kstep;
            if (last && has_next) S.a_ready(nxt);
            if constexpr (SP2) {
            PG8_STAGE(PG8_SA(1, 1), a1 + hstep, voffA); PG8_SCHED; PG8_LDB(B0, 0, 0); PG8_LDB(B1, 0, 1); PG8_SCHED; PG8_LDA(At, 0, 0);
            PG8_WAIT_V(8); PG8_WAIT_L(0); PG8_BAR; PG8_MMA(0, 0, At, B0); PG8_MMA(0, 1, At, B1); PG8_BAR; PG8_SCHED;
            PG8_STAGE(PG8_SB(0, 0), b2, voffB); PG8_STAGE(PG8_SB(0, 1), b2 + hstep, voffB); PG8_STAGE(PG8_SA(0, 0), a2, voffA); PG8_SCHED; PG8_LDA(At, 0, 1);
            PG8_WAIT_V(8); PG8_WAIT_L(0); PG8_BAR; PG8_MMA(1, 0, At, B0); PG8_MMA(1, 1, At, B1); PG8_BAR; PG8_SCHED;
            PG8_STAGE(PG8_SA(0, 1), a2 + hstep, voffA); PG8_SCHED; PG8_LDB(B0, 1, 0); PG8_LDB(B1, 1, 1); PG8_SCHED; PG8_LDA(At, 1, 0);
            PG8_WAIT_V(8); PG8_WAIT_L(0); PG8_BAR; PG8_MMA(0, 0, At, B0); PG8_MMA(0, 1, At, B1); PG8_BAR; PG8_SCHED;
            PG8_STAGE(PG8_SB(1, 0), b3, voffB); PG8_STAGE(PG8_SB(1, 1), b3 + hstep, voffB); PG8_STAGE(PG8_SA(1, 0), a3, voffA); PG8_SCHED; PG8_LDA(At, 1, 1);
            PG8_WAIT_V(8); PG8_WAIT_L(0); PG8_BAR; PG8_MMA(1, 0, At, B0); PG8_MMA(1, 1, At, B1); PG8_BAR; PG8_SCHED;
            } else {
            PG8_LDB(B0, 0, 0); PG8_SCHED; PG8_LDA(At, 0, 0); PG8_STAGE(PG8_SA(1, 1), a1 + hstep, voffA);
            PG8_WAIT_L(8); PG8_BAR; PG8_WAIT_L(0); PG8_MMA(0, 0, At, B0); PG8_BAR; PG8_SCHED;
            PG8_LDB(B1, 0, 1); PG8_STAGE(PG8_SB(0, 0), b2, voffB);
            PG8_BAR; PG8_WAIT_L(0); PG8_MMA(0, 1, At, B1); PG8_BAR;
            PG8_LDA(At, 0, 1); PG8_STAGE(PG8_SA(0, 0), a2, voffA);
            PG8_BAR; PG8_WAIT_L(0); PG8_MMA(1, 0, At, B0); PG8_BAR; PG8_SCHED;
            PG8_STAGE(PG8_SB(0, 1), b2 + hstep, voffB);
            PG8_WAIT_V(6); PG8_BAR; PG8_MMA(1, 1, At, B1); PG8_BAR;
            PG8_LDB(B0, 1, 0); PG8_SCHED; PG8_LDA(At, 1, 0); PG8_STAGE(PG8_SA(0, 1), a2 + hstep, voffA);
            PG8_WAIT_L(8); PG8_BAR; PG8_WAIT_L(0); PG8_MMA(0, 0, At, B0); PG8_BAR; PG8_SCHED;
            PG8_LDB(B1, 1, 1); PG8_STAGE(PG8_SB(1, 0), b3, voffB);
            PG8_BAR; PG8_WAIT_L(0); PG8_MMA(0, 1, At, B1); PG8_BAR;
            PG8_LDA(At, 1, 1); PG8_STAGE(PG8_SA(1, 0), a3, voffA);
            PG8_BAR; PG8_WAIT_L(0); PG8_MMA(1, 0, At, B0); PG8_BAR; PG8_SCHED;
            PG8_STAGE(PG8_SB(1, 1), b3 + hstep, voffB);
            PG8_WAIT_V(6); PG8_BAR; PG8_MMA(1, 1, At, B1); PG8_BAR;
            }
        }
        if constexpr (ALIGN_EPI) { if (wr == 0) PG8_BAR; }
        if constexpr (F8) { _Pragma("unroll") for (int a = 0; a < 2; ++a) _Pragma("unroll") for (int b = 0; b < 2; ++b) _Pragma("unroll") for (int m = 0; m < 4; ++m) _Pragma("unroll") for (int n = 0; n < 2; ++n)
            acc[a][b][m][n] = __builtin_convertvector(__builtin_bit_cast(pg8_i32x4, acc[a][b][m][n]), f32x4); }
        if constexpr (!Epi::AFTER_DRAIN) { E(acc, cur, wr, wc, fr, fq); S.done(cur); }
        if (!has_next) break;
#pragma unroll
        for (int a = 0; a < 2; ++a)
#pragma unroll
            for (int b = 0; b < 2; ++b)
#pragma unroll
                for (int m = 0; m < 4; ++m)
#pragma unroll
                    for (int n = 0; n < 2; ++n) acc[a][b][m][n] = (f32x4){0.f, 0.f, 0.f, 0.f};
        cur = nxt; cA = nA; cB = nB; ++ui;
        if constexpr (ALIGN_EPI) { if (wr == 1) PG8_BAR; }
    }
    PG8_WAIT_V(0);
    if constexpr (!ALIGN_EPI) { if (wr == 0) PG8_BAR; }
    PG8_BAR;
    if constexpr (Epi::AFTER_DRAIN) { E.fused(acc, cur, wr, wc, fr, fq, lds, wid, lane); S.done(cur); }
#undef PG8_SA
#undef PG8_SB
#undef PG8_STAGE
#undef PG8_LDA
#undef PG8_LDB
#undef PG8_MMA
#undef PG8_WAIT_V
#undef PG8_WAIT_L
#undef PG8_BAR
#undef PG8_SCHED
}
}
constexpr int NB_ = 2, S_ = 16384, D_ = 1024, M_ = NB_ * S_, H_ = 16, HD_ = 64, FF_ = 2816, NBLK_ = 64;
constexpr float LOG2E_ = 1.4426950408889634f;
constexpr float C2_ = 0.125f * LOG2E_;
constexpr float EPS_ = 1e-6f;

constexpr size_t MiB = 1u << 20;
constexpr size_t WS_CTL = 0, CTL_ZERO_BYTES = 256 * 1024;
constexpr size_t WS_CMAX = 128 * 1024;
constexpr size_t WS_MOD  = 1 * MiB;
constexpr size_t WS_GM   = WS_MOD + 256 * 1024, WS_WEXP = WS_GM;
constexpr size_t WS_COEF = WS_GM + 64 * 1024;
constexpr size_t WS_BFFN = WS_COEF + 64 * 1024;
constexpr size_t WS_BQKV = WS_BFFN + 192 * 1024;
constexpr size_t WS_BPW1 = WS_BQKV + 32 * 1024;
constexpr size_t WS_SSQ  = 4 * MiB;
constexpr size_t WS_KBAR = 6 * MiB;
constexpr size_t WS_SEL  = 7 * MiB;
constexpr size_t WS_LP   = 9 * MiB;
constexpr size_t WS_WIN  = 16 * MiB;
constexpr size_t WS_WQKV = 104 * MiB;
constexpr size_t WS_WPW1 = 116 * MiB;
constexpr size_t WS_WOUT = 124 * MiB;
constexpr size_t WS_WO   = 146 * MiB;
constexpr size_t WS_WPW2 = 148 * MiB;
constexpr size_t WS_XB   = 152 * MiB;
constexpr size_t WS_BIG  = 216 * MiB;
constexpr size_t WS_ACT  = WS_BIG;
constexpr size_t WS_Q = WS_BIG, WS_K = WS_BIG + 64 * MiB, WS_V = WS_BIG + 128 * MiB;
constexpr size_t WS_OP3 = 408 * MiB;
constexpr size_t WS_U = WS_BIG, WS_CV = WS_BIG + 64 * MiB;
constexpr size_t WS_X8  = 472 * MiB;
constexpr size_t WS_SSQ1 = 504 * MiB;
constexpr size_t WS_END = 506 * MiB;
constexpr float CQ_ = 8.0f;
#ifndef I8MASK
#define I8MASK 0
#endif
static_assert((I8MASK & 1) == 0, "FFN 0 follows the prologue, which has no adaLN vectors yet: it stays bf16");
constexpr int CW_BAR = 1024;

constexpr int RING_BYTES = 131072;
constexpr int LDSCTL_OFF = RING_BYTES, MISC_OFF = LDSCTL_OFF + 320;
constexpr int LDS_BYTES = 163840;
constexpr int LT_PM = LDSCTL_OFF + 896, LT_RSTD = LDSCTL_OFF + 1024, LT_VEC = LDSCTL_OFF + 3072, LT_EXP = LT_VEC + 22528;

#define GAS __attribute__((address_space(1)))
#define LAS __attribute__((address_space(3)))
typedef unsigned short bf16;
typedef float f32x4 __attribute__((ext_vector_type(4)));
typedef unsigned u32x4 __attribute__((ext_vector_type(4)));
typedef unsigned u32x2 __attribute__((ext_vector_type(2)));
typedef short bf16x8 __attribute__((ext_vector_type(8)));
typedef float f32x16 __attribute__((ext_vector_type(16)));
#define LDS_WAIT() asm volatile("s_waitcnt lgkmcnt(0)" ::: "memory")
#define VM_WAIT() asm volatile("s_waitcnt vmcnt(0)" ::: "memory")
#define LDS_BARRIER() do { asm volatile("s_waitcnt lgkmcnt(0)" ::: "memory"); __builtin_amdgcn_s_barrier(); asm volatile("" ::: "memory"); } while (0)
__device__ __forceinline__ unsigned f2bf(float f) { unsigned u = __builtin_bit_cast(unsigned, f); return (u + 0x7fffu + ((u >> 16) & 1u)) >> 16; }
__device__ __forceinline__ unsigned pk2(float lo, float hi) { return f2bf(lo) | (f2bf(hi) << 16); }
typedef __bf16 bf16x2_t __attribute__((ext_vector_type(2))); typedef float f32x2_t __attribute__((ext_vector_type(2)));
__device__ __forceinline__ unsigned cvtpk(float lo, float hi) { const f32x2_t v = {lo, hi}; const bf16x2_t b = __builtin_convertvector(v, bf16x2_t); return __builtin_bit_cast(unsigned, b); }
__device__ __forceinline__ float bf2f(unsigned h) { return __builtin_bit_cast(float, h << 16); }
__device__ __forceinline__ float bflo(unsigned w) { return __builtin_bit_cast(float, w << 16); }
__device__ __forceinline__ float bfhi(unsigned w) { return __builtin_bit_cast(float, w & 0xffff0000u); }
template <int CTRL> __device__ __forceinline__ float dppf(float v) { return __builtin_bit_cast(float, __builtin_amdgcn_mov_dpp(__builtin_bit_cast(int, v), CTRL, 0xF, 0xF, true)); }
typedef unsigned u32x2v __attribute__((ext_vector_type(2)));
__device__ __forceinline__ float u2f(unsigned u) { return __builtin_bit_cast(float, u); }
__device__ __forceinline__ unsigned f2u(float f) { return __builtin_bit_cast(unsigned, f); }
__device__ __forceinline__ float sum16(float v) { const auto r = __builtin_amdgcn_permlane16_swap(f2u(v), f2u(v), false, false); const unsigned r0 = r[0], r1 = r[1]; return u2f(r0) + u2f(r1); }
__device__ __forceinline__ float sum32(float v) { const auto r = __builtin_amdgcn_permlane32_swap(f2u(v), f2u(v), false, false); const unsigned r0 = r[0], r1 = r[1]; return u2f(r0) + u2f(r1); }
__device__ __forceinline__ float max16(float v) { const auto r = __builtin_amdgcn_permlane16_swap(f2u(v), f2u(v), false, false); const unsigned r0 = r[0], r1 = r[1]; return fmaxf(u2f(r0), u2f(r1)); }
__device__ __forceinline__ float max32(float v) { const auto r = __builtin_amdgcn_permlane32_swap(f2u(v), f2u(v), false, false); const unsigned r0 = r[0], r1 = r[1]; return fmaxf(u2f(r0), u2f(r1)); }
__device__ __forceinline__ float row_sum16(float v) { v += dppf<0xB1>(v); v += dppf<0x4E>(v); v += dppf<0x141>(v); v += dppf<0x140>(v); return v; }
__device__ __forceinline__ float wave_sum(float v) { v = row_sum16(v); v = sum16(v); return sum32(v); }
__device__ __forceinline__ float wave_max(float v) { v = fmaxf(v, dppf<0xB1>(v)); v = fmaxf(v, dppf<0x4E>(v)); v = fmaxf(v, dppf<0x141>(v)); v = fmaxf(v, dppf<0x140>(v)); v = max16(v); return max32(v); }
__device__ __forceinline__ unsigned other32(unsigned v, int hi) { const auto r = __builtin_amdgcn_permlane32_swap(v, v, false, false); const unsigned r0 = r[0], r1 = r[1]; return hi ? r0 : r1; }
#define XB_TMO      128
#define XB_XCNT(j)  (256  + 64 * (j))
#define XB_XSUB(j)  (1280 + 64 * (j))
#define XB_XGEN(j)  (2304 + 64 * (j))
#define XB_TOP      3328
#define XB_TOPGEN   3392
#define XCD_BAR_WORDS 3456
#define XB_SPIN_CAP (1u << 18)

__device__ __forceinline__ unsigned xb_ld(unsigned* p)              { return __hip_atomic_load(p, __ATOMIC_RELAXED, __HIP_MEMORY_SCOPE_AGENT); }
__device__ __forceinline__ unsigned xb_add(unsigned* p, unsigned v) { return __hip_atomic_fetch_add(p, v, __ATOMIC_RELAXED, __HIP_MEMORY_SCOPE_AGENT); }
__device__ __forceinline__ unsigned xb_xcc_id() { return (unsigned)__builtin_amdgcn_s_getreg((3 << 11) | 20) & 0xFu; }
#define XB_SPIN(cond, bar) do { unsigned _sp = 0; while (cond) { __builtin_amdgcn_s_sleep(1); \
    if ((++_sp & 255u) == 0u) { if (xb_ld(&(bar)[XB_TMO])) break; if (_sp > XB_SPIN_CAP) { atomicAdd(&(bar)[XB_TMO], 1u); break; } } } } while (0)

struct XcdBarrier {
    unsigned* bar; unsigned x;
    volatile LAS unsigned* st;
};

__device__ __forceinline__ XcdBarrier xcd_barrier_post(unsigned* bar, volatile LAS unsigned* st) {
    XcdBarrier b; b.bar = bar; b.x = xb_xcc_id(); b.st = st;
    if (threadIdx.x == 0) (void)xb_add(&bar[XB_XCNT(b.x)], 1u);
    return b;
}
__device__ __forceinline__ void xcd_barrier_complete(unsigned* bar, unsigned x, unsigned& nloc, unsigned& nx) {
    const unsigned G = gridDim.x * gridDim.y * gridDim.z;
    unsigned sum, cnt, mine, sp = 0u;
    for (;;) {
        sum = 0u; cnt = 0u; mine = 0u;
#pragma unroll
        for (unsigned j = 0; j < 16; ++j) { const unsigned c = xb_ld(&bar[XB_XCNT(j)]); sum += c; cnt += (c > 0u) ? 1u : 0u; mine = (j == x) ? c : mine; }
        if (sum == G) break;
        __builtin_amdgcn_s_sleep(1);
        if ((++sp & 255u) == 0u) { if (xb_ld(&bar[XB_TMO])) break; if (sp > XB_SPIN_CAP) { atomicAdd(&bar[XB_TMO], 1u); break; } }
    }
    nloc = mine > 0u ? mine : 1u; nx = cnt > 0u ? cnt : 1u;
}

__device__ __forceinline__ void xcd_barrier(const XcdBarrier& b) {
    asm volatile("s_waitcnt vmcnt(0)" ::: "memory");
    __syncthreads();
    if (threadIdx.x == 0) {
        unsigned* bar = b.bar;
        __builtin_amdgcn_s_waitcnt(0);
        unsigned nloc = b.st[0], nx = b.st[1];
        if (nloc == 0u) { xcd_barrier_complete(bar, b.x, nloc, nx); b.st[0] = nloc; b.st[1] = nx; }
        const unsigned old = xb_add(&bar[XB_XSUB(b.x)], 1u);
        const unsigned gen = old / nloc;
        if (old + 1u == (gen + 1u) * nloc) {
            __builtin_amdgcn_fence(__ATOMIC_RELEASE, "agent");
            asm volatile("s_waitcnt vmcnt(0)" ::: "memory");
            const unsigned og = xb_add(&bar[XB_TOP], 1u);
            const unsigned tg = og / nx;
            if (og + 1u == (tg + 1u) * nx) xb_add(&bar[XB_TOPGEN], 1u);
            else XB_SPIN(xb_ld(&bar[XB_TOPGEN]) == tg, bar);
            __builtin_amdgcn_fence(__ATOMIC_ACQUIRE, "agent");
            xb_add(&bar[XB_XGEN(b.x)], 1u);
            asm volatile("s_waitcnt vmcnt(0)" ::: "memory");
        } else {
            XB_SPIN(xb_ld(&bar[XB_XGEN(b.x)]) == gen, bar);
            __builtin_amdgcn_fence(__ATOMIC_ACQUIRE, "agent");
            asm volatile("s_waitcnt vmcnt(0)" ::: "memory");
        }
    }
    __syncthreads();
}
__device__ __forceinline__ int epi_tables_pm(LAS unsigned char* lds, const pg8::StaticOrder& S, int tid, int& pmA_out, int& pmB_out) {
    int pmA = -1, pmB = -1, ok = 1; pg8::Unit u;
    for (int i = 0; S.next(i, u); ++i) { if (pmA < 0) pmA = u.pm; else if (u.pm != pmA) { if (pmB < 0) pmB = u.pm; else if (u.pm != pmB) ok = 0; } }
    if (pmA < 0) pmA = 0;
    if (pmB < 0) pmB = pmA;
    if ((pmA >> 6) != (pmB >> 6)) ok = 0;
    if (tid == 0) { ((LAS int*)(lds + LT_PM))[0] = pmA; ((LAS int*)(lds + LT_PM))[1] = pmB; }
    pmA_out = pmA; pmB_out = pmB; return ok;
}
__device__ __forceinline__ float ssq_row(const float* ssq, int row) {
    const f32x4 p0 = *(const f32x4*)(ssq + (size_t)row * 16), p1 = *(const f32x4*)(ssq + (size_t)row * 16 + 4), p2 = *(const f32x4*)(ssq + (size_t)row * 16 + 8), p3 = *(const f32x4*)(ssq + (size_t)row * 16 + 12);
    return (((p0.x + p0.y) + (p0.z + p0.w)) + ((p1.x + p1.y) + (p1.z + p1.w))) + (((p2.x + p2.y) + (p2.z + p2.w)) + ((p3.x + p3.y) + (p3.z + p3.w)));
}
__device__ __forceinline__ void epi_tables_rstd(LAS unsigned char* lds, const float* ssq, int pmA, int pmB, int ok, int tid, float scale = 1.0f, const float* ssq_prev = nullptr) {
    const int slot = tid >> 8, r = tid & 255, row = (slot ? pmB : pmA) * 256 + r;
    float v = rsqrtf(ssq_row(ssq, row) * (1.0f / D_) + EPS_) * scale;
    if (ssq_prev) v *= sqrtf(ssq_row(ssq_prev, row) * (1.0f / D_) + EPS_);
    ((LAS float*)(lds + LT_RSTD))[tid] = ok ? v : __builtin_nanf("");
}
__device__ __forceinline__ float gm_rms(const float* ng, const float* scl, int lane) {
    float s = 0.f;
#pragma unroll
    for (int i = 0; i < 4; ++i) { const f32x4 g = *(const f32x4*)(ng + 256 * i + 4 * lane), c = *(const f32x4*)(scl + 256 * i + 4 * lane);
#pragma unroll
        for (int e = 0; e < 4; ++e) { const float t = g[e] * (1.0f + c[e]); s += t * t; } }
    return sqrtf(wave_sum(s) * (1.0f / D_));
}
__device__ __forceinline__ void epi_tables_vec(LAS unsigned char* lds, int dst_off, const float* src, int n, int tid) {
    for (int i = tid * 4; i < n; i += 2048) *(LAS f32x4*)(lds + LT_VEC + (dst_off + i) * 4) = src ? *(const f32x4*)(src + i) : (f32x4){0.f, 0.f, 0.f, 0.f};
}
__device__ __forceinline__ unsigned pk4_i8(float a, float b, float c, float d) {
    const float M = 12582912.0f;
    const unsigned ua = f2u(__builtin_amdgcn_fmed3f(a, -127.0f, 127.0f) + M), ub = f2u(__builtin_amdgcn_fmed3f(b, -127.0f, 127.0f) + M), uc = f2u(__builtin_amdgcn_fmed3f(c, -127.0f, 127.0f) + M), ud = f2u(__builtin_amdgcn_fmed3f(d, -127.0f, 127.0f) + M);
    const unsigned lo = __builtin_amdgcn_perm(ub, ua, 0x0c0c0400u), hi = __builtin_amdgcn_perm(ud, uc, 0x0c0c0400u);
    return lo | (hi << 16);
}
__device__ __forceinline__ int lane_id() { return (int)__builtin_amdgcn_mbcnt_hi(~0u, __builtin_amdgcn_mbcnt_lo(~0u, 0u)); }
__device__ __forceinline__ float sigm(float v) { return __builtin_amdgcn_rcpf(1.0f + __builtin_amdgcn_exp2f(-LOG2E_ * v)); }

template <int ACT, bool I8 = false> struct EpiGated {
    static constexpr bool PERM = true, AFTER_DRAIN = false;
    bf16* O; int ldo; const float* bias; int N; const float* ssq; LAS unsigned char* lds;
    const float* ssq_prev; const signed char* wexp; const float* ng; const float* scl;
    __device__ __forceinline__ void preload(const pg8::StaticOrder& S, int tid) const {
        int pmA, pmB; const int ok = epi_tables_pm(lds, S, tid, pmA, pmB);
        if constexpr (I8) {
            const float G = gm_rms(ng, scl + (size_t)(pmA >> 6) * 9216, tid & 63);
            epi_tables_rstd(lds, ssq, pmA, pmB, ok, tid, CQ_ * G * (1.0f / 127.0f), ssq_prev);
            for (int i = tid; i < N / 4; i += 512) ((LAS unsigned*)(lds + LT_EXP))[i] = ((const unsigned*)wexp)[i];
        } else epi_tables_rstd(lds, ssq, pmA, pmB, ok, tid);
        epi_tables_vec(lds, 0, bias + (size_t)(pmA >> 6) * N, N, tid);
    }
    __device__ __forceinline__ void operator()(const f32x4 (&acc)[2][2][4][2], const pg8::Unit& u, int wr, int wc, int fr, int fq) const {
        const LAS float* bp = (const LAS float*)(lds + LT_VEC) + u.pn * 256 + wc * 32 + 8 * fq;
        const LAS float* rt = (const LAS float*)(lds + LT_RSTD) + ((u.pm == ((const LAS int*)(lds + LT_PM))[0]) ? 0 : 256) + wr * 64 + fr;
        f32x4 bv[2][2];
#pragma unroll
        for (int bj = 0; bj < 2; ++bj)
#pragma unroll
            for (int n = 0; n < 2; ++n) bv[bj][n] = *(const LAS f32x4*)(bp + bj * 128 + 4 * n);
        float rsv[8];
#pragma unroll
        for (int k = 0; k < 8; ++k) rsv[k] = rt[(k >> 2) * 128 + (k & 3) * 16];
        f32x4 cs[2][2];
        if constexpr (I8) {
#pragma unroll
            for (int bj = 0; bj < 2; ++bj) { const u32x2 eb = *(const LAS u32x2*)(lds + LT_EXP + u.pn * 256 + bj * 128 + wc * 32 + 8 * fq);
#pragma unroll
                for (int n = 0; n < 2; ++n) { const unsigned w = n ? eb.y : eb.x;
#pragma unroll
                    for (int j = 0; j < 4; ++j) { const int e = (int)(signed char)(w >> (8 * j)); cs[bj][n][j] = u2f((unsigned)(e + 127) << 23); } } }
        }
#pragma unroll
        for (int ai = 0; ai < 2; ++ai)
#pragma unroll
            for (int m = 0; m < 4; ++m) {
                const int row = u.pm * 256 + ai * 128 + wr * 64 + m * 16 + fr;
                const float rs = rsv[ai * 4 + m];
                typedef float f2 __attribute__((ext_vector_type(2)));
                f2 a[4], g[4], t[4], e[4], d[4], r[4], v[4];
#pragma unroll
                for (int i = 0; i < 4; ++i) { const int n = i >> 1; const f32x4 a4 = I8 ? acc[ai][0][m][n] * cs[0][n] : acc[ai][0][m][n], g4 = I8 ? acc[ai][1][m][n] * cs[1][n] : acc[ai][1][m][n], ba4 = bv[0][n], bg4 = bv[1][n];
                    a[i] = ((i & 1) == 0 ? (f2){a4.x, a4.y} : (f2){a4.z, a4.w}) * rs + ((i & 1) == 0 ? (f2){ba4.x, ba4.y} : (f2){ba4.z, ba4.w});
                    g[i] = ((i & 1) == 0 ? (f2){g4.x, g4.y} : (f2){g4.z, g4.w}) * rs + ((i & 1) == 0 ? (f2){bg4.x, bg4.y} : (f2){bg4.z, bg4.w});
                    t[i] = ((ACT == 0) ? a[i] : g[i]) * (-LOG2E_); }
#pragma unroll
                for (int i = 0; i < 4; ++i) { e[i].x = __builtin_amdgcn_exp2f(t[i].x); e[i].y = __builtin_amdgcn_exp2f(t[i].y); }
#pragma unroll
                for (int i = 0; i < 4; ++i) d[i] = e[i] + 1.0f;
#pragma unroll
                for (int i = 0; i < 4; ++i) { r[i].x = __builtin_amdgcn_rcpf(d[i].x); r[i].y = __builtin_amdgcn_rcpf(d[i].y); }
#pragma unroll
                for (int i = 0; i < 4; ++i) v[i] = (ACT == 0) ? (a[i] * r[i]) * g[i] : a[i] * r[i];
                u32x4 w; w.x = cvtpk(v[0].x, v[0].y); w.y = cvtpk(v[1].x, v[1].y); w.z = cvtpk(v[2].x, v[2].y); w.w = cvtpk(v[3].x, v[3].y);
                *(u32x4*)(O + (size_t)row * ldo + u.pn * 128 + wc * 32 + 8 * fq) = w;
            }
    }
};

struct EpiRes {
    static constexpr bool PERM = true, AFTER_DRAIN = false;
    bf16* xb; float* out; const float* bias2; const float* coef; float* ssq; int last; LAS unsigned char* lds;
    unsigned char* x8; const float* ssq_prev; const float* ng_next; const float* scl_next;
    __device__ __forceinline__ void preload(const pg8::StaticOrder& S, int tid) const {
        int pmA, pmB; const int ok = epi_tables_pm(lds, S, tid, pmA, pmB);
        epi_tables_vec(lds, 0, ok ? coef + (size_t)(pmA >> 6) * D_ : nullptr, D_, tid);
        epi_tables_vec(lds, D_, bias2, D_, tid);
        if (x8) {
            const float* sc = scl_next + (size_t)(pmA >> 6) * 9216;
            const float G = gm_rms(ng_next, sc, tid & 63);
            epi_tables_rstd(lds, ssq_prev, pmA, pmB, ok, tid, 127.0f / (CQ_ * G));
            if (tid < 256) { const f32x4 g = *(const f32x4*)(ng_next + 4 * tid), c = *(const f32x4*)(sc + 4 * tid);
                *(LAS f32x4*)(lds + LT_VEC + (2 * D_ + 4 * tid) * 4) = (f32x4){g.x * (1.0f + c.x), g.y * (1.0f + c.y), g.z * (1.0f + c.z), g.w * (1.0f + c.w)}; }
        }
    }
    __device__ __forceinline__ void operator()(const f32x4 (&acc)[2][2][4][2], const pg8::Unit& u, int wr, int wc, int fr, int fq) const {
        const int col0 = u.pn * 256 + wc * 32 + 8 * fq;
        const size_t ro0 = (size_t)(u.pm * 256 + wr * 64 + fr) * D_ + col0;
        u32x4 xr[8][2];
#define EPIRES_LOAD(k) do { const bf16* xp_ = xb + ro0 + (size_t)(((k) >> 2) * 128 + ((k) & 3) * 16) * D_; xr[k][0] = *(const u32x4*)(xp_); xr[k][1] = *(const u32x4*)(xp_ + 128); } while (0)
        EPIRES_LOAD(0); EPIRES_LOAD(1); EPIRES_LOAD(2); EPIRES_LOAD(3);
        f32x4 cf[2][2], b2[2][2];
#pragma unroll
        for (int bj = 0; bj < 2; ++bj)
#pragma unroll
            for (int n = 0; n < 2; ++n) { const int c = col0 + bj * 128 + 4 * n;
                cf[bj][n] = *(const LAS f32x4*)(lds + LT_VEC + c * 4);
                b2[bj][n] = *(const LAS f32x4*)(lds + LT_VEC + (D_ + c) * 4); }
#pragma unroll
        for (int k = 0; k < 8; ++k) {
            const int ai = k >> 2, m = k & 3;
            if (k < 4) { switch (k) { case 0: EPIRES_LOAD(4); break; case 1: EPIRES_LOAD(5); break; case 2: EPIRES_LOAD(6); break; default: EPIRES_LOAD(7); break; } }
            const int row = u.pm * 256 + ai * 128 + wr * 64 + m * 16 + fr; const size_t ro = (size_t)row * D_;
            float ss = 0.f;
#pragma unroll
            for (int bj = 0; bj < 2; ++bj) {
                const u32x4 xw = xr[k][bj];
                const f32x4 x0 = (f32x4){bflo(xw.x), bfhi(xw.x), bflo(xw.y), bfhi(xw.y)}, x1 = (f32x4){bflo(xw.z), bfhi(xw.z), bflo(xw.w), bfhi(xw.w)};
                const f32x4 n0 = x0 + cf[bj][0] * (acc[ai][bj][m][0] + b2[bj][0]), n1 = x1 + cf[bj][1] * (acc[ai][bj][m][1] + b2[bj][1]);
                ss += ((n0[0] * n0[0] + n0[1] * n0[1]) + (n0[2] * n0[2] + n0[3] * n0[3])) + ((n1[0] * n1[0] + n1[1] * n1[1]) + (n1[2] * n1[2] + n1[3] * n1[3]));
                if (!last) { u32x4 w; w.x = cvtpk(n0[0], n0[1]); w.y = cvtpk(n0[2], n0[3]); w.z = cvtpk(n1[0], n1[1]); w.w = cvtpk(n1[2], n1[3]);
                    *(u32x4*)(xb + ro + col0 + bj * 128) = w;
                    if (x8) { const float qs = ((const LAS float*)(lds + LT_RSTD))[((u.pm == ((const LAS int*)(lds + LT_PM))[0]) ? 0 : 256) + ai * 128 + wr * 64 + m * 16 + fr];
                        const f32x4 q0 = n0 * *(const LAS f32x4*)(lds + LT_VEC + (2 * D_ + col0 + bj * 128) * 4) * qs, q1 = n1 * *(const LAS f32x4*)(lds + LT_VEC + (2 * D_ + col0 + bj * 128 + 4) * 4) * qs;
                        u32x2 w8; w8.x = pk4_i8(q0[0], q0[1], q0[2], q0[3]); w8.y = pk4_i8(q1[0], q1[1], q1[2], q1[3]); *(u32x2*)(x8 + ro + col0 + bj * 128) = w8; } }
                else { *(f32x4*)(out + ro + col0 + bj * 128) = n0; *(f32x4*)(out + ro + col0 + bj * 128 + 4) = n1; }
            }
            if (!last) { ss = sum32(sum16(ss)); if (fq == 0) ssq[(size_t)row * 16 + u.pn * 4 + wc] = ss; }
        }
#undef EPIRES_LOAD
    }
};

struct EpiQKV {
    static constexpr bool PERM = true, AFTER_DRAIN = false;
    bf16* Q;   const float* bias; const float* ssq; const float* gq; const float* gk; float* kbarp; LAS unsigned char* lds;
    __device__ __forceinline__ void preload(const pg8::StaticOrder& S, int tid) const {
        int pmA, pmB; const int ok = epi_tables_pm(lds, S, tid, pmA, pmB);
        epi_tables_rstd(lds, ssq, pmA, pmB, ok, tid);
        epi_tables_vec(lds, 0, bias + (size_t)(pmA >> 6) * 3072, 3072, tid);
        epi_tables_vec(lds, 3072, gq, 64, tid); epi_tables_vec(lds, 3072 + 64, gk, 64, tid);
    }
    __device__ __forceinline__ void operator()(const f32x4 (&acc)[2][2][4][2], const pg8::Unit& u, int wr, int wc, int fr, int fq) const {
        const int b = u.pm >> 6, part = u.pn >> 2, head = ((u.pn & 3) << 2) + wc;
        const LAS float* bp = (const LAS float*)(lds + LT_VEC) + u.pn * 256 + wc * 32 + 8 * fq;
        const LAS float* gsrc = (const LAS float*)(lds + LT_VEC) + 3072 + ((part == 0) ? 0 : 64); const float gs = (part == 0) ? C2_ : 1.0f;
        const LAS float* rt = (const LAS float*)(lds + LT_RSTD) + ((u.pm == ((const LAS int*)(lds + LT_PM))[0]) ? 0 : 256) + wr * 64 + fr;
        f32x4 bv[2][2], gv[2][2], ks[2][2];
#pragma unroll
        for (int bj = 0; bj < 2; ++bj)
#pragma unroll
            for (int n = 0; n < 2; ++n) { bv[bj][n] = *(const LAS f32x4*)(bp + bj * 128 + 4 * n); gv[bj][n] = *(const LAS f32x4*)(gsrc + 32 * bj + 8 * fq + 4 * n) * gs; ks[bj][n] = (f32x4){0.f, 0.f, 0.f, 0.f}; }
        bf16* dst = Q + (size_t)part * ((size_t)M_ * D_);
        float rsv[8];
#pragma unroll
        for (int k = 0; k < 8; ++k) rsv[k] = rt[(k >> 2) * 128 + (k & 3) * 16];
#pragma unroll
        for (int ai = 0; ai < 2; ++ai)
#pragma unroll
            for (int m = 0; m < 4; ++m) {
                const int row = u.pm * 256 + ai * 128 + wr * 64 + m * 16 + fr;
                const float rs = rsv[ai * 4 + m];
                f32x4 v[2][2]; float ss = 0.f;
#pragma unroll
                for (int bj = 0; bj < 2; ++bj)
#pragma unroll
                    for (int n = 0; n < 2; ++n) { v[bj][n] = acc[ai][bj][m][n] * rs + bv[bj][n]; const f32x4 t = v[bj][n]; ss += (t[0] * t[0] + t[1] * t[1]) + (t[2] * t[2] + t[3] * t[3]); }
                if (part < 2) {
                    ss = sum32(sum16(ss));
                    const float r = rsqrtf(ss * (1.0f / HD_) + EPS_);
#pragma unroll
                    for (int bj = 0; bj < 2; ++bj)
#pragma unroll
                        for (int n = 0; n < 2; ++n) v[bj][n] = v[bj][n] * r * gv[bj][n];
                }
                if (part == 1) {
#pragma unroll
                    for (int bj = 0; bj < 2; ++bj)
#pragma unroll
                        for (int n = 0; n < 2; ++n) ks[bj][n] += v[bj][n];
                }
#pragma unroll
                for (int bj = 0; bj < 2; ++bj) {
                    u32x4 w; w.x = cvtpk(v[bj][0][0], v[bj][0][1]); w.y = cvtpk(v[bj][0][2], v[bj][0][3]); w.z = cvtpk(v[bj][1][0], v[bj][1][1]); w.w = cvtpk(v[bj][1][2], v[bj][1][3]);
                    *(u32x4*)(dst + (size_t)row * D_ + head * 64 + 32 * bj + 8 * fq) = w; }
            }
        if (part == 1) {
            float* kp = kbarp + ((((size_t)(b * 16 + head) * 64 + (u.pm & 63)) * 2 + wr) * 64);
#pragma unroll
            for (int bj = 0; bj < 2; ++bj)
#pragma unroll
                for (int n = 0; n < 2; ++n) { f32x4 t = ks[bj][n];
#pragma unroll
                    for (int j = 0; j < 4; ++j) { t[j] = row_sum16(t[j]); }
                    if (fr == 0) *(f32x4*)(kp + 32 * bj + 8 * fq + 4 * n) = t; }
        }
    }
};

template <class Epi, bool F8 = false> __device__ __forceinline__ void run_gemm(LAS unsigned char* lds, const bf16* A, const bf16* Bt, long bb, int N, int K, int G, const Epi& E, int wave_in) {
    int t = lane_id(); asm volatile("" : "+v"(t)); t += 64 * wave_in;
    int bid = (int)blockIdx.x, Gq = G; asm volatile("" : "+s"(bid), "+s"(Gq));
    pg8::Gemm g{A, Bt, M_, N, K, bb}; pg8::StaticOrder S; S.init(M_, N, Gq, bid);
    E.preload(S, t);
    __syncthreads();
    pg8::gemm_phase<Epi, pg8::StaticOrder, true, true, F8>(lds, g, S, E, t);
}

__device__ __forceinline__ void tile_load(float (&w)[32], const float* W, int N, int k0, int n0, int lane) {
    const float* p = W + (size_t)(k0 + (lane >> 5)) * N + n0 + (lane & 31);
#pragma unroll
    for (int i = 0; i < 32; ++i) w[i] = p[(size_t)(2 * i) * N];
}
__device__ __forceinline__ void tile_to_lds(const float (&w)[32], LAS float* scr, int lane) {
#pragma unroll
    for (int i = 0; i < 32; ++i) scr[(2 * i + (lane >> 5)) * 33 + (lane & 31)] = w[i];
}
__device__ __forceinline__ void transpose_finish(int K, bf16* WT, int k0, int dst0, LAS float* scr, int lane) {
    LDS_WAIT(); asm volatile("" ::: "memory");
    const int c = lane & 7;
#pragma unroll
    for (int j = 0; j < 4; ++j) { const int n = (lane >> 3) + 8 * j; const LAS float* s = scr + (8 * c) * 33 + n;
        u32x4 o; o.x = cvtpk(s[0 * 33], s[1 * 33]); o.y = cvtpk(s[2 * 33], s[3 * 33]); o.z = cvtpk(s[4 * 33], s[5 * 33]); o.w = cvtpk(s[6 * 33], s[7 * 33]);
        *(GAS u32x4*)(WT + (size_t)(dst0 + n) * K + k0 + 8 * c) = o; }
    LDS_WAIT(); asm volatile("" ::: "memory");
}
__device__ __forceinline__ int gated_dst(int n0, int half) { const int c = (n0 < half) ? n0 : n0 - half; return 256 * (c >> 7) + (c & 127) + ((n0 < half) ? 0 : 128); }

constexpr int PT_OFF = MISC_OFF + 128;
__device__ __forceinline__ unsigned long long pt_get(LAS unsigned char* lds, int i) {
    const unsigned long long v = ((volatile LAS unsigned long long*)(lds + PT_OFF))[i];
    return ((unsigned long long)(unsigned)__builtin_amdgcn_readfirstlane((int)(v >> 32)) << 32) | (unsigned long long)(unsigned)__builtin_amdgcn_readfirstlane((int)(unsigned)v);
}
#define PIN(i) ((const float*)(const GAS float*)pt_get(lds, (i)))
#define POUT ((float*)(GAS float*)pt_get(lds, 19))
#define PWS ((unsigned char*)(GAS unsigned char*)pt_get(lds, 20))

__device__ __forceinline__ void inweight_item(const float* W, int N, bf16* WT, size_t wt_bstride, int kh, int n0, int dst0, const float* ng, const float* mod0,
                                              float* bias, int bias_bstride, const float* extra, LAS float* scr, int lane, int i8out = 0, const unsigned* cmax = nullptr, signed char* wexp = nullptr) {
    const int c = lane & 7;
    float dacc[4][2];
#pragma unroll
    for (int j = 0; j < 4; ++j) { dacc[j][0] = 0.f; dacc[j][1] = 0.f; }
    float qinv[4]; int qex[4];
#pragma unroll
    for (int j = 0; j < 4; ++j) { qinv[j] = 0.f; qex[j] = 0; }
    if (i8out) {
#pragma unroll
        for (int j = 0; j < 4; ++j) { const unsigned mb = f2u(u2f(cmax[n0 + (lane >> 3) + 8 * j]) * (1.0f / 127.0f));
            int e = (int)((mb >> 23) & 255u) - 127 + ((mb & 0x7fffffu) ? 1 : 0); e = e < -100 ? -100 : e; qex[j] = e; qinv[j] = u2f((unsigned)(127 - e) << 23); }
    }
    float w[32]; tile_load(w, W, N, 64 * 8 * kh, n0, lane);
    f32x4 gq[2], s0q[2], s1q[2], h0q[2], h1q[2];
#define INW_VECS(kq_) do { _Pragma("unroll") for (int q4 = 0; q4 < 2; ++q4) { gq[q4] = *(const f32x4*)(ng + (kq_) + 4 * q4); s0q[q4] = *(const f32x4*)(mod0 + 1024 + (kq_) + 4 * q4); \
        s1q[q4] = *(const f32x4*)(mod0 + 9216 + 1024 + (kq_) + 4 * q4); h0q[q4] = *(const f32x4*)(mod0 + (kq_) + 4 * q4); h1q[q4] = *(const f32x4*)(mod0 + 9216 + (kq_) + 4 * q4); } } while (0)
    INW_VECS(64 * 8 * kh + 8 * c);
#pragma unroll 1
    for (int kb = 8 * kh; kb < 8 * kh + 8; ++kb) {
        const int k0 = 64 * kb, kq = k0 + 8 * c;
        tile_to_lds(w, scr, lane);
        float gm0[8], gm1[8], sh0[8], sh1[8];
#pragma unroll
        for (int q4 = 0; q4 < 2; ++q4)
#pragma unroll
            for (int e = 0; e < 4; ++e) { gm0[4 * q4 + e] = gq[q4][e] * (1.0f + s0q[q4][e]); gm1[4 * q4 + e] = gq[q4][e] * (1.0f + s1q[q4][e]); sh0[4 * q4 + e] = h0q[q4][e]; sh1[4 * q4 + e] = h1q[q4][e]; }
        if (kb + 1 < 8 * kh + 8) { tile_load(w, W, N, k0 + 64, n0, lane); INW_VECS(kq + 64); }
        LDS_WAIT(); asm volatile("" ::: "memory");
#pragma unroll
        for (int j = 0; j < 4; ++j) { const int n = (lane >> 3) + 8 * j; const LAS float* sp = scr + (8 * c) * 33 + n;
            float v[8];
#pragma unroll
            for (int e = 0; e < 8; ++e) v[e] = sp[e * 33];
            if (i8out) {
                u32x2 o; const float qi = qinv[j];
                o.x = pk4_i8(v[0] * qi, v[1] * qi, v[2] * qi, v[3] * qi); o.y = pk4_i8(v[4] * qi, v[5] * qi, v[6] * qi, v[7] * qi);
                *(GAS u32x2*)((unsigned char*)WT + (size_t)(dst0 + n) * 1024 + kq) = o;
            } else {
            u32x4 o0, o1;
            o0.x = cvtpk(v[0] * gm0[0], v[1] * gm0[1]); o0.y = cvtpk(v[2] * gm0[2], v[3] * gm0[3]); o0.z = cvtpk(v[4] * gm0[4], v[5] * gm0[5]); o0.w = cvtpk(v[6] * gm0[6], v[7] * gm0[7]);
            o1.x = cvtpk(v[0] * gm1[0], v[1] * gm1[1]); o1.y = cvtpk(v[2] * gm1[2], v[3] * gm1[3]); o1.z = cvtpk(v[4] * gm1[4], v[5] * gm1[5]); o1.w = cvtpk(v[6] * gm1[6], v[7] * gm1[7]);
            bf16* wp = WT + (size_t)(dst0 + n) * 1024 + kq;
            *(GAS u32x4*)(wp) = o0; *(GAS u32x4*)(wp + wt_bstride) = o1;
            }
            float d0 = 0.f, d1 = 0.f;
#pragma unroll
            for (int e = 0; e < 8; ++e) { d0 += v[e] * sh0[e]; d1 += v[e] * sh1[e]; }
            dacc[j][0] += d0; dacc[j][1] += d1; }
        LDS_WAIT(); asm volatile("" ::: "memory");
    }
    if (i8out && kh == 0 && c == 0) {
#pragma unroll
        for (int j = 0; j < 4; ++j) wexp[dst0 + (lane >> 3) + 8 * j] = (signed char)qex[j]; }
#pragma unroll
    for (int j = 0; j < 4; ++j)
#pragma unroll
        for (int bb = 0; bb < 2; ++bb) { float v = dacc[j][bb]; v += dppf<0xB1>(v); v += dppf<0x4E>(v); v += dppf<0x141>(v);
            if (c == 0) { const int n = (lane >> 3) + 8 * j; if (kh == 0 && extra) v += extra[n0 + n];
                __hip_atomic_fetch_add(bias + (size_t)bb * bias_bstride + dst0 + n, v, __ATOMIC_RELAXED, __HIP_MEMORY_SCOPE_AGENT); } }
}

#undef INW_VECS
__device__ __forceinline__ void phase_p0(LAS unsigned char* lds, int vcu, int G, int wave_in) {
    int tid = lane_id(); asm volatile("" : "+v"(tid)); tid += 64 * wave_in;
    const int lane = tid & 63, wave = __builtin_amdgcn_readfirstlane(tid >> 6);
    LAS float* cs = (LAS float*)lds;
    LAS float* red = (LAS float*)(lds + 8192);
    LAS float* scr = (LAS float*)(lds + 16384 + wave * 8704);
    unsigned char* const ws = PWS;
    float* MOD = (float*)(ws + WS_MOD);
    { const float* cin = PIN(1); for (int i = tid; i < 2048; i += 512) { const float v = cin[i]; cs[i] = v / (1.0f + expf(-v)); } }
    { float* bz = (float*)(ws + WS_BFFN); for (int i = vcu * 512 + tid; i < (192 + 32 + 16) * 256; i += G * 512) bz[i] = 0.f; }
    __syncthreads();
    for (int it = blockIdx.x; it < 288; it += G) {
        const int li = it / 144, cg = it % 144;
        const float* W = PIN(3) + (size_t)li * 1024 * 9216 + cg * 64 + lane; const float* adab = PIN(4);
        float a0 = 0.f, a1 = 0.f;
#pragma unroll 64
        for (int k = wave * 128; k < wave * 128 + 128; ++k) { const float w = W[(size_t)k * 9216]; a0 += cs[k] * w; a1 += cs[1024 + k] * w; }
        red[(wave * 2 + 0) * 64 + lane] = a0; red[(wave * 2 + 1) * 64 + lane] = a1;
        __syncthreads();
        if (tid < 128) { const int b = tid >> 6, l = tid & 63; float s = 0.f;
#pragma unroll
            for (int w = 0; w < 8; ++w) s += red[(w * 2 + b) * 64 + l];
            MOD[(size_t)(li * 2 + b) * 9216 + cg * 64 + l] = s + adab[li * 9216 + cg * 64 + l]; }
        __syncthreads();
    }
    const int gw = vcu * 8 + wave, NGW = G * 8;
    bf16* WOUT = (bf16*)(ws + WS_WOUT); bf16* WO = (bf16*)(ws + WS_WO); bf16* WPW2 = (bf16*)(ws + WS_WPW2);
    constexpr int I_OUT = 44 * 32, I_O = 16 * 32, I_PW2 = 16 * 32;
    constexpr int NITEMS = 4 * I_OUT + I_O + I_PW2;
    {
        const float* w6 = PIN(6); const float* w10 = PIN(10); const float* w17 = PIN(17);
#define OUTW_DECODE(it_, W_, K_, WT_, k0_, n0_) do { int r_ = (it_); \
            if (r_ < 4 * I_OUT) { const int f_ = r_ / I_OUT; r_ %= I_OUT; W_ = w6 + (size_t)f_ * 2816 * 1024; K_ = 2816; WT_ = WOUT + (size_t)f_ * 1024 * 2816; } \
            else if (r_ < 4 * I_OUT + I_O) { r_ -= 4 * I_OUT; W_ = w10; K_ = 1024; WT_ = WO; } \
            else { r_ -= 4 * I_OUT + I_O; W_ = w17; K_ = 1024; WT_ = WPW2; } \
            k0_ = 64 * (r_ / 32); n0_ = 32 * (r_ % 32); } while (0)
        float w[32]; const float* Wc; int Kc, k0c, n0c; bf16* WTc;
        if (gw < NITEMS) { OUTW_DECODE(gw, Wc, Kc, WTc, k0c, n0c); tile_load(w, Wc, 1024, k0c, n0c, lane); }
        for (int it = gw; it < NITEMS; it += NGW) {
            tile_to_lds(w, scr, lane);
            const float* Wn = Wc; int Kn = Kc, k0n = k0c, n0n = n0c; bf16* WTn = WTc;
            if (it + NGW < NITEMS) { OUTW_DECODE(it + NGW, Wn, Kn, WTn, k0n, n0n); tile_load(w, Wn, 1024, k0n, n0n, lane); }
            transpose_finish(Kc, WTc, k0c, n0c, scr, lane);
            Wc = Wn; Kc = Kn; k0c = k0n; n0c = n0n; WTc = WTn;
        }
#undef OUTW_DECODE
    }
    if (I8MASK) {
        const float* w5 = PIN(5); unsigned* CM = (unsigned*)(ws + WS_CMAX);
        for (int it = gw; it < 4 * 352; it += NGW) {
            const int f = it / 352, r = it % 352, seg = r % 22, rb = r / 22;
            if (!((I8MASK >> f) & 1)) continue;
            const float* p = w5 + (size_t)f * 1024 * 5632 + (size_t)(64 * rb) * 5632 + 256 * seg + 4 * lane;
            float m0 = 0.f, m1 = 0.f, m2 = 0.f, m3 = 0.f;
#pragma unroll 16
            for (int k = 0; k < 64; ++k) { const f32x4 v = *(const f32x4*)(p + (size_t)k * 5632); m0 = fmaxf(m0, fabsf(v.x)); m1 = fmaxf(m1, fabsf(v.y)); m2 = fmaxf(m2, fabsf(v.z)); m3 = fmaxf(m3, fabsf(v.w)); }
            unsigned* d = CM + f * 5632 + 256 * seg + 4 * lane;
            __hip_atomic_fetch_max(d + 0, f2u(m0), __ATOMIC_RELAXED, __HIP_MEMORY_SCOPE_AGENT); __hip_atomic_fetch_max(d + 1, f2u(m1), __ATOMIC_RELAXED, __HIP_MEMORY_SCOPE_AGENT);
            __hip_atomic_fetch_max(d + 2, f2u(m2), __ATOMIC_RELAXED, __HIP_MEMORY_SCOPE_AGENT); __hip_atomic_fetch_max(d + 3, f2u(m3), __ATOMIC_RELAXED, __HIP_MEMORY_SCOPE_AGENT);
        }
    }
    const float* x = PIN(0); bf16* XB = (bf16*)(ws + WS_XB); float* SSQ = (float*)(ws + WS_SSQ);
    {
        f32x4 v[2][4], vn[2][4];
#define XROWS_LOAD(dst, r0_) do { _Pragma("unroll") for (int r = 0; r < 2; ++r) _Pragma("unroll") for (int jj = 0; jj < 4; ++jj) \
            dst[r][jj] = ((r0_) + r * NGW < M_) ? *(const f32x4*)(x + (size_t)((r0_) + r * NGW) * D_ + 4 * lane + 256 * jj) : (f32x4){0.f, 0.f, 0.f, 0.f}; } while (0)
        XROWS_LOAD(vn, gw);
        for (int row0 = gw; row0 < M_; row0 += 2 * NGW) {
#pragma unroll
            for (int r = 0; r < 2; ++r)
#pragma unroll
                for (int jj = 0; jj < 4; ++jj) v[r][jj] = vn[r][jj];
            if (row0 + 2 * NGW < M_) XROWS_LOAD(vn, row0 + 2 * NGW);
#pragma unroll
            for (int r = 0; r < 2; ++r) { const int row = row0 + r * NGW; if (row >= M_) break; float ss = 0.f;
#pragma unroll
                for (int jj = 0; jj < 4; ++jj) { const int c = 4 * lane + 256 * jj; const f32x4 t = v[r][jj];
                    ss += (t[0] * t[0] + t[1] * t[1]) + (t[2] * t[2] + t[3] * t[3]);
                    u32x2 w; w.x = cvtpk(t[0], t[1]); w.y = cvtpk(t[2], t[3]);
                    *(u32x2*)(XB + (size_t)row * D_ + c) = w; }
                ss = wave_sum(ss);
                if (lane < 4) *(f32x4*)(SSQ + (size_t)row * 16 + 4 * lane) = (f32x4){lane == 0 ? ss : 0.f, 0.f, 0.f, 0.f}; }
        }
#undef XROWS_LOAD
    }
}

__device__ __forceinline__ void phase_p1(LAS unsigned char* lds, int vcu, int G, int wave_in) {
    int tid = lane_id(); asm volatile("" : "+v"(tid)); tid += 64 * wave_in;
    const int lane = tid & 63, wave = __builtin_amdgcn_readfirstlane(tid >> 6);
    LAS float* scr = (LAS float*)(lds + 16384 + wave * 8704);
    unsigned char* const ws = PWS; const float* ng = PIN(2);
    const float* MOD = (const float*)(ws + WS_MOD);
    float* COEF = (float*)(ws + WS_COEF);
    for (int i = vcu * 512 + tid; i < 6 * 2 * 1024; i += G * 512) {
        const int sl = i >> 11, b = (i >> 10) & 1, d = i & 1023, li = sl / 3, j = sl % 3;
        const float* mod = MOD + (size_t)(li * 2 + b) * 9216 + j * 3 * 1024;
        COEF[i] = ((j == 1) ? 1.0f : 0.5f) * mod[2048 + d];
    }
    const int gw = vcu * 8 + wave, NGW = G * 8;
    constexpr int I_IN = 176 * 2, I_QKV = 96 * 2, I_PW1 = 64 * 2;
    for (int it = gw; it < 4 * I_IN + I_QKV + I_PW1; it += NGW) {
        int r = it;
        if (r < 4 * I_IN) { const int f = r / I_IN; r %= I_IN; const int kh = (r >> 3) & 1, n0 = 32 * ((r >> 4) * 8 + (r & 7)), sl = (f >> 1) * 3 + (f & 1) * 2;
            inweight_item(PIN(5) + (size_t)f * 1024 * 5632, 5632, (bf16*)(ws + WS_WIN) + (size_t)f * 2 * 5632 * 1024, (size_t)5632 * 1024, kh, n0, gated_dst(n0, FF_),
                          ng + sl * 1024, MOD + (size_t)((sl / 3) * 2) * 9216 + (sl % 3) * 3 * 1024, (float*)(ws + WS_BFFN) + (size_t)f * 2 * 5632, 5632, nullptr, scr, lane, (I8MASK >> f) & 1, (const unsigned*)(ws + WS_CMAX) + f * 5632, (signed char*)(ws + WS_WEXP) + f * 5632); continue; }
        r -= 4 * I_IN;
        if (r < I_QKV) { const int kh = (r >> 3) & 1, n0 = 32 * ((r >> 4) * 8 + (r & 7)); const int part = n0 >> 10, head = (n0 & 1023) >> 6, e0 = n0 & 63;
            const int dst0 = 256 * (part * 4 + (head >> 2)) + 128 * (e0 >> 5) + 32 * (head & 3);
            inweight_item(PIN(7), 3072, (bf16*)(ws + WS_WQKV), (size_t)3072 * 1024, kh, n0, dst0, ng + 1 * 1024, MOD + 1 * 3 * 1024, (float*)(ws + WS_BQKV), 3072, nullptr, scr, lane); continue; }
        r -= I_QKV;
        { const int kh = (r >> 3) & 1, n0 = 32 * ((r >> 4) * 8 + (r & 7));
            inweight_item(PIN(11), 2048, (bf16*)(ws + WS_WPW1), (size_t)2048 * 1024, kh, n0, gated_dst(n0, 1024), ng + 4 * 1024, MOD + (size_t)2 * 9216 + 1 * 3 * 1024, (float*)(ws + WS_BPW1), 2048, PIN(12), scr, lane); }
    }
}

typedef float f32x2 __attribute__((ext_vector_type(2)));
__device__ __forceinline__ f32x2 bfpair(unsigned v) { return (f32x2){bflo(v), bfhi(v)}; }
__device__ __forceinline__ void conv_phase(LAS unsigned char* lds, int vcu, int G, int wave_in) {
    int tid = lane_id(); asm volatile("" : "+v"(tid)); tid += 64 * wave_in;
    const int lane = tid & 63, wave = __builtin_amdgcn_readfirstlane(tid >> 6), c0 = 2 * tid;
    LAS float* part = (LAS float*)lds;
    unsigned char* const ws = PWS;
    const bf16* U = (const bf16*)(ws + WS_U); bf16* CV = (bf16*)(ws + WS_CV);
    f32x2 w[31];
    { const float* wdw = PIN(13);
#pragma unroll
    for (int j = 0; j < 31; ++j) w[j] = *(const f32x2*)(wdw + j * D_ + c0); }
    f32x2 bd, lg, lb;
    { const float* p = PIN(14); bd = *(const f32x2*)(p + c0); p = PIN(15); lg = *(const f32x2*)(p + c0); p = PIN(16); lb = *(const f32x2*)(p + c0); }
    for (int un = vcu; un < 256; un += G) {
        const int b = un >> 7, t0 = (un & 127) * 128;
        const unsigned* Up = (const unsigned*)(U + (size_t)b * S_ * D_ + c0);
        unsigned* Op = (unsigned*)(CV + (size_t)b * S_ * D_ + c0);
        f32x2 hist[38];
        unsigned nx0[8], nx1[8];
#pragma unroll
        for (int i = 0; i < 8; ++i) { nx0[i] = Up[(size_t)(t0 + i) * 512]; nx1[i] = Up[(size_t)(t0 + 8 + i) * 512]; }
#pragma unroll
        for (int i = 0; i < 30; ++i) { const int tt = t0 - 30 + i; const unsigned v = (tt >= 0) ? Up[(size_t)tt * 512] : 0u; hist[i] = bfpair(v); }
        int pb = 0;
#pragma unroll 1
        for (int st = 0; st < 16; ++st) {
#pragma unroll
            for (int i = 0; i < 8; ++i) { hist[30 + i] = bfpair(nx0[i]); nx0[i] = nx1[i]; }
            if (st < 14) {
#pragma unroll
                for (int i = 0; i < 8; ++i) nx1[i] = Up[(size_t)(t0 + (st + 2) * 8 + i) * 512];
            }
            f32x2 y[8]; float stat[16];
#pragma unroll
            for (int tt = 0; tt < 8; ++tt) { f32x2 a = bd;
#pragma unroll
                for (int j = 0; j < 31; ++j) a += w[j] * hist[tt + j];
                y[tt] = a; stat[2 * tt] = a.x + a.y; stat[2 * tt + 1] = a.x * a.x + a.y * a.y; }
            float s1[8], s2[4];
#pragma unroll
            for (int k = 0; k < 8; ++k) { const auto r = __builtin_amdgcn_permlane32_swap(f2u(stat[k]), f2u(stat[k + 8]), false, false); const unsigned r0 = r[0], r1 = r[1]; s1[k] = u2f(r0) + u2f(r1); }
#pragma unroll
            for (int k = 0; k < 4; ++k) { const auto r = __builtin_amdgcn_permlane16_swap(f2u(s1[k]), f2u(s1[k + 4]), false, false); const unsigned r0 = r[0], r1 = r[1]; s2[k] = row_sum16(u2f(r0) + u2f(r1)); }
            if ((lane & 15) == 0) *(LAS f32x4*)(part + (pb * 8 + wave) * 16 + 4 * (lane >> 4)) = (f32x4){s2[0], s2[1], s2[2], s2[3]};
            LDS_BARRIER();
            f32x4 tot[4];
#pragma unroll
            for (int k = 0; k < 4; ++k) { tot[k] = (f32x4){0.f, 0.f, 0.f, 0.f};
#pragma unroll
                for (int ww = 0; ww < 8; ++ww) tot[k] += *(const LAS f32x4*)(part + (pb * 8 + ww) * 16 + 4 * k); }
#pragma unroll
            for (int tt = 0; tt < 8; ++tt) {
                const float sum = tot[tt >> 1][(tt & 1) * 2], sq = tot[tt >> 1][(tt & 1) * 2 + 1];
                const float mean = sum * (1.0f / D_), var = sq * (1.0f / D_) - mean * mean, rstd = __builtin_amdgcn_rsqf(var + EPS_);
                const f32x2 z = (y[tt] - mean) * rstd * lg + lb;
                const f32x2 e = z * (-LOG2E_);
                f32x2 d; d.x = __builtin_amdgcn_exp2f(e.x); d.y = __builtin_amdgcn_exp2f(e.y); d = d + 1.0f;
                f32x2 r; r.x = __builtin_amdgcn_rcpf(d.x); r.y = __builtin_amdgcn_rcpf(d.y);
                const f32x2 o = z * r;
                Op[(size_t)(t0 + st * 8 + tt) * 512] = cvtpk(o.x, o.y);
            }
#pragma unroll
            for (int i = 0; i < 30; ++i) hist[i] = hist[i + 8];
            pb ^= 1;
        }
    }
}
constexpr int CW_Q2 = 8192;
constexpr int A_KS = 0, A_VT = 36864, A_LIST = 70656, A_MISC = 103424;
__device__ __forceinline__ float attn_m0(const float* gq, const float* gk, int lane) {
    float a = fabsf(gq[lane]), b = fabsf(gk[lane]); a = wave_max(a); b = wave_max(b);
    return 8.0f * LOG2E_ * a * b * 1.02f + 0.25f;
}
__device__ __forceinline__ void stage_kv_load(u32x4 (&kk)[4], u32x4 (&vv)[4], const bf16* K, const bf16* V, size_t rowbase, int h, int tid) {
    const int r = tid >> 1, hf = tid & 1;
    const bf16* kp = K + (rowbase + r) * D_ + h * 64 + 32 * hf;
#pragma unroll
    for (int c = 0; c < 4; ++c) kk[c] = *(const u32x4*)(kp + 8 * c);
    const int p = tid >> 2, dq = tid & 3;
    const bf16* vp = V + (rowbase + 2 * p) * D_ + h * 64 + 16 * dq;
    vv[0] = *(const u32x4*)(vp); vv[1] = *(const u32x4*)(vp + 8); vv[2] = *(const u32x4*)(vp + D_); vv[3] = *(const u32x4*)(vp + D_ + 8);
}
__device__ __forceinline__ void stage_kv_store(LAS unsigned char* lds, const u32x4 (&kk)[4], const u32x4 (&vv)[4], int tid) {
    const int r = tid >> 1, hf = tid & 1;
#pragma unroll
    for (int c = 0; c < 4; ++c) *(LAS u32x4*)(lds + A_KS + r * 144 + (32 * hf + 8 * c) * 2) = kk[c];
    const int p = tid >> 2, dq = tid & 3;
    LAS unsigned* vt = (LAS unsigned*)(lds + A_VT) + p;
#pragma unroll
    for (int c = 0; c < 2; ++c)
#pragma unroll
        for (int e = 0; e < 4; ++e) { const unsigned a = (e == 0) ? vv[c].x : (e == 1) ? vv[c].y : (e == 2) ? vv[c].z : vv[c].w;
            const unsigned bb = (e == 0) ? vv[2 + c].x : (e == 1) ? vv[2 + c].y : (e == 2) ? vv[2 + c].z : vv[2 + c].w;
            const int d = 16 * dq + 8 * c + 2 * e;
            vt[d * 132] = (a & 0xffffu) | (bb << 16); vt[(d + 1) * 132] = (a >> 16) | (bb & 0xffff0000u); }
}
__device__ __forceinline__ void stage_kv(LAS unsigned char* lds, const bf16* K, const bf16* V, size_t rowbase, int h, int tid) {
    u32x4 kk[4], vv[4]; stage_kv_load(kk, vv, K, V, rowbase, h, tid); stage_kv_store(lds, kk, vv, tid);
}
__device__ __forceinline__ int alibi_dmax(float slope2, float M0) { return (int)fminf((2.0f * M0 + 40.0f) / slope2, 1.0e9f); }
template <bool MASK> __device__ __forceinline__ void attn_tile(LAS unsigned char* lds, int s8, const bf16x8 (&qf)[4], float rowc, float slope2, int lane, f32x16& o0, f32x16& o1, float& lsum, int maskq) {
    const int i = lane & 31, hi = lane >> 5;
    const int prow = (i & ~12) | ((i & 4) << 1) | ((i & 8) >> 1);
    const LAS unsigned char* kp = lds + A_KS + (32 * s8 + prow) * 144 + 16 * hi;
    const float cb = rowc + slope2 * (float)(32 * s8 + 8 * hi);
    f32x16 c;
#pragma unroll
    for (int r = 0; r < 16; ++r) c[r] = cb + slope2 * (float)(16 * (r >> 3) + (r & 7));
#pragma unroll
    for (int d0 = 0; d0 < 4; ++d0) { const bf16x8 kf = *(const LAS bf16x8*)(kp + 32 * d0); c = __builtin_amdgcn_mfma_f32_32x32x16_bf16(kf, qf[d0], c, 0, 0, 0); }
    if (MASK) {
#pragma unroll
        for (int r = 0; r < 16; ++r) if (16 * (r >> 3) + 8 * hi + (r & 7) > maskq) c[r] = -INFINITY;
    }
    float ls = 0.f;
#pragma unroll
    for (int r = 0; r < 16; ++r) { c[r] = __builtin_amdgcn_exp2f(c[r]); ls += c[r]; }
    lsum += ls;
    u32x4 p0, p1;
    p0.x = cvtpk(c[0], c[1]); p0.y = cvtpk(c[2], c[3]); p0.z = cvtpk(c[4], c[5]); p0.w = cvtpk(c[6], c[7]);
    p1.x = cvtpk(c[8], c[9]); p1.y = cvtpk(c[10], c[11]); p1.z = cvtpk(c[12], c[13]); p1.w = cvtpk(c[14], c[15]);
    const bf16x8 pf0 = __builtin_bit_cast(bf16x8, p0), pf1 = __builtin_bit_cast(bf16x8, p1);
    const LAS unsigned char* vp = lds + A_VT + (i * 264 + 32 * s8 + 8 * hi) * 2;
    { const bf16x8 v00 = *(const LAS bf16x8*)(vp), v01 = *(const LAS bf16x8*)(vp + 32), v10 = *(const LAS bf16x8*)(vp + 32 * 528), v11 = *(const LAS bf16x8*)(vp + 32 * 528 + 32);
      o0 = __builtin_amdgcn_mfma_f32_32x32x16_bf16(v00, pf0, o0, 0, 0, 0); o1 = __builtin_amdgcn_mfma_f32_32x32x16_bf16(v10, pf0, o1, 0, 0, 0);
      o0 = __builtin_amdgcn_mfma_f32_32x32x16_bf16(v01, pf1, o0, 0, 0, 0); o1 = __builtin_amdgcn_mfma_f32_32x32x16_bf16(v11, pf1, o1, 0, 0, 0); }
}
__device__ __forceinline__ bf16* op_ptr(unsigned char* ws, float* out, int rank) { return (rank == 2) ? (bf16*)(ws + WS_OP3) : (bf16*)out + (size_t)rank * ((size_t)M_ * D_); }

struct A2Item { int n, bh, b, h, tbeg, tlim, dmax; float slope2; };
__device__ __forceinline__ A2Item a2_decode(int item, float M0) {
    A2Item I; I.n = item >> 5; I.bh = item & 31; I.b = I.bh >> 4; I.h = I.bh & 15;
    I.slope2 = exp2f(-0.5f * (float)(I.h + 1)) * LOG2E_; I.dmax = alibi_dmax(I.slope2, M0);
    I.tbeg = (I.n + 1) * 256; I.tlim = min(S_, 256 * I.n + 256 + I.dmax); return I;
}
__device__ __forceinline__ void a2_load(const A2Item& I, u32x4 (&kk)[4], u32x4 (&vv)[4], u32x4 (&sv)[8], const bf16* K, const bf16* V, const unsigned* sel, int tid) {
    stage_kv_load(kk, vv, K, V, (size_t)I.b * S_ + 256 * I.n, I.h, tid);
    const unsigned* sp = sel + (size_t)I.bh * S_;
#pragma unroll
    for (int c = 0; c < 8; ++c) { const int t0 = I.tbeg + 2048 * c + 4 * tid;
        sv[c] = (u32x4){0xFFFFFFFFu, 0xFFFFFFFFu, 0xFFFFFFFFu, 0xFFFFFFFFu};
        if (I.tbeg + 2048 * c < I.tlim) { if (t0 < S_) sv[c] = *(const u32x4*)(sp + t0); } }
}
__device__ __forceinline__ void a2_phase(LAS unsigned char* lds, int wave_in, int qword) {
    int tid = lane_id(); asm volatile("" : "+v"(tid)); tid += 64 * wave_in;
    const int lane = tid & 63, wave = __builtin_amdgcn_readfirstlane(tid >> 6), q = lane & 31, hi = lane >> 5;
    unsigned char* const ws = PWS;
    const bf16* Q = (const bf16*)(ws + WS_Q); const bf16* K = (const bf16*)(ws + WS_K); const bf16* V = (const bf16*)(ws + WS_V);
    const unsigned* sel = (const unsigned*)(ws + WS_SEL); unsigned* ctl = (unsigned*)(ws + WS_CTL); float* LP = (float*)(ws + WS_LP); float* const outp = POUT;
    const float M0 = attn_m0(PIN(8), PIN(9), lane);
    LAS unsigned short* list = (LAS unsigned short*)(lds + A_LIST); volatile LAS int* misc = (volatile LAS int*)(lds + A_MISC);
    constexpr int NIT = 63 * 32;
    int t_cur = 0, t_nxt = 0;
    if (tid == 0) { t_cur = (int)__hip_atomic_fetch_add(ctl + qword, 1u, __ATOMIC_RELAXED, __HIP_MEMORY_SCOPE_AGENT); t_nxt = (int)__hip_atomic_fetch_add(ctl + qword, 1u, __ATOMIC_RELAXED, __HIP_MEMORY_SCOPE_AGENT); }
    LDS_BARRIER();
    if (tid == 0) { misc[0] = t_cur; misc[2] = t_nxt; misc[1] = 0; }
    LDS_BARRIER();
    int item = __builtin_amdgcn_readfirstlane(misc[0]), item_n = __builtin_amdgcn_readfirstlane(misc[2]);
    u32x4 kk[4], vv[4], sv[8];
    if (item < NIT) { const A2Item I0 = a2_decode(item, M0); a2_load(I0, kk, vv, sv, K, V, sel, tid); }
    while (item < NIT) {
        const A2Item I = a2_decode(item, M0);
        const int n = I.n, b = I.b, h = I.h, dmax = I.dmax; const float slope2 = I.slope2;
        int t_nn = 0;
        if (tid == 0) t_nn = (int)__hip_atomic_fetch_add(ctl + qword, 1u, __ATOMIC_RELAXED, __HIP_MEMORY_SCOPE_AGENT);
        stage_kv_store(lds, kk, vv, tid);
#pragma unroll
        for (int c = 0; c < 8; ++c) {
            if (I.tbeg + 2048 * c < I.tlim) {
#pragma unroll
                for (int e = 0; e < 4; ++e) {
                    const unsigned s = (e == 0) ? sv[c].x : (e == 1) ? sv[c].y : (e == 2) ? sv[c].z : sv[c].w;
                    const int t = I.tbeg + 2048 * c + 4 * tid + e;
                    int rank = ((s & 255u) == (unsigned)n) ? 0 : (((s >> 8) & 255u) == (unsigned)n) ? 1 : (((s >> 16) & 255u) == (unsigned)n) ? 2 : -1;
                    if (t - 256 * n - 255 > dmax) rank = -1;
                    const unsigned long long bal = __ballot(rank >= 0);
                    if (bal) {
                        const int pre = __builtin_amdgcn_mbcnt_hi((unsigned)(bal >> 32), __builtin_amdgcn_mbcnt_lo((unsigned)bal, 0u));
                        int base = 0;
                        if (lane == 0) base = __hip_atomic_fetch_add((LAS int*)(lds + A_MISC) + 1, __popcll(bal), __ATOMIC_RELAXED, __HIP_MEMORY_SCOPE_WORKGROUP);
                        base = __builtin_amdgcn_readfirstlane(base);
                        if (rank >= 0) list[base + pre] = (unsigned short)(t | (rank << 14));
                    }
                }
            }
        }
        if (item_n < NIT) { const A2Item In = a2_decode(item_n, M0); a2_load(In, kk, vv, sv, K, V, sel, tid); }
        LDS_BARRIER();
        const int total = __builtin_amdgcn_readfirstlane(misc[1]);
        const int nr = (total + 255) >> 8;
        bf16x8 qn[4]; unsigned en = 0u;
        if (32 * wave < total) { const int idx = 32 * wave + q; en = list[(idx < total) ? idx : 32 * wave];
            const size_t rown = (size_t)b * S_ + (en & 16383);
#pragma unroll
            for (int d0 = 0; d0 < 4; ++d0) qn[d0] = *(const bf16x8*)(Q + rown * D_ + h * 64 + 16 * d0 + 8 * hi); }
        for (int r = 0; r < nr; ++r) {
            const int i0 = 256 * r + 32 * wave;
            if (i0 < total) {
                const int idx = i0 + q; const bool valid = idx < total;
                const unsigned e = en;
                const int t = e & 16383, rank = e >> 14;
                const size_t row = (size_t)b * S_ + t;
                bf16x8 qf[4];
#pragma unroll
                for (int d0 = 0; d0 < 4; ++d0) qf[d0] = qn[d0];
                if (i0 + 256 < total) { const int idx2 = idx + 256; en = list[(idx2 < total) ? idx2 : i0 + 256];
                    const size_t rown = (size_t)b * S_ + (en & 16383);
#pragma unroll
                    for (int d0 = 0; d0 < 4; ++d0) qn[d0] = *(const bf16x8*)(Q + rown * D_ + h * 64 + 16 * d0 + 8 * hi); }
                const float rowc = -slope2 * (float)(t - 256 * n) - M0;
                f32x16 o0, o1; float lsum = 0.f;
#pragma unroll
                for (int k = 0; k < 16; ++k) { o0[k] = 0.f; o1[k] = 0.f; }
#pragma unroll 2
                for (int s8 = 0; s8 < 8; ++s8) attn_tile<false>(lds, s8, qf, rowc, slope2, lane, o0, o1, lsum, 0);
                lsum = sum32(lsum);
                if (valid) {
                    bf16* op = op_ptr(ws, outp, rank) + row * D_ + h * 64 + 4 * hi;
#pragma unroll
                    for (int g = 0; g < 4; ++g) {
                        u32x2 w0, w1; w0.x = cvtpk(o0[4 * g], o0[4 * g + 1]); w0.y = cvtpk(o0[4 * g + 2], o0[4 * g + 3]);
                        w1.x = cvtpk(o1[4 * g], o1[4 * g + 1]); w1.y = cvtpk(o1[4 * g + 2], o1[4 * g + 3]);
                        *(u32x2*)(op + 8 * g) = w0; *(u32x2*)(op + 32 + 8 * g) = w1; }
                    if (hi == 0) LP[((size_t)rank * M_ + row) * 16 + h] = lsum;
                }
            }
        }
        LDS_BARRIER();
        if (tid == 0) { misc[0] = item_n; misc[2] = t_nn; misc[1] = 0; }
        LDS_BARRIER();
        item = __builtin_amdgcn_readfirstlane(misc[0]); item_n = __builtin_amdgcn_readfirstlane(misc[2]);
    }
}

__device__ __forceinline__ void a3_phase(LAS unsigned char* lds, int vcu, int G, int wave_in) {
    int tid = lane_id(); asm volatile("" : "+v"(tid)); tid += 64 * wave_in;
    const int lane = tid & 63, wave = __builtin_amdgcn_readfirstlane(tid >> 6), q = lane & 31, hi = lane >> 5;
    unsigned char* const ws = PWS;
    bf16* Q = (bf16*)(ws + WS_Q); const bf16* K = (const bf16*)(ws + WS_K); const bf16* V = (const bf16*)(ws + WS_V);
    const unsigned* sel = (const unsigned*)(ws + WS_SEL); const float* LP = (const float*)(ws + WS_LP); float* const outp = POUT;
    const float M0 = attn_m0(PIN(8), PIN(9), lane);
    u32x4 kk[4], vv[4];
    if (vcu < 2048) { const int bh = vcu >> 6, m = vcu & 63; stage_kv_load(kk, vv, K, V, (size_t)(bh >> 4) * S_ + 256 * m, bh & 15, tid); }
    for (int un = vcu; un < 2048; un += G) {
        const int bh = un >> 6, m = un & 63, b = bh >> 4, h = bh & 15;
        const float slope2 = exp2f(-0.5f * (float)(h + 1)) * LOG2E_;
        LDS_BARRIER();
        stage_kv_store(lds, kk, vv, tid);
        { const int un2 = un + G; if (un2 < 2048) { const int bh2 = un2 >> 6, m2 = un2 & 63; stage_kv_load(kk, vv, K, V, (size_t)(bh2 >> 4) * S_ + 256 * m2, bh2 & 15, tid); } }
        const int t = 256 * m + 32 * wave + q; const size_t row = (size_t)b * S_ + t;
        bf16x8 qf[4];
#pragma unroll
        for (int d0 = 0; d0 < 4; ++d0) qf[d0] = *(const bf16x8*)(Q + row * D_ + h * 64 + 16 * d0 + 8 * hi);
        const unsigned s = sel[(size_t)bh * S_ + t];
        float lp[3]; u32x2 pw[3][8];
#pragma unroll
        for (int rank = 0; rank < 3; ++rank) {
            lp[rank] = LP[((size_t)rank * M_ + row) * 16 + h];
            const bf16* op = op_ptr(ws, outp, rank) + row * D_ + h * 64 + 4 * hi;
#pragma unroll
            for (int g = 0; g < 4; ++g) { pw[rank][g] = *(const u32x2*)(op + 8 * g); pw[rank][4 + g] = *(const u32x2*)(op + 32 + 8 * g); }
        }
        LDS_BARRIER();
        const float rowc = -slope2 * (float)(32 * wave + q) - M0;
        f32x16 o0, o1; float lsum = 0.f;
#pragma unroll
        for (int k = 0; k < 16; ++k) { o0[k] = 0.f; o1[k] = 0.f; }
        for (int s8 = 0; s8 < wave; ++s8) attn_tile<false>(lds, s8, qf, rowc, slope2, lane, o0, o1, lsum, 0);
        attn_tile<true>(lds, wave, qf, rowc, slope2, lane, o0, o1, lsum, q);
        float l = sum32(lsum);
        const int dmax = alibi_dmax(slope2, M0);
#pragma unroll
        for (int rank = 0; rank < 3; ++rank) {
            const int nb = (int)((s >> (8 * rank)) & 255u);
            if (nb != 255 && (t - 256 * nb - 255) <= dmax) {
                l += lp[rank];
#pragma unroll
                for (int g = 0; g < 4; ++g) { const u32x2 w0 = pw[rank][g], w1 = pw[rank][4 + g];
                    o0[4 * g] += bflo(w0.x); o0[4 * g + 1] += bfhi(w0.x); o0[4 * g + 2] += bflo(w0.y); o0[4 * g + 3] += bfhi(w0.y);
                    o1[4 * g] += bflo(w1.x); o1[4 * g + 1] += bfhi(w1.x); o1[4 * g + 2] += bflo(w1.y); o1[4 * g + 3] += bfhi(w1.y); }
            }
        }
        const float inv = 1.0f / l;
        bf16* op = Q + row * D_ + h * 64 + 4 * hi;
#pragma unroll
        for (int g = 0; g < 4; ++g) {
            u32x2 w0, w1; w0.x = cvtpk(o0[4 * g] * inv, o0[4 * g + 1] * inv); w0.y = cvtpk(o0[4 * g + 2] * inv, o0[4 * g + 3] * inv);
            w1.x = cvtpk(o1[4 * g] * inv, o1[4 * g + 1] * inv); w1.y = cvtpk(o1[4 * g + 2] * inv, o1[4 * g + 3] * inv);
            *(u32x2*)(op + 8 * g) = w0; *(u32x2*)(op + 32 + 8 * g) = w1; }
    }
}

constexpr int A1_KH = 0, A1_KL = 9216;
__device__ __forceinline__ void top3_ins(float v, int n, float& v0, float& v1, float& v2, int& i0, int& i1, int& i2) {
    const bool c0 = v > v0, c1 = v > v1, c2 = v > v2;
    v2 = c1 ? v1 : (c2 ? v : v2); i2 = c1 ? i1 : (c2 ? n : i2);
    v1 = c0 ? v0 : (c1 ? v : v1); i1 = c0 ? i0 : (c1 ? n : i1);
    v0 = c0 ? v : v0;             i0 = c0 ? n : i0;
}
__device__ __forceinline__ void a1_phase(LAS unsigned char* lds, int vcu, int G, int wave_in) {
    int tid = lane_id(); asm volatile("" : "+v"(tid)); tid += 64 * wave_in;
    const int lane = tid & 63, wave = __builtin_amdgcn_readfirstlane(tid >> 6), q = lane & 31, hi = lane >> 5;
    unsigned char* const ws = PWS;
    const bf16* Q = (const bf16*)(ws + WS_Q); const float* kbarp = (const float*)(ws + WS_KBAR); unsigned* sel = (unsigned*)(ws + WS_SEL);
    for (int un = vcu; un < 256; un += G) {
        const int bh = un >> 3, mg = un & 7, b = bh >> 4, h = bh & 15;
        LDS_BARRIER();
        { const int n = tid >> 3, d0 = (tid & 7) * 8;
          const float* p = kbarp + ((size_t)bh * 64 + n) * 128 + d0;
          const f32x4 a0 = *(const f32x4*)p, a1 = *(const f32x4*)(p + 4), b0 = *(const f32x4*)(p + 64), b1 = *(const f32x4*)(p + 68);
          const f32x4 v0 = (a0 + b0) * (1.0f / 256.0f), v1 = (a1 + b1) * (1.0f / 256.0f);
          unsigned hb[8], lb[8];
#pragma unroll
          for (int e = 0; e < 8; ++e) { const float v = (e < 4) ? v0[e & 3] : v1[e & 3]; hb[e] = f2bf(v); lb[e] = f2bf(v - bf2f(hb[e])); }
          u32x4 wh, wl; wh.x = hb[0] | (hb[1] << 16); wh.y = hb[2] | (hb[3] << 16); wh.z = hb[4] | (hb[5] << 16); wh.w = hb[6] | (hb[7] << 16);
          wl.x = lb[0] | (lb[1] << 16); wl.y = lb[2] | (lb[3] << 16); wl.z = lb[4] | (lb[5] << 16); wl.w = lb[6] | (lb[7] << 16);
          *(LAS u32x4*)(lds + A1_KH + n * 144 + d0 * 2) = wh; *(LAS u32x4*)(lds + A1_KL + n * 144 + d0 * 2) = wl; }
        LDS_BARRIER();
        bf16x8 qn[4];
        { const size_t row0 = (size_t)b * S_ + 256 * (mg * 8) + 32 * wave + q;
#pragma unroll
          for (int d0 = 0; d0 < 4; ++d0) qn[d0] = *(const bf16x8*)(Q + row0 * D_ + h * 64 + 16 * d0 + 8 * hi); }
        for (int mi = 0; mi < 8; ++mi) {
            const int m = mg * 8 + mi, t = 256 * m + 32 * wave + q;
            bf16x8 qf[4];
#pragma unroll
            for (int d0 = 0; d0 < 4; ++d0) qf[d0] = qn[d0];
            if (mi < 7) { const size_t rown = (size_t)b * S_ + t + 256;
#pragma unroll
                for (int d0 = 0; d0 < 4; ++d0) qn[d0] = *(const bf16x8*)(Q + rown * D_ + h * 64 + 16 * d0 + 8 * hi); }
            if (m == 0) { if (hi == 0) sel[(size_t)bh * S_ + t] = 0x00FFFFFFu; continue; }
            f32x16 c0, c1;
#pragma unroll
            for (int k = 0; k < 16; ++k) { c0[k] = 0.f; c1[k] = 0.f; }
            const LAS unsigned char* kp = lds + q * 144 + 16 * hi;
#pragma unroll
            for (int d0 = 0; d0 < 4; ++d0) {
                const bf16x8 h0 = *(const LAS bf16x8*)(kp + A1_KH + 32 * d0), h1 = *(const LAS bf16x8*)(kp + A1_KH + 32 * 144 + 32 * d0);
                const bf16x8 l0 = *(const LAS bf16x8*)(kp + A1_KL + 32 * d0), l1 = *(const LAS bf16x8*)(kp + A1_KL + 32 * 144 + 32 * d0);
                c0 = __builtin_amdgcn_mfma_f32_32x32x16_bf16(h0, qf[d0], c0, 0, 0, 0); c1 = __builtin_amdgcn_mfma_f32_32x32x16_bf16(h1, qf[d0], c1, 0, 0, 0);
                c0 = __builtin_amdgcn_mfma_f32_32x32x16_bf16(l0, qf[d0], c0, 0, 0, 0); c1 = __builtin_amdgcn_mfma_f32_32x32x16_bf16(l1, qf[d0], c1, 0, 0, 0);
            }
            float v0 = -INFINITY, v1 = -INFINITY, v2 = -INFINITY; int i0 = 255, i1 = 255, i2 = 255;
#pragma unroll
            for (int r = 0; r < 16; ++r) { const int n = (r & 3) + 8 * (r >> 2) + 4 * hi; top3_ins((n < m) ? c0[r] : -INFINITY, n, v0, v1, v2, i0, i1, i2); }
#pragma unroll
            for (int r = 0; r < 16; ++r) { const int n = 32 + (r & 3) + 8 * (r >> 2) + 4 * hi; top3_ins((n < m) ? c1[r] : -INFINITY, n, v0, v1, v2, i0, i1, i2); }
            const float pv0 = __builtin_bit_cast(float, other32(__builtin_bit_cast(unsigned, v0), hi)), pv1 = __builtin_bit_cast(float, other32(__builtin_bit_cast(unsigned, v1), hi)), pv2 = __builtin_bit_cast(float, other32(__builtin_bit_cast(unsigned, v2), hi));
            const int pi0 = (int)other32((unsigned)i0, hi), pi1 = (int)other32((unsigned)i1, hi), pi2 = (int)other32((unsigned)i2, hi);
            top3_ins(pv0, pi0, v0, v1, v2, i0, i1, i2); top3_ins(pv1, pi1, v0, v1, v2, i0, i1, i2); top3_ins(pv2, pi2, v0, v1, v2, i0, i1, i2);
            if (hi == 0) sel[(size_t)bh * S_ + t] = (unsigned)i0 | ((unsigned)i1 << 8) | ((unsigned)i2 << 16);
        }
    }
}
#ifndef MK_MULTI
#define MK_MULTI 0
#endif
constexpr int NPH = 18;
struct Args { const float* in[19]; float* out; unsigned char* ws; int lo, hi; };
__global__ void __launch_bounds__(512, 2) fwd(Args a) {
    extern __shared__ __attribute__((aligned(16))) unsigned char lds_raw[];
    LAS unsigned char* lds = (LAS unsigned char*)lds_raw;
    const int tid = threadIdx.x, G = gridDim.x; const int wave = __builtin_amdgcn_readfirstlane(tid >> 6);
    const int vcu = (G % 8 == 0) ? ((int)blockIdx.x % 8) * (G / 8) + (int)blockIdx.x / 8 : (int)blockIdx.x;
    volatile LAS unsigned* MISC = (volatile LAS unsigned*)(lds + MISC_OFF);
    for (int u = tid; u < (LDS_BYTES - LDSCTL_OFF) / 4; u += 512) ((LAS unsigned*)(lds + LDSCTL_OFF))[u] = 0u;
    __syncthreads();
    if (tid == 0) {
        LAS unsigned long long* PT = (LAS unsigned long long*)(lds + PT_OFF);
#pragma unroll
        for (int i = 0; i < 19; ++i) PT[i] = (unsigned long long)a.in[i];
        PT[19] = (unsigned long long)a.out; PT[20] = (unsigned long long)a.ws;
        ((LAS int*)(lds + PT_OFF))[48] = a.lo; ((LAS int*)(lds + PT_OFF))[49] = a.hi;
    }
    __syncthreads();
    if (a.hi - a.lo > 1) (void)xcd_barrier_post((unsigned*)(a.ws + WS_CTL) + CW_BAR, MISC + 8);
#define LO (__builtin_amdgcn_readfirstlane(((volatile LAS int*)(lds + PT_OFF))[48]))
#define HI (__builtin_amdgcn_readfirstlane(((volatile LAS int*)(lds + PT_OFF))[49]))
#define IN(k) (LO <= (k) && (k) < HI)
#define SEAM(k) do { if (IN(k) && IN((k) + 1)) { XcdBarrier bar_; bar_.bar = (unsigned*)(PWS + WS_CTL) + CW_BAR; bar_.x = xb_xcc_id(); bar_.st = MISC + 8; xcd_barrier(bar_); } } while (0)

    if (IN(0)) { __syncthreads(); phase_p0(lds, vcu, G, wave); }
    SEAM(0);
    if (IN(1)) { __syncthreads(); phase_p1(lds, vcu, G, wave); }
    SEAM(1);

    int ph = 2;
#pragma unroll 1
    for (int sl = 0; sl < 6; ++sl) {
        if (sl == 1) {
            if (IN(ph)) { __syncthreads(); unsigned char* const ws = PWS;
                EpiQKV E{(bf16*)(ws + WS_Q), (const float*)(ws + WS_BQKV), (const float*)(ws + ((sl & 1) ? WS_SSQ1 : WS_SSQ)), PIN(8), PIN(9), (float*)(ws + WS_KBAR), lds};
                __syncthreads(); run_gemm(lds, (const bf16*)(ws + WS_XB), (const bf16*)(ws + WS_WQKV), 3072L * 1024 * 2, 3072, 1024, G, E, wave);
            }
            SEAM(ph); ++ph;
            if (IN(ph)) { __syncthreads(); a1_phase(lds, vcu, G, wave); }
            SEAM(ph); ++ph;
            if (IN(ph)) { __syncthreads(); a2_phase(lds, wave, CW_Q2); }
            SEAM(ph); ++ph;
            if (IN(ph)) { __syncthreads(); a3_phase(lds, vcu, G, wave); }
            SEAM(ph); ++ph;
        } else if (sl == 4) {
            if (IN(ph)) { __syncthreads(); unsigned char* const ws = PWS;
                EpiGated<1> E{(bf16*)(ws + WS_U), 1024, (const float*)(ws + WS_BPW1), 2048, (const float*)(ws + ((sl & 1) ? WS_SSQ1 : WS_SSQ)), lds, nullptr, nullptr, nullptr, nullptr};
                __syncthreads(); run_gemm(lds, (const bf16*)(ws + WS_XB), (const bf16*)(ws + WS_WPW1), 2048L * 1024 * 2, 2048, 1024, G, E, wave);
            }
            SEAM(ph); ++ph;
            if (IN(ph)) { __syncthreads(); conv_phase(lds, vcu, G, wave); }
            SEAM(ph); ++ph;
        } else {
            const int f = (sl / 3) * 2 + ((sl % 3) == 2);
            if (IN(ph)) { __syncthreads(); unsigned char* const ws = PWS;
                const float* ssq_cur = (const float*)(ws + ((sl & 1) ? WS_SSQ1 : WS_SSQ)); const float* ssq_prv = (const float*)(ws + ((sl & 1) ? WS_SSQ : WS_SSQ1));
                if ((I8MASK >> f) & 1) {
                    EpiGated<0, true> E{(bf16*)(ws + WS_ACT), FF_, (const float*)(ws + WS_BFFN) + (size_t)f * 2 * 5632, 5632, ssq_cur, lds, ssq_prv, (const signed char*)(ws + WS_WEXP) + f * 5632,
                                        PIN(2) + sl * 1024, (const float*)(ws + WS_MOD) + (size_t)((sl / 3) * 2) * 9216 + (sl % 3) * 3 * 1024 + 1024};
                    __syncthreads(); run_gemm<EpiGated<0, true>, true>(lds, (const bf16*)(ws + WS_X8), (const bf16*)(ws + WS_WIN) + (size_t)f * 2 * 5632 * 1024, 0L, 5632, 512, G, E, wave);
                } else {
                EpiGated<0> E{(bf16*)(ws + WS_ACT), FF_, (const float*)(ws + WS_BFFN) + (size_t)f * 2 * 5632, 5632, ssq_cur, lds, nullptr, nullptr, nullptr, nullptr};
                __syncthreads(); run_gemm(lds, (const bf16*)(ws + WS_XB), (const bf16*)(ws + WS_WIN) + (size_t)f * 2 * 5632 * 1024, 5632L * 1024 * 2, 5632, 1024, G, E, wave);
                }
            }
            SEAM(ph); ++ph;
        }
        if (IN(ph)) { __syncthreads(); unsigned char* const ws = PWS; float* const out = POUT;
            const bf16* Ares; const bf16* Wres; int Kres; const float* bias2 = nullptr;
            if (sl == 1) { Ares = (const bf16*)(ws + WS_Q); Wres = (const bf16*)(ws + WS_WO); Kres = 1024; }
            else if (sl == 4) { Ares = (const bf16*)(ws + WS_CV); Wres = (const bf16*)(ws + WS_WPW2); Kres = 1024; bias2 = PIN(18); }
            else { const int f = (sl / 3) * 2 + ((sl % 3) == 2); Ares = (const bf16*)(ws + WS_ACT); Wres = (const bf16*)(ws + WS_WOUT) + (size_t)f * 1024 * 2816; Kres = FF_; }
            const int fnext = (sl == 1) ? 1 : (sl == 2) ? 2 : (sl == 4) ? 3 : -1;
            const bool q8 = fnext >= 0 && ((I8MASK >> fnext) & 1); const int sn = sl + 1;
            EpiRes E{(bf16*)(ws + WS_XB), out, bias2, (const float*)(ws + WS_COEF) + (size_t)sl * 2048, (float*)(ws + ((sl & 1) ? WS_SSQ : WS_SSQ1)), (sl == 5) ? 1 : 0, lds,
                     q8 ? ws + WS_X8 : nullptr, (const float*)(ws + ((sl & 1) ? WS_SSQ1 : WS_SSQ)), PIN(2) + sn * 1024, (const float*)(ws + WS_MOD) + (size_t)((sn / 3) * 2) * 9216 + (sn % 3) * 3 * 1024 + 1024};
            run_gemm(lds, Ares, Wres, 0L, 1024, Kres, G, E, wave);
        }
        SEAM(ph); ++ph;
    }
#undef IN
#undef SEAM
}

extern "C" void kernel_launch(void* const* d_in, const int* in_sizes, int n_in, void* d_out, int out_size, void* d_ws, size_t ws_size, hipStream_t stream) {
    static int grid = 0;
    if (grid == 0) {
        if (n_in != 19 || in_sizes[0] != M_ * D_ || out_size != M_ * D_ || ws_size < WS_END) {
            fprintf(stderr, "kernel_launch: unexpected problem (n_in %d, in0 %d, out %d, ws %zu); nothing launched\n", n_in, n_in > 0 ? in_sizes[0] : -1, out_size, ws_size); grid = -1; return; }
        int dev = 0, cus = 0;
        if (hipGetDevice(&dev) != hipSuccess || hipDeviceGetAttribute(&cus, hipDeviceAttributeMultiprocessorCount, dev) != hipSuccess) { grid = -1; return; }
        if (hipFuncSetAttribute((const void*)fwd, hipFuncAttributeMaxDynamicSharedMemorySize, LDS_BYTES) != hipSuccess) { fprintf(stderr, "kernel_launch: hipFuncSetAttribute failed\n"); grid = -1; return; }
        int per_cu = 0;
        if (hipOccupancyMaxActiveBlocksPerMultiprocessor(&per_cu, (const void*)fwd, 512, LDS_BYTES) != hipSuccess || per_cu < 1) fprintf(stderr, "kernel_launch: occupancy query reports %d blocks per CU\n", per_cu);
        (void)hipGetLastError();
        grid = cus;
    }
    if (grid < 0) return;
    if (hipMemsetAsync((char*)d_ws + WS_CTL, 0, CTL_ZERO_BYTES, stream) != hipSuccess) return;
    Args a{};
    for (int i = 0; i < 19; ++i) a.in[i] = (const float*)d_in[i];
    a.out = (float*)d_out; a.ws = (unsigned char*)d_ws;
#if MK_MULTI
    for (int p = 0; p < NPH; ++p) { a.lo = p; a.hi = p + 1; hipLaunchKernelGGL(fwd, dim3(grid), dim3(512), LDS_BYTES, stream, a); }
#else
    a.lo = 0; a.hi = NPH; hipLaunchKernelGGL(fwd, dim3(grid), dim3(512), LDS_BYTES, stream, a);
#endif
}
```

```cpp
#define I8MASK 15
#include <hip/hip_runtime.h>
#include <cstdio>
#include <cstdint>
#include <cmath>
namespace pg8 {
#define PG8_LAS __attribute__((address_space(3)))
typedef unsigned short bf16_t;
typedef short bf16x8 __attribute__((ext_vector_type(8)));
typedef float f32x4 __attribute__((ext_vector_type(4)));
typedef unsigned u32x4 __attribute__((ext_vector_type(4)));
constexpr int BM = 256, BK = 64, HALF = 128, HTB = HALF * BK * 2  , STAGE_BYTES = 8 * HTB, NXCD = 8, WGM = 8;

__host__ __device__ __forceinline__ int lds_byte(int r, int c) { const int st = (r >> 4) * 2 + (c >> 5), rr = r & 15, cc = c & 31, ob = rr * 64 + cc * 2; return st * 1024 + (ob ^ (((ob >> 9) & 1) << 5)); }
__host__ __device__ __forceinline__ void stage_rc(int b, int& R, int& C) { const int st = b / 1024, sb = b % 1024, swz = sb ^ (((sb >> 9) & 1) << 5); R = (st >> 1) * 16 + swz / 64; C = (st & 1) * 32 + (swz % 64) / 2; }
__host__ __device__ __forceinline__ int perm32(int rho) { const int n = rho >> 4, i = rho & 15; return 8 * (i >> 2) + 4 * n + (i & 3); }

struct Unit { int pm, pn; };
struct Gemm { const bf16_t* A; const bf16_t* Bt; int M, N, K; long bb; };

struct StaticOrder {
    int nM, nN, nwg, G, c;
    __host__ __device__ void init(int M, int N, int G_, int c_) { nM = M / BM; nN = N / BM; nwg = nM * nN; G = G_; c = c_; }
    __host__ __device__ bool next(int i, Unit& u) const {
        const long L = (long)i * G + c; if (L >= nwg) return false;
        int wgid = (int)L; { const int q = nwg / NXCD, r = nwg % NXCD, xcd = wgid % NXCD, off = wgid / NXCD; wgid = (xcd < r ? xcd * (q + 1) : r * (q + 1) + (xcd - r) * q) + off; }
        const int nig = WGM * nN, gid = wgid / nig, fm = gid * WGM, gsz = (nM - fm) < WGM ? (nM - fm) : WGM;
        u.pm = fm + ((wgid % nig) % gsz); u.pn = (wgid % nig) / gsz; return true;
    }
    __device__ __forceinline__ void a_ready(const Unit&) const {}
    __device__ __forceinline__ void done(const Unit&) const {}
};

__device__ __forceinline__ unsigned cvt_pk_bf16(float lo, float hi) { unsigned r; asm volatile("v_cvt_pk_bf16_f32 %0, %1, %2" : "=v"(r) : "v"(lo), "v"(hi)); return r; }
typedef float f32x2 __attribute__((ext_vector_type(2)));
template <class Epi, class Sched, bool ALIGN_EPI = false, bool SP2 = false, bool F8 = false>
__device__ __forceinline__ void gemm_phase(PG8_LAS unsigned char* lds, const Gemm g, const Sched& S, const Epi& E, const int tid_in) {
    typedef int pg8_i32x8 __attribute__((ext_vector_type(8))); typedef int pg8_i32x4 __attribute__((ext_vector_type(4)));
    const int tid = tid_in, wid = __builtin_amdgcn_readfirstlane(tid >> 6), lane = tid & 63, wr = wid >> 2, wc = wid & 3, fr = lane & 15, fq = lane >> 4;
    const int K = g.K, nt = K / BK;
    unsigned voffA[2], voffB[2];
#pragma unroll
    for (int i = 0; i < 2; ++i) { int R, C; stage_rc(tid * 16 + i * 8192, R, C); const int Rb = Epi::PERM ? ((R & ~31) + perm32(R & 31)) : R;
        voffA[i] = (unsigned)(R * K + C) * 2u; voffB[i] = (unsigned)(Rb * K + C) * 2u; }
    const unsigned long long pa_ = (unsigned long long)g.A, pb_ = (unsigned long long)g.Bt;
    void* const ua_ = (void*)(((unsigned long long)(unsigned)__builtin_amdgcn_readfirstlane((int)(pa_ >> 32)) << 32) | (unsigned long long)(unsigned)__builtin_amdgcn_readfirstlane((int)(unsigned)pa_));
    void* const ub_ = (void*)(((unsigned long long)(unsigned)__builtin_amdgcn_readfirstlane((int)(pb_ >> 32)) << 32) | (unsigned long long)(unsigned)__builtin_amdgcn_readfirstlane((int)(unsigned)pb_));
    const __amdgpu_buffer_rsrc_t rs_voffA = __builtin_amdgcn_make_buffer_rsrc(ua_, 0, -1, 0x00020000), rs_voffB = __builtin_amdgcn_make_buffer_rsrc(ub_, 0, -1, 0x00020000);
    const unsigned kstep = (unsigned)(BK * 2);
    const unsigned hstep = (unsigned)(HALF * K * 2);
    const unsigned tstep = 2u * hstep;
    const unsigned ldsw = (unsigned)wid * 1024u;
    const int aoff = lds_byte(wr * 64 + fr, fq * 8), boff = lds_byte(wc * 32 + fr, fq * 8);
#define PG8_SA(b, h) (((b) * 2 + (h)) * HTB)
#define PG8_SB(b, h) ((4 + (b) * 2 + (h)) * HTB)
#define PG8_STAGE(bufoff, soff, voff) do { _Pragma("unroll") for (int _i = 0; _i < 2; ++_i) \
        __builtin_amdgcn_raw_ptr_buffer_load_lds(rs_##voff, (PG8_LAS void*)(lds + (bufoff) + ldsw + _i * 8192), 16, (int)(voff)[_i], (int)(soff), 0, 0); } while (0)
#define PG8_LDA(dst, b, h) do { _Pragma("unroll") for (int m = 0; m < 4; ++m) _Pragma("unroll") for (int k = 0; k < 2; ++k) dst[m][k] = *(const PG8_LAS bf16x8*)(lds + PG8_SA(b, h) + aoff + m * 2048 + k * 1024); } while (0)
#define PG8_LDB(dst, b, h) do { _Pragma("unroll") for (int n = 0; n < 2; ++n) _Pragma("unroll") for (int k = 0; k < 2; ++k) dst[n][k] = *(const PG8_LAS bf16x8*)(lds + PG8_SB(b, h) + boff + n * 2048 + k * 1024); } while (0)
#ifndef PG8_PRIO_MMA
#define PG8_PRIO_MMA 3
#define PG8_PRIO_LOAD 0
#endif
#define PG8_MMA(ai, bj, At, Bt) do { __builtin_amdgcn_s_setprio(PG8_PRIO_MMA); \
        if constexpr (F8) { _Pragma("unroll") for (int m = 0; m < 4; ++m) _Pragma("unroll") for (int n = 0; n < 2; ++n) _Pragma("unroll") for (int k = 0; k < 2; ++k) \
            acc[ai][bj][m][n] = __builtin_bit_cast(f32x4, __builtin_amdgcn_mfma_i32_16x16x64_i8(__builtin_bit_cast(pg8_i32x4, Bt[n][k]), __builtin_bit_cast(pg8_i32x4, At[m][k]), __builtin_bit_cast(pg8_i32x4, acc[ai][bj][m][n]), 0, 0, 0)); } \
        else { _Pragma("unroll") for (int m = 0; m < 4; ++m) _Pragma("unroll") for (int n = 0; n < 2; ++n) _Pragma("unroll") for (int k = 0; k < 2; ++k) \
            acc[ai][bj][m][n] = __builtin_amdgcn_mfma_f32_16x16x32_bf16(Bt[n][k], At[m][k], acc[ai][bj][m][n], 0, 0, 0); } \
        __builtin_amdgcn_s_setprio(PG8_PRIO_LOAD); } while (0)
#define PG8_WAIT_V(n) asm volatile("s_waitcnt vmcnt(" #n ")" ::: "memory")
#define PG8_WAIT_L(n) asm volatile("s_waitcnt lgkmcnt(" #n ")" ::: "memory")
#define PG8_BAR __builtin_amdgcn_s_barrier()
#define PG8_SCHED __builtin_amdgcn_sched_barrier(0)
    Unit cur, nxt; int ui = 0;
    if (!S.next(0, cur)) return;
    f32x4 acc[2][2][4][2];
#pragma unroll
    for (int a = 0; a < 2; ++a)
#pragma unroll
        for (int b = 0; b < 2; ++b)
#pragma unroll
            for (int m = 0; m < 4; ++m)
#pragma unroll
                for (int n = 0; n < 2; ++n) acc[a][b][m][n] = (f32x4){0.f, 0.f, 0.f, 0.f};
    bf16x8 At[4][2], B0[2][2], B1[2][2];
    unsigned cA = (unsigned)cur.pm * tstep, cB = (unsigned)cur.pn * tstep + (unsigned)(cur.pm >> 6) * (unsigned)g.bb;
    S.a_ready(cur);
    if constexpr (SP2) {
        PG8_STAGE(PG8_SB(0, 0), cB, voffB); PG8_STAGE(PG8_SB(0, 1), cB + hstep, voffB); PG8_STAGE(PG8_SA(0, 0), cA, voffA); PG8_STAGE(PG8_SA(0, 1), cA + hstep, voffA);
        if (wr == 1) PG8_BAR;
        PG8_WAIT_V(2); PG8_BAR;
        PG8_STAGE(PG8_SB(1, 0), cB + kstep, voffB); PG8_STAGE(PG8_SA(1, 0), cA + kstep, voffA); PG8_STAGE(PG8_SB(1, 1), cB + hstep + kstep, voffB);
        PG8_WAIT_V(6); PG8_BAR;
    } else {
        PG8_STAGE(PG8_SB(0, 0), cB, voffB); PG8_STAGE(PG8_SA(0, 0), cA, voffA); PG8_STAGE(PG8_SB(0, 1), cB + hstep, voffB); PG8_STAGE(PG8_SA(0, 1), cA + hstep, voffA);
        if (wr == 1) PG8_BAR;
        PG8_WAIT_V(4); PG8_BAR;
        PG8_STAGE(PG8_SB(1, 0), cB + kstep, voffB); PG8_STAGE(PG8_SA(1, 0), cA + kstep, voffA); PG8_STAGE(PG8_SB(1, 1), cB + hstep + kstep, voffB);
        PG8_WAIT_V(6); PG8_BAR;
    }
    for (;;) {
        const bool has_next = S.next(ui + 1, nxt);
        const unsigned nA = has_next ? (unsigned)nxt.pm * tstep : cA, nB = has_next ? (unsigned)nxt.pn * tstep + (unsigned)(nxt.pm >> 6) * (unsigned)g.bb : cB;
        for (int t = 0; t < nt; t += 2) {
            const bool last = (t == nt - 2);
            const unsigned a1 = cA + (unsigned)(t + 1) * kstep;
            const unsigned a2 = last ? nA : cA + (unsigned)(t + 2) * kstep, b2 = last ? nB : cB + (unsigned)(t + 2) * kstep;
            const unsigned a3 = a2 + kstep, b3 = b2 + kstep;
            if (last && has_next) S.a_ready(nxt);
            if constexpr (SP2) {
            PG8_STAGE(PG8_SA(1, 1), a1 + hstep, voffA); PG8_SCHED; PG8_LDB(B0, 0, 0); PG8_LDB(B1, 0, 1); PG8_SCHED; PG8_LDA(At, 0, 0);
            PG8_WAIT_V(8); PG8_WAIT_L(0); PG8_BAR; PG8_MMA(0, 0, At, B0); PG8_MMA(0, 1, At, B1); PG8_BAR; PG8_SCHED;
            PG8_STAGE(PG8_SB(0, 0), b2, voffB); PG8_STAGE(PG8_SB(0, 1), b2 + hstep, voffB); PG8_STAGE(PG8_SA(0, 0), a2, voffA); PG8_SCHED; PG8_LDA(At, 0, 1);
            PG8_WAIT_V(8); PG8_WAIT_L(0); PG8_BAR; PG8_MMA(1, 0, At, B0); PG8_MMA(1, 1, At, B1); PG8_BAR; PG8_SCHED;
            PG8_STAGE(PG8_SA(0, 1), a2 + hstep, voffA); PG8_SCHED; PG8_LDB(B0, 1, 0); PG8_LDB(B1, 1, 1); PG8_SCHED; PG8_LDA(At, 1, 0);
            PG8_WAIT_V(8); PG8_WAIT_L(0); PG8_BAR; PG8_MMA(0, 0, At, B0); PG8_MMA(0, 1, At, B1); PG8_BAR; PG8_SCHED;
            PG8_STAGE(PG8_SB(1, 0), b3, voffB); PG8_STAGE(PG8_SB(1, 1), b3 + hstep, voffB); PG8_STAGE(PG8_SA(1, 0), a3, voffA); PG8_SCHED; PG8_LDA(At, 1, 1);
            PG8_WAIT_V(8); PG8_WAIT_L(0); PG8_BAR; PG8_MMA(1, 0, At, B0); PG8_MMA(1, 1, At, B1); PG8_BAR; PG8_SCHED;
            } else {
            PG8_LDB(B0, 0, 0); PG8_SCHED; PG8_LDA(At, 0, 0); PG8_STAGE(PG8_SA(1, 1), a1 + hstep, voffA);
            PG8_WAIT_L(8); PG8_BAR; PG8_WAIT_L(0); PG8_MMA(0, 0, At, B0); PG8_BAR; PG8_SCHED;
            PG8_LDB(B1, 0, 1); PG8_STAGE(PG8_SB(0, 0), b2, voffB);
            PG8_BAR; PG8_WAIT_L(0); PG8_MMA(0, 1, At, B1); PG8_BAR;
            PG8_LDA(At, 0, 1); PG8_STAGE(PG8_SA(0, 0), a2, voffA);
            PG8_BAR; PG8_WAIT_L(0); PG8_MMA(1, 0, At, B0); PG8_BAR; PG8_SCHED;
            PG8_STAGE(PG8_SB(0, 1), b2 + hstep, voffB);
            PG8_WAIT_V(6); PG8_BAR; PG8_MMA(1, 1, At, B1); PG8_BAR;
            PG8_LDB(B0, 1, 0); PG8_SCHED; PG8_LDA(At, 1, 0); PG8_STAGE(PG8_SA(0, 1), a2 + hstep, voffA);
            PG8_WAIT_L(8); PG8_BAR; PG8_WAIT_L(0); PG8_MMA(0, 0, At, B0); PG8_BAR; PG8_SCHED;
            PG8_LDB(B1, 1, 1); PG8_STAGE(PG8_SB(1, 0), b3, voffB);
            PG8_BAR; PG8_WAIT_L(0); PG8_MMA(0, 1, At, B1); PG8_BAR;
            PG8_LDA(At, 1, 1); PG8_STAGE(PG8_SA(1, 0), a3, voffA);
            PG8_BAR; PG8_WAIT_L(0); PG8_MMA(1, 0, At, B0); PG8_BAR; PG8_SCHED;
            PG8_STAGE(PG8_SB(1, 1), b3 + hstep, voffB);
            PG8_WAIT_V(6); PG8_BAR; PG8_MMA(1, 1, At, B1); PG8_BAR;
            }
        }
        if constexpr (ALIGN_EPI) { if (wr == 0) PG8_BAR; }
        if constexpr (F8) { _Pragma("unroll") for (int a = 0; a < 2; ++a) _Pragma("unroll") for (int b = 0; b < 2; ++b) _Pragma("unroll") for (int m = 0; m < 4; ++m) _Pragma("unroll") for (int n = 0; n < 2; ++n)
            acc[a][b][m][n] = __builtin_convertvector(__builtin_bit_cast(pg8_i32x4, acc[a][b][m][n]), f32x4); }
        if constexpr (!Epi::AFTER_DRAIN) { E(acc, cur, wr, wc, fr, fq); S.done(cur); }
        if (!has_next) break;
#pragma unroll
        for (int a = 0; a < 2; ++a)
#pragma unroll
            for (int b = 0; b < 2; ++b)
#pragma unroll
                for (int m = 0; m < 4; ++m)
#pragma unroll
                    for (int n = 0; n < 2; ++n) acc[a][b][m][n] = (f32x4){0.f, 0.f, 0.f, 0.f};
        cur = nxt; cA = nA; cB = nB; ++ui;
        if constexpr (ALIGN_EPI) { if (wr == 1) PG8_BAR; }
    }
    PG8_WAIT_V(0);
    if constexpr (!ALIGN_EPI) { if (wr == 0) PG8_BAR; }
    PG8_BAR;
    if constexpr (Epi::AFTER_DRAIN) { E.fused(acc, cur, wr, wc, fr, fq, lds, wid, lane); S.done(cur); }
#undef PG8_SA
#undef PG8_SB
#undef PG8_STAGE
#undef PG8_LDA
#undef PG8_LDB
#undef PG8_MMA
#undef PG8_WAIT_V
#undef PG8_WAIT_L
#undef PG8_BAR
#undef PG8_SCHED
}
}
constexpr int NB_ = 2, S_ = 16384, D_ = 1024, M_ = NB_ * S_, H_ = 16, HD_ = 64, FF_ = 2816, NBLK_ = 64;
constexpr float LOG2E_ = 1.4426950408889634f;
constexpr float C2_ = 0.125f * LOG2E_;
constexpr float EPS_ = 1e-6f;

constexpr size_t MiB = 1u << 20;
constexpr size_t WS_CTL = 0, CTL_ZERO_BYTES = 256 * 1024;
constexpr size_t WS_CMAX = 128 * 1024;
constexpr size_t WS_MOD  = 1 * MiB;
constexpr size_t WS_GM   = WS_MOD + 256 * 1024, WS_WEXP = WS_GM;
constexpr size_t WS_COEF = WS_GM + 64 * 1024;
constexpr size_t WS_BFFN = WS_COEF + 64 * 1024;
constexpr size_t WS_BQKV = WS_BFFN + 192 * 1024;
constexpr size_t WS_BPW1 = WS_BQKV + 32 * 1024;
constexpr size_t WS_SSQ  = 4 * MiB;
constexpr size_t WS_KBAR = 6 * MiB;
constexpr size_t WS_SEL  = 7 * MiB;
constexpr size_t WS_LP   = 9 * MiB;
constexpr size_t WS_WIN  = 16 * MiB;
constexpr size_t WS_WQKV = 104 * MiB;
constexpr size_t WS_WPW1 = 116 * MiB;
constexpr size_t WS_WOUT = 124 * MiB;
constexpr size_t WS_WO   = 146 * MiB;
constexpr size_t WS_WPW2 = 148 * MiB;
constexpr size_t WS_XB   = 152 * MiB;
constexpr size_t WS_BIG  = 216 * MiB;
constexpr size_t WS_ACT  = WS_BIG;
constexpr size_t WS_Q = WS_BIG, WS_K = WS_BIG + 64 * MiB, WS_V = WS_BIG + 128 * MiB;
constexpr size_t WS_OP3 = 408 * MiB;
constexpr size_t WS_U = WS_BIG, WS_CV = WS_BIG + 64 * MiB;
constexpr size_t WS_X8  = 472 * MiB;
constexpr size_t WS_SSQ1 = 504 * MiB;
constexpr size_t WS_END = 506 * MiB;
constexpr float CQ_ = 8.0f;
#ifndef I8MASK
#define I8MASK 0
#endif

constexpr int CW_BAR = 1024;

constexpr int RING_BYTES = 131072;
constexpr int LDSCTL_OFF = RING_BYTES, MISC_OFF = LDSCTL_OFF + 320;
constexpr int LDS_BYTES = 163840;
constexpr int LT_PM = LDSCTL_OFF + 896, LT_RSTD = LDSCTL_OFF + 1024, LT_VEC = LDSCTL_OFF + 3072, LT_EXP = LT_VEC + 22528;

#define GAS __attribute__((address_space(1)))
#define LAS __attribute__((address_space(3)))
typedef unsigned short bf16;
typedef float f32x4 __attribute__((ext_vector_type(4)));
typedef unsigned u32x4 __attribute__((ext_vector_type(4)));
typedef unsigned u32x2 __attribute__((ext_vector_type(2)));
typedef short bf16x8 __attribute__((ext_vector_type(8)));
typedef float f32x16 __attribute__((ext_vector_type(16)));
#define LDS_WAIT() asm volatile("s_waitcnt lgkmcnt(0)" ::: "memory")
#define VM_WAIT() asm volatile("s_waitcnt vmcnt(0)" ::: "memory")
#define LDS_BARRIER() do { asm volatile("s_waitcnt lgkmcnt(0)" ::: "memory"); __builtin_amdgcn_s_barrier(); asm volatile("" ::: "memory"); } while (0)
__device__ __forceinline__ unsigned f2bf(float f) { unsigned u = __builtin_bit_cast(unsigned, f); return (u + 0x7fffu + ((u >> 16) & 1u)) >> 16; }
__device__ __forceinline__ unsigned pk2(float lo, float hi) { return f2bf(lo) | (f2bf(hi) << 16); }
typedef __bf16 bf16x2_t __attribute__((ext_vector_type(2))); typedef float f32x2_t __attribute__((ext_vector_type(2)));
__device__ __forceinline__ unsigned cvtpk(float lo, float hi) { const f32x2_t v = {lo, hi}; const bf16x2_t b = __builtin_convertvector(v, bf16x2_t); return __builtin_bit_cast(unsigned, b); }
__device__ __forceinline__ float bf2f(unsigned h) { return __builtin_bit_cast(float, h << 16); }
__device__ __forceinline__ float bflo(unsigned w) { return __builtin_bit_cast(float, w << 16); }
__device__ __forceinline__ float bfhi(unsigned w) { return __builtin_bit_cast(float, w & 0xffff0000u); }
template <int CTRL> __device__ __forceinline__ float dppf(float v) { return __builtin_bit_cast(float, __builtin_amdgcn_mov_dpp(__builtin_bit_cast(int, v), CTRL, 0xF, 0xF, true)); }
typedef unsigned u32x2v __attribute__((ext_vector_type(2)));
__device__ __forceinline__ float u2f(unsigned u) { return __builtin_bit_cast(float, u); }
__device__ __forceinline__ unsigned f2u(float f) { return __builtin_bit_cast(unsigned, f); }
__device__ __forceinline__ float sum16(float v) { const auto r = __builtin_amdgcn_permlane16_swap(f2u(v), f2u(v), false, false); const unsigned r0 = r[0], r1 = r[1]; return u2f(r0) + u2f(r1); }
__device__ __forceinline__ float sum32(float v) { const auto r = __builtin_amdgcn_permlane32_swap(f2u(v), f2u(v), false, false); const unsigned r0 = r[0], r1 = r[1]; return u2f(r0) + u2f(r1); }
__device__ __forceinline__ float max16(float v) { const auto r = __builtin_amdgcn_permlane16_swap(f2u(v), f2u(v), false, false); const unsigned r0 = r[0], r1 = r[1]; return fmaxf(u2f(r0), u2f(r1)); }
__device__ __forceinline__ float max32(float v) { const auto r = __builtin_amdgcn_permlane32_swap(f2u(v), f2u(v), false, false); const unsigned r0 = r[0], r1 = r[1]; return fmaxf(u2f(r0), u2f(r1)); }
__device__ __forceinline__ float row_sum16(float v) { v += dppf<0xB1>(v); v += dppf<0x4E>(v); v += dppf<0x141>(v); v += dppf<0x140>(v); return v; }
__device__ __forceinline__ float wave_sum(float v) { v = row_sum16(v); v = sum16(v); return sum32(v); }
__device__ __forceinline__ float wave_max(float v) { v = fmaxf(v, dppf<0xB1>(v)); v = fmaxf(v, dppf<0x4E>(v)); v = fmaxf(v, dppf<0x141>(v)); v = fmaxf(v, dppf<0x140>(v)); v = max16(v); return max32(v); }
__device__ __forceinline__ unsigned other32(unsigned v, int hi) { const auto r = __builtin_amdgcn_permlane32_swap(v, v, false, false); const unsigned r0 = r[0], r1 = r[1]; return hi ? r0 : r1; }
#define XB_TMO      128
#define XB_XCNT(j)  (256  + 64 * (j))
#define XB_XSUB(j)  (1280 + 64 * (j))
#define XB_XGEN(j)  (2304 + 64 * (j))
#define XB_TOP      3328
#define XB_TOPGEN   3392
#define XCD_BAR_WORDS 3456
#define XB_SPIN_CAP (1u << 18)

__device__ __forceinline__ unsigned xb_ld(unsigned* p)              { return __hip_atomic_load(p, __ATOMIC_RELAXED, __HIP_MEMORY_SCOPE_AGENT); }
__device__ __forceinline__ unsigned xb_add(unsigned* p, unsigned v) { return __hip_atomic_fetch_add(p, v, __ATOMIC_RELAXED, __HIP_MEMORY_SCOPE_AGENT); }
__device__ __forceinline__ unsigned xb_xcc_id() { return (unsigned)__builtin_amdgcn_s_getreg((3 << 11) | 20) & 0xFu; }
#define XB_SPIN(cond, bar) do { unsigned _sp = 0; while (cond) { __builtin_amdgcn_s_sleep(1); \
    if ((++_sp & 255u) == 0u) { if (xb_ld(&(bar)[XB_TMO])) break; if (_sp > XB_SPIN_CAP) { atomicAdd(&(bar)[XB_TMO], 1u); break; } } } } while (0)

struct XcdBarrier {
    unsigned* bar; unsigned x;
    volatile LAS unsigned* st;
};

__device__ __forceinline__ XcdBarrier xcd_barrier_post(unsigned* bar, volatile LAS unsigned* st) {
    XcdBarrier b; b.bar = bar; b.x = xb_xcc_id(); b.st = st;
    if (threadIdx.x == 0) (void)xb_add(&bar[XB_XCNT(b.x)], 1u);
    return b;
}
__device__ __forceinline__ void xcd_barrier_complete(unsigned* bar, unsigned x, unsigned& nloc, unsigned& nx) {
    const unsigned G = gridDim.x * gridDim.y * gridDim.z;
    unsigned sum, cnt, mine, sp = 0u;
    for (;;) {
        sum = 0u; cnt = 0u; mine = 0u;
#pragma unroll
        for (unsigned j = 0; j < 16; ++j) { const unsigned c = xb_ld(&bar[XB_XCNT(j)]); sum += c; cnt += (c > 0u) ? 1u : 0u; mine = (j == x) ? c : mine; }
        if (sum == G) break;
        __builtin_amdgcn_s_sleep(1);
        if ((++sp & 255u) == 0u) { if (xb_ld(&bar[XB_TMO])) break; if (sp > XB_SPIN_CAP) { atomicAdd(&bar[XB_TMO], 1u); break; } }
    }
    nloc = mine > 0u ? mine : 1u; nx = cnt > 0u ? cnt : 1u;
}

__device__ __forceinline__ void xcd_barrier(const XcdBarrier& b) {
    asm volatile("s_waitcnt vmcnt(0)" ::: "memory");
    __syncthreads();
    if (threadIdx.x == 0) {
        unsigned* bar = b.bar;
        __builtin_amdgcn_s_waitcnt(0);
        unsigned nloc = b.st[0], nx = b.st[1];
        if (nloc == 0u) { xcd_barrier_complete(bar, b.x, nloc, nx); b.st[0] = nloc; b.st[1] = nx; }
        const unsigned old = xb_add(&bar[XB_XSUB(b.x)], 1u);
        const unsigned gen = old / nloc;
        if (old + 1u == (gen + 1u) * nloc) {
            __builtin_amdgcn_fence(__ATOMIC_RELEASE, "agent");
            asm volatile("s_waitcnt vmcnt(0)" ::: "memory");
            const unsigned og = xb_add(&bar[XB_TOP], 1u);
            const unsigned tg = og / nx;
            if (og + 1u == (tg + 1u) * nx) xb_add(&bar[XB_TOPGEN], 1u);
            else XB_SPIN(xb_ld(&bar[XB_TOPGEN]) == tg, bar);
            __builtin_amdgcn_fence(__ATOMIC_ACQUIRE, "agent");
            xb_add(&bar[XB_XGEN(b.x)], 1u);
            asm volatile("s_waitcnt vmcnt(0)" ::: "memory");
        } else {
            XB_SPIN(xb_ld(&bar[XB_XGEN(b.x)]) == gen, bar);
            __builtin_amdgcn_fence(__ATOMIC_ACQUIRE, "agent");
            asm volatile("s_waitcnt vmcnt(0)" ::: "memory");
        }
    }
    __syncthreads();
}
__device__ __forceinline__ int epi_tables_pm(LAS unsigned char* lds, const pg8::StaticOrder& S, int tid, int& pmA_out, int& pmB_out) {
    int pmA = -1, pmB = -1, ok = 1; pg8::Unit u;
    for (int i = 0; S.next(i, u); ++i) { if (pmA < 0) pmA = u.pm; else if (u.pm != pmA) { if (pmB < 0) pmB = u.pm; else if (u.pm != pmB) ok = 0; } }
    if (pmA < 0) pmA = 0;
    if (pmB < 0) pmB = pmA;
    if ((pmA >> 6) != (pmB >> 6)) ok = 0;
    if (tid == 0) { ((LAS int*)(lds + LT_PM))[0] = pmA; ((LAS int*)(lds + LT_PM))[1] = pmB; }
    pmA_out = pmA; pmB_out = pmB; return ok;
}
__device__ __forceinline__ float ssq_row(const float* ssq, int row) {
    const f32x4 p0 = *(const f32x4*)(ssq + (size_t)row * 16), p1 = *(const f32x4*)(ssq + (size_t)row * 16 + 4), p2 = *(const f32x4*)(ssq + (size_t)row * 16 + 8), p3 = *(const f32x4*)(ssq + (size_t)row * 16 + 12);
    return (((p0.x + p0.y) + (p0.z + p0.w)) + ((p1.x + p1.y) + (p1.z + p1.w))) + (((p2.x + p2.y) + (p2.z + p2.w)) + ((p3.x + p3.y) + (p3.z + p3.w)));
}
__device__ __forceinline__ void epi_tables_rstd(LAS unsigned char* lds, const float* ssq, int pmA, int pmB, int ok, int tid, float scale = 1.0f, const float* ssq_prev = nullptr) {
    const int slot = tid >> 8, r = tid & 255, row = (slot ? pmB : pmA) * 256 + r;
    float v = rsqrtf(ssq_row(ssq, row) * (1.0f / D_) + EPS_) * scale;
    if (ssq_prev) v *= sqrtf(ssq_row(ssq_prev, row) * (1.0f / D_) + EPS_);
    ((LAS float*)(lds + LT_RSTD))[tid] = ok ? v : __builtin_nanf("");
}
__device__ __forceinline__ float gm_rms(const float* ng, const float* scl, int lane) {
    float s = 0.f;
#pragma unroll
    for (int i = 0; i < 4; ++i) { const f32x4 g = *(const f32x4*)(ng + 256 * i + 4 * lane), c = *(const f32x4*)(scl + 256 * i + 4 * lane);
#pragma unroll
        for (int e = 0; e < 4; ++e) { const float t = g[e] * (1.0f + c[e]); s += t * t; } }
    return sqrtf(wave_sum(s) * (1.0f / D_));
}
__device__ __forceinline__ void epi_tables_vec(LAS unsigned char* lds, int dst_off, const float* src, int n, int tid) {
    for (int i = tid * 4; i < n; i += 2048) *(LAS f32x4*)(lds + LT_VEC + (dst_off + i) * 4) = src ? *(const f32x4*)(src + i) : (f32x4){0.f, 0.f, 0.f, 0.f};
}
__device__ __forceinline__ unsigned pk4_i8(float a, float b, float c, float d) {
    const float M = 12582912.0f;
    const unsigned ua = f2u(__builtin_amdgcn_fmed3f(a, -127.0f, 127.0f) + M), ub = f2u(__builtin_amdgcn_fmed3f(b, -127.0f, 127.0f) + M), uc = f2u(__builtin_amdgcn_fmed3f(c, -127.0f, 127.0f) + M), ud = f2u(__builtin_amdgcn_fmed3f(d, -127.0f, 127.0f) + M);
    const unsigned lo = __builtin_amdgcn_perm(ub, ua, 0x0c0c0400u), hi = __builtin_amdgcn_perm(ud, uc, 0x0c0c0400u);
    return lo | (hi << 16);
}
__device__ __forceinline__ int lane_id() { return (int)__builtin_amdgcn_mbcnt_hi(~0u, __builtin_amdgcn_mbcnt_lo(~0u, 0u)); }
__device__ __forceinline__ float sigm(float v) { return __builtin_amdgcn_rcpf(1.0f + __builtin_amdgcn_exp2f(-LOG2E_ * v)); }

template <int ACT, bool I8 = false> struct EpiGated {
    static constexpr bool PERM = true, AFTER_DRAIN = false;
    bf16* O; int ldo; const float* bias; int N; const float* ssq; LAS unsigned char* lds;
    const float* ssq_prev; const signed char* wexp; const float* ng; const float* scl;
    __device__ __forceinline__ void preload(const pg8::StaticOrder& S, int tid) const {
        int pmA, pmB; const int ok = epi_tables_pm(lds, S, tid, pmA, pmB);
        if constexpr (I8) {
            const float G = gm_rms(ng, scl + (size_t)(pmA >> 6) * 9216, tid & 63);
            epi_tables_rstd(lds, ssq, pmA, pmB, ok, tid, CQ_ * G * (1.0f / 127.0f), ssq_prev);
            for (int i = tid; i < N / 4; i += 512) ((LAS unsigned*)(lds + LT_EXP))[i] = ((const unsigned*)wexp)[i];
        } else epi_tables_rstd(lds, ssq, pmA, pmB, ok, tid);
        epi_tables_vec(lds, 0, bias + (size_t)(pmA >> 6) * N, N, tid);
    }
    __device__ __forceinline__ void operator()(const f32x4 (&acc)[2][2][4][2], const pg8::Unit& u, int wr, int wc, int fr, int fq) const {
        const LAS float* bp = (const LAS float*)(lds + LT_VEC) + u.pn * 256 + wc * 32 + 8 * fq;
        const LAS float* rt = (const LAS float*)(lds + LT_RSTD) + ((u.pm == ((const LAS int*)(lds + LT_PM))[0]) ? 0 : 256) + wr * 64 + fr;
        f32x4 bv[2][2];
#pragma unroll
        for (int bj = 0; bj < 2; ++bj)
#pragma unroll
            for (int n = 0; n < 2; ++n) bv[bj][n] = *(const LAS f32x4*)(bp + bj * 128 + 4 * n);
        float rsv[8];
#pragma unroll
        for (int k = 0; k < 8; ++k) rsv[k] = rt[(k >> 2) * 128 + (k & 3) * 16];
        f32x4 cs[2][2];
        if constexpr (I8) {
#pragma unroll
            for (int bj = 0; bj < 2; ++bj) { const u32x2 eb = *(const LAS u32x2*)(lds + LT_EXP + u.pn * 256 + bj * 128 + wc * 32 + 8 * fq);
#pragma unroll
                for (int n = 0; n < 2; ++n) { const unsigned w = n ? eb.y : eb.x;
#pragma unroll
                    for (int j = 0; j < 4; ++j) { const int e = (int)(signed char)(w >> (8 * j)); cs[bj][n][j] = u2f((unsigned)(e + 127) << 23); } } }
        }
#pragma unroll
        for (int ai = 0; ai < 2; ++ai)
#pragma unroll
            for (int m = 0; m < 4; ++m) {
                const int row = u.pm * 256 + ai * 128 + wr * 64 + m * 16 + fr;
                const float rs = rsv[ai * 4 + m];
                typedef float f2 __attribute__((ext_vector_type(2)));
                f2 a[4], g[4], t[4], e[4], d[4], r[4], v[4];
#pragma unroll
                for (int i = 0; i < 4; ++i) { const int n = i >> 1; const f32x4 a4 = I8 ? acc[ai][0][m][n] * cs[0][n] : acc[ai][0][m][n], g4 = I8 ? acc[ai][1][m][n] * cs[1][n] : acc[ai][1][m][n], ba4 = bv[0][n], bg4 = bv[1][n];
                    a[i] = ((i & 1) == 0 ? (f2){a4.x, a4.y} : (f2){a4.z, a4.w}) * rs + ((i & 1) == 0 ? (f2){ba4.x, ba4.y} : (f2){ba4.z, ba4.w});
                    g[i] = ((i & 1) == 0 ? (f2){g4.x, g4.y} : (f2){g4.z, g4.w}) * rs + ((i & 1) == 0 ? (f2){bg4.x, bg4.y} : (f2){bg4.z, bg4.w});
                    t[i] = ((ACT == 0) ? a[i] : g[i]) * (-LOG2E_); }
#pragma unroll
                for (int i = 0; i < 4; ++i) { e[i].x = __builtin_amdgcn_exp2f(t[i].x); e[i].y = __builtin_amdgcn_exp2f(t[i].y); }
#pragma unroll
                for (int i = 0; i < 4; ++i) d[i] = e[i] + 1.0f;
#pragma unroll
                for (int i = 0; i < 4; ++i) { r[i].x = __builtin_amdgcn_rcpf(d[i].x); r[i].y = __builtin_amdgcn_rcpf(d[i].y); }
#pragma unroll
                for (int i = 0; i < 4; ++i) v[i] = (ACT == 0) ? (a[i] * r[i]) * g[i] : a[i] * r[i];
                u32x4 w; w.x = cvtpk(v[0].x, v[0].y); w.y = cvtpk(v[1].x, v[1].y); w.z = cvtpk(v[2].x, v[2].y); w.w = cvtpk(v[3].x, v[3].y);
                *(u32x4*)(O + (size_t)row * ldo + u.pn * 128 + wc * 32 + 8 * fq) = w;
            }
    }
};

struct EpiRes {
    static constexpr bool PERM = true, AFTER_DRAIN = false;
    bf16* xb; float* out; const float* bias2; const float* coef; float* ssq; int last; LAS unsigned char* lds;
    unsigned char* x8; const float* ssq_prev; const float* ng_next; const float* scl_next;
    __device__ __forceinline__ void preload(const pg8::StaticOrder& S, int tid) const {
        int pmA, pmB; const int ok = epi_tables_pm(lds, S, tid, pmA, pmB);
        epi_tables_vec(lds, 0, ok ? coef + (size_t)(pmA >> 6) * D_ : nullptr, D_, tid);
        epi_tables_vec(lds, D_, bias2, D_, tid);
        if (x8) {
            const float* sc = scl_next + (size_t)(pmA >> 6) * 9216;
            const float G = gm_rms(ng_next, sc, tid & 63);
            epi_tables_rstd(lds, ssq_prev, pmA, pmB, ok, tid, 127.0f / (CQ_ * G));
            if (tid < 256) { const f32x4 g = *(const f32x4*)(ng_next + 4 * tid), c = *(const f32x4*)(sc + 4 * tid);
                *(LAS f32x4*)(lds + LT_VEC + (2 * D_ + 4 * tid) * 4) = (f32x4){g.x * (1.0f + c.x), g.y * (1.0f + c.y), g.z * (1.0f + c.z), g.w * (1.0f + c.w)}; }
        }
    }
    __device__ __forceinline__ void operator()(const f32x4 (&acc)[2][2][4][2], const pg8::Unit& u, int wr, int wc, int fr, int fq) const {
        const int col0 = u.pn * 256 + wc * 32 + 8 * fq;
        const size_t ro0 = (size_t)(u.pm * 256 + wr * 64 + fr) * D_ + col0;
        u32x4 xr[8][2];
#define EPIRES_LOAD(k) do { const bf16* xp_ = xb + ro0 + (size_t)(((k) >> 2) * 128 + ((k) & 3) * 16) * D_; xr[k][0] = *(const u32x4*)(xp_); xr[k][1] = *(const u32x4*)(xp_ + 128); } while (0)
        EPIRES_LOAD(0); EPIRES_LOAD(1); EPIRES_LOAD(2); EPIRES_LOAD(3);
        f32x4 cf[2][2], b2[2][2];
#pragma unroll
        for (int bj = 0; bj < 2; ++bj)
#pragma unroll
            for (int n = 0; n < 2; ++n) { const int c = col0 + bj * 128 + 4 * n;
                cf[bj][n] = *(const LAS f32x4*)(lds + LT_VEC + c * 4);
                b2[bj][n] = *(const LAS f32x4*)(lds + LT_VEC + (D_ + c) * 4); }
#pragma unroll
        for (int k = 0; k < 8; ++k) {
            const int ai = k >> 2, m = k & 3;
            if (k < 4) { switch (k) { case 0: EPIRES_LOAD(4); break; case 1: EPIRES_LOAD(5); break; case 2: EPIRES_LOAD(6); break; default: EPIRES_LOAD(7); break; } }
            const int row = u.pm * 256 + ai * 128 + wr * 64 + m * 16 + fr; const size_t ro = (size_t)row * D_;
            float ss = 0.f;
#pragma unroll
            for (int bj = 0; bj < 2; ++bj) {
                const u32x4 xw = xr[k][bj];
                const f32x4 x0 = (f32x4){bflo(xw.x), bfhi(xw.x), bflo(xw.y), bfhi(xw.y)}, x1 = (f32x4){bflo(xw.z), bfhi(xw.z), bflo(xw.w), bfhi(xw.w)};
                const f32x4 n0 = x0 + cf[bj][0] * (acc[ai][bj][m][0] + b2[bj][0]), n1 = x1 + cf[bj][1] * (acc[ai][bj][m][1] + b2[bj][1]);
                ss += ((n0[0] * n0[0] + n0[1] * n0[1]) + (n0[2] * n0[2] + n0[3] * n0[3])) + ((n1[0] * n1[0] + n1[1] * n1[1]) + (n1[2] * n1[2] + n1[3] * n1[3]));
                if (!last) { u32x4 w; w.x = cvtpk(n0[0], n0[1]); w.y = cvtpk(n0[2], n0[3]); w.z = cvtpk(n1[0], n1[1]); w.w = cvtpk(n1[2], n1[3]);
                    *(u32x4*)(xb + ro + col0 + bj * 128) = w;
                    if (x8) { const float qs = ((const LAS float*)(lds + LT_RSTD))[((u.pm == ((const LAS int*)(lds + LT_PM))[0]) ? 0 : 256) + ai * 128 + wr * 64 + m * 16 + fr];
                        const f32x4 q0 = n0 * *(const LAS f32x4*)(lds + LT_VEC + (2 * D_ + col0 + bj * 128) * 4) * qs, q1 = n1 * *(const LAS f32x4*)(lds + LT_VEC + (2 * D_ + col0 + bj * 128 + 4) * 4) * qs;
                        u32x2 w8; w8.x = pk4_i8(q0[0], q0[1], q0[2], q0[3]); w8.y = pk4_i8(q1[0], q1[1], q1[2], q1[3]); *(u32x2*)(x8 + ro + col0 + bj * 128) = w8; } }
                else { *(f32x4*)(out + ro + col0 + bj * 128) = n0; *(f32x4*)(out + ro + col0 + bj * 128 + 4) = n1; }
            }
            if (!last) { ss = sum32(sum16(ss)); if (fq == 0) ssq[(size_t)row * 16 + u.pn * 4 + wc] = ss; }
        }
#undef EPIRES_LOAD
    }
};

struct EpiQKV {
    static constexpr bool PERM = true, AFTER_DRAIN = false;
    bf16* Q;   const float* bias; const float* ssq; const float* gq; const float* gk; float* kbarp; LAS unsigned char* lds;
    __device__ __forceinline__ void preload(const pg8::StaticOrder& S, int tid) const {
        int pmA, pmB; const int ok = epi_tables_pm(lds, S, tid, pmA, pmB);
        epi_tables_rstd(lds, ssq, pmA, pmB, ok, tid);
        epi_tables_vec(lds, 0, bias + (size_t)(pmA >> 6) * 3072, 3072, tid);
        epi_tables_vec(lds, 3072, gq, 64, tid); epi_tables_vec(lds, 3072 + 64, gk, 64, tid);
    }
    __device__ __forceinline__ void operator()(const f32x4 (&acc)[2][2][4][2], const pg8::Unit& u, int wr, int wc, int fr, int fq) const {
        const int b = u.pm >> 6, part = u.pn >> 2, head = ((u.pn & 3) << 2) + wc;
        const LAS float* bp = (const LAS float*)(lds + LT_VEC) + u.pn * 256 + wc * 32 + 8 * fq;
        const LAS float* gsrc = (const LAS float*)(lds + LT_VEC) + 3072 + ((part == 0) ? 0 : 64); const float gs = (part == 0) ? C2_ : 1.0f;
        const LAS float* rt = (const LAS float*)(lds + LT_RSTD) + ((u.pm == ((const LAS int*)(lds + LT_PM))[0]) ? 0 : 256) + wr * 64 + fr;
        f32x4 bv[2][2], gv[2][2], ks[2][2];
#pragma unroll
        for (int bj = 0; bj < 2; ++bj)
#pragma unroll
            for (int n = 0; n < 2; ++n) { bv[bj][n] = *(const LAS f32x4*)(bp + bj * 128 + 4 * n); gv[bj][n] = *(const LAS f32x4*)(gsrc + 32 * bj + 8 * fq + 4 * n) * gs; ks[bj][n] = (f32x4){0.f, 0.f, 0.f, 0.f}; }
        bf16* dst = Q + (size_t)part * ((size_t)M_ * D_);
        float rsv[8];
#pragma unroll
        for (int k = 0; k < 8; ++k) rsv[k] = rt[(k >> 2) * 128 + (k & 3) * 16];
#pragma unroll
        for (int ai = 0; ai < 2; ++ai)
#pragma unroll
            for (int m = 0; m < 4; ++m) {
                const int row = u.pm * 256 + ai * 128 + wr * 64 + m * 16 + fr;
                const float rs = rsv[ai * 4 + m];
                f32x4 v[2][2]; float ss = 0.f;
#pragma unroll
                for (int bj = 0; bj < 2; ++bj)
#pragma unroll
                    for (int n = 0; n < 2; ++n) { v[bj][n] = acc[ai][bj][m][n] * rs + bv[bj][n]; const f32x4 t = v[bj][n]; ss += (t[0] * t[0] + t[1] * t[1]) + (t[2] * t[2] + t[3] * t[3]); }
                if (part < 2) {
                    ss = sum32(sum16(ss));
                    const float r = rsqrtf(ss * (1.0f / HD_) + EPS_);
#pragma unroll
                    for (int bj = 0; bj < 2; ++bj)
#pragma unroll
                        for (int n = 0; n < 2; ++n) v[bj][n] = v[bj][n] * r * gv[bj][n];
                }
                if (part == 1) {
#pragma unroll
                    for (int bj = 0; bj < 2; ++bj)
#pragma unroll
                        for (int n = 0; n < 2; ++n) ks[bj][n] += v[bj][n];
                }
#pragma unroll
                for (int bj = 0; bj < 2; ++bj) {
                    u32x4 w; w.x = cvtpk(v[bj][0][0], v[bj][0][1]); w.y = cvtpk(v[bj][0][2], v[bj][0][3]); w.z = cvtpk(v[bj][1][0], v[bj][1][1]); w.w = cvtpk(v[bj][1][2], v[bj][1][3]);
                    *(u32x4*)(dst + (size_t)row * D_ + head * 64 + 32 * bj + 8 * fq) = w; }
            }
        if (part == 1) {
            float* kp = kbarp + ((((size_t)(b * 16 + head) * 64 + (u.pm & 63)) * 2 + wr) * 64);
#pragma unroll
            for (int bj = 0; bj < 2; ++bj)
#pragma unroll
                for (int n = 0; n < 2; ++n) { f32x4 t = ks[bj][n];
#pragma unroll
                    for (int j = 0; j < 4; ++j) { t[j] = row_sum16(t[j]); }
                    if (fr == 0) *(f32x4*)(kp + 32 * bj + 8 * fq + 4 * n) = t; }
        }
    }
};

template <class Epi, bool F8 = false> __device__ __forceinline__ void run_gemm(LAS unsigned char* lds, const bf16* A, const bf16* Bt, long bb, int N, int K, int G, const Epi& E, int wave_in) {
    int t = lane_id(); asm volatile("" : "+v"(t)); t += 64 * wave_in;
    int bid = (int)blockIdx.x, Gq = G; asm volatile("" : "+s"(bid), "+s"(Gq));
    pg8::Gemm g{A, Bt, M_, N, K, bb}; pg8::StaticOrder S; S.init(M_, N, Gq, bid);
    E.preload(S, t);
    __syncthreads();
    pg8::gemm_phase<Epi, pg8::StaticOrder, true, true, F8>(lds, g, S, E, t);
}

__device__ __forceinline__ void tile_load(float (&w)[32], const float* W, int N, int k0, int n0, int lane) {
    const float* p = W + (size_t)(k0 + (lane >> 5)) * N + n0 + (lane & 31);
#pragma unroll
    for (int i = 0; i < 32; ++i) w[i] = p[(size_t)(2 * i) * N];
}
__device__ __forceinline__ void tile_to_lds(const float (&w)[32], LAS float* scr, int lane) {
#pragma unroll
    for (int i = 0; i < 32; ++i) scr[(2 * i + (lane >> 5)) * 33 + (lane & 31)] = w[i];
}
__device__ __forceinline__ void transpose_finish(int K, bf16* WT, int k0, int dst0, LAS float* scr, int lane) {
    LDS_WAIT(); asm volatile("" ::: "memory");
    const int c = lane & 7;
#pragma unroll
    for (int j = 0; j < 4; ++j) { const int n = (lane >> 3) + 8 * j; const LAS float* s = scr + (8 * c) * 33 + n;
        u32x4 o; o.x = cvtpk(s[0 * 33], s[1 * 33]); o.y = cvtpk(s[2 * 33], s[3 * 33]); o.z = cvtpk(s[4 * 33], s[5 * 33]); o.w = cvtpk(s[6 * 33], s[7 * 33]);
        *(GAS u32x4*)(WT + (size_t)(dst0 + n) * K + k0 + 8 * c) = o; }
    LDS_WAIT(); asm volatile("" ::: "memory");
}
__device__ __forceinline__ int gated_dst(int n0, int half) { const int c = (n0 < half) ? n0 : n0 - half; return 256 * (c >> 7) + (c & 127) + ((n0 < half) ? 0 : 128); }

constexpr int PT_OFF = MISC_OFF + 128;
__device__ __forceinline__ unsigned long long pt_get(LAS unsigned char* lds, int i) {
    const unsigned long long v = ((volatile LAS unsigned long long*)(lds + PT_OFF))[i];
    return ((unsigned long long)(unsigned)__builtin_amdgcn_readfirstlane((int)(v >> 32)) << 32) | (unsigned long long)(unsigned)__builtin_amdgcn_readfirstlane((int)(unsigned)v);
}
#define PIN(i) ((const float*)(const GAS float*)pt_get(lds, (i)))
#define POUT ((float*)(GAS float*)pt_get(lds, 19))
#define PWS ((unsigned char*)(GAS unsigned char*)pt_get(lds, 20))

__device__ __forceinline__ void inweight_item(const float* W, int N, bf16* WT, size_t wt_bstride, int kh, int n0, int dst0, const float* ng, const float* mod0,
                                              float* bias, int bias_bstride, const float* extra, LAS float* scr, int lane, int i8out = 0, const unsigned* cmax = nullptr, signed char* wexp = nullptr) {
    const int c = lane & 7;
    float dacc[4][2];
#pragma unroll
    for (int j = 0; j < 4; ++j) { dacc[j][0] = 0.f; dacc[j][1] = 0.f; }
    float qinv[4]; int qex[4];
#pragma unroll
    for (int j = 0; j < 4; ++j) { qinv[j] = 0.f; qex[j] = 0; }
    if (i8out) {
#pragma unroll
        for (int j = 0; j < 4; ++j) { const unsigned mb = f2u(u2f(cmax[n0 + (lane >> 3) + 8 * j]) * (1.0f / 127.0f));
            int e = (int)((mb >> 23) & 255u) - 127 + ((mb & 0x7fffffu) ? 1 : 0); e = e < -100 ? -100 : e; qex[j] = e; qinv[j] = u2f((unsigned)(127 - e) << 23); }
    }
    float w[32]; tile_load(w, W, N, 64 * 8 * kh, n0, lane);
    f32x4 gq[2], s0q[2], s1q[2], h0q[2], h1q[2];
#define INW_VECS(kq_) do { _Pragma("unroll") for (int q4 = 0; q4 < 2; ++q4) { gq[q4] = *(const f32x4*)(ng + (kq_) + 4 * q4); s0q[q4] = *(const f32x4*)(mod0 + 1024 + (kq_) + 4 * q4); \
        s1q[q4] = *(const f32x4*)(mod0 + 9216 + 1024 + (kq_) + 4 * q4); h0q[q4] = *(const f32x4*)(mod0 + (kq_) + 4 * q4); h1q[q4] = *(const f32x4*)(mod0 + 9216 + (kq_) + 4 * q4); } } while (0)
    INW_VECS(64 * 8 * kh + 8 * c);
#pragma unroll 1
    for (int kb = 8 * kh; kb < 8 * kh + 8; ++kb) {
        const int k0 = 64 * kb, kq = k0 + 8 * c;
        tile_to_lds(w, scr, lane);
        float gm0[8], gm1[8], sh0[8], sh1[8];
#pragma unroll
        for (int q4 = 0; q4 < 2; ++q4)
#pragma unroll
            for (int e = 0; e < 4; ++e) { gm0[4 * q4 + e] = gq[q4][e] * (1.0f + s0q[q4][e]); gm1[4 * q4 + e] = gq[q4][e] * (1.0f + s1q[q4][e]); sh0[4 * q4 + e] = h0q[q4][e]; sh1[4 * q4 + e] = h1q[q4][e]; }
        if (kb + 1 < 8 * kh + 8) { tile_load(w, W, N, k0 + 64, n0, lane); INW_VECS(kq + 64); }
        LDS_WAIT(); asm volatile("" ::: "memory");
#pragma unroll
        for (int j = 0; j < 4; ++j) { const int n = (lane >> 3) + 8 * j; const LAS float* sp = scr + (8 * c) * 33 + n;
            float v[8];
#pragma unroll
            for (int e = 0; e < 8; ++e) v[e] = sp[e * 33];
            if (i8out) {
                u32x2 o; const float qi = qinv[j];
                o.x = pk4_i8(v[0] * qi, v[1] * qi, v[2] * qi, v[3] * qi); o.y = pk4_i8(v[4] * qi, v[5] * qi, v[6] * qi, v[7] * qi);
                *(GAS u32x2*)((unsigned char*)WT + (size_t)(dst0 + n) * 1024 + kq) = o;
            } else {
            u32x4 o0, o1;
            o0.x = cvtpk(v[0] * gm0[0], v[1] * gm0[1]); o0.y = cvtpk(v[2] * gm0[2], v[3] * gm0[3]); o0.z = cvtpk(v[4] * gm0[4], v[5] * gm0[5]); o0.w = cvtpk(v[6] * gm0[6], v[7] * gm0[7]);
            o1.x = cvtpk(v[0] * gm1[0], v[1] * gm1[1]); o1.y = cvtpk(v[2] * gm1[2], v[3] * gm1[3]); o1.z = cvtpk(v[4] * gm1[4], v[5] * gm1[5]); o1.w = cvtpk(v[6] * gm1[6], v[7] * gm1[7]);
            bf16* wp = WT + (size_t)(dst0 + n) * 1024 + kq;
            *(GAS u32x4*)(wp) = o0; *(GAS u32x4*)(wp + wt_bstride) = o1;
            }
            float d0 = 0.f, d1 = 0.f;
#pragma unroll
            for (int e = 0; e < 8; ++e) { d0 += v[e] * sh0[e]; d1 += v[e] * sh1[e]; }
            dacc[j][0] += d0; dacc[j][1] += d1; }
        LDS_WAIT(); asm volatile("" ::: "memory");
    }
    if (i8out && kh == 0 && c == 0) {
#pragma unroll
        for (int j = 0; j < 4; ++j) wexp[dst0 + (lane >> 3) + 8 * j] = (signed char)qex[j]; }
#pragma unroll
    for (int j = 0; j < 4; ++j)
#pragma unroll
        for (int bb = 0; bb < 2; ++bb) { float v = dacc[j][bb]; v += dppf<0xB1>(v); v += dppf<0x4E>(v); v += dppf<0x141>(v);
            if (c == 0) { const int n = (lane >> 3) + 8 * j; if (kh == 0 && extra) v += extra[n0 + n];
                __hip_atomic_fetch_add(bias + (size_t)bb * bias_bstride + dst0 + n, v, __ATOMIC_RELAXED, __HIP_MEMORY_SCOPE_AGENT); } }
}

#undef INW_VECS
__device__ __forceinline__ void phase_p0(LAS unsigned char* lds, int vcu, int G, int wave_in) {
    int tid = lane_id(); asm volatile("" : "+v"(tid)); tid += 64 * wave_in;
    const int lane = tid & 63, wave = __builtin_amdgcn_readfirstlane(tid >> 6);
    LAS float* cs = (LAS float*)lds;
    LAS float* red = (LAS float*)(lds + 8192);
    LAS float* scr = (LAS float*)(lds + 16384 + wave * 8704);
    unsigned char* const ws = PWS;
    float* MOD = (float*)(ws + WS_MOD);
    { const float* cin = PIN(1); for (int i = tid; i < 2048; i += 512) { const float v = cin[i]; cs[i] = v / (1.0f + expf(-v)); } }
    { float* bz = (float*)(ws + WS_BFFN); for (int i = vcu * 512 + tid; i < (192 + 32 + 16) * 256; i += G * 512) bz[i] = 0.f; }
    __syncthreads();
    for (int it = blockIdx.x; it < 288; it += G) {
        const int li = it / 144, cg = it % 144;
        const float* W = PIN(3) + (size_t)li * 1024 * 9216 + cg * 64 + lane; const float* adab = PIN(4);
        float a0 = 0.f, a1 = 0.f;
#pragma unroll 64
        for (int k = wave * 128; k < wave * 128 + 128; ++k) { const float w = W[(size_t)k * 9216]; a0 += cs[k] * w; a1 += cs[1024 + k] * w; }
        red[(wave * 2 + 0) * 64 + lane] = a0; red[(wave * 2 + 1) * 64 + lane] = a1;
        __syncthreads();
        if (tid < 128) { const int b = tid >> 6, l = tid & 63; float s = 0.f;
#pragma unroll
            for (int w = 0; w < 8; ++w) s += red[(w * 2 + b) * 64 + l];
            MOD[(size_t)(li * 2 + b) * 9216 + cg * 64 + l] = s + adab[li * 9216 + cg * 64 + l]; }
        __syncthreads();
    }
    const int gw = vcu * 8 + wave, NGW = G * 8;
    bf16* WOUT = (bf16*)(ws + WS_WOUT); bf16* WO = (bf16*)(ws + WS_WO); bf16* WPW2 = (bf16*)(ws + WS_WPW2);
    constexpr int I_OUT = 44 * 32, I_O = 16 * 32, I_PW2 = 16 * 32;
    constexpr int NITEMS = 4 * I_OUT + I_O + I_PW2;
    {
        const float* w6 = PIN(6); const float* w10 = PIN(10); const float* w17 = PIN(17);
#define OUTW_DECODE(it_, W_, K_, WT_, k0_, n0_) do { int r_ = (it_); \
            if (r_ < 4 * I_OUT) { const int f_ = r_ / I_OUT; r_ %= I_OUT; W_ = w6 + (size_t)f_ * 2816 * 1024; K_ = 2816; WT_ = WOUT + (size_t)f_ * 1024 * 2816; } \
            else if (r_ < 4 * I_OUT + I_O) { r_ -= 4 * I_OUT; W_ = w10; K_ = 1024; WT_ = WO; } \
            else { r_ -= 4 * I_OUT + I_O; W_ = w17; K_ = 1024; WT_ = WPW2; } \
            k0_ = 64 * (r_ / 32); n0_ = 32 * (r_ % 32); } while (0)
        float w[32]; const float* Wc; int Kc, k0c, n0c; bf16* WTc;
        if (gw < NITEMS) { OUTW_DECODE(gw, Wc, Kc, WTc, k0c, n0c); tile_load(w, Wc, 1024, k0c, n0c, lane); }
        for (int it = gw; it < NITEMS; it += NGW) {
            tile_to_lds(w, scr, lane);
            const float* Wn = Wc; int Kn = Kc, k0n = k0c, n0n = n0c; bf16* WTn = WTc;
            if (it + NGW < NITEMS) { OUTW_DECODE(it + NGW, Wn, Kn, WTn, k0n, n0n); tile_load(w, Wn, 1024, k0n, n0n, lane); }
            transpose_finish(Kc, WTc, k0c, n0c, scr, lane);
            Wc = Wn; Kc = Kn; k0c = k0n; n0c = n0n; WTc = WTn;
        }
#undef OUTW_DECODE
    }
    if (I8MASK) {
        const float* w5 = PIN(5); unsigned* CM = (unsigned*)(ws + WS_CMAX);
        for (int it = gw; it < 4 * 352; it += NGW) {
            const int f = it / 352, r = it % 352, seg = r % 22, rb = r / 22;
            if (!((I8MASK >> f) & 1)) continue;
            const float* p = w5 + (size_t)f * 1024 * 5632 + (size_t)(64 * rb) * 5632 + 256 * seg + 4 * lane;
            float m0 = 0.f, m1 = 0.f, m2 = 0.f, m3 = 0.f;
#pragma unroll 16
            for (int k = 0; k < 64; ++k) { const f32x4 v = *(const f32x4*)(p + (size_t)k * 5632); m0 = fmaxf(m0, fabsf(v.x)); m1 = fmaxf(m1, fabsf(v.y)); m2 = fmaxf(m2, fabsf(v.z)); m3 = fmaxf(m3, fabsf(v.w)); }
            unsigned* d = CM + f * 5632 + 256 * seg + 4 * lane;
            __hip_atomic_fetch_max(d + 0, f2u(m0), __ATOMIC_RELAXED, __HIP_MEMORY_SCOPE_AGENT); __hip_atomic_fetch_max(d + 1, f2u(m1), __ATOMIC_RELAXED, __HIP_MEMORY_SCOPE_AGENT);
            __hip_atomic_fetch_max(d + 2, f2u(m2), __ATOMIC_RELAXED, __HIP_MEMORY_SCOPE_AGENT); __hip_atomic_fetch_max(d + 3, f2u(m3), __ATOMIC_RELAXED, __HIP_MEMORY_SCOPE_AGENT);
        }
    }
    const float* x = PIN(0); bf16* XB = (bf16*)(ws + WS_XB); float* SSQ = (float*)(ws + WS_SSQ);
    {
        f32x4 v[2][4], vn[2][4];
#define XROWS_LOAD(dst, r0_) do { _Pragma("unroll") for (int r = 0; r < 2; ++r) _Pragma("unroll") for (int jj = 0; jj < 4; ++jj) \
            dst[r][jj] = ((r0_) + r * NGW < M_) ? *(const f32x4*)(x + (size_t)((r0_) + r * NGW) * D_ + 4 * lane + 256 * jj) : (f32x4){0.f, 0.f, 0.f, 0.f}; } while (0)
        XROWS_LOAD(vn, gw);
        for (int row0 = gw; row0 < M_; row0 += 2 * NGW) {
#pragma unroll
            for (int r = 0; r < 2; ++r)
#pragma unroll
                for (int jj = 0; jj < 4; ++jj) v[r][jj] = vn[r][jj];
            if (row0 + 2 * NGW < M_) XROWS_LOAD(vn, row0 + 2 * NGW);
#pragma unroll
            for (int r = 0; r < 2; ++r) { const int row = row0 + r * NGW; if (row >= M_) break; float ss = 0.f;
#pragma unroll
                for (int jj = 0; jj < 4; ++jj) { const int c = 4 * lane + 256 * jj; const f32x4 t = v[r][jj];
                    ss += (t[0] * t[0] + t[1] * t[1]) + (t[2] * t[2] + t[3] * t[3]);
                    u32x2 w; w.x = cvtpk(t[0], t[1]); w.y = cvtpk(t[2], t[3]);
                    *(u32x2*)(XB + (size_t)row * D_ + c) = w; }
                ss = wave_sum(ss);
                if (lane < 4) *(f32x4*)(SSQ + (size_t)row * 16 + 4 * lane) = (f32x4){lane == 0 ? ss : 0.f, 0.f, 0.f, 0.f}; }
        }
#undef XROWS_LOAD
    }
}

__device__ __forceinline__ void phase_p1(LAS unsigned char* lds, int vcu, int G, int wave_in) {
    int tid = lane_id(); asm volatile("" : "+v"(tid)); tid += 64 * wave_in;
    const int lane = tid & 63, wave = __builtin_amdgcn_readfirstlane(tid >> 6);
    LAS float* scr = (LAS float*)(lds + 16384 + wave * 8704);
    unsigned char* const ws = PWS; const float* ng = PIN(2);
    const float* MOD = (const float*)(ws + WS_MOD);
    float* COEF = (float*)(ws + WS_COEF);
    for (int i = vcu * 512 + tid; i < 6 * 2 * 1024; i += G * 512) {
        const int sl = i >> 11, b = (i >> 10) & 1, d = i & 1023, li = sl / 3, j = sl % 3;
        const float* mod = MOD + (size_t)(li * 2 + b) * 9216 + j * 3 * 1024;
        COEF[i] = ((j == 1) ? 1.0f : 0.5f) * mod[2048 + d];
    }
    const int gw = vcu * 8 + wave, NGW = G * 8;
    constexpr int I_IN = 176 * 2, I_QKV = 96 * 2, I_PW1 = 64 * 2;
    for (int it = gw; it < 4 * I_IN + I_QKV + I_PW1; it += NGW) {
        int r = it;
        if (r < 4 * I_IN) { const int f = r / I_IN; r %= I_IN; const int kh = (r >> 3) & 1, n0 = 32 * ((r >> 4) * 8 + (r & 7)), sl = (f >> 1) * 3 + (f & 1) * 2;
            inweight_item(PIN(5) + (size_t)f * 1024 * 5632, 5632, (bf16*)(ws + WS_WIN) + (size_t)f * 2 * 5632 * 1024, (size_t)5632 * 1024, kh, n0, gated_dst(n0, FF_),
                          ng + sl * 1024, MOD + (size_t)((sl / 3) * 2) * 9216 + (sl % 3) * 3 * 1024, (float*)(ws + WS_BFFN) + (size_t)f * 2 * 5632, 5632, nullptr, scr, lane, (I8MASK >> f) & 1, (const unsigned*)(ws + WS_CMAX) + f * 5632, (signed char*)(ws + WS_WEXP) + f * 5632); continue; }
        r -= 4 * I_IN;
        if (r < I_QKV) { const int kh = (r >> 3) & 1, n0 = 32 * ((r >> 4) * 8 + (r & 7)); const int part = n0 >> 10, head = (n0 & 1023) >> 6, e0 = n0 & 63;
            const int dst0 = 256 * (part * 4 + (head >> 2)) + 128 * (e0 >> 5) + 32 * (head & 3);
            inweight_item(PIN(7), 3072, (bf16*)(ws + WS_WQKV), (size_t)3072 * 1024, kh, n0, dst0, ng + 1 * 1024, MOD + 1 * 3 * 1024, (float*)(ws + WS_BQKV), 3072, nullptr, scr, lane); continue; }
        r -= I_QKV;
        { const int kh = (r >> 3) & 1, n0 = 32 * ((r >> 4) * 8 + (r & 7));
            inweight_item(PIN(11), 2048, (bf16*)(ws + WS_WPW1), (size_t)2048 * 1024, kh, n0, gated_dst(n0, 1024), ng + 4 * 1024, MOD + (size_t)2 * 9216 + 1 * 3 * 1024, (float*)(ws + WS_BPW1), 2048, PIN(12), scr, lane); }
    }
    if (I8MASK & 1) {
        const bf16* XB = (const bf16*)(ws + WS_XB); unsigned char* X8 = ws + WS_X8; const float* SSQ = (const float*)(ws + WS_SSQ);
        float gmv[2][16], qc[2];
#pragma unroll
        for (int b = 0; b < 2; ++b) { const float* sc = MOD + (size_t)b * 9216 + 1024;
            qc[b] = 127.0f / (CQ_ * gm_rms(ng, sc, lane));
#pragma unroll
            for (int q = 0; q < 4; ++q) { const f32x4 g = *(const f32x4*)(ng + 16 * lane + 4 * q), c = *(const f32x4*)(sc + 16 * lane + 4 * q);
                gmv[b][4 * q + 0] = g.x * (1.0f + c.x); gmv[b][4 * q + 1] = g.y * (1.0f + c.y); gmv[b][4 * q + 2] = g.z * (1.0f + c.z); gmv[b][4 * q + 3] = g.w * (1.0f + c.w); } }
        u32x4 xa, xc, xan, xcn; float sq, sqn;
#define XQ_LOAD(a_, c_, s_, row_) do { const bf16* p_ = XB + (size_t)(row_) * D_ + 16 * lane; a_ = *(const u32x4*)(p_); c_ = *(const u32x4*)(p_ + 8); s_ = ssq_row(SSQ, (row_)); } while (0)
        if (gw < M_) XQ_LOAD(xan, xcn, sqn, gw);
        for (int row = gw; row < M_; row += NGW) {
            xa = xan; xc = xcn; sq = sqn;
            if (row + NGW < M_) XQ_LOAD(xan, xcn, sqn, row + NGW);
            const int b = row >> 14; const float qs = qc[b] * rsqrtf(sq * (1.0f / D_) + EPS_);
            const unsigned wv[8] = {xa.x, xa.y, xa.z, xa.w, xc.x, xc.y, xc.z, xc.w};
            u32x4 o;
#pragma unroll
            for (int q = 0; q < 4; ++q) { const unsigned w0 = wv[2 * q], w1 = wv[2 * q + 1];
                const unsigned r = pk4_i8(bflo(w0) * (b ? gmv[1][4 * q] : gmv[0][4 * q]) * qs, bfhi(w0) * (b ? gmv[1][4 * q + 1] : gmv[0][4 * q + 1]) * qs,
                                          bflo(w1) * (b ? gmv[1][4 * q + 2] : gmv[0][4 * q + 2]) * qs, bfhi(w1) * (b ? gmv[1][4 * q + 3] : gmv[0][4 * q + 3]) * qs);
                if (q == 0) o.x = r; else if (q == 1) o.y = r; else if (q == 2) o.z = r; else o.w = r; }
            *(u32x4*)(X8 + (size_t)row * D_ + 16 * lane) = o;
        }
#undef XQ_LOAD
    }
}

typedef float f32x2 __attribute__((ext_vector_type(2)));
__device__ __forceinline__ f32x2 bfpair(unsigned v) { return (f32x2){bflo(v), bfhi(v)}; }
__device__ __forceinline__ void conv_phase(LAS unsigned char* lds, int vcu, int G, int wave_in) {
    int tid = lane_id(); asm volatile("" : "+v"(tid)); tid += 64 * wave_in;
    const int lane = tid & 63, wave = __builtin_amdgcn_readfirstlane(tid >> 6), c0 = 2 * tid;
    LAS float* part = (LAS float*)lds;
    unsigned char* const ws = PWS;
    const bf16* U = (const bf16*)(ws + WS_U); bf16* CV = (bf16*)(ws + WS_CV);
    f32x2 w[31];
    { const float* wdw = PIN(13);
#pragma unroll
    for (int j = 0; j < 31; ++j) w[j] = *(const f32x2*)(wdw + j * D_ + c0); }
    f32x2 bd, lg, lb;
    { const float* p = PIN(14); bd = *(const f32x2*)(p + c0); p = PIN(15); lg = *(const f32x2*)(p + c0); p = PIN(16); lb = *(const f32x2*)(p + c0); }
    for (int un = vcu; un < 256; un += G) {
        const int b = un >> 7, t0 = (un & 127) * 128;
        const unsigned* Up = (const unsigned*)(U + (size_t)b * S_ * D_ + c0);
        unsigned* Op = (unsigned*)(CV + (size_t)b * S_ * D_ + c0);
        f32x2 hist[38];
        unsigned nx0[8], nx1[8];
#pragma unroll
        for (int i = 0; i < 8; ++i) { nx0[i] = Up[(size_t)(t0 + i) * 512]; nx1[i] = Up[(size_t)(t0 + 8 + i) * 512]; }
#pragma unroll
        for (int i = 0; i < 30; ++i) { const int tt = t0 - 30 + i; const unsigned v = (tt >= 0) ? Up[(size_t)tt * 512] : 0u; hist[i] = bfpair(v); }
        int pb = 0;
#pragma unroll 1
        for (int st = 0; st < 16; ++st) {
#pragma unroll
            for (int i = 0; i < 8; ++i) { hist[30 + i] = bfpair(nx0[i]); nx0[i] = nx1[i]; }
            if (st < 14) {
#pragma unroll
                for (int i = 0; i < 8; ++i) nx1[i] = Up[(size_t)(t0 + (st + 2) * 8 + i) * 512];
            }
            f32x2 y[8]; float stat[16];
#pragma unroll
            for (int tt = 0; tt < 8; ++tt) { f32x2 a = bd;
#pragma unroll
                for (int j = 0; j < 31; ++j) a += w[j] * hist[tt + j];
                y[tt] = a; stat[2 * tt] = a.x + a.y; stat[2 * tt + 1] = a.x * a.x + a.y * a.y; }
            float s1[8], s2[4];
#pragma unroll
            for (int k = 0; k < 8; ++k) { const auto r = __builtin_amdgcn_permlane32_swap(f2u(stat[k]), f2u(stat[k + 8]), false, false); const unsigned r0 = r[0], r1 = r[1]; s1[k] = u2f(r0) + u2f(r1); }
#pragma unroll
            for (int k = 0; k < 4; ++k) { const auto r = __builtin_amdgcn_permlane16_swap(f2u(s1[k]), f2u(s1[k + 4]), false, false); const unsigned r0 = r[0], r1 = r[1]; s2[k] = row_sum16(u2f(r0) + u2f(r1)); }
            if ((lane & 15) == 0) *(LAS f32x4*)(part + (pb * 8 + wave) * 16 + 4 * (lane >> 4)) = (f32x4){s2[0], s2[1], s2[2], s2[3]};
            LDS_BARRIER();
            f32x4 tot[4];
#pragma unroll
            for (int k = 0; k < 4; ++k) { tot[k] = (f32x4){0.f, 0.f, 0.f, 0.f};
#pragma unroll
                for (int ww = 0; ww < 8; ++ww) tot[k] += *(const LAS f32x4*)(part + (pb * 8 + ww) * 16 + 4 * k); }
#pragma unroll
            for (int tt = 0; tt < 8; ++tt) {
                const float sum = tot[tt >> 1][(tt & 1) * 2], sq = tot[tt >> 1][(tt & 1) * 2 + 1];
                const float mean = sum * (1.0f / D_), var = sq * (1.0f / D_) - mean * mean, rstd = __builtin_amdgcn_rsqf(var + EPS_);
                const f32x2 z = (y[tt] - mean) * rstd * lg + lb;
                const f32x2 e = z * (-LOG2E_);
                f32x2 d; d.x = __builtin_amdgcn_exp2f(e.x); d.y = __builtin_amdgcn_exp2f(e.y); d = d + 1.0f;
                f32x2 r; r.x = __builtin_amdgcn_rcpf(d.x); r.y = __builtin_amdgcn_rcpf(d.y);
                const f32x2 o = z * r;
                Op[(size_t)(t0 + st * 8 + tt) * 512] = cvtpk(o.x, o.y);
            }
#pragma unroll
            for (int i = 0; i < 30; ++i) hist[i] = hist[i + 8];
            pb ^= 1;
        }
    }
}
constexpr int CW_Q2 = 8192;
constexpr int A_KS = 0, A_VT = 36864, A_LIST = 70656, A_MISC = 103424;
__device__ __forceinline__ float attn_m0(const float* gq, const float* gk, int lane) {
    float a = fabsf(gq[lane]), b = fabsf(gk[lane]); a = wave_max(a); b = wave_max(b);
    return 8.0f * LOG2E_ * a * b * 1.02f + 0.25f;
}
__device__ __forceinline__ void stage_kv_load(u32x4 (&kk)[4], u32x4 (&vv)[4], const bf16* K, const bf16* V, size_t rowbase, int h, int tid) {
    const int r = tid >> 1, hf = tid & 1;
    const bf16* kp = K + (rowbase + r) * D_ + h * 64 + 32 * hf;
#pragma unroll
    for (int c = 0; c < 4; ++c) kk[c] = *(const u32x4*)(kp + 8 * c);
    const int p = tid >> 2, dq = tid & 3;
    const bf16* vp = V + (rowbase + 2 * p) * D_ + h * 64 + 16 * dq;
    vv[0] = *(const u32x4*)(vp); vv[1] = *(const u32x4*)(vp + 8); vv[2] = *(const u32x4*)(vp + D_); vv[3] = *(const u32x4*)(vp + D_ + 8);
}
__device__ __forceinline__ void stage_kv_store(LAS unsigned char* lds, const u32x4 (&kk)[4], const u32x4 (&vv)[4], int tid) {
    const int r = tid >> 1, hf = tid & 1;
#pragma unroll
    for (int c = 0; c < 4; ++c) *(LAS u32x4*)(lds + A_KS + r * 144 + (32 * hf + 8 * c) * 2) = kk[c];
    const int p = tid >> 2, dq = tid & 3;
    LAS unsigned* vt = (LAS unsigned*)(lds + A_VT) + p;
#pragma unroll
    for (int c = 0; c < 2; ++c)
#pragma unroll
        for (int e = 0; e < 4; ++e) { const unsigned a = (e == 0) ? vv[c].x : (e == 1) ? vv[c].y : (e == 2) ? vv[c].z : vv[c].w;
            const unsigned bb = (e == 0) ? vv[2 + c].x : (e == 1) ? vv[2 + c].y : (e == 2) ? vv[2 + c].z : vv[2 + c].w;
            const int d = 16 * dq + 8 * c + 2 * e;
            vt[d * 132] = (a & 0xffffu) | (bb << 16); vt[(d + 1) * 132] = (a >> 16) | (bb & 0xffff0000u); }
}
__device__ __forceinline__ void stage_kv(LAS unsigned char* lds, const bf16* K, const bf16* V, size_t rowbase, int h, int tid) {
    u32x4 kk[4], vv[4]; stage_kv_load(kk, vv, K, V, rowbase, h, tid); stage_kv_store(lds, kk, vv, tid);
}
__device__ __forceinline__ int alibi_dmax(float slope2, float M0) { return (int)fminf((2.0f * M0 + 40.0f) / slope2, 1.0e9f); }
template <bool MASK> __device__ __forceinline__ void attn_tile(LAS unsigned char* lds, int s8, const bf16x8 (&qf)[4], float rowc, float slope2, int lane, f32x16& o0, f32x16& o1, float& lsum, int maskq) {
    const int i = lane & 31, hi = lane >> 5;
    const int prow = (i & ~12) | ((i & 4) << 1) | ((i & 8) >> 1);
    const LAS unsigned char* kp = lds + A_KS + (32 * s8 + prow) * 144 + 16 * hi;
    const float cb = rowc + slope2 * (float)(32 * s8 + 8 * hi);
    f32x16 c;
#pragma unroll
    for (int r = 0; r < 16; ++r) c[r] = cb + slope2 * (float)(16 * (r >> 3) + (r & 7));
#pragma unroll
    for (int d0 = 0; d0 < 4; ++d0) { const bf16x8 kf = *(const LAS bf16x8*)(kp + 32 * d0); c = __builtin_amdgcn_mfma_f32_32x32x16_bf16(kf, qf[d0], c, 0, 0, 0); }
    if (MASK) {
#pragma unroll
        for (int r = 0; r < 16; ++r) if (16 * (r >> 3) + 8 * hi + (r & 7) > maskq) c[r] = -INFINITY;
    }
    float ls = 0.f;
#pragma unroll
    for (int r = 0; r < 16; ++r) { c[r] = __builtin_amdgcn_exp2f(c[r]); ls += c[r]; }
    lsum += ls;
    u32x4 p0, p1;
    p0.x = cvtpk(c[0], c[1]); p0.y = cvtpk(c[2], c[3]); p0.z = cvtpk(c[4], c[5]); p0.w = cvtpk(c[6], c[7]);
    p1.x = cvtpk(c[8], c[9]); p1.y = cvtpk(c[10], c[11]); p1.z = cvtpk(c[12], c[13]); p1.w = cvtpk(c[14], c[15]);
    const bf16x8 pf0 = __builtin_bit_cast(bf16x8, p0), pf1 = __builtin_bit_cast(bf16x8, p1);
    const LAS unsigned char* vp = lds + A_VT + (i * 264 + 32 * s8 + 8 * hi) * 2;
    { const bf16x8 v00 = *(const LAS bf16x8*)(vp), v01 = *(const LAS bf16x8*)(vp + 32), v10 = *(const LAS bf16x8*)(vp + 32 * 528), v11 = *(const LAS bf16x8*)(vp + 32 * 528 + 32);
      o0 = __builtin_amdgcn_mfma_f32_32x32x16_bf16(v00, pf0, o0, 0, 0, 0); o1 = __builtin_amdgcn_mfma_f32_32x32x16_bf16(v10, pf0, o1, 0, 0, 0);
      o0 = __builtin_amdgcn_mfma_f32_32x32x16_bf16(v01, pf1, o0, 0, 0, 0); o1 = __builtin_amdgcn_mfma_f32_32x32x16_bf16(v11, pf1, o1, 0, 0, 0); }
}
__device__ __forceinline__ bf16* op_ptr(unsigned char* ws, float* out, int rank) { return (rank == 2) ? (bf16*)(ws + WS_OP3) : (bf16*)out + (size_t)rank * ((size_t)M_ * D_); }

struct A2Item { int n, bh, b, h, tbeg, tlim, dmax; float slope2; };
__device__ __forceinline__ A2Item a2_decode(int item, float M0) {
    A2Item I; I.n = item >> 5; I.bh = item & 31; I.b = I.bh >> 4; I.h = I.bh & 15;
    I.slope2 = exp2f(-0.5f * (float)(I.h + 1)) * LOG2E_; I.dmax = alibi_dmax(I.slope2, M0);
    I.tbeg = (I.n + 1) * 256; I.tlim = min(S_, 256 * I.n + 256 + I.dmax); return I;
}
__device__ __forceinline__ void a2_load(const A2Item& I, u32x4 (&kk)[4], u32x4 (&vv)[4], u32x4 (&sv)[8], const bf16* K, const bf16* V, const unsigned* sel, int tid) {
    stage_kv_load(kk, vv, K, V, (size_t)I.b * S_ + 256 * I.n, I.h, tid);
    const unsigned* sp = sel + (size_t)I.bh * S_;
#pragma unroll
    for (int c = 0; c < 8; ++c) { const int t0 = I.tbeg + 2048 * c + 4 * tid;
        sv[c] = (u32x4){0xFFFFFFFFu, 0xFFFFFFFFu, 0xFFFFFFFFu, 0xFFFFFFFFu};
        if (I.tbeg + 2048 * c < I.tlim) { if (t0 < S_) sv[c] = *(const u32x4*)(sp + t0); } }
}
__device__ __forceinline__ void a2_phase(LAS unsigned char* lds, int wave_in, int qword) {
    int tid = lane_id(); asm volatile("" : "+v"(tid)); tid += 64 * wave_in;
    const int lane = tid & 63, wave = __builtin_amdgcn_readfirstlane(tid >> 6), q = lane & 31, hi = lane >> 5;
    unsigned char* const ws = PWS;
    const bf16* Q = (const bf16*)(ws + WS_Q); const bf16* K = (const bf16*)(ws + WS_K); const bf16* V = (const bf16*)(ws + WS_V);
    const unsigned* sel = (const unsigned*)(ws + WS_SEL); unsigned* ctl = (unsigned*)(ws + WS_CTL); float* LP = (float*)(ws + WS_LP); float* const outp = POUT;
    const float M0 = attn_m0(PIN(8), PIN(9), lane);
    LAS unsigned short* list = (LAS unsigned short*)(lds + A_LIST); volatile LAS int* misc = (volatile LAS int*)(lds + A_MISC);
    constexpr int NIT = 63 * 32;
    int t_cur = 0, t_nxt = 0;
    if (tid == 0) { t_cur = (int)__hip_atomic_fetch_add(ctl + qword, 1u, __ATOMIC_RELAXED, __HIP_MEMORY_SCOPE_AGENT); t_nxt = (int)__hip_atomic_fetch_add(ctl + qword, 1u, __ATOMIC_RELAXED, __HIP_MEMORY_SCOPE_AGENT); }
    LDS_BARRIER();
    if (tid == 0) { misc[0] = t_cur; misc[2] = t_nxt; misc[1] = 0; }
    LDS_BARRIER();
    int item = __builtin_amdgcn_readfirstlane(misc[0]), item_n = __builtin_amdgcn_readfirstlane(misc[2]);
    u32x4 kk[4], vv[4], sv[8];
    if (item < NIT) { const A2Item I0 = a2_decode(item, M0); a2_load(I0, kk, vv, sv, K, V, sel, tid); }
    while (item < NIT) {
        const A2Item I = a2_decode(item, M0);
        const int n = I.n, b = I.b, h = I.h, dmax = I.dmax; const float slope2 = I.slope2;
        int t_nn = 0;
        if (tid == 0) t_nn = (int)__hip_atomic_fetch_add(ctl + qword, 1u, __ATOMIC_RELAXED, __HIP_MEMORY_SCOPE_AGENT);
        stage_kv_store(lds, kk, vv, tid);
#pragma unroll
        for (int c = 0; c < 8; ++c) {
            if (I.tbeg + 2048 * c < I.tlim) {
#pragma unroll
                for (int e = 0; e < 4; ++e) {
                    const unsigned s = (e == 0) ? sv[c].x : (e == 1) ? sv[c].y : (e == 2) ? sv[c].z : sv[c].w;
                    const int t = I.tbeg + 2048 * c + 4 * tid + e;
                    int rank = ((s & 255u) == (unsigned)n) ? 0 : (((s >> 8) & 255u) == (unsigned)n) ? 1 : (((s >> 16) & 255u) == (unsigned)n) ? 2 : -1;
                    if (t - 256 * n - 255 > dmax) rank = -1;
                    const unsigned long long bal = __ballot(rank >= 0);
                    if (bal) {
                        const int pre = __builtin_amdgcn_mbcnt_hi((unsigned)(bal >> 32), __builtin_amdgcn_mbcnt_lo((unsigned)bal, 0u));
                        int base = 0;
                        if (lane == 0) base = __hip_atomic_fetch_add((LAS int*)(lds + A_MISC) + 1, __popcll(bal), __ATOMIC_RELAXED, __HIP_MEMORY_SCOPE_WORKGROUP);
                        base = __builtin_amdgcn_readfirstlane(base);
                        if (rank >= 0) list[base + pre] = (unsigned short)(t | (rank << 14));
                    }
                }
            }
        }
        if (item_n < NIT) { const A2Item In = a2_decode(item_n, M0); a2_load(In, kk, vv, sv, K, V, sel, tid); }
        LDS_BARRIER();
        const int total = __builtin_amdgcn_readfirstlane(misc[1]);
        const int nr = (total + 255) >> 8;
        bf16x8 qn[4]; unsigned en = 0u;
        if (32 * wave < total) { const int idx = 32 * wave + q; en = list[(idx < total) ? idx : 32 * wave];
            const size_t rown = (size_t)b * S_ + (en & 16383);
#pragma unroll
            for (int d0 = 0; d0 < 4; ++d0) qn[d0] = *(const bf16x8*)(Q + rown * D_ + h * 64 + 16 * d0 + 8 * hi); }
        for (int r = 0; r < nr; ++r) {
            const int i0 = 256 * r + 32 * wave;
            if (i0 < total) {
                const int idx = i0 + q; const bool valid = idx < total;
                const unsigned e = en;
                const int t = e & 16383, rank = e >> 14;
                const size_t row = (size_t)b * S_ + t;
                bf16x8 qf[4];
#pragma unroll
                for (int d0 = 0; d0 < 4; ++d0) qf[d0] = qn[d0];
                if (i0 + 256 < total) { const int idx2 = idx + 256; en = list[(idx2 < total) ? idx2 : i0 + 256];
                    const size_t rown = (size_t)b * S_ + (en & 16383);
#pragma unroll
                    for (int d0 = 0; d0 < 4; ++d0) qn[d0] = *(const bf16x8*)(Q + rown * D_ + h * 64 + 16 * d0 + 8 * hi); }
                const float rowc = -slope2 * (float)(t - 256 * n) - M0;
                f32x16 o0, o1; float lsum = 0.f;
#pragma unroll
                for (int k = 0; k < 16; ++k) { o0[k] = 0.f; o1[k] = 0.f; }
#pragma unroll 2
                for (int s8 = 0; s8 < 8; ++s8) attn_tile<false>(lds, s8, qf, rowc, slope2, lane, o0, o1, lsum, 0);
                lsum = sum32(lsum);
                if (valid) {
                    bf16* op = op_ptr(ws, outp, rank) + row * D_ + h * 64 + 4 * hi;
#pragma unroll
                    for (int g = 0; g < 4; ++g) {
                        u32x2 w0, w1; w0.x = cvtpk(o0[4 * g], o0[4 * g + 1]); w0.y = cvtpk(o0[4 * g + 2], o0[4 * g + 3]);
                        w1.x = cvtpk(o1[4 * g], o1[4 * g + 1]); w1.y = cvtpk(o1[4 * g + 2], o1[4 * g + 3]);
                        *(u32x2*)(op + 8 * g) = w0; *(u32x2*)(op + 32 + 8 * g) = w1; }
                    if (hi == 0) LP[((size_t)rank * M_ + row) * 16 + h] = lsum;
                }
            }
        }
        LDS_BARRIER();
        if (tid == 0) { misc[0] = item_n; misc[2] = t_nn; misc[1] = 0; }
        LDS_BARRIER();
        item = __builtin_amdgcn_readfirstlane(misc[0]); item_n = __builtin_amdgcn_readfirstlane(misc[2]);
    }
}

__device__ __forceinline__ void a3_phase(LAS unsigned char* lds, int vcu, int G, int wave_in) {
    int tid = lane_id(); asm volatile("" : "+v"(tid)); tid += 64 * wave_in;
    const int lane = tid & 63, wave = __builtin_amdgcn_readfirstlane(tid >> 6), q = lane & 31, hi = lane >> 5;
    unsigned char* const ws = PWS;
    bf16* Q = (bf16*)(ws + WS_Q); const bf16* K = (const bf16*)(ws + WS_K); const bf16* V = (const bf16*)(ws + WS_V);
    const unsigned* sel = (const unsigned*)(ws + WS_SEL); const float* LP = (const float*)(ws + WS_LP); float* const outp = POUT;
    const float M0 = attn_m0(PIN(8), PIN(9), lane);
    u32x4 kk[4], vv[4];
    if (vcu < 2048) { const int bh = vcu >> 6, m = vcu & 63; stage_kv_load(kk, vv, K, V, (size_t)(bh >> 4) * S_ + 256 * m, bh & 15, tid); }
    for (int un = vcu; un < 2048; un += G) {
        const int bh = un >> 6, m = un & 63, b = bh >> 4, h = bh & 15;
        const float slope2 = exp2f(-0.5f * (float)(h + 1)) * LOG2E_;
        LDS_BARRIER();
        stage_kv_store(lds, kk, vv, tid);
        { const int un2 = un + G; if (un2 < 2048) { const int bh2 = un2 >> 6, m2 = un2 & 63; stage_kv_load(kk, vv, K, V, (size_t)(bh2 >> 4) * S_ + 256 * m2, bh2 & 15, tid); } }
        const int t = 256 * m + 32 * wave + q; const size_t row = (size_t)b * S_ + t;
        bf16x8 qf[4];
#pragma unroll
        for (int d0 = 0; d0 < 4; ++d0) qf[d0] = *(const bf16x8*)(Q + row * D_ + h * 64 + 16 * d0 + 8 * hi);
        const unsigned s = sel[(size_t)bh * S_ + t];
        float lp[3]; u32x2 pw[3][8];
#pragma unroll
        for (int rank = 0; rank < 3; ++rank) {
            lp[rank] = LP[((size_t)rank * M_ + row) * 16 + h];
            const bf16* op = op_ptr(ws, outp, rank) + row * D_ + h * 64 + 4 * hi;
#pragma unroll
            for (int g = 0; g < 4; ++g) { pw[rank][g] = *(const u32x2*)(op + 8 * g); pw[rank][4 + g] = *(const u32x2*)(op + 32 + 8 * g); }
        }
        LDS_BARRIER();
        const float rowc = -slope2 * (float)(32 * wave + q) - M0;
        f32x16 o0, o1; float lsum = 0.f;
#pragma unroll
        for (int k = 0; k < 16; ++k) { o0[k] = 0.f; o1[k] = 0.f; }
        for (int s8 = 0; s8 < wave; ++s8) attn_tile<false>(lds, s8, qf, rowc, slope2, lane, o0, o1, lsum, 0);
        attn_tile<true>(lds, wave, qf, rowc, slope2, lane, o0, o1, lsum, q);
        float l = sum32(lsum);
        const int dmax = alibi_dmax(slope2, M0);
#pragma unroll
        for (int rank = 0; rank < 3; ++rank) {
            const int nb = (int)((s >> (8 * rank)) & 255u);
            if (nb != 255 && (t - 256 * nb - 255) <= dmax) {
                l += lp[rank];
#pragma unroll
                for (int g = 0; g < 4; ++g) { const u32x2 w0 = pw[rank][g], w1 = pw[rank][4 + g];
                    o0[4 * g] += bflo(w0.x); o0[4 * g + 1] += bfhi(w0.x); o0[4 * g + 2] += bflo(w0.y); o0[4 * g + 3] += bfhi(w0.y);
                    o1[4 * g] += bflo(w1.x); o1[4 * g + 1] += bfhi(w1.x); o1[4 * g + 2] += bflo(w1.y); o1[4 * g + 3] += bfhi(w1.y); }
            }
        }
        const float inv = 1.0f / l;
        bf16* op = Q + row * D_ + h * 64 + 4 * hi;
#pragma unroll
        for (int g = 0; g < 4; ++g) {
            u32x2 w0, w1; w0.x = cvtpk(o0[4 * g] * inv, o0[4 * g + 1] * inv); w0.y = cvtpk(o0[4 * g + 2] * inv, o0[4 * g + 3] * inv);
            w1.x = cvtpk(o1[4 * g] * inv, o1[4 * g + 1] * inv); w1.y = cvtpk(o1[4 * g + 2] * inv, o1[4 * g + 3] * inv);
            *(u32x2*)(op + 8 * g) = w0; *(u32x2*)(op + 32 + 8 * g) = w1; }
    }
}

constexpr int A1_KH = 0, A1_KL = 9216;
__device__ __forceinline__ void top3_ins(float v, int n, float& v0, float& v1, float& v2, int& i0, int& i1, int& i2) {
    const bool c0 = v > v0, c1 = v > v1, c2 = v > v2;
    v2 = c1 ? v1 : (c2 ? v : v2); i2 = c1 ? i1 : (c2 ? n : i2);
    v1 = c0 ? v0 : (c1 ? v : v1); i1 = c0 ? i0 : (c1 ? n : i1);
    v0 = c0 ? v : v0;             i0 = c0 ? n : i0;
}
__device__ __forceinline__ void a1_phase(LAS unsigned char* lds, int vcu, int G, int wave_in) {
    int tid = lane_id(); asm volatile("" : "+v"(tid)); tid += 64 * wave_in;
    const int lane = tid & 63, wave = __builtin_amdgcn_readfirstlane(tid >> 6), q = lane & 31, hi = lane >> 5;
    unsigned char* const ws = PWS;
    const bf16* Q = (const bf16*)(ws + WS_Q); const float* kbarp = (const float*)(ws + WS_KBAR); unsigned* sel = (unsigned*)(ws + WS_SEL);
    for (int un = vcu; un < 256; un += G) {
        const int bh = un >> 3, mg = un & 7, b = bh >> 4, h = bh & 15;
        LDS_BARRIER();
        { const int n = tid >> 3, d0 = (tid & 7) * 8;
          const float* p = kbarp + ((size_t)bh * 64 + n) * 128 + d0;
          const f32x4 a0 = *(const f32x4*)p, a1 = *(const f32x4*)(p + 4), b0 = *(const f32x4*)(p + 64), b1 = *(const f32x4*)(p + 68);
          const f32x4 v0 = (a0 + b0) * (1.0f / 256.0f), v1 = (a1 + b1) * (1.0f / 256.0f);
          unsigned hb[8], lb[8];
#pragma unroll
          for (int e = 0; e < 8; ++e) { const float v = (e < 4) ? v0[e & 3] : v1[e & 3]; hb[e] = f2bf(v); lb[e] = f2bf(v - bf2f(hb[e])); }
          u32x4 wh, wl; wh.x = hb[0] | (hb[1] << 16); wh.y = hb[2] | (hb[3] << 16); wh.z = hb[4] | (hb[5] << 16); wh.w = hb[6] | (hb[7] << 16);
          wl.x = lb[0] | (lb[1] << 16); wl.y = lb[2] | (lb[3] << 16); wl.z = lb[4] | (lb[5] << 16); wl.w = lb[6] | (lb[7] << 16);
          *(LAS u32x4*)(lds + A1_KH + n * 144 + d0 * 2) = wh; *(LAS u32x4*)(lds + A1_KL + n * 144 + d0 * 2) = wl; }
        LDS_BARRIER();
        bf16x8 qn[4];
        { const size_t row0 = (size_t)b * S_ + 256 * (mg * 8) + 32 * wave + q;
#pragma unroll
          for (int d0 = 0; d0 < 4; ++d0) qn[d0] = *(const bf16x8*)(Q + row0 * D_ + h * 64 + 16 * d0 + 8 * hi); }
        for (int mi = 0; mi < 8; ++mi) {
            const int m = mg * 8 + mi, t = 256 * m + 32 * wave + q;
            bf16x8 qf[4];
#pragma unroll
            for (int d0 = 0; d0 < 4; ++d0) qf[d0] = qn[d0];
            if (mi < 7) { const size_t rown = (size_t)b * S_ + t + 256;
#pragma unroll
                for (int d0 = 0; d0 < 4; ++d0) qn[d0] = *(const bf16x8*)(Q + rown * D_ + h * 64 + 16 * d0 + 8 * hi); }
            if (m == 0) { if (hi == 0) sel[(size_t)bh * S_ + t] = 0x00FFFFFFu; continue; }
            f32x16 c0, c1;
#pragma unroll
            for (int k = 0; k < 16; ++k) { c0[k] = 0.f; c1[k] = 0.f; }
            const LAS unsigned char* kp = lds + q * 144 + 16 * hi;
#pragma unroll
            for (int d0 = 0; d0 < 4; ++d0) {
                const bf16x8 h0 = *(const LAS bf16x8*)(kp + A1_KH + 32 * d0), h1 = *(const LAS bf16x8*)(kp + A1_KH + 32 * 144 + 32 * d0);
                const bf16x8 l0 = *(const LAS bf16x8*)(kp + A1_KL + 32 * d0), l1 = *(const LAS bf16x8*)(kp + A1_KL + 32 * 144 + 32 * d0);
                c0 = __builtin_amdgcn_mfma_f32_32x32x16_bf16(h0, qf[d0], c0, 0, 0, 0); c1 = __builtin_amdgcn_mfma_f32_32x32x16_bf16(h1, qf[d0], c1, 0, 0, 0);
                c0 = __builtin_amdgcn_mfma_f32_32x32x16_bf16(l0, qf[d0], c0, 0, 0, 0); c1 = __builtin_amdgcn_mfma_f32_32x32x16_bf16(l1, qf[d0], c1, 0, 0, 0);
            }
            float v0 = -INFINITY, v1 = -INFINITY, v2 = -INFINITY; int i0 = 255, i1 = 255, i2 = 255;
#pragma unroll
            for (int r = 0; r < 16; ++r) { const int n = (r & 3) + 8 * (r >> 2) + 4 * hi; top3_ins((n < m) ? c0[r] : -INFINITY, n, v0, v1, v2, i0, i1, i2); }
#pragma unroll
            for (int r = 0; r < 16; ++r) { const int n = 32 + (r & 3) + 8 * (r >> 2) + 4 * hi; top3_ins((n < m) ? c1[r] : -INFINITY, n, v0, v1, v2, i0, i1, i2); }
            const float pv0 = __builtin_bit_cast(float, other32(__builtin_bit_cast(unsigned, v0), hi)), pv1 = __builtin_bit_cast(float, other32(__builtin_bit_cast(unsigned, v1), hi)), pv2 = __builtin_bit_cast(float, other32(__builtin_bit_cast(unsigned, v2), hi));
            const int pi0 = (int)other32((unsigned)i0, hi), pi1 = (int)other32((unsigned)i1, hi), pi2 = (int)other32((unsigned)i2, hi);
            top3_ins(pv0, pi0, v0, v1, v2, i0, i1, i2); top3_ins(pv1, pi1, v0, v1, v2, i0, i1, i2); top3_ins(pv2, pi2, v0, v1, v2, i0, i1, i2);
            if (hi == 0) sel[(size_t)bh * S_ + t] = (unsigned)i0 | ((unsigned)i1 << 8) | ((unsigned)i2 << 16);
        }
    }
}
#ifndef MK_MULTI
#define MK_MULTI 0
#endif
constexpr int NPH = 18;
struct Args { const float* in[19]; float* out; unsigned char* ws; int lo, hi; };
__global__ void __launch_bounds__(512, 2) fwd(Args a) {
    extern __shared__ __attribute__((aligned(16))) unsigned char lds_raw[];
    LAS unsigned char* lds = (LAS unsigned char*)lds_raw;
    const int tid = threadIdx.x, G = gridDim.x; const int wave = __builtin_amdgcn_readfirstlane(tid >> 6);
    const int vcu = (G % 8 == 0) ? ((int)blockIdx.x % 8) * (G / 8) + (int)blockIdx.x / 8 : (int)blockIdx.x;
    volatile LAS unsigned* MISC = (volatile LAS unsigned*)(lds + MISC_OFF);
    for (int u = tid; u < (LDS_BYTES - LDSCTL_OFF) / 4; u += 512) ((LAS unsigned*)(lds + LDSCTL_OFF))[u] = 0u;
    __syncthreads();
    if (tid == 0) {
        LAS unsigned long long* PT = (LAS unsigned long long*)(lds + PT_OFF);
#pragma unroll
        for (int i = 0; i < 19; ++i) PT[i] = (unsigned long long)a.in[i];
        PT[19] = (unsigned long long)a.out; PT[20] = (unsigned long long)a.ws;
        ((LAS int*)(lds + PT_OFF))[48] = a.lo; ((LAS int*)(lds + PT_OFF))[49] = a.hi;
    }
    __syncthreads();
    if (a.hi - a.lo > 1) (void)xcd_barrier_post((unsigned*)(a.ws + WS_CTL) + CW_BAR, MISC + 8);
#define LO (__builtin_amdgcn_readfirstlane(((volatile LAS int*)(lds + PT_OFF))[48]))
#define HI (__builtin_amdgcn_readfirstlane(((volatile LAS int*)(lds + PT_OFF))[49]))
#define IN(k) (LO <= (k) && (k) < HI)
#define SEAM(k) do { if (IN(k) && IN((k) + 1)) { XcdBarrier bar_; bar_.bar = (unsigned*)(PWS + WS_CTL) + CW_BAR; bar_.x = xb_xcc_id(); bar_.st = MISC + 8; xcd_barrier(bar_); } } while (0)

    if (IN(0)) { __syncthreads(); phase_p0(lds, vcu, G, wave); }
    SEAM(0);
    if (IN(1)) { __syncthreads(); phase_p1(lds, vcu, G, wave); }
    SEAM(1);

    int ph = 2;
#pragma unroll 1
    for (int sl = 0; sl < 6; ++sl) {
        if (sl == 1) {
            if (IN(ph)) { __syncthreads(); unsigned char* const ws = PWS;
                EpiQKV E{(bf16*)(ws + WS_Q), (const float*)(ws + WS_BQKV), (const float*)(ws + ((sl & 1) ? WS_SSQ1 : WS_SSQ)), PIN(8), PIN(9), (float*)(ws + WS_KBAR), lds};
                __syncthreads(); run_gemm(lds, (const bf16*)(ws + WS_XB), (const bf16*)(ws + WS_WQKV), 3072L * 1024 * 2, 3072, 1024, G, E, wave);
            }
            SEAM(ph); ++ph;
            if (IN(ph)) { __syncthreads(); a1_phase(lds, vcu, G, wave); }
            SEAM(ph); ++ph;
            if (IN(ph)) { __syncthreads(); a2_phase(lds, wave, CW_Q2); }
            SEAM(ph); ++ph;
            if (IN(ph)) { __syncthreads(); a3_phase(lds, vcu, G, wave); }
            SEAM(ph); ++ph;
        } else if (sl == 4) {
            if (IN(ph)) { __syncthreads(); unsigned char* const ws = PWS;
                EpiGated<1> E{(bf16*)(ws + WS_U), 1024, (const float*)(ws + WS_BPW1), 2048, (const float*)(ws + ((sl & 1) ? WS_SSQ1 : WS_SSQ)), lds, nullptr, nullptr, nullptr, nullptr};
                __syncthreads(); run_gemm(lds, (const bf16*)(ws + WS_XB), (const bf16*)(ws + WS_WPW1), 2048L * 1024 * 2, 2048, 1024, G, E, wave);
            }
            SEAM(ph); ++ph;
            if (IN(ph)) { __syncthreads(); conv_phase(lds, vcu, G, wave); }
            SEAM(ph); ++ph;
        } else {
            const int f = (sl / 3) * 2 + ((sl % 3) == 2);
            if (IN(ph)) { __syncthreads(); unsigned char* const ws = PWS;
                const float* ssq_cur = (const float*)(ws + ((sl & 1) ? WS_SSQ1 : WS_SSQ)); const float* ssq_prv = (const float*)(ws + ((sl == 0) ? WS_SSQ : (sl & 1) ? WS_SSQ : WS_SSQ1));
                if ((I8MASK >> f) & 1) {
                    EpiGated<0, true> E{(bf16*)(ws + WS_ACT), FF_, (const float*)(ws + WS_BFFN) + (size_t)f * 2 * 5632, 5632, ssq_cur, lds, ssq_prv, (const signed char*)(ws + WS_WEXP) + f * 5632,
                                        PIN(2) + sl * 1024, (const float*)(ws + WS_MOD) + (size_t)((sl / 3) * 2) * 9216 + (sl % 3) * 3 * 1024 + 1024};
                    __syncthreads(); run_gemm<EpiGated<0, true>, true>(lds, (const bf16*)(ws + WS_X8), (const bf16*)(ws + WS_WIN) + (size_t)f * 2 * 5632 * 1024, 0L, 5632, 512, G, E, wave);
                } else {
                EpiGated<0> E{(bf16*)(ws + WS_ACT), FF_, (const float*)(ws + WS_BFFN) + (size_t)f * 2 * 5632, 5632, ssq_cur, lds, nullptr, nullptr, nullptr, nullptr};
                __syncthreads(); run_gemm(lds, (const bf16*)(ws + WS_XB), (const bf16*)(ws + WS_WIN) + (size_t)f * 2 * 5632 * 1024, 5632L * 1024 * 2, 5632, 1024, G, E, wave);
                }
            }
            SEAM(ph); ++ph;
        }
        if (IN(ph)) { __syncthreads(); unsigned char* const ws = PWS; float* const out = POUT;
            const bf16* Ares; const bf16* Wres; int Kres; const float* bias2 = nullptr;
            if (sl == 1) { Ares = (const bf16*)(ws + WS_Q); Wres = (const bf16*)(ws + WS_WO); Kres = 1024; }
            else if (sl == 4) { Ares = (const bf16*)(ws + WS_CV); Wres = (const bf16*)(ws + WS_WPW2); Kres = 1024; bias2 = PIN(18); }
            else { const int f = (sl / 3) * 2 + ((sl % 3) == 2); Ares = (const bf16*)(ws + WS_ACT); Wres = (const bf16*)(ws + WS_WOUT) + (size_t)f * 1024 * 2816; Kres = FF_; }
            const int fnext = (sl == 1) ? 1 : (sl == 2) ? 2 : (sl == 4) ? 3 : -1;
            const bool q8 = fnext >= 0 && ((I8MASK >> fnext) & 1); const int sn = sl + 1;
            EpiRes E{(bf16*)(ws + WS_XB), out, bias2, (const float*)(ws + WS_COEF) + (size_t)sl * 2048, (float*)(ws + ((sl & 1) ? WS_SSQ : WS_SSQ1)), (sl == 5) ? 1 : 0, lds,
                     q8 ? ws + WS_X8 : nullptr, (const float*)(ws + ((sl & 1) ? WS_SSQ1 : WS_SSQ)), PIN(2) + sn * 1024, (const float*)(ws + WS_MOD) + (size_t)((sn / 3) * 2) * 9216 + (sn % 3) * 3 * 1024 + 1024};
            run_gemm(lds, Ares, Wres, 0L, 1024, Kres, G, E, wave);
        }
        SEAM(ph); ++ph;
    }
#undef IN
#undef SEAM
}

extern "C" void kernel_launch(void* const* d_in, const int* in_sizes, int n_in, void* d_out, int out_size, void* d_ws, size_t ws_size, hipStream_t stream) {
    static int grid = 0;
    if (grid == 0) {
        if (n_in != 19 || in_sizes[0] != M_ * D_ || out_size != M_ * D_ || ws_size < WS_END) {
            fprintf(stderr, "kernel_launch: unexpected problem (n_in %d, in0 %d, out %d, ws %zu); nothing launched\n", n_in, n_in > 0 ? in_sizes[0] : -1, out_size, ws_size); grid = -1; return; }
        int dev = 0, cus = 0;
        if (hipGetDevice(&dev) != hipSuccess || hipDeviceGetAttribute(&cus, hipDeviceAttributeMultiprocessorCount, dev) != hipSuccess) { grid = -1; return; }
        if (hipFuncSetAttribute((const void*)fwd, hipFuncAttributeMaxDynamicSharedMemorySize, LDS_BYTES) != hipSuccess) { fprintf(stderr, "kernel_launch: hipFuncSetAttribute failed\n"); grid = -1; return; }
        int per_cu = 0;
        if (hipOccupancyMaxActiveBlocksPerMultiprocessor(&per_cu, (const void*)fwd, 512, LDS_BYTES) != hipSuccess || per_cu < 1) fprintf(stderr, "kernel_launch: occupancy query reports %d blocks per CU\n", per_cu);
        (void)hipGetLastError();
        grid = cus;
    }
    if (grid < 0) return;
    if (hipMemsetAsync((char*)d_ws + WS_CTL, 0, CTL_ZERO_BYTES, stream) != hipSuccess) return;
    Args a{};
    for (int i = 0; i < 19; ++i) a.in[i] = (const float*)d_in[i];
    a.out = (float*)d_out; a.ws = (unsigned char*)d_ws;
#if MK_MULTI
    for (int p = 0; p < NPH; ++p) { a.lo = p; a.hi = p + 1; hipLaunchKernelGGL(fwd, dim3(grid), dim3(512), LDS_BYTES, stream, a); }
#else
    a.lo = 0; a.hi = NPH; hipLaunchKernelGGL(fwd, dim3(grid), dim3(512), LDS_BYTES, stream, a);
#endif
}
```

```cpp
#define I8MASK 63
#include <hip/hip_runtime.h>
#include <cstdio>
#include <cstdint>
#include <cmath>
namespace pg8 {
#define PG8_LAS __attribute__((address_space(3)))
typedef unsigned short bf16_t;
typedef short bf16x8 __attribute__((ext_vector_type(8)));
typedef float f32x4 __attribute__((ext_vector_type(4)));
typedef unsigned u32x4 __attribute__((ext_vector_type(4)));
constexpr int BM = 256, BK = 64, HALF = 128, HTB = HALF * BK * 2  , STAGE_BYTES = 8 * HTB, NXCD = 8, WGM = 8;

__host__ __device__ __forceinline__ int lds_byte(int r, int c) { const int st = (r >> 4) * 2 + (c >> 5), rr = r & 15, cc = c & 31, ob = rr * 64 + cc * 2; return st * 1024 + (ob ^ (((ob >> 9) & 1) << 5)); }
__host__ __device__ __forceinline__ void stage_rc(int b, int& R, int& C) { const int st = b / 1024, sb = b % 1024, swz = sb ^ (((sb >> 9) & 1) << 5); R = (st >> 1) * 16 + swz / 64; C = (st & 1) * 32 + (swz % 64) / 2; }
__host__ __device__ __forceinline__ int perm32(int rho) { const int n = rho >> 4, i = rho & 15; return 8 * (i >> 2) + 4 * n + (i & 3); }

struct Unit { int pm, pn; };
struct Gemm { const bf16_t* A; const bf16_t* Bt; int M, N, K; long bb; };

struct StaticOrder {
    int nM, nN, nwg, G, c;
    __host__ __device__ void init(int M, int N, int G_, int c_) { nM = M / BM; nN = N / BM; nwg = nM * nN; G = G_; c = c_; }
    __host__ __device__ bool next(int i, Unit& u) const {
        const long L = (long)i * G + c; if (L >= nwg) return false;
        int wgid = (int)L; { const int q = nwg / NXCD, r = nwg % NXCD, xcd = wgid % NXCD, off = wgid / NXCD; wgid = (xcd < r ? xcd * (q + 1) : r * (q + 1) + (xcd - r) * q) + off; }
        const int nig = WGM * nN, gid = wgid / nig, fm = gid * WGM, gsz = (nM - fm) < WGM ? (nM - fm) : WGM;
        u.pm = fm + ((wgid % nig) % gsz); u.pn = (wgid % nig) / gsz; return true;
    }
    __device__ __forceinline__ void a_ready(const Unit&) const {}
    __device__ __forceinline__ void done(const Unit&) const {}
};

__device__ __forceinline__ unsigned cvt_pk_bf16(float lo, float hi) { unsigned r; asm volatile("v_cvt_pk_bf16_f32 %0, %1, %2" : "=v"(r) : "v"(lo), "v"(hi)); return r; }
typedef float f32x2 __attribute__((ext_vector_type(2)));
template <class Epi, class Sched, bool ALIGN_EPI = false, bool SP2 = false, bool F8 = false>
__device__ __forceinline__ void gemm_phase(PG8_LAS unsigned char* lds, const Gemm g, const Sched& S, const Epi& E, const int tid_in) {
    typedef int pg8_i32x8 __attribute__((ext_vector_type(8))); typedef int pg8_i32x4 __attribute__((ext_vector_type(4)));
    const int tid = tid_in, wid = __builtin_amdgcn_readfirstlane(tid >> 6), lane = tid & 63, wr = wid >> 2, wc = wid & 3, fr = lane & 15, fq = lane >> 4;
    const int K = g.K, nt = K / BK;
    unsigned voffA[2], voffB[2];
#pragma unroll
    for (int i = 0; i < 2; ++i) { int R, C; stage_rc(tid * 16 + i * 8192, R, C); const int Rb = Epi::PERM ? ((R & ~31) + perm32(R & 31)) : R;
        voffA[i] = (unsigned)(R * K + C) * 2u; voffB[i] = (unsigned)(Rb * K + C) * 2u; }
    const unsigned long long pa_ = (unsigned long long)g.A, pb_ = (unsigned long long)g.Bt;
    void* const ua_ = (void*)(((unsigned long long)(unsigned)__builtin_amdgcn_readfirstlane((int)(pa_ >> 32)) << 32) | (unsigned long long)(unsigned)__builtin_amdgcn_readfirstlane((int)(unsigned)pa_));
    void* const ub_ = (void*)(((unsigned long long)(unsigned)__builtin_amdgcn_readfirstlane((int)(pb_ >> 32)) << 32) | (unsigned long long)(unsigned)__builtin_amdgcn_readfirstlane((int)(unsigned)pb_));
    const __amdgpu_buffer_rsrc_t rs_voffA = __builtin_amdgcn_make_buffer_rsrc(ua_, 0, -1, 0x00020000), rs_voffB = __builtin_amdgcn_make_buffer_rsrc(ub_, 0, -1, 0x00020000);
    const unsigned kstep = (unsigned)(BK * 2);
    const unsigned hstep = (unsigned)(HALF * K * 2);
    const unsigned tstep = 2u * hstep;
    const unsigned ldsw = (unsigned)wid * 1024u;
    const int aoff = lds_byte(wr * 64 + fr, fq * 8), boff = lds_byte(wc * 32 + fr, fq * 8);
#define PG8_SA(b, h) (((b) * 2 + (h)) * HTB)
#define PG8_SB(b, h) ((4 + (b) * 2 + (h)) * HTB)
#define PG8_STAGE(bufoff, soff, voff) do { _Pragma("unroll") for (int _i = 0; _i < 2; ++_i) \
        __builtin_amdgcn_raw_ptr_buffer_load_lds(rs_##voff, (PG8_LAS void*)(lds + (bufoff) + ldsw + _i * 8192), 16, (int)(voff)[_i], (int)(soff), 0, 0); } while (0)
#define PG8_STAGE1(bufoff, soff, voff, i_) __builtin_amdgcn_raw_ptr_buffer_load_lds(rs_##voff, (PG8_LAS void*)(lds + (bufoff) + ldsw + (i_) * 8192), 16, (int)(voff)[i_], (int)(soff), 0, 0)
#define PG8_LDA1(dst, b, h, m_) do { _Pragma("unroll") for (int k = 0; k < 2; ++k) dst[m_][k] = *(const PG8_LAS bf16x8*)(lds + PG8_SA(b, h) + aoff + (m_) * 2048 + k * 1024); } while (0)
#define PG8_LDA(dst, b, h) do { _Pragma("unroll") for (int m = 0; m < 4; ++m) _Pragma("unroll") for (int k = 0; k < 2; ++k) dst[m][k] = *(const PG8_LAS bf16x8*)(lds + PG8_SA(b, h) + aoff + m * 2048 + k * 1024); } while (0)
#define PG8_LDB(dst, b, h) do { _Pragma("unroll") for (int n = 0; n < 2; ++n) _Pragma("unroll") for (int k = 0; k < 2; ++k) dst[n][k] = *(const PG8_LAS bf16x8*)(lds + PG8_SB(b, h) + boff + n * 2048 + k * 1024); } while (0)
#ifndef PG8_PRIO_MMA
#define PG8_PRIO_MMA 3
#define PG8_PRIO_LOAD 0
#endif
#define PG8_MMA(ai, bj, At, Bt) do { __builtin_amdgcn_s_setprio(PG8_PRIO_MMA); \
        if constexpr (F8) { _Pragma("unroll") for (int m = 0; m < 4; ++m) _Pragma("unroll") for (int n = 0; n < 2; ++n) _Pragma("unroll") for (int k = 0; k < 2; ++k) \
            acc[ai][bj][m][n] = __builtin_bit_cast(f32x4, __builtin_amdgcn_mfma_i32_16x16x64_i8(__builtin_bit_cast(pg8_i32x4, Bt[n][k]), __builtin_bit_cast(pg8_i32x4, At[m][k]), __builtin_bit_cast(pg8_i32x4, acc[ai][bj][m][n]), 0, 0, 0)); } \
        else { _Pragma("unroll") for (int m = 0; m < 4; ++m) _Pragma("unroll") for (int n = 0; n < 2; ++n) _Pragma("unroll") for (int k = 0; k < 2; ++k) \
            acc[ai][bj][m][n] = __builtin_amdgcn_mfma_f32_16x16x32_bf16(Bt[n][k], At[m][k], acc[ai][bj][m][n], 0, 0, 0); } \
        __builtin_amdgcn_s_setprio(PG8_PRIO_LOAD); } while (0)
#define PG8_WAIT_V(n) asm volatile("s_waitcnt vmcnt(" #n ")" ::: "memory")
#define PG8_WAIT_L(n) asm volatile("s_waitcnt lgkmcnt(" #n ")" ::: "memory")
#define PG8_BAR __builtin_amdgcn_s_barrier()
#define PG8_SCHED __builtin_amdgcn_sched_barrier(0)
    Unit cur, nxt; int ui = 0;
    if (!S.next(0, cur)) return;
    f32x4 acc[2][2][4][2];
#pragma unroll
    for (int a = 0; a < 2; ++a)
#pragma unroll
        for (int b = 0; b < 2; ++b)
#pragma unroll
            for (int m = 0; m < 4; ++m)
#pragma unroll
                for (int n = 0; n < 2; ++n) acc[a][b][m][n] = (f32x4){0.f, 0.f, 0.f, 0.f};
    bf16x8 At[4][2], B0[2][2], B1[2][2];
    unsigned cA = (unsigned)cur.pm * tstep, cB = (unsigned)cur.pn * tstep + (unsigned)(cur.pm >> 6) * (unsigned)g.bb;
    S.a_ready(cur);
    if constexpr (SP2) {
        PG8_STAGE(PG8_SB(0, 0), cB, voffB); PG8_STAGE(PG8_SB(0, 1), cB + hstep, voffB); PG8_STAGE(PG8_SA(0, 0), cA, voffA); PG8_STAGE(PG8_SA(0, 1), cA + hstep, voffA);
        if (wr == 1) PG8_BAR;
        PG8_WAIT_V(2); PG8_BAR;
        PG8_STAGE(PG8_SB(1, 0), cB + kstep, voffB); PG8_STAGE(PG8_SA(1, 0), cA + kstep, voffA); PG8_STAGE(PG8_SB(1, 1), cB + hstep + kstep, voffB);
        PG8_WAIT_V(6); PG8_BAR;
    } else {
        PG8_STAGE(PG8_SB(0, 0), cB, voffB); PG8_STAGE(PG8_SA(0, 0), cA, voffA); PG8_STAGE(PG8_SB(0, 1), cB + hstep, voffB); PG8_STAGE(PG8_SA(0, 1), cA + hstep, voffA);
        if (wr == 1) PG8_BAR;
        PG8_WAIT_V(4); PG8_BAR;
        PG8_STAGE(PG8_SB(1, 0), cB + kstep, voffB); PG8_STAGE(PG8_SA(1, 0), cA + kstep, voffA); PG8_STAGE(PG8_SB(1, 1), cB + hstep + kstep, voffB);
        PG8_WAIT_V(6); PG8_BAR;
    }
    for (;;) {
        const bool has_next = S.next(ui + 1, nxt);
        const unsigned nA = has_next ? (unsigned)nxt.pm * tstep : cA, nB = has_next ? (unsigned)nxt.pn * tstep + (unsigned)(nxt.pm >> 6) * (unsigned)g.bb : cB;
        for (int t = 0; t < nt; t += 2) {
            const bool last = (t == nt - 2);
            const unsigned a1 = cA + (unsigned)(t + 1) * kstep;
            const unsigned a2 = last ? nA : cA + (unsigned)(t + 2) * kstep, b2 = last ? nB : cB + (unsigned)(t + 2) * kstep;
            const unsigned a3 = a2 + kstep, b3 = b2 + kstep;
            if (last && has_next) S.a_ready(nxt);
            if constexpr (SP2) {
            PG8_LDB(B0, 0, 0); PG8_SCHED; PG8_STAGE1(PG8_SA(1, 1), a1 + hstep, voffA, 0); PG8_SCHED; PG8_LDB(B1, 0, 1); PG8_SCHED; PG8_STAGE1(PG8_SA(1, 1), a1 + hstep, voffA, 1); PG8_SCHED; PG8_LDA(At, 0, 0);
            PG8_WAIT_V(8); PG8_WAIT_L(0); PG8_BAR; PG8_MMA(0, 0, At, B0); PG8_MMA(0, 1, At, B1); PG8_BAR; PG8_SCHED;
            PG8_LDA1(At, 0, 1, 0); PG8_SCHED; PG8_STAGE1(PG8_SB(0, 0), b2, voffB, 0); PG8_SCHED; PG8_LDA1(At, 0, 1, 1); PG8_SCHED; PG8_STAGE1(PG8_SB(0, 0), b2, voffB, 1); PG8_STAGE1(PG8_SB(0, 1), b2 + hstep, voffB, 0); PG8_SCHED; PG8_LDA1(At, 0, 1, 2); PG8_SCHED; PG8_STAGE1(PG8_SB(0, 1), b2 + hstep, voffB, 1); PG8_STAGE1(PG8_SA(0, 0), a2, voffA, 0); PG8_SCHED; PG8_LDA1(At, 0, 1, 3); PG8_SCHED; PG8_STAGE1(PG8_SA(0, 0), a2, voffA, 1);
            PG8_WAIT_V(8); PG8_WAIT_L(0); PG8_BAR; PG8_MMA(1, 0, At, B0); PG8_MMA(1, 1, At, B1); PG8_BAR; PG8_SCHED;
            PG8_LDB(B0, 1, 0); PG8_SCHED; PG8_STAGE1(PG8_SA(0, 1), a2 + hstep, voffA, 0); PG8_SCHED; PG8_LDB(B1, 1, 1); PG8_SCHED; PG8_STAGE1(PG8_SA(0, 1), a2 + hstep, voffA, 1); PG8_SCHED; PG8_LDA(At, 1, 0);
            PG8_WAIT_V(8); PG8_WAIT_L(0); PG8_BAR; PG8_MMA(0, 0, At, B0); PG8_MMA(0, 1, At, B1); PG8_BAR; PG8_SCHED;
            PG8_LDA1(At, 1, 1, 0); PG8_SCHED; PG8_STAGE1(PG8_SB(1, 0), b3, voffB, 0); PG8_SCHED; PG8_LDA1(At, 1, 1, 1); PG8_SCHED; PG8_STAGE1(PG8_SB(1, 0), b3, voffB, 1); PG8_STAGE1(PG8_SB(1, 1), b3 + hstep, voffB, 0); PG8_SCHED; PG8_LDA1(At, 1, 1, 2); PG8_SCHED; PG8_STAGE1(PG8_SB(1, 1), b3 + hstep, voffB, 1); PG8_STAGE1(PG8_SA(1, 0), a3, voffA, 0); PG8_SCHED; PG8_LDA1(At, 1, 1, 3); PG8_SCHED; PG8_STAGE1(PG8_SA(1, 0), a3, voffA, 1);
            PG8_WAIT_V(8); PG8_WAIT_L(0); PG8_BAR; PG8_MMA(1, 0, At, B0); PG8_MMA(1, 1, At, B1); PG8_BAR; PG8_SCHED;
            } else {
            PG8_LDB(B0, 0, 0); PG8_SCHED; PG8_LDA(At, 0, 0); PG8_STAGE(PG8_SA(1, 1), a1 + hstep, voffA);
            PG8_WAIT_L(8); PG8_BAR; PG8_WAIT_L(0); PG8_MMA(0, 0, At, B0); PG8_BAR; PG8_SCHED;
            PG8_LDB(B1, 0, 1); PG8_STAGE(PG8_SB(0, 0), b2, voffB);
            PG8_BAR; PG8_WAIT_L(0); PG8_MMA(0, 1, At, B1); PG8_BAR;
            PG8_LDA(At, 0, 1); PG8_STAGE(PG8_SA(0, 0), a2, voffA);
            PG8_BAR; PG8_WAIT_L(0); PG8_MMA(1, 0, At, B0); PG8_BAR; PG8_SCHED;
            PG8_STAGE(PG8_SB(0, 1), b2 + hstep, voffB);
            PG8_WAIT_V(6); PG8_BAR; PG8_MMA(1, 1, At, B1); PG8_BAR;
            PG8_LDB(B0, 1, 0); PG8_SCHED; PG8_LDA(At, 1, 0); PG8_STAGE(PG8_SA(0, 1), a2 + hstep, voffA);
            PG8_WAIT_L(8); PG8_BAR; PG8_WAIT_L(0); PG8_MMA(0, 0, At, B0); PG8_BAR; PG8_SCHED;
            PG8_LDB(B1, 1, 1); PG8_STAGE(PG8_SB(1, 0), b3, voffB);
            PG8_BAR; PG8_WAIT_L(0); PG8_MMA(0, 1, At, B1); PG8_BAR;
            PG8_LDA(At, 1, 1); PG8_STAGE(PG8_SA(1, 0), a3, voffA);
            PG8_BAR; PG8_WAIT_L(0); PG8_MMA(1, 0, At, B0); PG8_BAR; PG8_SCHED;
            PG8_STAGE(PG8_SB(1, 1), b3 + hstep, voffB);
            PG8_WAIT_V(6); PG8_BAR; PG8_MMA(1, 1, At, B1); PG8_BAR;
            }
        }
        if constexpr (ALIGN_EPI) { if (wr == 0) PG8_BAR; }
        if constexpr (F8) { _Pragma("unroll") for (int a = 0; a < 2; ++a) _Pragma("unroll") for (int b = 0; b < 2; ++b) _Pragma("unroll") for (int m = 0; m < 4; ++m) _Pragma("unroll") for (int n = 0; n < 2; ++n)
            acc[a][b][m][n] = __builtin_convertvector(__builtin_bit_cast(pg8_i32x4, acc[a][b][m][n]), f32x4); }
        if constexpr (!Epi::AFTER_DRAIN) { E(acc, cur, wr, wc, fr, fq); S.done(cur); }
        if (!has_next) break;
#pragma unroll
        for (int a = 0; a < 2; ++a)
#pragma unroll
            for (int b = 0; b < 2; ++b)
#pragma unroll
                for (int m = 0; m < 4; ++m)
#pragma unroll
                    for (int n = 0; n < 2; ++n) acc[a][b][m][n] = (f32x4){0.f, 0.f, 0.f, 0.f};
        cur = nxt; cA = nA; cB = nB; ++ui;
        if constexpr (ALIGN_EPI) { if (wr == 1) PG8_BAR; }
    }
    PG8_WAIT_V(0);
    if constexpr (!ALIGN_EPI) { if (wr == 0) PG8_BAR; }
    PG8_BAR;
    if constexpr (Epi::AFTER_DRAIN) { E.fused(acc, cur, wr, wc, fr, fq, lds, wid, lane); S.done(cur); }
#undef PG8_SA
#undef PG8_SB
#undef PG8_STAGE
#undef PG8_LDA
#undef PG8_LDA1
#undef PG8_STAGE1
#undef PG8_LDB
#undef PG8_MMA
#undef PG8_WAIT_V
#undef PG8_WAIT_L
#undef PG8_BAR
#undef PG8_SCHED
}
}
constexpr int NB_ = 2, S_ = 16384, D_ = 1024, M_ = NB_ * S_, H_ = 16, HD_ = 64, FF_ = 2816, NBLK_ = 64;
constexpr float LOG2E_ = 1.4426950408889634f;
constexpr float C2_ = 0.125f * LOG2E_;
constexpr float EPS_ = 1e-6f;

constexpr size_t MiB = 1u << 20;
constexpr size_t WS_CTL = 0, CTL_ZERO_BYTES = 256 * 1024;
constexpr size_t WS_CMAX = 128 * 1024;
constexpr size_t WS_MOD  = 1 * MiB;
constexpr size_t WS_GM   = WS_MOD + 256 * 1024, WS_WEXP = WS_GM;
constexpr size_t WS_COEF = WS_GM + 64 * 1024;
constexpr size_t WS_BFFN = WS_COEF + 64 * 1024;
constexpr size_t WS_BQKV = WS_BFFN + 192 * 1024;
constexpr size_t WS_BPW1 = WS_BQKV + 32 * 1024;
constexpr size_t WS_SSQ  = 4 * MiB;
constexpr size_t WS_KBAR = 6 * MiB;
constexpr size_t WS_SEL  = 7 * MiB;
constexpr size_t WS_LP   = 9 * MiB;
constexpr size_t WS_WIN  = 16 * MiB;
constexpr size_t WS_WQKV = 104 * MiB;
constexpr size_t WS_WPW1 = 116 * MiB;
constexpr size_t WS_WOUT = 124 * MiB;
constexpr size_t WS_WO   = 146 * MiB;
constexpr size_t WS_WPW2 = 148 * MiB;
constexpr size_t WS_XB   = 152 * MiB;
constexpr size_t WS_BIG  = 216 * MiB;
constexpr size_t WS_ACT  = WS_BIG;
constexpr size_t WS_Q = WS_BIG, WS_K = WS_BIG + 64 * MiB, WS_V = WS_BIG + 128 * MiB;
constexpr size_t WS_OP3 = 408 * MiB;
constexpr size_t WS_U = WS_BIG, WS_CV = WS_BIG + 64 * MiB;
constexpr size_t WS_X8  = 472 * MiB;
constexpr size_t WS_SSQ1 = 504 * MiB;
constexpr size_t WS_END = 506 * MiB;
#ifndef CQ_VAL
#define CQ_VAL 8.0f
#endif
constexpr float CQ_ = CQ_VAL;
#ifndef I8MASK
#define I8MASK 31
#endif

constexpr int CW_BAR = 1024;

constexpr int RING_BYTES = 131072;
constexpr int LDSCTL_OFF = RING_BYTES, MISC_OFF = LDSCTL_OFF + 320;
constexpr int LDS_BYTES = 163840;
constexpr int LT_PM = LDSCTL_OFF + 896, LT_RSTD = LDSCTL_OFF + 1024, LT_VEC = LDSCTL_OFF + 3072, LT_EXP = LT_VEC + 22528;

#define GAS __attribute__((address_space(1)))
#define LAS __attribute__((address_space(3)))
typedef unsigned short bf16;
typedef float f32x4 __attribute__((ext_vector_type(4)));
typedef unsigned u32x4 __attribute__((ext_vector_type(4)));
typedef unsigned u32x2 __attribute__((ext_vector_type(2)));
typedef short bf16x8 __attribute__((ext_vector_type(8)));
typedef float f32x16 __attribute__((ext_vector_type(16)));
#define LDS_WAIT() asm volatile("s_waitcnt lgkmcnt(0)" ::: "memory")
#define VM_WAIT() asm volatile("s_waitcnt vmcnt(0)" ::: "memory")
#define LDS_BARRIER() do { asm volatile("s_waitcnt lgkmcnt(0)" ::: "memory"); __builtin_amdgcn_s_barrier(); asm volatile("" ::: "memory"); } while (0)
__device__ __forceinline__ unsigned f2bf(float f) { unsigned u = __builtin_bit_cast(unsigned, f); return (u + 0x7fffu + ((u >> 16) & 1u)) >> 16; }
__device__ __forceinline__ unsigned pk2(float lo, float hi) { return f2bf(lo) | (f2bf(hi) << 16); }
typedef __bf16 bf16x2_t __attribute__((ext_vector_type(2))); typedef float f32x2_t __attribute__((ext_vector_type(2)));
__device__ __forceinline__ unsigned cvtpk(float lo, float hi) { const f32x2_t v = {lo, hi}; const bf16x2_t b = __builtin_convertvector(v, bf16x2_t); return __builtin_bit_cast(unsigned, b); }
__device__ __forceinline__ float bf2f(unsigned h) { return __builtin_bit_cast(float, h << 16); }
__device__ __forceinline__ float bflo(unsigned w) { return __builtin_bit_cast(float, w << 16); }
__device__ __forceinline__ float bfhi(unsigned w) { return __builtin_bit_cast(float, w & 0xffff0000u); }
template <int CTRL> __device__ __forceinline__ float dppf(float v) { return __builtin_bit_cast(float, __builtin_amdgcn_mov_dpp(__builtin_bit_cast(int, v), CTRL, 0xF, 0xF, true)); }
typedef unsigned u32x2v __attribute__((ext_vector_type(2)));
__device__ __forceinline__ float u2f(unsigned u) { return __builtin_bit_cast(float, u); }
__device__ __forceinline__ unsigned f2u(float f) { return __builtin_bit_cast(unsigned, f); }
__device__ __forceinline__ float sum16(float v) { const auto r = __builtin_amdgcn_permlane16_swap(f2u(v), f2u(v), false, false); const unsigned r0 = r[0], r1 = r[1]; return u2f(r0) + u2f(r1); }
__device__ __forceinline__ float sum32(float v) { const auto r = __builtin_amdgcn_permlane32_swap(f2u(v), f2u(v), false, false); const unsigned r0 = r[0], r1 = r[1]; return u2f(r0) + u2f(r1); }
__device__ __forceinline__ float max16(float v) { const auto r = __builtin_amdgcn_permlane16_swap(f2u(v), f2u(v), false, false); const unsigned r0 = r[0], r1 = r[1]; return fmaxf(u2f(r0), u2f(r1)); }
__device__ __forceinline__ float max32(float v) { const auto r = __builtin_amdgcn_permlane32_swap(f2u(v), f2u(v), false, false); const unsigned r0 = r[0], r1 = r[1]; return fmaxf(u2f(r0), u2f(r1)); }
__device__ __forceinline__ float row_sum16(float v) { v += dppf<0xB1>(v); v += dppf<0x4E>(v); v += dppf<0x141>(v); v += dppf<0x140>(v); return v; }
__device__ __forceinline__ float wave_sum(float v) { v = row_sum16(v); v = sum16(v); return sum32(v); }
__device__ __forceinline__ float wave_max(float v) { v = fmaxf(v, dppf<0xB1>(v)); v = fmaxf(v, dppf<0x4E>(v)); v = fmaxf(v, dppf<0x141>(v)); v = fmaxf(v, dppf<0x140>(v)); v = max16(v); return max32(v); }
__device__ __forceinline__ unsigned other32(unsigned v, int hi) { const auto r = __builtin_amdgcn_permlane32_swap(v, v, false, false); const unsigned r0 = r[0], r1 = r[1]; return hi ? r0 : r1; }
#define XB_TMO      128
#define XB_XCNT(j)  (256  + 64 * (j))
#define XB_XSUB(j)  (1280 + 64 * (j))
#define XB_XGEN(j)  (2304 + 64 * (j))
#define XB_TOP      3328
#define XB_TOPGEN   3392
#define XCD_BAR_WORDS 3456
#define XB_SPIN_CAP (1u << 18)

__device__ __forceinline__ unsigned xb_ld(unsigned* p)              { return __hip_atomic_load(p, __ATOMIC_RELAXED, __HIP_MEMORY_SCOPE_AGENT); }
__device__ __forceinline__ unsigned xb_add(unsigned* p, unsigned v) { return __hip_atomic_fetch_add(p, v, __ATOMIC_RELAXED, __HIP_MEMORY_SCOPE_AGENT); }
__device__ __forceinline__ unsigned xb_xcc_id() { return (unsigned)__builtin_amdgcn_s_getreg((3 << 11) | 20) & 0xFu; }
#define XB_SPIN(cond, bar) do { unsigned _sp = 0; while (cond) { __builtin_amdgcn_s_sleep(1); \
    if ((++_sp & 255u) == 0u) { if (xb_ld(&(bar)[XB_TMO])) break; if (_sp > XB_SPIN_CAP) { atomicAdd(&(bar)[XB_TMO], 1u); break; } } } } while (0)

struct XcdBarrier {
    unsigned* bar; unsigned x;
    volatile LAS unsigned* st;
};

__device__ __forceinline__ XcdBarrier xcd_barrier_post(unsigned* bar, volatile LAS unsigned* st) {
    XcdBarrier b; b.bar = bar; b.x = xb_xcc_id(); b.st = st;
    if (threadIdx.x == 0) (void)xb_add(&bar[XB_XCNT(b.x)], 1u);
    return b;
}
__device__ __forceinline__ void xcd_barrier_complete(unsigned* bar, unsigned x, unsigned& nloc, unsigned& nx) {
    const unsigned G = gridDim.x * gridDim.y * gridDim.z;
    unsigned sum, cnt, mine, sp = 0u;
    for (;;) {
        sum = 0u; cnt = 0u; mine = 0u;
#pragma unroll
        for (unsigned j = 0; j < 16; ++j) { const unsigned c = xb_ld(&bar[XB_XCNT(j)]); sum += c; cnt += (c > 0u) ? 1u : 0u; mine = (j == x) ? c : mine; }
        if (sum == G) break;
        __builtin_amdgcn_s_sleep(1);
        if ((++sp & 255u) == 0u) { if (xb_ld(&bar[XB_TMO])) break; if (sp > XB_SPIN_CAP) { atomicAdd(&bar[XB_TMO], 1u); break; } }
    }
    nloc = mine > 0u ? mine : 1u; nx = cnt > 0u ? cnt : 1u;
}

__device__ __forceinline__ void xcd_barrier(const XcdBarrier& b) {
    asm volatile("s_waitcnt vmcnt(0)" ::: "memory");
    __syncthreads();
    if (threadIdx.x == 0) {
        unsigned* bar = b.bar;
        __builtin_amdgcn_s_waitcnt(0);
        unsigned nloc = b.st[0], nx = b.st[1];
        if (nloc == 0u) { xcd_barrier_complete(bar, b.x, nloc, nx); b.st[0] = nloc; b.st[1] = nx; }
        const unsigned old = xb_add(&bar[XB_XSUB(b.x)], 1u);
        const unsigned gen = old / nloc;
        if (old + 1u == (gen + 1u) * nloc) {
            __builtin_amdgcn_fence(__ATOMIC_RELEASE, "agent");
            asm volatile("s_waitcnt vmcnt(0)" ::: "memory");
            const unsigned og = xb_add(&bar[XB_TOP], 1u);
            const unsigned tg = og / nx;
            if (og + 1u == (tg + 1u) * nx) xb_add(&bar[XB_TOPGEN], 1u);
            else XB_SPIN(xb_ld(&bar[XB_TOPGEN]) == tg, bar);
            __builtin_amdgcn_fence(__ATOMIC_ACQUIRE, "agent");
            xb_add(&bar[XB_XGEN(b.x)], 1u);
            asm volatile("s_waitcnt vmcnt(0)" ::: "memory");
        } else {
            XB_SPIN(xb_ld(&bar[XB_XGEN(b.x)]) == gen, bar);
            __builtin_amdgcn_fence(__ATOMIC_ACQUIRE, "agent");
            asm volatile("s_waitcnt vmcnt(0)" ::: "memory");
        }
    }
    __syncthreads();
}
__device__ __forceinline__ int epi_tables_pm(LAS unsigned char* lds, const pg8::StaticOrder& S, int tid, int& pmA_out, int& pmB_out) {
    int pmA = -1, pmB = -1, ok = 1; pg8::Unit u;
    for (int i = 0; S.next(i, u); ++i) { if (pmA < 0) pmA = u.pm; else if (u.pm != pmA) { if (pmB < 0) pmB = u.pm; else if (u.pm != pmB) ok = 0; } }
    if (pmA < 0) pmA = 0;
    if (pmB < 0) pmB = pmA;
    if ((pmA >> 6) != (pmB >> 6)) ok = 0;
    if (tid == 0) { ((LAS int*)(lds + LT_PM))[0] = pmA; ((LAS int*)(lds + LT_PM))[1] = pmB; }
    pmA_out = pmA; pmB_out = pmB; return ok;
}
__device__ __forceinline__ float ssq_row(const float* ssq, int row) {
    const f32x4 p0 = *(const f32x4*)(ssq + (size_t)row * 16), p1 = *(const f32x4*)(ssq + (size_t)row * 16 + 4), p2 = *(const f32x4*)(ssq + (size_t)row * 16 + 8), p3 = *(const f32x4*)(ssq + (size_t)row * 16 + 12);
    return (((p0.x + p0.y) + (p0.z + p0.w)) + ((p1.x + p1.y) + (p1.z + p1.w))) + (((p2.x + p2.y) + (p2.z + p2.w)) + ((p3.x + p3.y) + (p3.z + p3.w)));
}
__device__ __forceinline__ void epi_tables_rstd(LAS unsigned char* lds, const float* ssq, int pmA, int pmB, int ok, int tid, float scale = 1.0f, const float* ssq_prev = nullptr) {
    const int slot = tid >> 8, r = tid & 255, row = (slot ? pmB : pmA) * 256 + r;
    float v = rsqrtf(ssq_row(ssq, row) * (1.0f / D_) + EPS_) * scale;
    if (ssq_prev) v *= sqrtf(ssq_row(ssq_prev, row) * (1.0f / D_) + EPS_);
    ((LAS float*)(lds + LT_RSTD))[tid] = ok ? v : __builtin_nanf("");
}
__device__ __forceinline__ float gm_rms(const float* ng, const float* scl, int lane) {
    float s = 0.f;
#pragma unroll
    for (int i = 0; i < 4; ++i) { const f32x4 g = *(const f32x4*)(ng + 256 * i + 4 * lane), c = *(const f32x4*)(scl + 256 * i + 4 * lane);
#pragma unroll
        for (int e = 0; e < 4; ++e) { const float t = g[e] * (1.0f + c[e]); s += t * t; } }
    return sqrtf(wave_sum(s) * (1.0f / D_));
}
__device__ __forceinline__ void epi_tables_vec(LAS unsigned char* lds, int dst_off, const float* src, int n, int tid) {
    for (int i = tid * 4; i < n; i += 2048) *(LAS f32x4*)(lds + LT_VEC + (dst_off + i) * 4) = src ? *(const f32x4*)(src + i) : (f32x4){0.f, 0.f, 0.f, 0.f};
}
__device__ __forceinline__ unsigned pk4_i8(float a, float b, float c, float d) {
    const float M = 12582912.0f;
    const unsigned ua = f2u(__builtin_amdgcn_fmed3f(a, -127.0f, 127.0f) + M), ub = f2u(__builtin_amdgcn_fmed3f(b, -127.0f, 127.0f) + M), uc = f2u(__builtin_amdgcn_fmed3f(c, -127.0f, 127.0f) + M), ud = f2u(__builtin_amdgcn_fmed3f(d, -127.0f, 127.0f) + M);
    const unsigned lo = __builtin_amdgcn_perm(ub, ua, 0x0c0c0400u), hi = __builtin_amdgcn_perm(ud, uc, 0x0c0c0400u);
    return lo | (hi << 16);
}
__device__ __forceinline__ int lane_id() { return (int)__builtin_amdgcn_mbcnt_hi(~0u, __builtin_amdgcn_mbcnt_lo(~0u, 0u)); }
__device__ __forceinline__ float sigm(float v) { return __builtin_amdgcn_rcpf(1.0f + __builtin_amdgcn_exp2f(-LOG2E_ * v)); }

__device__ __forceinline__ void i8_preload(LAS unsigned char* lds, const float* ssq, const float* ssq_prev, const signed char* wexp, const float* ng, const float* scl, int N, int pmA, int pmB, int ok, int tid) {
    const float G = gm_rms(ng, scl + (size_t)(pmA >> 6) * 9216, tid & 63);
    epi_tables_rstd(lds, ssq, pmA, pmB, ok, tid, CQ_ * G * (1.0f / 127.0f), ssq_prev);
    for (int i = tid; i < N / 4; i += 512) ((LAS unsigned*)(lds + LT_EXP))[i] = ((const unsigned*)wexp)[i];
}
__device__ __forceinline__ void i8_colscale(LAS unsigned char* lds, int colbase, float (&cs)[2]) {
#pragma unroll
    for (int bj = 0; bj < 2; ++bj) { const int e = (int)((const LAS signed char*)(lds + LT_EXP))[colbase + bj * 128]; cs[bj] = __builtin_amdgcn_exp2f((float)e * 0.25f); }
}
template <int ACT, bool I8 = false> struct EpiGated {
    static constexpr bool PERM = true, AFTER_DRAIN = false;
    bf16* O; int ldo; const float* bias; int N; const float* ssq; LAS unsigned char* lds;
    const float* ssq_prev; const signed char* wexp; const float* ng; const float* scl;
    __device__ __forceinline__ void preload(const pg8::StaticOrder& S, int tid) const {
        int pmA, pmB; const int ok = epi_tables_pm(lds, S, tid, pmA, pmB);
        if constexpr (I8) i8_preload(lds, ssq, ssq_prev, wexp, ng, scl, N, pmA, pmB, ok, tid);
        else epi_tables_rstd(lds, ssq, pmA, pmB, ok, tid);
        epi_tables_vec(lds, 0, bias + (size_t)(pmA >> 6) * N, N, tid);
    }
    __device__ __forceinline__ void operator()(const f32x4 (&acc)[2][2][4][2], const pg8::Unit& u, int wr, int wc, int fr, int fq) const {
        constexpr float KA = (ACT == 0) ? -LOG2E_ : 1.0f, KG = (ACT == 0) ? -0.6931471805599453f : -LOG2E_;
        const LAS float* bp = (const LAS float*)(lds + LT_VEC) + u.pn * 256 + wc * 32 + 8 * fq;
        const LAS float* rt = (const LAS float*)(lds + LT_RSTD) + ((u.pm == ((const LAS int*)(lds + LT_PM))[0]) ? 0 : 256) + wr * 64 + fr;
        f32x4 bv[2][2];
#pragma unroll
        for (int bj = 0; bj < 2; ++bj)
#pragma unroll
            for (int n = 0; n < 2; ++n) bv[bj][n] = *(const LAS f32x4*)(bp + bj * 128 + 4 * n) * (bj == 0 ? KA : KG);
        float rsv[8];
#pragma unroll
        for (int k = 0; k < 8; ++k) rsv[k] = rt[(k >> 2) * 128 + (k & 3) * 16];
        float cs[2] = {1.0f, 1.0f};
        if constexpr (I8) i8_colscale(lds, u.pn * 256 + wc * 32 + 8 * fq, cs);
#pragma unroll
        for (int ai = 0; ai < 2; ++ai)
#pragma unroll
            for (int m = 0; m < 4; ++m) {
                const int row = u.pm * 256 + ai * 128 + wr * 64 + m * 16 + fr;
                const float rs = rsv[ai * 4 + m], rsa = (I8 ? rs * cs[0] : rs) * KA, rsg = (I8 ? rs * cs[1] : rs) * KG;
                typedef float f2 __attribute__((ext_vector_type(2)));
                f2 a[4], g[4], t[4], e[4], d[4], r[4], v[4];
#pragma unroll
                for (int i = 0; i < 4; ++i) { const int n = i >> 1; const f32x4 a4 = acc[ai][0][m][n], g4 = acc[ai][1][m][n], ba4 = bv[0][n], bg4 = bv[1][n];
                    a[i] = ((i & 1) == 0 ? (f2){a4.x, a4.y} : (f2){a4.z, a4.w}) * rsa + ((i & 1) == 0 ? (f2){ba4.x, ba4.y} : (f2){ba4.z, ba4.w});
                    g[i] = ((i & 1) == 0 ? (f2){g4.x, g4.y} : (f2){g4.z, g4.w}) * rsg + ((i & 1) == 0 ? (f2){bg4.x, bg4.y} : (f2){bg4.z, bg4.w});
                    t[i] = (ACT == 0) ? a[i] : g[i]; }
#pragma unroll
                for (int i = 0; i < 4; ++i) { e[i].x = __builtin_amdgcn_exp2f(t[i].x); e[i].y = __builtin_amdgcn_exp2f(t[i].y); }
#pragma unroll
                for (int i = 0; i < 4; ++i) d[i] = e[i] + 1.0f;
#pragma unroll
                for (int i = 0; i < 4; ++i) { r[i].x = __builtin_amdgcn_rcpf(d[i].x); r[i].y = __builtin_amdgcn_rcpf(d[i].y); }
#pragma unroll
                for (int i = 0; i < 4; ++i) v[i] = (ACT == 0) ? (a[i] * r[i]) * g[i] : a[i] * r[i];
                u32x4 w; w.x = cvtpk(v[0].x, v[0].y); w.y = cvtpk(v[1].x, v[1].y); w.z = cvtpk(v[2].x, v[2].y); w.w = cvtpk(v[3].x, v[3].y);
                *(u32x4*)(O + (size_t)row * ldo + u.pn * 128 + wc * 32 + 8 * fq) = w;
            }
    }
};

struct EpiRes {
    static constexpr bool PERM = true, AFTER_DRAIN = false;
    bf16* xb; float* out; const float* bias2; const float* coef; float* ssq; int last; LAS unsigned char* lds;
    unsigned char* x8; const float* ssq_prev; const float* ng_next; const float* scl_next;
    __device__ __forceinline__ void preload(const pg8::StaticOrder& S, int tid) const {
        int pmA, pmB; const int ok = epi_tables_pm(lds, S, tid, pmA, pmB);
        epi_tables_vec(lds, 0, ok ? coef + (size_t)(pmA >> 6) * D_ : nullptr, D_, tid);
        epi_tables_vec(lds, D_, bias2, D_, tid);
        if (x8) {
            const float* sc = scl_next + (size_t)(pmA >> 6) * 9216;
            const float G = gm_rms(ng_next, sc, tid & 63);
            epi_tables_rstd(lds, ssq_prev, pmA, pmB, ok, tid, 127.0f / (CQ_ * G));
            if (tid < 256) { const f32x4 g = *(const f32x4*)(ng_next + 4 * tid), c = *(const f32x4*)(sc + 4 * tid);
                *(LAS f32x4*)(lds + LT_VEC + (2 * D_ + 4 * tid) * 4) = (f32x4){g.x * (1.0f + c.x), g.y * (1.0f + c.y), g.z * (1.0f + c.z), g.w * (1.0f + c.w)}; }
        }
    }
    __device__ __forceinline__ void operator()(const f32x4 (&acc)[2][2][4][2], const pg8::Unit& u, int wr, int wc, int fr, int fq) const {
        const int col0 = u.pn * 256 + wc * 32 + 8 * fq;
        const size_t ro0 = (size_t)(u.pm * 256 + wr * 64 + fr) * D_ + col0;
        u32x4 xr[8][2];
#define EPIRES_LOAD(k) do { const bf16* xp_ = xb + ro0 + (size_t)(((k) >> 2) * 128 + ((k) & 3) * 16) * D_; xr[k][0] = *(const u32x4*)(xp_); xr[k][1] = *(const u32x4*)(xp_ + 128); } while (0)
        EPIRES_LOAD(0); EPIRES_LOAD(1); EPIRES_LOAD(2); EPIRES_LOAD(3);
        f32x4 cf[2][2], b2[2][2];
#pragma unroll
        for (int bj = 0; bj < 2; ++bj)
#pragma unroll
            for (int n = 0; n < 2; ++n) { const int c = col0 + bj * 128 + 4 * n;
                cf[bj][n] = *(const LAS f32x4*)(lds + LT_VEC + c * 4);
                b2[bj][n] = *(const LAS f32x4*)(lds + LT_VEC + (D_ + c) * 4); }
#pragma unroll
        for (int k = 0; k < 8; ++k) {
            const int ai = k >> 2, m = k & 3;
            if (k < 4) { switch (k) { case 0: EPIRES_LOAD(4); break; case 1: EPIRES_LOAD(5); break; case 2: EPIRES_LOAD(6); break; default: EPIRES_LOAD(7); break; } }
            const int row = u.pm * 256 + ai * 128 + wr * 64 + m * 16 + fr; const size_t ro = (size_t)row * D_;
            float ss = 0.f;
#pragma unroll
            for (int bj = 0; bj < 2; ++bj) {
                const u32x4 xw = xr[k][bj];
                const f32x4 x0 = (f32x4){bflo(xw.x), bfhi(xw.x), bflo(xw.y), bfhi(xw.y)}, x1 = (f32x4){bflo(xw.z), bfhi(xw.z), bflo(xw.w), bfhi(xw.w)};
                const f32x4 n0 = x0 + cf[bj][0] * (acc[ai][bj][m][0] + b2[bj][0]), n1 = x1 + cf[bj][1] * (acc[ai][bj][m][1] + b2[bj][1]);
                ss += ((n0[0] * n0[0] + n0[1] * n0[1]) + (n0[2] * n0[2] + n0[3] * n0[3])) + ((n1[0] * n1[0] + n1[1] * n1[1]) + (n1[2] * n1[2] + n1[3] * n1[3]));
                if (!last) { u32x4 w; w.x = cvtpk(n0[0], n0[1]); w.y = cvtpk(n0[2], n0[3]); w.z = cvtpk(n1[0], n1[1]); w.w = cvtpk(n1[2], n1[3]);
                    *(u32x4*)(xb + ro + col0 + bj * 128) = w;
                    if (x8) { const float qs = ((const LAS float*)(lds + LT_RSTD))[((u.pm == ((const LAS int*)(lds + LT_PM))[0]) ? 0 : 256) + ai * 128 + wr * 64 + m * 16 + fr];
                        const f32x4 q0 = n0 * *(const LAS f32x4*)(lds + LT_VEC + (2 * D_ + col0 + bj * 128) * 4) * qs, q1 = n1 * *(const LAS f32x4*)(lds + LT_VEC + (2 * D_ + col0 + bj * 128 + 4) * 4) * qs;
                        u32x2 w8; w8.x = pk4_i8(q0[0], q0[1], q0[2], q0[3]); w8.y = pk4_i8(q1[0], q1[1], q1[2], q1[3]); *(u32x2*)(x8 + ro + col0 + bj * 128) = w8; } }
                else { *(f32x4*)(out + ro + col0 + bj * 128) = n0; *(f32x4*)(out + ro + col0 + bj * 128 + 4) = n1; }
            }
            if (!last) { ss = sum32(sum16(ss)); if (fq == 0) ssq[(size_t)row * 16 + u.pn * 4 + wc] = ss; }
        }
#undef EPIRES_LOAD
    }
};

template <bool I8 = false> struct EpiQKV {
    static constexpr bool PERM = true, AFTER_DRAIN = false;
    bf16* Q;   const float* bias; const float* ssq; const float* gq; const float* gk; float* kbarp; LAS unsigned char* lds;
    const float* ssq_prev; const signed char* wexp; const float* ng; const float* scl;
    __device__ __forceinline__ void preload(const pg8::StaticOrder& S, int tid) const {
        int pmA, pmB; const int ok = epi_tables_pm(lds, S, tid, pmA, pmB);
        if constexpr (I8) i8_preload(lds, ssq, ssq_prev, wexp, ng, scl, 3072, pmA, pmB, ok, tid);
        else epi_tables_rstd(lds, ssq, pmA, pmB, ok, tid);
        epi_tables_vec(lds, 0, bias + (size_t)(pmA >> 6) * 3072, 3072, tid);
        epi_tables_vec(lds, 3072, gq, 64, tid); epi_tables_vec(lds, 3072 + 64, gk, 64, tid);
    }
    __device__ __forceinline__ void operator()(const f32x4 (&acc)[2][2][4][2], const pg8::Unit& u, int wr, int wc, int fr, int fq) const {
        const int b = u.pm >> 6, part = u.pn >> 2, head = ((u.pn & 3) << 2) + wc;
        const LAS float* bp = (const LAS float*)(lds + LT_VEC) + u.pn * 256 + wc * 32 + 8 * fq;
        const LAS float* gsrc = (const LAS float*)(lds + LT_VEC) + 3072 + ((part == 0) ? 0 : 64); const float gs = (part == 0) ? C2_ : 1.0f;
        const LAS float* rt = (const LAS float*)(lds + LT_RSTD) + ((u.pm == ((const LAS int*)(lds + LT_PM))[0]) ? 0 : 256) + wr * 64 + fr;
        f32x4 bv[2][2], gv[2][2], ks[2][2];
#pragma unroll
        for (int bj = 0; bj < 2; ++bj)
#pragma unroll
            for (int n = 0; n < 2; ++n) { bv[bj][n] = *(const LAS f32x4*)(bp + bj * 128 + 4 * n); gv[bj][n] = *(const LAS f32x4*)(gsrc + 32 * bj + 8 * fq + 4 * n) * gs; ks[bj][n] = (f32x4){0.f, 0.f, 0.f, 0.f}; }
        bf16* dst = Q + (size_t)part * ((size_t)M_ * D_);
        float cs[2] = {1.0f, 1.0f};
        if constexpr (I8) i8_colscale(lds, u.pn * 256 + wc * 32 + 8 * fq, cs);
        float rsv[8];
#pragma unroll
        for (int k = 0; k < 8; ++k) rsv[k] = rt[(k >> 2) * 128 + (k & 3) * 16];
#pragma unroll
        for (int ai = 0; ai < 2; ++ai)
#pragma unroll
            for (int m = 0; m < 4; ++m) {
                const int row = u.pm * 256 + ai * 128 + wr * 64 + m * 16 + fr;
                const float rs = rsv[ai * 4 + m];
                f32x4 v[2][2]; float ss = 0.f;
#pragma unroll
                for (int bj = 0; bj < 2; ++bj)
#pragma unroll
                    for (int n = 0; n < 2; ++n) { v[bj][n] = acc[ai][bj][m][n] * (I8 ? rs * cs[bj] : rs) + bv[bj][n]; const f32x4 t = v[bj][n]; ss += (t[0] * t[0] + t[1] * t[1]) + (t[2] * t[2] + t[3] * t[3]); }
                if (part < 2) {
                    ss = sum32(sum16(ss));
                    const float r = rsqrtf(ss * (1.0f / HD_) + EPS_);
#pragma unroll
                    for (int bj = 0; bj < 2; ++bj)
#pragma unroll
                        for (int n = 0; n < 2; ++n) v[bj][n] = v[bj][n] * r * gv[bj][n];
                }
                if (part == 1) {
#pragma unroll
                    for (int bj = 0; bj < 2; ++bj)
#pragma unroll
                        for (int n = 0; n < 2; ++n) ks[bj][n] += v[bj][n];
                }
#pragma unroll
                for (int bj = 0; bj < 2; ++bj) {
                    u32x4 w; w.x = cvtpk(v[bj][0][0], v[bj][0][1]); w.y = cvtpk(v[bj][0][2], v[bj][0][3]); w.z = cvtpk(v[bj][1][0], v[bj][1][1]); w.w = cvtpk(v[bj][1][2], v[bj][1][3]);
                    *(u32x4*)(dst + (size_t)row * D_ + head * 64 + 32 * bj + 8 * fq) = w; }
            }
        if (part == 1) {
            float* kp = kbarp + ((((size_t)(b * 16 + head) * 64 + (u.pm & 63)) * 2 + wr) * 64);
#pragma unroll
            for (int bj = 0; bj < 2; ++bj)
#pragma unroll
                for (int n = 0; n < 2; ++n) { f32x4 t = ks[bj][n];
#pragma unroll
                    for (int j = 0; j < 4; ++j) { t[j] = row_sum16(t[j]); }
                    if (fr == 0) *(f32x4*)(kp + 32 * bj + 8 * fq + 4 * n) = t; }
        }
    }
};

template <class Epi, bool F8 = false> __device__ __forceinline__ void run_gemm(LAS unsigned char* lds, const bf16* A, const bf16* Bt, long bb, int N, int K, int G, const Epi& E, int wave_in) {
    int t = lane_id(); asm volatile("" : "+v"(t)); t += 64 * wave_in;
    int bid = (int)blockIdx.x, Gq = G; asm volatile("" : "+s"(bid), "+s"(Gq));
    pg8::Gemm g{A, Bt, M_, N, K, bb}; pg8::StaticOrder S; S.init(M_, N, Gq, bid);
    E.preload(S, t);
    __syncthreads();
#ifndef F8_ALIGN
#define F8_ALIGN true
#endif
#ifndef F8_SP2
#define F8_SP2 true
#endif
    if constexpr (F8) pg8::gemm_phase<Epi, pg8::StaticOrder, F8_ALIGN, F8_SP2, true>(lds, g, S, E, t); else pg8::gemm_phase<Epi, pg8::StaticOrder, true, true, false>(lds, g, S, E, t);
}

__device__ __forceinline__ void tile_load(float (&w)[32], const float* W, int N, int k0, int n0, int lane) {
    const float* p = W + (size_t)(k0 + (lane >> 5)) * N + n0 + (lane & 31);
#pragma unroll
    for (int i = 0; i < 32; ++i) w[i] = p[(size_t)(2 * i) * N];
}
__device__ __forceinline__ void tile_to_lds(const float (&w)[32], LAS float* scr, int lane) {
#pragma unroll
    for (int i = 0; i < 32; ++i) scr[(2 * i + (lane >> 5)) * 33 + (lane & 31)] = w[i];
}
__device__ __forceinline__ void transpose_finish(int K, bf16* WT, int k0, int dst0, LAS float* scr, int lane) {
    LDS_WAIT(); asm volatile("" ::: "memory");
    const int c = lane & 7;
#pragma unroll
    for (int j = 0; j < 4; ++j) { const int n = (lane >> 3) + 8 * j; const LAS float* s = scr + (8 * c) * 33 + n;
        u32x4 o; o.x = cvtpk(s[0 * 33], s[1 * 33]); o.y = cvtpk(s[2 * 33], s[3 * 33]); o.z = cvtpk(s[4 * 33], s[5 * 33]); o.w = cvtpk(s[6 * 33], s[7 * 33]);
        *(GAS u32x4*)(WT + (size_t)(dst0 + n) * K + k0 + 8 * c) = o; }
    LDS_WAIT(); asm volatile("" ::: "memory");
}
__device__ __forceinline__ int gated_dst(int n0, int half) { const int c = (n0 < half) ? n0 : n0 - half; return 256 * (c >> 7) + (c & 127) + ((n0 < half) ? 0 : 128); }

constexpr int PT_OFF = MISC_OFF + 128;
__device__ __forceinline__ unsigned long long pt_get(LAS unsigned char* lds, int i) {
    const unsigned long long v = ((volatile LAS unsigned long long*)(lds + PT_OFF))[i];
    return ((unsigned long long)(unsigned)__builtin_amdgcn_readfirstlane((int)(v >> 32)) << 32) | (unsigned long long)(unsigned)__builtin_amdgcn_readfirstlane((int)(unsigned)v);
}
#define PIN(i) ((const float*)(const GAS float*)pt_get(lds, (i)))
#define POUT ((float*)(GAS float*)pt_get(lds, 19))
#define PWS ((unsigned char*)(GAS unsigned char*)pt_get(lds, 20))

__device__ __forceinline__ void inweight_item(const float* W, int N, bf16* WT, size_t wt_bstride, int kh, int n0, int dst0, const float* ng, const float* mod0,
                                              float* bias, int bias_bstride, const float* extra, LAS float* scr, int lane, int i8out = 0, const unsigned* cmax = nullptr, signed char* wexp = nullptr) {
    const int c = lane & 7;
    float dacc[4][2];
#pragma unroll
    for (int j = 0; j < 4; ++j) { dacc[j][0] = 0.f; dacc[j][1] = 0.f; }
    float qinv[4]; int qex[4];
#pragma unroll
    for (int j = 0; j < 4; ++j) { qinv[j] = 0.f; qex[j] = 0; }
    if (i8out) {
#pragma unroll
        for (int j = 0; j < 4; ++j) { float cmg = u2f(cmax[n0 + (lane >> 3) + 8 * j]); cmg = fmaxf(cmg, dppf<0x128>(cmg)); cmg = max16(cmg); cmg = max32(cmg);
            const float mq = cmg * (1.0f / 127.0f);
            int e = (mq > 0.f) ? (int)ceilf(4.0f * __builtin_amdgcn_logf(mq)) : -128; e = e < -128 ? -128 : (e > 127 ? 127 : e);
            if (e < 127 && __builtin_amdgcn_exp2f((float)e * 0.25f) < mq) ++e;
            qex[j] = e; qinv[j] = __builtin_amdgcn_exp2f((float)e * -0.25f); }
    }
    float w[32]; tile_load(w, W, N, 64 * 8 * kh, n0, lane);
    f32x4 gq[2], s0q[2], s1q[2], h0q[2], h1q[2];
#define INW_VECS(kq_) do { _Pragma("unroll") for (int q4 = 0; q4 < 2; ++q4) { gq[q4] = *(const f32x4*)(ng + (kq_) + 4 * q4); s0q[q4] = *(const f32x4*)(mod0 + 1024 + (kq_) + 4 * q4); \
        s1q[q4] = *(const f32x4*)(mod0 + 9216 + 1024 + (kq_) + 4 * q4); h0q[q4] = *(const f32x4*)(mod0 + (kq_) + 4 * q4); h1q[q4] = *(const f32x4*)(mod0 + 9216 + (kq_) + 4 * q4); } } while (0)
    INW_VECS(64 * 8 * kh + 8 * c);
#pragma unroll 1
    for (int kb = 8 * kh; kb < 8 * kh + 8; ++kb) {
        const int k0 = 64 * kb, kq = k0 + 8 * c;
        tile_to_lds(w, scr, lane);
        float gm0[8], gm1[8], sh0[8], sh1[8];
#pragma unroll
        for (int q4 = 0; q4 < 2; ++q4)
#pragma unroll
            for (int e = 0; e < 4; ++e) { gm0[4 * q4 + e] = gq[q4][e] * (1.0f + s0q[q4][e]); gm1[4 * q4 + e] = gq[q4][e] * (1.0f + s1q[q4][e]); sh0[4 * q4 + e] = h0q[q4][e]; sh1[4 * q4 + e] = h1q[q4][e]; }
        if (kb + 1 < 8 * kh + 8) { tile_load(w, W, N, k0 + 64, n0, lane); INW_VECS(kq + 64); }
        LDS_WAIT(); asm volatile("" ::: "memory");
#pragma unroll
        for (int j = 0; j < 4; ++j) { const int n = (lane >> 3) + 8 * j; const LAS float* sp = scr + (8 * c) * 33 + n;
            float v[8];
#pragma unroll
            for (int e = 0; e < 8; ++e) v[e] = sp[e * 33];
            if (i8out) {
                u32x2 o; const float qi = qinv[j];
                o.x = pk4_i8(v[0] * qi, v[1] * qi, v[2] * qi, v[3] * qi); o.y = pk4_i8(v[4] * qi, v[5] * qi, v[6] * qi, v[7] * qi);
                *(GAS u32x2*)((unsigned char*)WT + (size_t)(dst0 + n) * 1024 + kq) = o;
            } else {
            u32x4 o0, o1;
            o0.x = cvtpk(v[0] * gm0[0], v[1] * gm0[1]); o0.y = cvtpk(v[2] * gm0[2], v[3] * gm0[3]); o0.z = cvtpk(v[4] * gm0[4], v[5] * gm0[5]); o0.w = cvtpk(v[6] * gm0[6], v[7] * gm0[7]);
            o1.x = cvtpk(v[0] * gm1[0], v[1] * gm1[1]); o1.y = cvtpk(v[2] * gm1[2], v[3] * gm1[3]); o1.z = cvtpk(v[4] * gm1[4], v[5] * gm1[5]); o1.w = cvtpk(v[6] * gm1[6], v[7] * gm1[7]);
            bf16* wp = WT + (size_t)(dst0 + n) * 1024 + kq;
            *(GAS u32x4*)(wp) = o0; *(GAS u32x4*)(wp + wt_bstride) = o1;
            }
            float d0 = 0.f, d1 = 0.f;
#pragma unroll
            for (int e = 0; e < 8; ++e) { d0 += v[e] * sh0[e]; d1 += v[e] * sh1[e]; }
            dacc[j][0] += d0; dacc[j][1] += d1; }
        LDS_WAIT(); asm volatile("" ::: "memory");
    }
    if (i8out && kh == 0 && c == 0) {
#pragma unroll
        for (int j = 0; j < 4; ++j) wexp[dst0 + (lane >> 3) + 8 * j] = (signed char)qex[j]; }
#pragma unroll
    for (int j = 0; j < 4; ++j)
#pragma unroll
        for (int bb = 0; bb < 2; ++bb) { float v = dacc[j][bb]; v += dppf<0xB1>(v); v += dppf<0x4E>(v); v += dppf<0x141>(v);
            if (c == 0) { const int n = (lane >> 3) + 8 * j; if (kh == 0 && extra) v += extra[n0 + n];
                __hip_atomic_fetch_add(bias + (size_t)bb * bias_bstride + dst0 + n, v, __ATOMIC_RELAXED, __HIP_MEMORY_SCOPE_AGENT); } }
}

#undef INW_VECS
__device__ __forceinline__ void phase_p0(LAS unsigned char* lds, int vcu, int G, int wave_in) {
    int tid = lane_id(); asm volatile("" : "+v"(tid)); tid += 64 * wave_in;
    const int lane = tid & 63, wave = __builtin_amdgcn_readfirstlane(tid >> 6);
    LAS float* cs = (LAS float*)lds;
    LAS float* red = (LAS float*)(lds + 8192);
    LAS float* scr = (LAS float*)(lds + 16384 + wave * 8704);
    unsigned char* const ws = PWS;
    float* MOD = (float*)(ws + WS_MOD);
    { const float* cin = PIN(1); for (int i = tid; i < 2048; i += 512) { const float v = cin[i]; cs[i] = v / (1.0f + expf(-v)); } }
    { float* bz = (float*)(ws + WS_BFFN); for (int i = vcu * 512 + tid; i < (192 + 32 + 16) * 256; i += G * 512) bz[i] = 0.f; }
    __syncthreads();
    for (int it = blockIdx.x; it < 288; it += G) {
        const int li = it / 144, cg = it % 144;
        const float* W = PIN(3) + (size_t)li * 1024 * 9216 + cg * 64 + lane; const float* adab = PIN(4);
        float a0 = 0.f, a1 = 0.f;
#pragma unroll 64
        for (int k = wave * 128; k < wave * 128 + 128; ++k) { const float w = W[(size_t)k * 9216]; a0 += cs[k] * w; a1 += cs[1024 + k] * w; }
        red[(wave * 2 + 0) * 64 + lane] = a0; red[(wave * 2 + 1) * 64 + lane] = a1;
        __syncthreads();
        if (tid < 128) { const int b = tid >> 6, l = tid & 63; float s = 0.f;
#pragma unroll
            for (int w = 0; w < 8; ++w) s += red[(w * 2 + b) * 64 + l];
            MOD[(size_t)(li * 2 + b) * 9216 + cg * 64 + l] = s + adab[li * 9216 + cg * 64 + l]; }
        __syncthreads();
    }
    const int gw = vcu * 8 + wave, NGW = G * 8;
    bf16* WOUT = (bf16*)(ws + WS_WOUT); bf16* WO = (bf16*)(ws + WS_WO); bf16* WPW2 = (bf16*)(ws + WS_WPW2);
    constexpr int I_OUT = 44 * 32, I_O = 16 * 32, I_PW2 = 16 * 32;
    constexpr int NITEMS = 4 * I_OUT + I_O + I_PW2;
    {
        const float* w6 = PIN(6); const float* w10 = PIN(10); const float* w17 = PIN(17);
#define OUTW_DECODE(it_, W_, K_, WT_, k0_, n0_) do { int r_ = (it_); \
            if (r_ < 4 * I_OUT) { const int f_ = r_ / I_OUT; r_ %= I_OUT; W_ = w6 + (size_t)f_ * 2816 * 1024; K_ = 2816; WT_ = WOUT + (size_t)f_ * 1024 * 2816; } \
            else if (r_ < 4 * I_OUT + I_O) { r_ -= 4 * I_OUT; W_ = w10; K_ = 1024; WT_ = WO; } \
            else { r_ -= 4 * I_OUT + I_O; W_ = w17; K_ = 1024; WT_ = WPW2; } \
            k0_ = 64 * (r_ / 32); n0_ = 32 * (r_ % 32); } while (0)
        float w[32]; const float* Wc; int Kc, k0c, n0c; bf16* WTc;
        if (gw < NITEMS) { OUTW_DECODE(gw, Wc, Kc, WTc, k0c, n0c); tile_load(w, Wc, 1024, k0c, n0c, lane); }
        for (int it = gw; it < NITEMS; it += NGW) {
            tile_to_lds(w, scr, lane);
            const float* Wn = Wc; int Kn = Kc, k0n = k0c, n0n = n0c; bf16* WTn = WTc;
            if (it + NGW < NITEMS) { OUTW_DECODE(it + NGW, Wn, Kn, WTn, k0n, n0n); tile_load(w, Wn, 1024, k0n, n0n, lane); }
            transpose_finish(Kc, WTc, k0c, n0c, scr, lane);
            Wc = Wn; Kc = Kn; k0c = k0n; n0c = n0n; WTc = WTn;
        }
#undef OUTW_DECODE
    }
    if (I8MASK) {
        unsigned* CM = (unsigned*)(ws + WS_CMAX);
        for (int it = gw; it < 4 * 352 + 192 + 128; it += NGW) {
            const float* Wm; int N, r, cmo, bit;
            if (it < 4 * 352) { const int f = it / 352; r = it % 352; Wm = PIN(5) + (size_t)f * 1024 * 5632; N = 5632; cmo = f * 5632; bit = f; }
            else if (it < 4 * 352 + 192) { r = it - 4 * 352; Wm = PIN(7); N = 3072; cmo = 22528; bit = 4; }
            else { r = it - 4 * 352 - 192; Wm = PIN(11); N = 2048; cmo = 25600; bit = 5; }
            if (!((I8MASK >> bit) & 1)) continue;
            const int nseg = N / 256, seg = r % nseg, rb = r / nseg;
            const float* p = Wm + (size_t)(64 * rb) * N + 256 * seg + 4 * lane;
            float m0 = 0.f, m1 = 0.f, m2 = 0.f, m3 = 0.f;
#pragma unroll 16
            for (int k = 0; k < 64; ++k) { const f32x4 v = *(const f32x4*)(p + (size_t)k * N); m0 = fmaxf(m0, fabsf(v.x)); m1 = fmaxf(m1, fabsf(v.y)); m2 = fmaxf(m2, fabsf(v.z)); m3 = fmaxf(m3, fabsf(v.w)); }
            unsigned* d = CM + cmo + 256 * seg + 4 * lane;
            __hip_atomic_fetch_max(d + 0, f2u(m0), __ATOMIC_RELAXED, __HIP_MEMORY_SCOPE_AGENT); __hip_atomic_fetch_max(d + 1, f2u(m1), __ATOMIC_RELAXED, __HIP_MEMORY_SCOPE_AGENT);
            __hip_atomic_fetch_max(d + 2, f2u(m2), __ATOMIC_RELAXED, __HIP_MEMORY_SCOPE_AGENT); __hip_atomic_fetch_max(d + 3, f2u(m3), __ATOMIC_RELAXED, __HIP_MEMORY_SCOPE_AGENT);
        }
    }
}

__device__ __forceinline__ void phase_p1(LAS unsigned char* lds, int vcu, int G, int wave_in) {
    int tid = lane_id(); asm volatile("" : "+v"(tid)); tid += 64 * wave_in;
    const int lane = tid & 63, wave = __builtin_amdgcn_readfirstlane(tid >> 6);
    LAS float* scr = (LAS float*)(lds + 16384 + wave * 8704);
    unsigned char* const ws = PWS; const float* ng = PIN(2);
    const float* MOD = (const float*)(ws + WS_MOD);
    float* COEF = (float*)(ws + WS_COEF);
    for (int i = vcu * 512 + tid; i < 6 * 2 * 1024; i += G * 512) {
        const int sl = i >> 11, b = (i >> 10) & 1, d = i & 1023, li = sl / 3, j = sl % 3;
        const float* mod = MOD + (size_t)(li * 2 + b) * 9216 + j * 3 * 1024;
        COEF[i] = ((j == 1) ? 1.0f : 0.5f) * mod[2048 + d];
    }
    {
        const int gw = vcu * 8 + wave, NGW = G * 8;
        const float* x = PIN(0); bf16* XB = (bf16*)(ws + WS_XB); unsigned char* X8 = ws + WS_X8; float* SSQ = (float*)(ws + WS_SSQ);
        float gmv[2][16], qc[2];
#pragma unroll
        for (int b = 0; b < 2; ++b) { qc[b] = 0.f;
#pragma unroll
            for (int e = 0; e < 16; ++e) gmv[b][e] = 0.f; }
        if (I8MASK & 1) {
#pragma unroll
            for (int b = 0; b < 2; ++b) { const float* sc = MOD + (size_t)b * 9216 + 1024;
                qc[b] = 127.0f / (CQ_ * gm_rms(ng, sc, lane));
#pragma unroll
                for (int jj = 0; jj < 4; ++jj) { const f32x4 g = *(const f32x4*)(ng + 4 * lane + 256 * jj), c = *(const f32x4*)(sc + 4 * lane + 256 * jj);
                    gmv[b][4 * jj + 0] = g.x * (1.0f + c.x); gmv[b][4 * jj + 1] = g.y * (1.0f + c.y); gmv[b][4 * jj + 2] = g.z * (1.0f + c.z); gmv[b][4 * jj + 3] = g.w * (1.0f + c.w); } }
        }
        f32x4 v[2][4], vn[2][4];
#define XROWS_LOAD(dst, r0_) do { _Pragma("unroll") for (int r = 0; r < 2; ++r) _Pragma("unroll") for (int jj = 0; jj < 4; ++jj) \
            dst[r][jj] = ((r0_) + r * NGW < M_) ? *(const f32x4*)(x + (size_t)((r0_) + r * NGW) * D_ + 4 * lane + 256 * jj) : (f32x4){0.f, 0.f, 0.f, 0.f}; } while (0)
        XROWS_LOAD(vn, gw);
        for (int row0 = gw; row0 < M_; row0 += 2 * NGW) {
#pragma unroll
            for (int r = 0; r < 2; ++r)
#pragma unroll
                for (int jj = 0; jj < 4; ++jj) v[r][jj] = vn[r][jj];
            if (row0 + 2 * NGW < M_) XROWS_LOAD(vn, row0 + 2 * NGW);
#pragma unroll
            for (int r = 0; r < 2; ++r) { const int row = row0 + r * NGW; if (row >= M_) break; float ss = 0.f;
#pragma unroll
                for (int jj = 0; jj < 4; ++jj) { const int c = 4 * lane + 256 * jj; const f32x4 t = v[r][jj];
                    ss += (t[0] * t[0] + t[1] * t[1]) + (t[2] * t[2] + t[3] * t[3]);
                    u32x2 w; w.x = cvtpk(t[0], t[1]); w.y = cvtpk(t[2], t[3]);
                    *(u32x2*)(XB + (size_t)row * D_ + c) = w; }
                ss = wave_sum(ss);
                if (lane < 4) *(f32x4*)(SSQ + (size_t)row * 16 + 4 * lane) = (f32x4){lane == 0 ? ss : 0.f, 0.f, 0.f, 0.f};
                if (I8MASK & 1) { const int b = row >> 14; const float qs = qc[b] * rsqrtf(ss * (1.0f / D_) + EPS_);
#pragma unroll
                    for (int jj = 0; jj < 4; ++jj) { const f32x4 t = v[r][jj];
                        *(unsigned*)(X8 + (size_t)row * D_ + 4 * lane + 256 * jj) = pk4_i8(t[0] * (b ? gmv[1][4 * jj] : gmv[0][4 * jj]) * qs, t[1] * (b ? gmv[1][4 * jj + 1] : gmv[0][4 * jj + 1]) * qs,
                                                                                         t[2] * (b ? gmv[1][4 * jj + 2] : gmv[0][4 * jj + 2]) * qs, t[3] * (b ? gmv[1][4 * jj + 3] : gmv[0][4 * jj + 3]) * qs); } }
            }
        }
#undef XROWS_LOAD
    }
    const int gw = vcu * 8 + wave, NGW = G * 8;
    constexpr int I_IN = 176 * 2, I_QKV = 96 * 2, I_PW1 = 64 * 2;
    for (int it = gw; it < 4 * I_IN + I_QKV + I_PW1; it += NGW) {
        int r = it;
        if (r < 4 * I_IN) { const int f = r / I_IN; r %= I_IN; const int kh = (r >> 3) & 1, n0 = 32 * ((r >> 4) * 8 + (r & 7)), sl = (f >> 1) * 3 + (f & 1) * 2;
            inweight_item(PIN(5) + (size_t)f * 1024 * 5632, 5632, (bf16*)(ws + WS_WIN) + (size_t)f * 2 * 5632 * 1024, (size_t)5632 * 1024, kh, n0, gated_dst(n0, FF_),
                          ng + sl * 1024, MOD + (size_t)((sl / 3) * 2) * 9216 + (sl % 3) * 3 * 1024, (float*)(ws + WS_BFFN) + (size_t)f * 2 * 5632, 5632, nullptr, scr, lane, (I8MASK >> f) & 1, (const unsigned*)(ws + WS_CMAX) + f * 5632, (signed char*)(ws + WS_WEXP) + f * 5632); continue; }
        r -= 4 * I_IN;
        if (r < I_QKV) { const int kh = (r >> 3) & 1, n0 = 32 * ((r >> 4) * 8 + (r & 7)); const int part = n0 >> 10, head = (n0 & 1023) >> 6, e0 = n0 & 63;
            const int dst0 = 256 * (part * 4 + (head >> 2)) + 128 * (e0 >> 5) + 32 * (head & 3);
            inweight_item(PIN(7), 3072, (bf16*)(ws + WS_WQKV), (size_t)3072 * 1024, kh, n0, dst0, ng + 1 * 1024, MOD + 1 * 3 * 1024, (float*)(ws + WS_BQKV), 3072, nullptr, scr, lane, (I8MASK >> 4) & 1, (const unsigned*)(ws + WS_CMAX) + 22528, (signed char*)(ws + WS_WEXP) + 22528); continue; }
        r -= I_QKV;
        { const int kh = (r >> 3) & 1, n0 = 32 * ((r >> 4) * 8 + (r & 7));
            inweight_item(PIN(11), 2048, (bf16*)(ws + WS_WPW1), (size_t)2048 * 1024, kh, n0, gated_dst(n0, 1024), ng + 4 * 1024, MOD + (size_t)2 * 9216 + 1 * 3 * 1024, (float*)(ws + WS_BPW1), 2048, PIN(12), scr, lane, (I8MASK >> 5) & 1, (const unsigned*)(ws + WS_CMAX) + 25600, (signed char*)(ws + WS_WEXP) + 25600); }
    }
}

typedef float f32x2 __attribute__((ext_vector_type(2)));
__device__ __forceinline__ f32x2 bfpair(unsigned v) { return (f32x2){bflo(v), bfhi(v)}; }
__device__ __forceinline__ void conv_phase(LAS unsigned char* lds, int vcu, int G, int wave_in) {
    int tid = lane_id(); asm volatile("" : "+v"(tid)); tid += 64 * wave_in;
    const int lane = tid & 63, wave = __builtin_amdgcn_readfirstlane(tid >> 6), c0 = 2 * tid;
    LAS float* part = (LAS float*)lds;
    unsigned char* const ws = PWS;
    const bf16* U = (const bf16*)(ws + WS_U); bf16* CV = (bf16*)(ws + WS_CV);
    f32x2 w[31];
    { const float* wdw = PIN(13);
#pragma unroll
    for (int j = 0; j < 31; ++j) w[j] = *(const f32x2*)(wdw + j * D_ + c0); }
    f32x2 bd, lg, lb;
    { const float* p = PIN(14); bd = *(const f32x2*)(p + c0); p = PIN(15); lg = *(const f32x2*)(p + c0); p = PIN(16); lb = *(const f32x2*)(p + c0); }
    for (int un = vcu; un < 256; un += G) {
        const int b = un >> 7, t0 = (un & 127) * 128;
        const unsigned* Up = (const unsigned*)(U + (size_t)b * S_ * D_ + c0);
        unsigned* Op = (unsigned*)(CV + (size_t)b * S_ * D_ + c0);
        f32x2 hist[38];
        unsigned nx0[8], nx1[8];
#pragma unroll
        for (int i = 0; i < 8; ++i) { nx0[i] = Up[(size_t)(t0 + i) * 512]; nx1[i] = Up[(size_t)(t0 + 8 + i) * 512]; }
#pragma unroll
        for (int i = 0; i < 30; ++i) { const int tt = t0 - 30 + i; const unsigned v = (tt >= 0) ? Up[(size_t)tt * 512] : 0u; hist[i] = bfpair(v); }
        int pb = 0;
#pragma unroll 1
        for (int st = 0; st < 16; ++st) {
#pragma unroll
            for (int i = 0; i < 8; ++i) { hist[30 + i] = bfpair(nx0[i]); nx0[i] = nx1[i]; }
            if (st < 14) {
#pragma unroll
                for (int i = 0; i < 8; ++i) nx1[i] = Up[(size_t)(t0 + (st + 2) * 8 + i) * 512];
            }
            f32x2 y[8]; float stat[16];
#pragma unroll
            for (int tt = 0; tt < 8; ++tt) { f32x2 a = bd;
#pragma unroll
                for (int j = 0; j < 31; ++j) a += w[j] * hist[tt + j];
                y[tt] = a; stat[2 * tt] = a.x + a.y; stat[2 * tt + 1] = a.x * a.x + a.y * a.y; }
            float s1[8], s2[4];
#pragma unroll
            for (int k = 0; k < 8; ++k) { const auto r = __builtin_amdgcn_permlane32_swap(f2u(stat[k]), f2u(stat[k + 8]), false, false); const unsigned r0 = r[0], r1 = r[1]; s1[k] = u2f(r0) + u2f(r1); }
#pragma unroll
            for (int k = 0; k < 4; ++k) { const auto r = __builtin_amdgcn_permlane16_swap(f2u(s1[k]), f2u(s1[k + 4]), false, false); const unsigned r0 = r[0], r1 = r[1]; s2[k] = row_sum16(u2f(r0) + u2f(r1)); }
            if ((lane & 15) == 0) *(LAS f32x4*)(part + (pb * 8 + wave) * 16 + 4 * (lane >> 4)) = (f32x4){s2[0], s2[1], s2[2], s2[3]};
            LDS_BARRIER();
            f32x4 tot[4];
#pragma unroll
            for (int k = 0; k < 4; ++k) { tot[k] = (f32x4){0.f, 0.f, 0.f, 0.f};
#pragma unroll
                for (int ww = 0; ww < 8; ++ww) tot[k] += *(const LAS f32x4*)(part + (pb * 8 + ww) * 16 + 4 * k); }
#pragma unroll
            for (int tt = 0; tt < 8; ++tt) {
                const float sum = tot[tt >> 1][(tt & 1) * 2], sq = tot[tt >> 1][(tt & 1) * 2 + 1];
                const float mean = sum * (1.0f / D_), var = sq * (1.0f / D_) - mean * mean, rstd = __builtin_amdgcn_rsqf(var + EPS_);
                const f32x2 z = (y[tt] - mean) * rstd * lg + lb;
                const f32x2 e = z * (-LOG2E_);
                f32x2 d; d.x = __builtin_amdgcn_exp2f(e.x); d.y = __builtin_amdgcn_exp2f(e.y); d = d + 1.0f;
                f32x2 r; r.x = __builtin_amdgcn_rcpf(d.x); r.y = __builtin_amdgcn_rcpf(d.y);
                const f32x2 o = z * r;
                Op[(size_t)(t0 + st * 8 + tt) * 512] = cvtpk(o.x, o.y);
            }
#pragma unroll
            for (int i = 0; i < 30; ++i) hist[i] = hist[i + 8];
            pb ^= 1;
        }
    }
}
constexpr int CW_Q2 = 8192;
constexpr int A_KS = 0, A_VT = 36864, A_LIST = 70656, A_MISC = 103424;
__device__ __forceinline__ float attn_m0(const float* gq, const float* gk, int lane) {
    float a = fabsf(gq[lane]), b = fabsf(gk[lane]); a = wave_max(a); b = wave_max(b);
    return 8.0f * LOG2E_ * a * b * 1.02f + 0.25f;
}
__device__ __forceinline__ void stage_kv_load(u32x4 (&kk)[4], u32x4 (&vv)[4], const bf16* K, const bf16* V, size_t rowbase, int h, int tid) {
    const int r = tid >> 1, hf = tid & 1;
    const bf16* kp = K + (rowbase + r) * D_ + h * 64 + 32 * hf;
#pragma unroll
    for (int c = 0; c < 4; ++c) kk[c] = *(const u32x4*)(kp + 8 * c);
    const int p = tid >> 2, dq = tid & 3;
    const bf16* vp = V + (rowbase + 2 * p) * D_ + h * 64 + 16 * dq;
    vv[0] = *(const u32x4*)(vp); vv[1] = *(const u32x4*)(vp + 8); vv[2] = *(const u32x4*)(vp + D_); vv[3] = *(const u32x4*)(vp + D_ + 8);
}
__device__ __forceinline__ void stage_kv_store(LAS unsigned char* lds, const u32x4 (&kk)[4], const u32x4 (&vv)[4], int tid) {
    const int r = tid >> 1, hf = tid & 1;
#pragma unroll
    for (int c = 0; c < 4; ++c) *(LAS u32x4*)(lds + A_KS + r * 144 + (32 * hf + 8 * c) * 2) = kk[c];
    const int p = tid >> 2, dq = tid & 3;
    LAS unsigned* vt = (LAS unsigned*)(lds + A_VT) + p;
#pragma unroll
    for (int c = 0; c < 2; ++c)
#pragma unroll
        for (int e = 0; e < 4; ++e) { const unsigned a = (e == 0) ? vv[c].x : (e == 1) ? vv[c].y : (e == 2) ? vv[c].z : vv[c].w;
            const unsigned bb = (e == 0) ? vv[2 + c].x : (e == 1) ? vv[2 + c].y : (e == 2) ? vv[2 + c].z : vv[2 + c].w;
            const int d = 16 * dq + 8 * c + 2 * e;
            vt[d * 132] = (a & 0xffffu) | (bb << 16); vt[(d + 1) * 132] = (a >> 16) | (bb & 0xffff0000u); }
}
__device__ __forceinline__ void stage_kv(LAS unsigned char* lds, const bf16* K, const bf16* V, size_t rowbase, int h, int tid) {
    u32x4 kk[4], vv[4]; stage_kv_load(kk, vv, K, V, rowbase, h, tid); stage_kv_store(lds, kk, vv, tid);
}
__device__ __forceinline__ int alibi_dmax(float slope2, float M0) { return (int)fminf((2.0f * M0 + 40.0f) / slope2, 1.0e9f); }
template <bool MASK> __device__ __forceinline__ void attn_tile(LAS unsigned char* lds, int s8, const bf16x8 (&qf)[4], float rowc, float slope2, int lane, f32x16& o0, f32x16& o1, float& lsum, int maskq) {
    const int i = lane & 31, hi = lane >> 5;
    const int prow = (i & ~12) | ((i & 4) << 1) | ((i & 8) >> 1);
    const LAS unsigned char* kp = lds + A_KS + (32 * s8 + prow) * 144 + 16 * hi;
    const float cb = rowc + slope2 * (float)(32 * s8 + 8 * hi);
    f32x16 c;
#pragma unroll
    for (int r = 0; r < 16; ++r) c[r] = cb + slope2 * (float)(16 * (r >> 3) + (r & 7));
#pragma unroll
    for (int d0 = 0; d0 < 4; ++d0) { const bf16x8 kf = *(const LAS bf16x8*)(kp + 32 * d0); c = __builtin_amdgcn_mfma_f32_32x32x16_bf16(kf, qf[d0], c, 0, 0, 0); }
    if (MASK) {
#pragma unroll
        for (int r = 0; r < 16; ++r) if (16 * (r >> 3) + 8 * hi + (r & 7) > maskq) c[r] = -INFINITY;
    }
    float ls = 0.f;
#pragma unroll
    for (int r = 0; r < 16; ++r) { c[r] = __builtin_amdgcn_exp2f(c[r]); ls += c[r]; }
    lsum += ls;
    u32x4 p0, p1;
    p0.x = cvtpk(c[0], c[1]); p0.y = cvtpk(c[2], c[3]); p0.z = cvtpk(c[4], c[5]); p0.w = cvtpk(c[6], c[7]);
    p1.x = cvtpk(c[8], c[9]); p1.y = cvtpk(c[10], c[11]); p1.z = cvtpk(c[12], c[13]); p1.w = cvtpk(c[14], c[15]);
    const bf16x8 pf0 = __builtin_bit_cast(bf16x8, p0), pf1 = __builtin_bit_cast(bf16x8, p1);
    const LAS unsigned char* vp = lds + A_VT + (i * 264 + 32 * s8 + 8 * hi) * 2;
    { const bf16x8 v00 = *(const LAS bf16x8*)(vp), v01 = *(const LAS bf16x8*)(vp + 32), v10 = *(const LAS bf16x8*)(vp + 32 * 528), v11 = *(const LAS bf16x8*)(vp + 32 * 528 + 32);
      o0 = __builtin_amdgcn_mfma_f32_32x32x16_bf16(v00, pf0, o0, 0, 0, 0); o1 = __builtin_amdgcn_mfma_f32_32x32x16_bf16(v10, pf0, o1, 0, 0, 0);
      o0 = __builtin_amdgcn_mfma_f32_32x32x16_bf16(v01, pf1, o0, 0, 0, 0); o1 = __builtin_amdgcn_mfma_f32_32x32x16_bf16(v11, pf1, o1, 0, 0, 0); }
}
__device__ __forceinline__ bf16* op_ptr(unsigned char* ws, float* out, int rank) { return (rank == 2) ? (bf16*)(ws + WS_OP3) : (bf16*)out + (size_t)rank * ((size_t)M_ * D_); }

struct A2Item { int n, bh, b, h, tbeg, tlim, dmax; float slope2; };
__device__ __forceinline__ A2Item a2_decode(int item, float M0) {
    A2Item I; I.n = item >> 5; I.bh = item & 31; I.b = I.bh >> 4; I.h = I.bh & 15;
    I.slope2 = exp2f(-0.5f * (float)(I.h + 1)) * LOG2E_; I.dmax = alibi_dmax(I.slope2, M0);
    I.tbeg = (I.n + 1) * 256; I.tlim = min(S_, 256 * I.n + 256 + I.dmax); return I;
}
__device__ __forceinline__ void a2_load(const A2Item& I, u32x4 (&kk)[4], u32x4 (&vv)[4], u32x4 (&sv)[8], const bf16* K, const bf16* V, const unsigned* sel, int tid) {
    stage_kv_load(kk, vv, K, V, (size_t)I.b * S_ + 256 * I.n, I.h, tid);
    const unsigned* sp = sel + (size_t)I.bh * S_;
#pragma unroll
    for (int c = 0; c < 8; ++c) { const int t0 = I.tbeg + 2048 * c + 4 * tid;
        sv[c] = (u32x4){0xFFFFFFFFu, 0xFFFFFFFFu, 0xFFFFFFFFu, 0xFFFFFFFFu};
        if (I.tbeg + 2048 * c < I.tlim) { if (t0 < S_) sv[c] = *(const u32x4*)(sp + t0); } }
}
__device__ __forceinline__ void a2_phase(LAS unsigned char* lds, int wave_in, int qword) {
    int tid = lane_id(); asm volatile("" : "+v"(tid)); tid += 64 * wave_in;
    const int lane = tid & 63, wave = __builtin_amdgcn_readfirstlane(tid >> 6), q = lane & 31, hi = lane >> 5;
    unsigned char* const ws = PWS;
    const bf16* Q = (const bf16*)(ws + WS_Q); const bf16* K = (const bf16*)(ws + WS_K); const bf16* V = (const bf16*)(ws + WS_V);
    const unsigned* sel = (const unsigned*)(ws + WS_SEL); unsigned* ctl = (unsigned*)(ws + WS_CTL); float* LP = (float*)(ws + WS_LP); float* const outp = POUT;
    const float M0 = attn_m0(PIN(8), PIN(9), lane);
    LAS unsigned short* list = (LAS unsigned short*)(lds + A_LIST); volatile LAS int* misc = (volatile LAS int*)(lds + A_MISC);
    constexpr int NIT = 63 * 32;
    int t_cur = 0, t_nxt = 0;
    if (tid == 0) { t_cur = (int)__hip_atomic_fetch_add(ctl + qword, 1u, __ATOMIC_RELAXED, __HIP_MEMORY_SCOPE_AGENT); t_nxt = (int)__hip_atomic_fetch_add(ctl + qword, 1u, __ATOMIC_RELAXED, __HIP_MEMORY_SCOPE_AGENT); }
    LDS_BARRIER();
    if (tid == 0) { misc[0] = t_cur; misc[2] = t_nxt; misc[1] = 0; }
    LDS_BARRIER();
    int item = __builtin_amdgcn_readfirstlane(misc[0]), item_n = __builtin_amdgcn_readfirstlane(misc[2]);
    u32x4 kk[4], vv[4], sv[8];
    if (item < NIT) { const A2Item I0 = a2_decode(item, M0); a2_load(I0, kk, vv, sv, K, V, sel, tid); }
    while (item < NIT) {
        const A2Item I = a2_decode(item, M0);
        const int n = I.n, b = I.b, h = I.h, dmax = I.dmax; const float slope2 = I.slope2;
        int t_nn = 0;
        if (tid == 0) t_nn = (int)__hip_atomic_fetch_add(ctl + qword, 1u, __ATOMIC_RELAXED, __HIP_MEMORY_SCOPE_AGENT);
        stage_kv_store(lds, kk, vv, tid);
#pragma unroll
        for (int c = 0; c < 8; ++c) {
            if (I.tbeg + 2048 * c < I.tlim) {
#pragma unroll
                for (int e = 0; e < 4; ++e) {
                    const unsigned s = (e == 0) ? sv[c].x : (e == 1) ? sv[c].y : (e == 2) ? sv[c].z : sv[c].w;
                    const int t = I.tbeg + 2048 * c + 4 * tid + e;
                    int rank = ((s & 255u) == (unsigned)n) ? 0 : (((s >> 8) & 255u) == (unsigned)n) ? 1 : (((s >> 16) & 255u) == (unsigned)n) ? 2 : -1;
                    if (t - 256 * n - 255 > dmax) rank = -1;
                    const unsigned long long bal = __ballot(rank >= 0);
                    if (bal) {
                        const int pre = __builtin_amdgcn_mbcnt_hi((unsigned)(bal >> 32), __builtin_amdgcn_mbcnt_lo((unsigned)bal, 0u));
                        int base = 0;
                        if (lane == 0) base = __hip_atomic_fetch_add((LAS int*)(lds + A_MISC) + 1, __popcll(bal), __ATOMIC_RELAXED, __HIP_MEMORY_SCOPE_WORKGROUP);
                        base = __builtin_amdgcn_readfirstlane(base);
                        if (rank >= 0) list[base + pre] = (unsigned short)(t | (rank << 14));
                    }
                }
            }
        }
        if (item_n < NIT) { const A2Item In = a2_decode(item_n, M0); a2_load(In, kk, vv, sv, K, V, sel, tid); }
        LDS_BARRIER();
        const int total = __builtin_amdgcn_readfirstlane(misc[1]);
        const int nr = (total + 255) >> 8;
        bf16x8 qn[4]; unsigned en = 0u;
        if (32 * wave < total) { const int idx = 32 * wave + q; en = list[(idx < total) ? idx : 32 * wave];
            const size_t rown = (size_t)b * S_ + (en & 16383);
#pragma unroll
            for (int d0 = 0; d0 < 4; ++d0) qn[d0] = *(const bf16x8*)(Q + rown * D_ + h * 64 + 16 * d0 + 8 * hi); }
        for (int r = 0; r < nr; ++r) {
            const int i0 = 256 * r + 32 * wave;
            if (i0 < total) {
                const int idx = i0 + q; const bool valid = idx < total;
                const unsigned e = en;
                const int t = e & 16383, rank = e >> 14;
                const size_t row = (size_t)b * S_ + t;
                bf16x8 qf[4];
#pragma unroll
                for (int d0 = 0; d0 < 4; ++d0) qf[d0] = qn[d0];
                if (i0 + 256 < total) { const int idx2 = idx + 256; en = list[(idx2 < total) ? idx2 : i0 + 256];
                    const size_t rown = (size_t)b * S_ + (en & 16383);
#pragma unroll
                    for (int d0 = 0; d0 < 4; ++d0) qn[d0] = *(const bf16x8*)(Q + rown * D_ + h * 64 + 16 * d0 + 8 * hi); }
                const float rowc = -slope2 * (float)(t - 256 * n) - M0;
                f32x16 o0, o1; float lsum = 0.f;
#pragma unroll
                for (int k = 0; k < 16; ++k) { o0[k] = 0.f; o1[k] = 0.f; }
#pragma unroll 2
                for (int s8 = 0; s8 < 8; ++s8) attn_tile<false>(lds, s8, qf, rowc, slope2, lane, o0, o1, lsum, 0);
                lsum = sum32(lsum);
                if (valid) {
                    bf16* op = op_ptr(ws, outp, rank) + row * D_ + h * 64 + 4 * hi;
#pragma unroll
                    for (int g = 0; g < 4; ++g) {
                        u32x2 w0, w1; w0.x = cvtpk(o0[4 * g], o0[4 * g + 1]); w0.y = cvtpk(o0[4 * g + 2], o0[4 * g + 3]);
                        w1.x = cvtpk(o1[4 * g], o1[4 * g + 1]); w1.y = cvtpk(o1[4 * g + 2], o1[4 * g + 3]);
                        *(u32x2*)(op + 8 * g) = w0; *(u32x2*)(op + 32 + 8 * g) = w1; }
                    if (hi == 0) LP[((size_t)rank * M_ + row) * 16 + h] = lsum;
                }
            }
        }
        LDS_BARRIER();
        if (tid == 0) { misc[0] = item_n; misc[2] = t_nn; misc[1] = 0; }
        LDS_BARRIER();
        item = __builtin_amdgcn_readfirstlane(misc[0]); item_n = __builtin_amdgcn_readfirstlane(misc[2]);
    }
}

__device__ __forceinline__ void a3_phase(LAS unsigned char* lds, int vcu, int G, int wave_in) {
    int tid = lane_id(); asm volatile("" : "+v"(tid)); tid += 64 * wave_in;
    const int lane = tid & 63, wave = __builtin_amdgcn_readfirstlane(tid >> 6), q = lane & 31, hi = lane >> 5;
    unsigned char* const ws = PWS;
    bf16* Q = (bf16*)(ws + WS_Q); const bf16* K = (const bf16*)(ws + WS_K); const bf16* V = (const bf16*)(ws + WS_V);
    const unsigned* sel = (const unsigned*)(ws + WS_SEL); const float* LP = (const float*)(ws + WS_LP); float* const outp = POUT;
    const float M0 = attn_m0(PIN(8), PIN(9), lane);
    u32x4 kk[4], vv[4];
    if (vcu < 2048) { const int bh = vcu >> 6, m = vcu & 63; stage_kv_load(kk, vv, K, V, (size_t)(bh >> 4) * S_ + 256 * m, bh & 15, tid); }
    for (int un = vcu; un < 2048; un += G) {
        const int bh = un >> 6, m = un & 63, b = bh >> 4, h = bh & 15;
        const float slope2 = exp2f(-0.5f * (float)(h + 1)) * LOG2E_;
        LDS_BARRIER();
        stage_kv_store(lds, kk, vv, tid);
        { const int un2 = un + G; if (un2 < 2048) { const int bh2 = un2 >> 6, m2 = un2 & 63; stage_kv_load(kk, vv, K, V, (size_t)(bh2 >> 4) * S_ + 256 * m2, bh2 & 15, tid); } }
        const int t = 256 * m + 32 * wave + q; const size_t row = (size_t)b * S_ + t;
        bf16x8 qf[4];
#pragma unroll
        for (int d0 = 0; d0 < 4; ++d0) qf[d0] = *(const bf16x8*)(Q + row * D_ + h * 64 + 16 * d0 + 8 * hi);
        const unsigned s = sel[(size_t)bh * S_ + t];
        float lp[3]; u32x2 pw[3][8];
#pragma unroll
        for (int rank = 0; rank < 3; ++rank) {
            lp[rank] = LP[((size_t)rank * M_ + row) * 16 + h];
            const bf16* op = op_ptr(ws, outp, rank) + row * D_ + h * 64 + 4 * hi;
#pragma unroll
            for (int g = 0; g < 4; ++g) { pw[rank][g] = *(const u32x2*)(op + 8 * g); pw[rank][4 + g] = *(const u32x2*)(op + 32 + 8 * g); }
        }
        LDS_BARRIER();
        const float rowc = -slope2 * (float)(32 * wave + q) - M0;
        f32x16 o0, o1; float lsum = 0.f;
#pragma unroll
        for (int k = 0; k < 16; ++k) { o0[k] = 0.f; o1[k] = 0.f; }
        for (int s8 = 0; s8 < wave; ++s8) attn_tile<false>(lds, s8, qf, rowc, slope2, lane, o0, o1, lsum, 0);
        attn_tile<true>(lds, wave, qf, rowc, slope2, lane, o0, o1, lsum, q);
        float l = sum32(lsum);
        const int dmax = alibi_dmax(slope2, M0);
#pragma unroll
        for (int rank = 0; rank < 3; ++rank) {
            const int nb = (int)((s >> (8 * rank)) & 255u);
            if (nb != 255 && (t - 256 * nb - 255) <= dmax) {
                l += lp[rank];
#pragma unroll
                for (int g = 0; g < 4; ++g) { const u32x2 w0 = pw[rank][g], w1 = pw[rank][4 + g];
                    o0[4 * g] += bflo(w0.x); o0[4 * g + 1] += bfhi(w0.x); o0[4 * g + 2] += bflo(w0.y); o0[4 * g + 3] += bfhi(w0.y);
                    o1[4 * g] += bflo(w1.x); o1[4 * g + 1] += bfhi(w1.x); o1[4 * g + 2] += bflo(w1.y); o1[4 * g + 3] += bfhi(w1.y); }
            }
        }
        const float inv = 1.0f / l;
        bf16* op = Q + row * D_ + h * 64 + 4 * hi;
#pragma unroll
        for (int g = 0; g < 4; ++g) {
            u32x2 w0, w1; w0.x = cvtpk(o0[4 * g] * inv, o0[4 * g + 1] * inv); w0.y = cvtpk(o0[4 * g + 2] * inv, o0[4 * g + 3] * inv);
            w1.x = cvtpk(o1[4 * g] * inv, o1[4 * g + 1] * inv); w1.y = cvtpk(o1[4 * g + 2] * inv, o1[4 * g + 3] * inv);
            *(u32x2*)(op + 8 * g) = w0; *(u32x2*)(op + 32 + 8 * g) = w1; }
    }
}

constexpr int A1_KH = 0, A1_KL = 9216;
__device__ __forceinline__ void top3_ins(float v, int n, float& v0, float& v1, float& v2, int& i0, int& i1, int& i2) {
    const bool c0 = v > v0, c1 = v > v1, c2 = v > v2;
    v2 = c1 ? v1 : (c2 ? v : v2); i2 = c1 ? i1 : (c2 ? n : i2);
    v1 = c0 ? v0 : (c1 ? v : v1); i1 = c0 ? i0 : (c1 ? n : i1);
    v0 = c0 ? v : v0;             i0 = c0 ? n : i0;
}
__device__ __forceinline__ void a1_phase(LAS unsigned char* lds, int vcu, int G, int wave_in) {
    int tid = lane_id(); asm volatile("" : "+v"(tid)); tid += 64 * wave_in;
    const int lane = tid & 63, wave = __builtin_amdgcn_readfirstlane(tid >> 6), q = lane & 31, hi = lane >> 5;
    unsigned char* const ws = PWS;
    const bf16* Q = (const bf16*)(ws + WS_Q); const float* kbarp = (const float*)(ws + WS_KBAR); unsigned* sel = (unsigned*)(ws + WS_SEL);
    for (int un = vcu; un < 256; un += G) {
        const int bh = un >> 3, mg = un & 7, b = bh >> 4, h = bh & 15;
        LDS_BARRIER();
        { const int n = tid >> 3, d0 = (tid & 7) * 8;
          const float* p = kbarp + ((size_t)bh * 64 + n) * 128 + d0;
          const f32x4 a0 = *(const f32x4*)p, a1 = *(const f32x4*)(p + 4), b0 = *(const f32x4*)(p + 64), b1 = *(const f32x4*)(p + 68);
          const f32x4 v0 = (a0 + b0) * (1.0f / 256.0f), v1 = (a1 + b1) * (1.0f / 256.0f);
          unsigned hb[8], lb[8];
#pragma unroll
          for (int e = 0; e < 8; ++e) { const float v = (e < 4) ? v0[e & 3] : v1[e & 3]; hb[e] = f2bf(v); lb[e] = f2bf(v - bf2f(hb[e])); }
          u32x4 wh, wl; wh.x = hb[0] | (hb[1] << 16); wh.y = hb[2] | (hb[3] << 16); wh.z = hb[4] | (hb[5] << 16); wh.w = hb[6] | (hb[7] << 16);
          wl.x = lb[0] | (lb[1] << 16); wl.y = lb[2] | (lb[3] << 16); wl.z = lb[4] | (lb[5] << 16); wl.w = lb[6] | (lb[7] << 16);
          *(LAS u32x4*)(lds + A1_KH + n * 144 + d0 * 2) = wh; *(LAS u32x4*)(lds + A1_KL + n * 144 + d0 * 2) = wl; }
        LDS_BARRIER();
        bf16x8 qn[4];
        { const size_t row0 = (size_t)b * S_ + 256 * (mg * 8) + 32 * wave + q;
#pragma unroll
          for (int d0 = 0; d0 < 4; ++d0) qn[d0] = *(const bf16x8*)(Q + row0 * D_ + h * 64 + 16 * d0 + 8 * hi); }
        for (int mi = 0; mi < 8; ++mi) {
            const int m = mg * 8 + mi, t = 256 * m + 32 * wave + q;
            bf16x8 qf[4];
#pragma unroll
            for (int d0 = 0; d0 < 4; ++d0) qf[d0] = qn[d0];
            if (mi < 7) { const size_t rown = (size_t)b * S_ + t + 256;
#pragma unroll
                for (int d0 = 0; d0 < 4; ++d0) qn[d0] = *(const bf16x8*)(Q + rown * D_ + h * 64 + 16 * d0 + 8 * hi); }
            if (m == 0) { if (hi == 0) sel[(size_t)bh * S_ + t] = 0x00FFFFFFu; continue; }
            f32x16 c0, c1;
#pragma unroll
            for (int k = 0; k < 16; ++k) { c0[k] = 0.f; c1[k] = 0.f; }
            const LAS unsigned char* kp = lds + q * 144 + 16 * hi;
#pragma unroll
            for (int d0 = 0; d0 < 4; ++d0) {
                const bf16x8 h0 = *(const LAS bf16x8*)(kp + A1_KH + 32 * d0), h1 = *(const LAS bf16x8*)(kp + A1_KH + 32 * 144 + 32 * d0);
                const bf16x8 l0 = *(const LAS bf16x8*)(kp + A1_KL + 32 * d0), l1 = *(const LAS bf16x8*)(kp + A1_KL + 32 * 144 + 32 * d0);
                c0 = __builtin_amdgcn_mfma_f32_32x32x16_bf16(h0, qf[d0], c0, 0, 0, 0); c1 = __builtin_amdgcn_mfma_f32_32x32x16_bf16(h1, qf[d0], c1, 0, 0, 0);
                c0 = __builtin_amdgcn_mfma_f32_32x32x16_bf16(l0, qf[d0], c0, 0, 0, 0); c1 = __builtin_amdgcn_mfma_f32_32x32x16_bf16(l1, qf[d0], c1, 0, 0, 0);
            }
            float v0 = -INFINITY, v1 = -INFINITY, v2 = -INFINITY; int i0 = 255, i1 = 255, i2 = 255;
#pragma unroll
            for (int r = 0; r < 16; ++r) { const int n = (r & 3) + 8 * (r >> 2) + 4 * hi; top3_ins((n < m) ? c0[r] : -INFINITY, n, v0, v1, v2, i0, i1, i2); }
#pragma unroll
            for (int r = 0; r < 16; ++r) { const int n = 32 + (r & 3) + 8 * (r >> 2) + 4 * hi; top3_ins((n < m) ? c1[r] : -INFINITY, n, v0, v1, v2, i0, i1, i2); }
            const float pv0 = __builtin_bit_cast(float, other32(__builtin_bit_cast(unsigned, v0), hi)), pv1 = __builtin_bit_cast(float, other32(__builtin_bit_cast(unsigned, v1), hi)), pv2 = __builtin_bit_cast(float, other32(__builtin_bit_cast(unsigned, v2), hi));
            const int pi0 = (int)other32((unsigned)i0, hi), pi1 = (int)other32((unsigned)i1, hi), pi2 = (int)other32((unsigned)i2, hi);
            top3_ins(pv0, pi0, v0, v1, v2, i0, i1, i2); top3_ins(pv1, pi1, v0, v1, v2, i0, i1, i2); top3_ins(pv2, pi2, v0, v1, v2, i0, i1, i2);
            if (hi == 0) sel[(size_t)bh * S_ + t] = (unsigned)i0 | ((unsigned)i1 << 8) | ((unsigned)i2 << 16);
        }
    }
}
#ifndef MK_MULTI
#define MK_MULTI 0
#endif
constexpr int NPH = 18;
struct Args { const float* in[19]; float* out; unsigned char* ws; int lo, hi; };
__global__ void __launch_bounds__(512, 2) fwd(Args a) {
    extern __shared__ __attribute__((aligned(16))) unsigned char lds_raw[];
    LAS unsigned char* lds = (LAS unsigned char*)lds_raw;
    const int tid = threadIdx.x, G = gridDim.x; const int wave = __builtin_amdgcn_readfirstlane(tid >> 6);
    const int vcu = (G % 8 == 0) ? ((int)blockIdx.x % 8) * (G / 8) + (int)blockIdx.x / 8 : (int)blockIdx.x;
    volatile LAS unsigned* MISC = (volatile LAS unsigned*)(lds + MISC_OFF);
    for (int u = tid; u < (LDS_BYTES - LDSCTL_OFF) / 4; u += 512) ((LAS unsigned*)(lds + LDSCTL_OFF))[u] = 0u;
    __syncthreads();
    if (tid == 0) {
        LAS unsigned long long* PT = (LAS unsigned long long*)(lds + PT_OFF);
#pragma unroll
        for (int i = 0; i < 19; ++i) PT[i] = (unsigned long long)a.in[i];
        PT[19] = (unsigned long long)a.out; PT[20] = (unsigned long long)a.ws;
        ((LAS int*)(lds + PT_OFF))[48] = a.lo; ((LAS int*)(lds + PT_OFF))[49] = a.hi;
    }
    __syncthreads();
    if (a.hi - a.lo > 1) (void)xcd_barrier_post((unsigned*)(a.ws + WS_CTL) + CW_BAR, MISC + 8);
#define LO (__builtin_amdgcn_readfirstlane(((volatile LAS int*)(lds + PT_OFF))[48]))
#define HI (__builtin_amdgcn_readfirstlane(((volatile LAS int*)(lds + PT_OFF))[49]))
#define IN(k) (LO <= (k) && (k) < HI)
#define SEAM(k) do { if (IN(k) && IN((k) + 1)) { XcdBarrier bar_; bar_.bar = (unsigned*)(PWS + WS_CTL) + CW_BAR; bar_.x = xb_xcc_id(); bar_.st = MISC + 8; xcd_barrier(bar_); } } while (0)

#ifndef REP_PRO
#define REP_PRO 1
#endif
#pragma unroll 1
    for (int rep_ = 0; rep_ < REP_PRO; ++rep_) {
    if (IN(0)) { __syncthreads(); phase_p0(lds, vcu, G, wave); }
    SEAM(0);
    if (IN(1)) { __syncthreads(); phase_p1(lds, vcu, G, wave); }
    SEAM(1);
    }

    int ph = 2;
#pragma unroll 1
    for (int sl = 0; sl < 6; ++sl) {
        if (sl == 1) {
            if (IN(ph)) { __syncthreads(); unsigned char* const ws = PWS;
                const float* ssq_cur = (const float*)(ws + ((sl & 1) ? WS_SSQ1 : WS_SSQ)); const float* ssq_prv = (const float*)(ws + ((sl & 1) ? WS_SSQ : WS_SSQ1));
                if ((I8MASK >> 4) & 1) {
                    EpiQKV<true> E{(bf16*)(ws + WS_Q), (const float*)(ws + WS_BQKV), ssq_cur, PIN(8), PIN(9), (float*)(ws + WS_KBAR), lds, ssq_prv, (const signed char*)(ws + WS_WEXP) + 22528,
                                   PIN(2) + sl * 1024, (const float*)(ws + WS_MOD) + (size_t)((sl / 3) * 2) * 9216 + (sl % 3) * 3 * 1024 + 1024};
                    __syncthreads(); run_gemm<EpiQKV<true>, true>(lds, (const bf16*)(ws + WS_X8), (const bf16*)(ws + WS_WQKV), 0L, 3072, 512, G, E, wave);
                } else {
                EpiQKV<false> E{(bf16*)(ws + WS_Q), (const float*)(ws + WS_BQKV), ssq_cur, PIN(8), PIN(9), (float*)(ws + WS_KBAR), lds, nullptr, nullptr, nullptr, nullptr};
                __syncthreads(); run_gemm(lds, (const bf16*)(ws + WS_XB), (const bf16*)(ws + WS_WQKV), 3072L * 1024 * 2, 3072, 1024, G, E, wave);
                }
            }
            SEAM(ph); ++ph;
            if (IN(ph)) { __syncthreads(); a1_phase(lds, vcu, G, wave); }
            SEAM(ph); ++ph;
            if (IN(ph)) { __syncthreads(); a2_phase(lds, wave, CW_Q2); }
            SEAM(ph); ++ph;
            if (IN(ph)) { __syncthreads(); a3_phase(lds, vcu, G, wave); }
            SEAM(ph); ++ph;
        } else if (sl == 4) {
            if (IN(ph)) { __syncthreads(); unsigned char* const ws = PWS;
                const float* ssq_cur = (const float*)(ws + ((sl & 1) ? WS_SSQ1 : WS_SSQ)); const float* ssq_prv = (const float*)(ws + ((sl & 1) ? WS_SSQ : WS_SSQ1));
                if ((I8MASK >> 5) & 1) {
                    EpiGated<1, true> E{(bf16*)(ws + WS_U), 1024, (const float*)(ws + WS_BPW1), 2048, ssq_cur, lds, ssq_prv, (const signed char*)(ws + WS_WEXP) + 25600,
                                        PIN(2) + sl * 1024, (const float*)(ws + WS_MOD) + (size_t)((sl / 3) * 2) * 9216 + (sl % 3) * 3 * 1024 + 1024};
                    __syncthreads(); run_gemm<EpiGated<1, true>, true>(lds, (const bf16*)(ws + WS_X8), (const bf16*)(ws + WS_WPW1), 0L, 2048, 512, G, E, wave);
                } else {
                EpiGated<1> E{(bf16*)(ws + WS_U), 1024, (const float*)(ws + WS_BPW1), 2048, ssq_cur, lds, nullptr, nullptr, nullptr, nullptr};
                __syncthreads(); run_gemm(lds, (const bf16*)(ws + WS_XB), (const bf16*)(ws + WS_WPW1), 2048L * 1024 * 2, 2048, 1024, G, E, wave);
                }
            }
            SEAM(ph); ++ph;
            if (IN(ph)) { __syncthreads(); conv_phase(lds, vcu, G, wave); }
            SEAM(ph); ++ph;
        } else {
            const int f = (sl / 3) * 2 + ((sl % 3) == 2);
            if (IN(ph)) { __syncthreads(); unsigned char* const ws = PWS;
                const float* ssq_cur = (const float*)(ws + ((sl & 1) ? WS_SSQ1 : WS_SSQ)); const float* ssq_prv = (const float*)(ws + ((sl == 0) ? WS_SSQ : (sl & 1) ? WS_SSQ : WS_SSQ1));
                if ((I8MASK >> f) & 1) {
                    EpiGated<0, true> E{(bf16*)(ws + WS_ACT), FF_, (const float*)(ws + WS_BFFN) + (size_t)f * 2 * 5632, 5632, ssq_cur, lds, ssq_prv, (const signed char*)(ws + WS_WEXP) + f * 5632,
                                        PIN(2) + sl * 1024, (const float*)(ws + WS_MOD) + (size_t)((sl / 3) * 2) * 9216 + (sl % 3) * 3 * 1024 + 1024};
                    __syncthreads(); run_gemm<EpiGated<0, true>, true>(lds, (const bf16*)(ws + WS_X8), (const bf16*)(ws + WS_WIN) + (size_t)f * 2 * 5632 * 1024, 0L, 5632, 512, G, E, wave);
                } else {
                EpiGated<0> E{(bf16*)(ws + WS_ACT), FF_, (const float*)(ws + WS_BFFN) + (size_t)f * 2 * 5632, 5632, ssq_cur, lds, nullptr, nullptr, nullptr, nullptr};
                __syncthreads(); run_gemm(lds, (const bf16*)(ws + WS_XB), (const bf16*)(ws + WS_WIN) + (size_t)f * 2 * 5632 * 1024, 5632L * 1024 * 2, 5632, 1024, G, E, wave);
                }
            }
            SEAM(ph); ++ph;
        }
        if (IN(ph)) { __syncthreads(); unsigned char* const ws = PWS; float* const out = POUT;
            const bf16* Ares; const bf16* Wres; int Kres; const float* bias2 = nullptr;
            if (sl == 1) { Ares = (const bf16*)(ws + WS_Q); Wres = (const bf16*)(ws + WS_WO); Kres = 1024; }
            else if (sl == 4) { Ares = (const bf16*)(ws + WS_CV); Wres = (const bf16*)(ws + WS_WPW2); Kres = 1024; bias2 = PIN(18); }
            else { const int f = (sl / 3) * 2 + ((sl % 3) == 2); Ares = (const bf16*)(ws + WS_ACT); Wres = (const bf16*)(ws + WS_WOUT) + (size_t)f * 1024 * 2816; Kres = FF_; }
            const int fnext = (sl == 1) ? 1 : (sl == 2) ? 2 : (sl == 4) ? 3 : -1;
            const int sn = sl + 1; const bool q8 = (fnext >= 0 && ((I8MASK >> fnext) & 1)) || (sn == 1 && ((I8MASK >> 4) & 1)) || (sn == 4 && ((I8MASK >> 5) & 1));
            EpiRes E{(bf16*)(ws + WS_XB), out, bias2, (const float*)(ws + WS_COEF) + (size_t)sl * 2048, (float*)(ws + ((sl & 1) ? WS_SSQ : WS_SSQ1)), (sl == 5) ? 1 : 0, lds,
                     q8 ? ws + WS_X8 : nullptr, (const float*)(ws + ((sl & 1) ? WS_SSQ1 : WS_SSQ)), PIN(2) + sn * 1024, (const float*)(ws + WS_MOD) + (size_t)((sn / 3) * 2) * 9216 + (sn % 3) * 3 * 1024 + 1024};
            run_gemm(lds, Ares, Wres, 0L, 1024, Kres, G, E, wave);
        }
        SEAM(ph); ++ph;
    }
#undef IN
#undef SEAM
}

extern "C" void kernel_launch(void* const* d_in, const int* in_sizes, int n_in, void* d_out, int out_size, void* d_ws, size_t ws_size, hipStream_t stream) {
    static int grid = 0;
    if (grid == 0) {
        if (n_in != 19 || in_sizes[0] != M_ * D_ || out_size != M_ * D_ || ws_size < WS_END) {
            fprintf(stderr, "kernel_launch: unexpected problem (n_in %d, in0 %d, out %d, ws %zu); nothing launched\n", n_in, n_in > 0 ? in_sizes[0] : -1, out_size, ws_size); grid = -1; return; }
        int dev = 0, cus = 0;
        if (hipGetDevice(&dev) != hipSuccess || hipDeviceGetAttribute(&cus, hipDeviceAttributeMultiprocessorCount, dev) != hipSuccess) { grid = -1; return; }
        if (hipFuncSetAttribute((const void*)fwd, hipFuncAttributeMaxDynamicSharedMemorySize, LDS_BYTES) != hipSuccess) { fprintf(stderr, "kernel_launch: hipFuncSetAttribute failed\n"); grid = -1; return; }
        int per_cu = 0;
        if (hipOccupancyMaxActiveBlocksPerMultiprocessor(&per_cu, (const void*)fwd, 512, LDS_BYTES) != hipSuccess || per_cu < 1) fprintf(stderr, "kernel_launch: occupancy query reports %d blocks per CU\n", per_cu);
        (void)hipGetLastError();
        grid = cus;
    }
    if (grid < 0) return;
    if (hipMemsetAsync((char*)d_ws + WS_CTL, 0, CTL_ZERO_BYTES, stream) != hipSuccess) return;
    Args a{};
    for (int i = 0; i < 19; ++i) a.in[i] = (const float*)d_in[i];
    a.out = (float*)d_out; a.ws = (unsigned char*)d_ws;
#if MK_MULTI
    for (int p = 0; p < NPH; ++p) { a.lo = p; a.hi = p + 1; hipLaunchKernelGGL(fwd, dim3(grid), dim3(512), LDS_BYTES, stream, a); }
#else
    a.lo = 0; a.hi = NPH; hipLaunchKernelGGL(fwd, dim3(grid), dim3(512), LDS_BYTES, stream, a);
#endif
}
```
